# Optimizing an MI355X kernel written in HIP

```python
import jax, jax.numpy as jnp
from jax import lax
import numpy as np


D_MODEL = 1024
BATCH = 4
SEQ = 4096
DEPTH = 4

N_MIXERS = 3
N_A = (DEPTH + 2) // 3
N_B = (DEPTH + 1) // 3
N_C = DEPTH // 3
EPS = 1e-6

GM_CHUNK = 128
GM_GROUPS = 8
GM_INNER = 2 * D_MODEL
GM_GROUP_DIM = GM_INNER // GM_GROUPS

MLA_HEADS = 8
MLA_Q_RANK = D_MODEL // 4
MLA_KV_RANK = D_MODEL // 8
MLA_NOPE = 128
MLA_ROPE = 64
MLA_V = 128
ROPE_THETA = 10000.0
ATTN_BLOCK = 128

HG_HEADS = 8
HG_DK = 128
HG_DV = D_MODEL // HG_HEADS
HG_CHUNK = 64

FF_DIM = 2816
CONV_W = 3

kernel_name = 'hybrid_gmlp_mla_hgrn2_convffn_adaln'


def rmsnorm(x, g):
    xf = x.astype(jnp.float32)
    y = xf * lax.rsqrt(jnp.mean(xf * xf, axis=-1, keepdims=True) + EPS)
    return (y * g.astype(jnp.float32)).astype(x.dtype)


def layernorm(x, g, b):
    xf = x.astype(jnp.float32)
    mu = jnp.mean(xf, axis=-1, keepdims=True)
    var = jnp.mean(jnp.square(xf - mu), axis=-1, keepdims=True)
    y = (xf - mu) * lax.rsqrt(var + EPS) * g.astype(jnp.float32) + b.astype(jnp.float32)
    return y.astype(x.dtype)


def modulate(h, shift, scale):
    return h * (1.0 + scale[:, None, :]) + shift[:, None, :]


def rope_tables(positions):
    inv_freq = ROPE_THETA ** (-jnp.arange(0, MLA_ROPE, 2, dtype=jnp.float32) / MLA_ROPE)
    ang = positions.astype(jnp.float32)[..., None] * inv_freq
    return jnp.cos(ang)[:, :, None, :], jnp.sin(ang)[:, :, None, :]


def apply_rope(x, cos, sin):
    x1, x2 = jnp.split(x, 2, axis=-1)
    cos = cos.astype(x.dtype)
    sin = sin.astype(x.dtype)
    return jnp.concatenate([x1 * cos - x2 * sin, x2 * cos + x1 * sin], axis=-1)


def gmlp_mixer(h, w_in, ln_g, ln_b, w_s, b_s, w_out):
    B, S, _ = h.shape
    z = jax.nn.gelu(h @ w_in)
    u, v = jnp.split(z, 2, axis=-1)
    v = layernorm(v, ln_g, ln_b)
    n = S // GM_CHUNK
    v = v.reshape(B, n, GM_CHUNK, GM_GROUPS, GM_GROUP_DIM)
    mask = jnp.tril(jnp.ones((GM_CHUNK, GM_CHUNK), dtype=bool))
    ws = jnp.where(mask[None], w_s, jnp.zeros_like(w_s))
    sv = jnp.einsum('gts,bnsgd->bntgd', ws, v) + b_s.T[None, None, :, :, None]
    y = u * sv.reshape(B, S, GM_INNER)
    return y @ w_out


def causal_block_attention(q, k, v, scale):
    B, S, H, Dk = q.shape
    nb = S // ATTN_BLOCK
    qb = q.reshape(B, nb, ATTN_BLOCK, H, Dk).transpose(1, 0, 2, 3, 4)
    kpos = jnp.arange(S)

    def one_block(args):
        qi, bi = args
        s = jnp.einsum('bqhd,bkhd->bhqk', qi, k).astype(jnp.float32) * scale
        qpos = bi * ATTN_BLOCK + jnp.arange(ATTN_BLOCK)
        s = jnp.where(kpos[None, :] <= qpos[:, None], s, -jnp.inf)
        p = jax.nn.softmax(s, axis=-1).astype(v.dtype)
        return jnp.einsum('bhqk,bkhd->bqhd', p, v)

    o = lax.map(one_block, (qb, jnp.arange(nb)))
    return o.transpose(1, 0, 2, 3, 4).reshape(B, S, H, v.shape[-1])


def mla_mixer(h, cos, sin, w_a, q_norm_g, kv_norm_g, w_qb, w_kvb, w_o):
    B, S, _ = h.shape
    a = h @ w_a
    cq = a[..., :MLA_Q_RANK]
    ckv = a[..., MLA_Q_RANK:MLA_Q_RANK + MLA_KV_RANK]
    k_rope = a[..., MLA_Q_RANK + MLA_KV_RANK:]
    q = (rmsnorm(cq, q_norm_g) @ w_qb).reshape(B, S, MLA_HEADS, MLA_NOPE + MLA_ROPE)
    q_nope, q_rope = q[..., :MLA_NOPE], q[..., MLA_NOPE:]
    kv = (rmsnorm(ckv, kv_norm_g) @ w_kvb).reshape(B, S, MLA_HEADS, MLA_NOPE + MLA_V)
    k_nope, v = kv[..., :MLA_NOPE], kv[..., MLA_NOPE:]
    q_rope = apply_rope(q_rope, cos, sin)
    k_rope = apply_rope(k_rope[:, :, None, :], cos, sin)
    k_rope = jnp.broadcast_to(k_rope, (B, S, MLA_HEADS, MLA_ROPE))
    q = jnp.concatenate([q_nope, q_rope], axis=-1)
    k = jnp.concatenate([k_nope, k_rope], axis=-1)
    o = causal_block_attention(q, k, v, (MLA_NOPE + MLA_ROPE) ** -0.5)
    return o.reshape(B, S, MLA_HEADS * MLA_V) @ w_o


def hgrn_lower_bounds(lb_param):
    p = jax.nn.softmax(lb_param.astype(jnp.float32), axis=0)
    return jnp.cumsum(p, axis=0) - p[0:1]


def chunked_gated_recurrence(q, k, v, log_f):
    B, S, H, DK = q.shape
    DV = v.shape[-1]
    C = HG_CHUNK
    n = S // C

    def to_chunks(t):
        return t.astype(jnp.float32).reshape(B, n, C, H, t.shape[-1]).transpose(1, 0, 3, 2, 4)

    qc, kc, vc, gc = to_chunks(q), to_chunks(k), to_chunks(v), to_chunks(log_f)
    causal = jnp.tril(jnp.ones((C, C), dtype=bool))[:, :, None]

    def step(state, inp):
        qi, ki, vi, gi = inp
        bcum = jnp.cumsum(gi, axis=2)
        rel = bcum[:, :, :, None, :] - bcum[:, :, None, :, :]
        decay = jnp.exp(jnp.where(causal, rel, -jnp.inf))
        attn = jnp.einsum('bhtk,bhtsk,bhsk->bhts', qi, decay, ki)
        o = jnp.einsum('bhts,bhsv->bhtv', attn, vi) + jnp.einsum('bhtk,bhkv->bhtv', qi * jnp.exp(bcum), state)
        blast = bcum[:, :, -1:, :]
        new_state = jnp.exp(blast[:, :, 0, :])[..., None] * state + jnp.einsum('bhsk,bhsv->bhkv', ki * jnp.exp(blast - bcum), vi)
        return new_state, o

    state0 = jnp.zeros((B, H, DK, DV), jnp.float32)
    _, o = lax.scan(step, state0, (qc, kc, vc, gc))
    return o.transpose(1, 0, 3, 2, 4).reshape(B, S, H, DV).astype(v.dtype)


def hgrn2_mixer(h, lb, w_in, norm_g, w_o):
    B, S, _ = h.shape
    nk = HG_HEADS * HG_DK
    nv = HG_HEADS * HG_DV
    proj = h @ w_in
    q = proj[..., :nk]
    fl = proj[..., nk:2 * nk]
    i = proj[..., 2 * nk:2 * nk + nv]
    g = proj[..., 2 * nk + nv:]
    f = lb + (1.0 - lb) * jax.nn.sigmoid(fl.astype(jnp.float32))
    log_f = jnp.log(f)
    k = 1.0 - f
    o = chunked_gated_recurrence(
        q.reshape(B, S, HG_HEADS, HG_DK), k.reshape(B, S, HG_HEADS, HG_DK),
        i.reshape(B, S, HG_HEADS, HG_DV), log_f.reshape(B, S, HG_HEADS, HG_DK))
    o = rmsnorm(o, norm_g).reshape(B, S, nv) * jax.nn.silu(g)
    return o @ w_o


def conv_ffn(h, w_up, conv_w, conv_b, w_down):
    S = h.shape[1]
    a = h @ w_up
    pad = jnp.pad(a, ((0, 0), (CONV_W - 1, 0), (0, 0)))
    y = conv_b
    for j in range(CONV_W):
        y = y + conv_w[j] * pad[:, j:j + S, :]
    gate, val = jnp.split(y, 2, axis=-1)
    return (jax.nn.silu(gate) * val) @ w_down


def setup_inputs(seed: int = 0) -> dict:
    key = jax.random.key(seed)
    ks = jax.random.split(key, 32)
    f32 = jnp.float32

    def nrm(k, shape, scale):
        return jax.random.normal(k, shape, f32) * scale

    D = D_MODEL
    x = nrm(ks[0], (BATCH, SEQ, D), 1.0)
    c = nrm(ks[1], (BATCH, D), 1.0)
    offset = jax.random.randint(ks[2], (BATCH, 1), 0, 1024, dtype=jnp.int32)
    positions = offset + jnp.arange(SEQ, dtype=jnp.int32)[None, :]
    ada_w = nrm(ks[3], (DEPTH, D, 6 * D), 0.2 * D ** -0.5)
    ada_b = nrm(ks[4], (DEPTH, 6 * D), 0.02)
    mix_norm_g = 1.0 + nrm(ks[5], (DEPTH, D), 0.05)
    ffn_norm_g = 1.0 + nrm(ks[6], (DEPTH, D), 0.05)
    gm_w_in = nrm(ks[7], (N_A, D, 2 * GM_INNER), D ** -0.5)
    gm_ln_g = 1.0 + nrm(ks[8], (N_A, GM_INNER), 0.05)
    gm_ln_b = nrm(ks[9], (N_A, GM_INNER), 0.02)
    gm_w_s = nrm(ks[10], (N_A, GM_GROUPS, GM_CHUNK, GM_CHUNK), GM_CHUNK ** -0.5)
    gm_b_s = 1.0 + nrm(ks[11], (N_A, GM_GROUPS, GM_CHUNK), 0.1)
    gm_w_out = nrm(ks[12], (N_A, GM_INNER, D), GM_INNER ** -0.5)
    mla_w_a = nrm(ks[13], (N_B, D, MLA_Q_RANK + MLA_KV_RANK + MLA_ROPE), D ** -0.5)
    mla_q_norm_g = 1.0 + nrm(ks[14], (N_B, MLA_Q_RANK), 0.05)
    mla_kv_norm_g = 1.0 + nrm(ks[15], (N_B, MLA_KV_RANK), 0.05)
    mla_w_qb = nrm(ks[16], (N_B, MLA_Q_RANK, MLA_HEADS * (MLA_NOPE + MLA_ROPE)), MLA_Q_RANK ** -0.5)
    mla_w_kvb = nrm(ks[17], (N_B, MLA_KV_RANK, MLA_HEADS * (MLA_NOPE + MLA_V)), MLA_KV_RANK ** -0.5)
    mla_w_o = nrm(ks[18], (N_B, MLA_HEADS * MLA_V, D), (MLA_HEADS * MLA_V) ** -0.5)
    hg_lb = nrm(ks[19], (DEPTH, HG_HEADS * HG_DK), 0.5)
    hg_w_in = nrm(ks[20], (N_C, D, 2 * HG_HEADS * HG_DK + 2 * HG_HEADS * HG_DV), D ** -0.5)
    hg_norm_g = 1.0 + nrm(ks[21], (N_C, HG_DV), 0.05)
    hg_w_o = nrm(ks[22], (N_C, HG_HEADS * HG_DV, D), (HG_HEADS * HG_DV) ** -0.5)
    ff_w_up = nrm(ks[23], (DEPTH, D, 2 * FF_DIM), D ** -0.5)
    ff_conv_w = nrm(ks[24], (DEPTH, CONV_W, 2 * FF_DIM), CONV_W ** -0.5)
    ff_conv_b = nrm(ks[25], (DEPTH, 2 * FF_DIM), 0.02)
    ff_w_down = nrm(ks[26], (DEPTH, FF_DIM, D), FF_DIM ** -0.5)
    final_g = 1.0 + nrm(ks[27], (D,), 0.05)
    return {'x': x, 'c': c, 'positions': positions, 'ada_w': ada_w, 'ada_b': ada_b,
            'mix_norm_g': mix_norm_g, 'ffn_norm_g': ffn_norm_g,
            'gm_w_in': gm_w_in, 'gm_ln_g': gm_ln_g, 'gm_ln_b': gm_ln_b, 'gm_w_s': gm_w_s,
            'gm_b_s': gm_b_s, 'gm_w_out': gm_w_out,
            'mla_w_a': mla_w_a, 'mla_q_norm_g': mla_q_norm_g, 'mla_kv_norm_g': mla_kv_norm_g,
            'mla_w_qb': mla_w_qb, 'mla_w_kvb': mla_w_kvb, 'mla_w_o': mla_w_o,
            'hg_lb': hg_lb, 'hg_w_in': hg_w_in, 'hg_norm_g': hg_norm_g, 'hg_w_o': hg_w_o,
            'ff_w_up': ff_w_up, 'ff_conv_w': ff_conv_w, 'ff_conv_b': ff_conv_b, 'ff_w_down': ff_w_down,
            'final_g': final_g}


def reference(x, c, positions, ada_w, ada_b, mix_norm_g, ffn_norm_g,
              gm_w_in, gm_ln_g, gm_ln_b, gm_w_s, gm_b_s, gm_w_out,
              mla_w_a, mla_q_norm_g, mla_kv_norm_g, mla_w_qb, mla_w_kvb, mla_w_o,
              hg_lb, hg_w_in, hg_norm_g, hg_w_o,
              ff_w_up, ff_conv_w, ff_conv_b, ff_w_down, final_g):
    cos, sin = rope_tables(positions)
    lb_all = hgrn_lower_bounds(hg_lb)
    c_act = jax.nn.silu(c)
    for i in range(DEPTH):
        mod = c_act @ ada_w[i] + ada_b[i]
        sh1, sc1, g1, sh2, sc2, g2 = jnp.split(mod, 6, axis=-1)
        h = modulate(rmsnorm(x, mix_norm_g[i]), sh1, sc1)
        kind, j = i % N_MIXERS, i // N_MIXERS
        if kind == 0:
            y = gmlp_mixer(h, gm_w_in[j], gm_ln_g[j], gm_ln_b[j], gm_w_s[j], gm_b_s[j], gm_w_out[j])
        elif kind == 1:
            y = mla_mixer(h, cos, sin, mla_w_a[j], mla_q_norm_g[j], mla_kv_norm_g[j],
                          mla_w_qb[j], mla_w_kvb[j], mla_w_o[j])
        else:
            y = hgrn2_mixer(h, lb_all[i].astype(h.dtype), hg_w_in[j], hg_norm_g[j], hg_w_o[j])
        x = x + (1.0 + g1)[:, None, :] * y
        h = modulate(rmsnorm(x, ffn_norm_g[i]), sh2, sc2)
        x = x + (1.0 + g2)[:, None, :] * conv_ffn(h, ff_w_up[i], ff_conv_w[i], ff_conv_b[i], ff_w_down[i])
    return rmsnorm(x, final_g)
```

```cpp
#include <hip/hip_runtime.h>
#include <hip/hip_cooperative_groups.h>
#include <cstdio>
#include <cstdint>
namespace cg = cooperative_groups;
__device__ __forceinline__ int otid() { int t = threadIdx.x; asm volatile("" : "+v"(t)); return t; }
__device__ __forceinline__ int obid() { int t = blockIdx.x; asm volatile("" : "+s"(t)); return t; }
namespace pg8 {
#define PG8_LAS __attribute__((address_space(3)))
typedef unsigned short bf16_t;
typedef short bf16x8 __attribute__((ext_vector_type(8)));
typedef float f32x4 __attribute__((ext_vector_type(4)));
typedef unsigned u32x4 __attribute__((ext_vector_type(4)));
constexpr int BM = 256, BK = 64, HALF = 128, HTB = HALF * BK * 2  , STAGE_BYTES = 8 * HTB, NXCD = 8, WGM = 8;

__host__ __device__ __forceinline__ int lds_byte(int r, int c) { const int st = (r >> 4) * 2 + (c >> 5), rr = r & 15, cc = c & 31, ob = rr * 64 + cc * 2; return st * 1024 + (ob ^ (((ob >> 9) & 1) << 5)); }
__host__ __device__ __forceinline__ void stage_rc(int b, int& R, int& C) { const int st = b / 1024, sb = b % 1024, swz = sb ^ (((sb >> 9) & 1) << 5); R = (st >> 1) * 16 + swz / 64; C = (st & 1) * 32 + (swz % 64) / 2; }
__host__ __device__ __forceinline__ int perm32(int rho) { const int n = rho >> 4, i = rho & 15; return 8 * (i >> 2) + 4 * n + (i & 3); }

struct Unit { int pm, pn; };
struct Gemm { const bf16_t* A; const bf16_t* Bt; int M, N, K; };

struct StaticOrder {
    int nM, nN, nwg, G, c;
    __host__ __device__ void init(int M, int N, int G_, int c_) { nM = M / BM; nN = N / BM; nwg = nM * nN; G = G_; c = c_; }
    __host__ __device__ bool next(int i, Unit& u) const {
        const long L = (long)i * G + c; if (L >= nwg) return false;
        int wgid = (int)L; { const int q = nwg / NXCD, r = nwg % NXCD, xcd = wgid % NXCD, off = wgid / NXCD; wgid = (xcd < r ? xcd * (q + 1) : r * (q + 1) + (xcd - r) * q) + off; }
        const int nig = WGM * nN, gid = wgid / nig, fm = gid * WGM, gsz = (nM - fm) < WGM ? (nM - fm) : WGM;
        u.pm = fm + ((wgid % nig) % gsz); u.pn = (wgid % nig) / gsz; return true;
    }
    __device__ __forceinline__ void a_ready(const Unit&) const {}
    __device__ __forceinline__ void done(const Unit&) const {}
};
__device__ __forceinline__ unsigned cvt_pk_bf16(float lo, float hi) { unsigned r; asm volatile("v_cvt_pk_bf16_f32 %0, %1, %2" : "=v"(r) : "v"(lo), "v"(hi)); return r; }

template <class Epi, class Sched, bool STAMP = false>
__device__ __forceinline__ void gemm_phase(PG8_LAS unsigned char* lds, const Gemm g, const Sched& S, const Epi& E, unsigned long long* stamps) {
    const int tid = otid(), wid = __builtin_amdgcn_readfirstlane(tid >> 6), lane = tid & 63, wr = wid >> 2, wc = wid & 3, fr = lane & 15, fq = lane >> 4;
    const int K = g.K, nt = K / BK;
    int ts_lo = 0, ts_hi = 0, nts = 0; const unsigned long long rt_entry = STAMP ? (unsigned long long)wall_clock64() : 0ull;
#define PG8_STAMP() do { if (STAMP && wid == 0 && nts < 64) { const unsigned long long _c = (unsigned long long)clock64(); \
        ts_lo = (lane == nts) ? (int)(unsigned)_c : ts_lo; ts_hi = (lane == nts) ? (int)(unsigned)(_c >> 32) : ts_hi; ++nts; } } while (0)
    PG8_STAMP();
    unsigned voffA[2], voffB[2];
#pragma unroll
    for (int i = 0; i < 2; ++i) { int R, C; stage_rc(tid * 16 + i * 8192, R, C); const int Rb = Epi::PERM ? ((R & ~31) + perm32(R & 31)) : R;
        voffA[i] = (unsigned)(R * K + C) * 2u; voffB[i] = (unsigned)(Rb * K + C) * 2u; }
    const size_t kstep = (size_t)(BK * 2);
    const size_t hstep = (size_t)HALF * K * 2;
    const size_t tstep = 2 * hstep;
    const unsigned ldsw = (unsigned)wid * 1024u;
    const int aoff = lds_byte(wr * 64 + fr, fq * 8), boff = lds_byte(wc * 32 + fr, fq * 8);
#define PG8_SA(b, h) (((b) * 2 + (h)) * HTB)
#define PG8_SB(b, h) ((4 + (b) * 2 + (h)) * HTB)
#define PG8_STAGE(bufoff, gbase, voff) do { _Pragma("unroll") for (int _i = 0; _i < 2; ++_i) \
        __builtin_amdgcn_global_load_lds((const unsigned*)((const char*)(gbase) + (voff)[_i]), (PG8_LAS unsigned*)(lds + (bufoff) + ldsw + _i * 8192), 16, 0, 0); } while (0)
#define PG8_LDA(dst, b, h) do { _Pragma("unroll") for (int m = 0; m < 4; ++m) _Pragma("unroll") for (int k = 0; k < 2; ++k) dst[m][k] = *(const PG8_LAS bf16x8*)(lds + PG8_SA(b, h) + aoff + m * 2048 + k * 1024); } while (0)
#define PG8_LDB(dst, b, h) do { _Pragma("unroll") for (int n = 0; n < 2; ++n) _Pragma("unroll") for (int k = 0; k < 2; ++k) dst[n][k] = *(const PG8_LAS bf16x8*)(lds + PG8_SB(b, h) + boff + n * 2048 + k * 1024); } while (0)
#define PG8_MMA(ai, bj, At, Bt) do { __builtin_amdgcn_s_setprio(1); _Pragma("unroll") for (int m = 0; m < 4; ++m) _Pragma("unroll") for (int n = 0; n < 2; ++n) _Pragma("unroll") for (int k = 0; k < 2; ++k) \
        acc[ai][bj][m][n] = __builtin_amdgcn_mfma_f32_16x16x32_bf16(Bt[n][k], At[m][k], acc[ai][bj][m][n], 0, 0, 0); __builtin_amdgcn_s_setprio(0); } while (0)
#define PG8_WAIT_V(n) asm volatile("s_waitcnt vmcnt(" #n ")" ::: "memory")
#define PG8_WAIT_L(n) asm volatile("s_waitcnt lgkmcnt(" #n ")" ::: "memory")
#define PG8_BAR __builtin_amdgcn_s_barrier()
#define PG8_SCHED __builtin_amdgcn_sched_barrier(0)
    Unit cur, nxt; int ui = 0;
    if (!S.next(0, cur)) return;
    f32x4 acc[2][2][4][2];
#pragma unroll
    for (int a = 0; a < 2; ++a)
#pragma unroll
        for (int b = 0; b < 2; ++b)
#pragma unroll
            for (int m = 0; m < 4; ++m)
#pragma unroll
                for (int n = 0; n < 2; ++n) acc[a][b][m][n] = (f32x4){0.f, 0.f, 0.f, 0.f};
    bf16x8 At[4][2], B0[2][2], B1[2][2];
    const char* cA = (const char*)g.A + (size_t)cur.pm * tstep; const char* cB = (const char*)g.Bt + (size_t)cur.pn * tstep;
    S.a_ready(cur);
    PG8_STAGE(PG8_SB(0, 0), cB, voffB); PG8_STAGE(PG8_SA(0, 0), cA, voffA); PG8_STAGE(PG8_SB(0, 1), cB + hstep, voffB); PG8_STAGE(PG8_SA(0, 1), cA + hstep, voffA);
    if (wr == 1) PG8_BAR;
    PG8_WAIT_V(4); PG8_BAR;
    PG8_STAGE(PG8_SB(1, 0), cB + kstep, voffB); PG8_STAGE(PG8_SA(1, 0), cA + kstep, voffA); PG8_STAGE(PG8_SB(1, 1), cB + hstep + kstep, voffB);
    PG8_WAIT_V(6); PG8_BAR;
    PG8_STAMP();
    for (;;) {
        const bool has_next = S.next(ui + 1, nxt);
        const char* nA = has_next ? (const char*)g.A + (size_t)nxt.pm * tstep : cA; const char* nB = has_next ? (const char*)g.Bt + (size_t)nxt.pn * tstep : cB;
        for (int t = 0; t < nt; t += 2) {
            const bool last = (t == nt - 2);
            const char* a1 = cA + (size_t)(t + 1) * kstep;
            const char* a2 = last ? nA : cA + (size_t)(t + 2) * kstep; const char* b2 = last ? nB : cB + (size_t)(t + 2) * kstep;
            const char* a3 = a2 + kstep; const char* b3 = b2 + kstep;
            if (last && has_next) S.a_ready(nxt);
            PG8_LDB(B0, 0, 0); PG8_SCHED; PG8_LDA(At, 0, 0); PG8_STAGE(PG8_SA(1, 1), a1 + hstep, voffA);
            PG8_WAIT_L(8); PG8_BAR; PG8_WAIT_L(0); PG8_MMA(0, 0, At, B0); PG8_BAR; PG8_SCHED;
            PG8_LDB(B1, 0, 1); PG8_STAGE(PG8_SB(0, 0), b2, voffB);
            PG8_BAR; PG8_WAIT_L(0); PG8_MMA(0, 1, At, B1); PG8_BAR;
            PG8_LDA(At, 0, 1); PG8_STAGE(PG8_SA(0, 0), a2, voffA);
            PG8_BAR; PG8_WAIT_L(0); PG8_MMA(1, 0, At, B0); PG8_BAR; PG8_SCHED;
            PG8_STAGE(PG8_SB(0, 1), b2 + hstep, voffB);
            PG8_WAIT_V(6); PG8_BAR; PG8_MMA(1, 1, At, B1); PG8_BAR;
            PG8_LDB(B0, 1, 0); PG8_SCHED; PG8_LDA(At, 1, 0); PG8_STAGE(PG8_SA(0, 1), a2 + hstep, voffA);
            PG8_WAIT_L(8); PG8_BAR; PG8_WAIT_L(0); PG8_MMA(0, 0, At, B0); PG8_BAR; PG8_SCHED;
            PG8_LDB(B1, 1, 1); PG8_STAGE(PG8_SB(1, 0), b3, voffB);
            PG8_BAR; PG8_WAIT_L(0); PG8_MMA(0, 1, At, B1); PG8_BAR;
            PG8_LDA(At, 1, 1); PG8_STAGE(PG8_SA(1, 0), a3, voffA);
            PG8_BAR; PG8_WAIT_L(0); PG8_MMA(1, 0, At, B0); PG8_BAR; PG8_SCHED;
            PG8_STAGE(PG8_SB(1, 1), b3 + hstep, voffB);
            PG8_WAIT_V(6); PG8_BAR; PG8_MMA(1, 1, At, B1); PG8_BAR;
        }
        PG8_STAMP();
        if constexpr (!Epi::AFTER_DRAIN) { E(acc, cur, wr, wc, fr, fq); S.done(cur); }
        PG8_STAMP();
        if (!has_next) break;
#pragma unroll
        for (int a = 0; a < 2; ++a)
#pragma unroll
            for (int b = 0; b < 2; ++b)
#pragma unroll
                for (int m = 0; m < 4; ++m)
#pragma unroll
                    for (int n = 0; n < 2; ++n) acc[a][b][m][n] = (f32x4){0.f, 0.f, 0.f, 0.f};
        cur = nxt; cA = nA; cB = nB; ++ui;
    }
    PG8_WAIT_V(0);
    if (wr == 0) PG8_BAR;
    PG8_BAR;
    if constexpr (Epi::AFTER_DRAIN) { E.fused(acc, cur, wr, wc, fr, fq, lds, wid, lane); S.done(cur); }
    PG8_STAMP();
    if (STAMP && wid == 0) { stamps[lane] = lane < nts ? (((unsigned long long)(unsigned)ts_hi << 32) | (unsigned)ts_lo) : 0ull;
        if (lane == 62) stamps[62] = rt_entry; if (lane == 63) stamps[63] = (unsigned long long)wall_clock64(); }
#undef PG8_STAMP
#undef PG8_SA
#undef PG8_SB
#undef PG8_STAGE
#undef PG8_LDA
#undef PG8_LDB
#undef PG8_MMA
#undef PG8_WAIT_V
#undef PG8_WAIT_L
#undef PG8_BAR
#undef PG8_SCHED
}
}

using pg8::bf16_t; using pg8::bf16x8; using pg8::f32x4; using pg8::u32x4; using pg8::Unit;
typedef unsigned u32x2 __attribute__((ext_vector_type(2)));
typedef short bf16x4 __attribute__((ext_vector_type(4)));
#define LAS __attribute__((address_space(3)))
typedef LAS unsigned char* ldsp;

constexpr int T = 16384, D = 1024, SEQ = 4096, NBATCH = 4, FF = 2816;
constexpr int NTHREADS = 512, LDS_BYTES = 131072;
constexpr float EPS = 1e-6f;
constexpr size_t MiB = 1024 * 1024;
constexpr size_t OFF_MOD = 0, OFF_LB = 512 * 1024, OFF_CSC = 1 * MiB, OFF_CSS = 3 * MiB, OFF_WT = 8 * MiB, OFF_HB = 40 * MiB, OFF_R1 = 72 * MiB, OFF_R2 = 248 * MiB, WS_END = 336 * MiB;
constexpr size_t WT_MIXA = 0, WT_MIXB = 4194304, WT_FUP = 6291456, WT_FDN = 12058624, WT_MQKV = 524288;
enum { OP_PRO = 0, OP_NORM1, OP_G1, OP_GSP, OP_GOUT, OP_M1, OP_M2, OP_M3, OP_ATT, OP_MOUT, OP_H1, OP_HA, OP_HSCAN, OP_HC, OP_HOUT, OP_NORM2, OP_FUP, OP_FCONV, OP_FDN, OP_FINAL };

struct Params;
struct Params {
    const float* in[28];
    float* out;
    unsigned char* ws;
    int ph_lo, ph_hi;
    unsigned char op[48];
    unsigned char lay[48];
};

typedef const __attribute__((address_space(4))) Params* KP;
__device__ __forceinline__ unsigned pk2(float lo, float hi) { return pg8::cvt_pk_bf16(lo, hi); }
__device__ __forceinline__ float bflo(unsigned u) { return __uint_as_float(u << 16); }
__device__ __forceinline__ float bfhi(unsigned u) { return __uint_as_float(u & 0xffff0000u); }
__device__ __forceinline__ float wave_sum(float v) {
#pragma unroll
    for (int o = 32; o >= 1; o >>= 1) v += __shfl_xor(v, o);
    return v;
}
__device__ __forceinline__ float fast_sigmoid(float x) { return __builtin_amdgcn_rcpf(1.f + __builtin_amdgcn_exp2f(-1.4426950408889634f * x)); }
__device__ __forceinline__ float gelu_tanh(float x) { const float u = 0.7978845608028654f * (x + 0.044715f * x * x * x); return x * fast_sigmoid(2.f * u); }
__device__ __forceinline__ bf16x8 mk8(unsigned a, unsigned b, unsigned c, unsigned d) { u32x4 v = {a, b, c, d}; return __builtin_bit_cast(bf16x8, v); }
__device__ __forceinline__ f32x4 zero4() { float z = 0.f; asm volatile("" : "+v"(z)); return (f32x4){z, z, z, z}; }
#define MFMA16(X, Y, C) __builtin_amdgcn_mfma_f32_16x16x32_bf16((X), (Y), (C), 0, 0, 0)

template <int ACT> struct EpiBf16 {
    static constexpr bool PERM = true, AFTER_DRAIN = false;
    bf16_t* O; int ldc;
    __device__ __forceinline__ void operator()(const f32x4 (&acc)[2][2][4][2], const Unit& u, int wr, int wc, int fr, int fq) const {
        const int row0 = u.pm * 256 + wr * 64 + fr, col0 = u.pn * 256 + wc * 32 + 8 * fq;
#pragma unroll
        for (int ai = 0; ai < 2; ++ai)
#pragma unroll
            for (int m = 0; m < 4; ++m) { bf16_t* rowp = O + (size_t)(row0 + ai * 128 + m * 16) * ldc + col0;
#pragma unroll
                for (int bj = 0; bj < 2; ++bj) { f32x4 v0 = acc[ai][bj][m][0], v1 = acc[ai][bj][m][1];
                    if (ACT == 1) {
#pragma unroll
                        for (int e = 0; e < 4; ++e) { v0[e] = gelu_tanh(v0[e]); v1[e] = gelu_tanh(v1[e]); } }
                    u32x4 o = {pk2(v0[0], v0[1]), pk2(v0[2], v0[3]), pk2(v1[0], v1[1]), pk2(v1[2], v1[3])};
                    *(u32x4*)(rowp + bj * 128) = o; } }
    }
};
struct EpiF32 {
    static constexpr bool PERM = false, AFTER_DRAIN = false;
    float* C; int ldc;
    __device__ __forceinline__ void operator()(const f32x4 (&acc)[2][2][4][2], const Unit& u, int wr, int wc, int fr, int fq) const {
        const int row0 = u.pm * 256 + wr * 64 + fr, col0 = u.pn * 256 + wc * 32 + 4 * fq;
#pragma unroll
        for (int ai = 0; ai < 2; ++ai)
#pragma unroll
            for (int m = 0; m < 4; ++m) { float* rowp = C + (size_t)(row0 + ai * 128 + m * 16) * ldc + col0;
#pragma unroll
                for (int bj = 0; bj < 2; ++bj)
#pragma unroll
                    for (int n = 0; n < 2; ++n) *(f32x4*)(rowp + bj * 128 + n * 16) = acc[ai][bj][m][n]; }
    }
};
struct EpiRes {
    static constexpr bool PERM = false, AFTER_DRAIN = false;
    const float* Xs; float* Xd; const float* gate;
    __device__ __forceinline__ void operator()(const f32x4 (&acc)[2][2][4][2], const Unit& u, int wr, int wc, int fr, int fq) const {
        const int row0 = u.pm * 256 + wr * 64 + fr, col0 = u.pn * 256 + wc * 32 + 4 * fq;
        const float* gp = gate + (size_t)(u.pm >> 4) * 6144 + col0;
        f32x4 gv[2][2];
#pragma unroll
        for (int bj = 0; bj < 2; ++bj)
#pragma unroll
            for (int n = 0; n < 2; ++n) { gv[bj][n] = *(const f32x4*)(gp + bj * 128 + n * 16); gv[bj][n] = gv[bj][n] + 1.f; }
#pragma unroll
        for (int ai = 0; ai < 2; ++ai)
#pragma unroll
            for (int m = 0; m < 4; ++m) { const size_t ro = (size_t)(row0 + ai * 128 + m * 16) * 1024 + col0;
#pragma unroll
                for (int bj = 0; bj < 2; ++bj)
#pragma unroll
                    for (int n = 0; n < 2; ++n) { const f32x4 xs = *(const f32x4*)(Xs + ro + bj * 128 + n * 16);
                        *(f32x4*)(Xd + ro + bj * 128 + n * 16) = xs + gv[bj][n] * acc[ai][bj][m][n]; } }
    }
};
struct EpiQ {
    static constexpr bool PERM = false, AFTER_DRAIN = false;
    bf16_t* QF; const float* CSC; const float* CSS; float qs;
    __device__ __forceinline__ void operator()(const f32x4 (&acc)[2][2][4][2], const Unit& u, int wr, int wc, int fr, int fq) const {
        const int b = u.pm >> 4;
#pragma unroll
        for (int bj = 0; bj < 2; ++bj) {
            const int c0 = u.pn * 256 + bj * 128 + wc * 32;
            const int head = c0 / 192, off = c0 - head * 192;
            if (off < 128) {
#pragma unroll
                for (int ai = 0; ai < 2; ++ai)
#pragma unroll
                    for (int m = 0; m < 4; ++m) { const int r = u.pm * 256 + ai * 128 + wr * 64 + m * 16 + fr, s = r & 4095;
                        bf16_t* qp = QF + (unsigned)(((b * 8 + head) * 4096 + s) * 192 + off + 4 * fq);
#pragma unroll
                        for (int n = 0; n < 2; ++n) { const f32x4 v = acc[ai][bj][m][n] * qs; u32x2 o = {pk2(v[0], v[1]), pk2(v[2], v[3])}; *(u32x2*)(qp + 16 * n) = o; } __builtin_amdgcn_sched_barrier(0); }
            } else {
                const int jb = ((off - 128) >> 5) * 16 + 4 * fq;
#pragma unroll
                for (int ai = 0; ai < 2; ++ai)
#pragma unroll
                    for (int m = 0; m < 4; ++m) { const int r = u.pm * 256 + ai * 128 + wr * 64 + m * 16 + fr, s = r & 4095;
                        const f32x4 cs = *(const f32x4*)(CSC + (unsigned)(r * 32 + jb)), sn = *(const f32x4*)(CSS + (unsigned)(r * 32 + jb));
                        const f32x4 x1 = acc[ai][bj][m][0], x2 = acc[ai][bj][m][1];
                        const f32x4 r1 = (x1 * cs - x2 * sn) * qs, r2 = (x2 * cs + x1 * sn) * qs;
                        bf16_t* qp = QF + (unsigned)(((b * 8 + head) * 4096 + s) * 192 + 128 + jb);
                        u32x2 o1 = {pk2(r1[0], r1[1]), pk2(r1[2], r1[3])}, o2 = {pk2(r2[0], r2[1]), pk2(r2[2], r2[3])};
                        *(u32x2*)(qp) = o1; *(u32x2*)(qp + 32) = o2; __builtin_amdgcn_sched_barrier(0); }
            }
        }
    }
};
struct EpiKV {
    static constexpr bool PERM = false, AFTER_DRAIN = false;
    bf16_t* KF; bf16_t* VT;
    __device__ __forceinline__ void operator()(const f32x4 (&acc)[2][2][4][2], const Unit& u, int wr, int wc, int fr, int fq) const {
        const int b = u.pm >> 4, head = u.pn;
#pragma unroll
        for (int bj = 0; bj < 2; ++bj) {
            const int off = wc * 32;
            if (bj == 0) {
#pragma unroll
                for (int ai = 0; ai < 2; ++ai)
#pragma unroll
                    for (int m = 0; m < 4; ++m) { const int r = u.pm * 256 + ai * 128 + wr * 64 + m * 16 + fr, s = r & 4095;
                        bf16_t* kp = KF + (unsigned)(((b * 8 + head) * 4096 + s) * 192 + off + 4 * fq);
#pragma unroll
                        for (int n = 0; n < 2; ++n) { const f32x4 v = acc[ai][bj][m][n]; u32x2 o = {pk2(v[0], v[1]), pk2(v[2], v[3])}; *(u32x2*)(kp + 16 * n) = o; } __builtin_amdgcn_sched_barrier(0); }
            } else {
#pragma unroll
                for (int ai = 0; ai < 2; ++ai)
#pragma unroll
                    for (int m = 0; m < 4; ++m) { const int r = u.pm * 256 + ai * 128 + wr * 64 + m * 16 + fr, s = r & 4095;
#pragma unroll
                        for (int n = 0; n < 2; ++n) { const f32x4 v = acc[ai][bj][m][n]; const int dv = off + 16 * n + 4 * fq;
                            bf16_t* vp = VT + (unsigned)(((b * 8 + head) * 128 + dv) * 4096 + s);
                            const unsigned p01 = pk2(v[0], v[1]), p23 = pk2(v[2], v[3]);
                            vp[0] = (bf16_t)(p01 & 0xffffu); vp[4096] = (bf16_t)(p01 >> 16); vp[8192] = (bf16_t)(p23 & 0xffffu); vp[12288] = (bf16_t)(p23 >> 16); } __builtin_amdgcn_sched_barrier(0); }
            }
        }
    }
};
struct EpiHg {
    static constexpr bool PERM = true, AFTER_DRAIN = false;
    unsigned char* R1b; const float* LB;
    __device__ __forceinline__ void operator()(const f32x4 (&acc)[2][2][4][2], const Unit& u, int wr, int wc, int fr, int fq) const {
        const int region = u.pn >> 2, row0 = u.pm * 256 + wr * 64 + fr, cc0 = (u.pn & 3) * 256 + wc * 32 + 8 * fq;
        if (region == 1) {
#pragma unroll
            for (int bj = 0; bj < 2; ++bj) { const int cc = cc0 + bj * 128;
                const f32x4 l0 = *(const f32x4*)(LB + cc), l1 = *(const f32x4*)(LB + cc + 4);
#pragma unroll
                for (int ai = 0; ai < 2; ++ai)
#pragma unroll
                    for (int m = 0; m < 4; ++m) { float* fp = (float*)(R1b + 32 * MiB) + (unsigned)((row0 + ai * 128 + m * 16) * 1024 + cc);
                        f32x4 v0 = acc[ai][bj][m][0], v1 = acc[ai][bj][m][1];
#pragma unroll
                        for (int e = 0; e < 4; ++e) { v0[e] = l0[e] + (1.f - l0[e]) * fast_sigmoid(v0[e]); v1[e] = l1[e] + (1.f - l1[e]) * fast_sigmoid(v1[e]); }
                        *(f32x4*)fp = v0; *(f32x4*)(fp + 4) = v1; __builtin_amdgcn_sched_barrier(0); } }
        } else {
            bf16_t* base = (bf16_t*)(R1b + (region == 0 ? (size_t)0 : (region == 2 ? 96 * MiB : 128 * MiB)));
#pragma unroll
            for (int ai = 0; ai < 2; ++ai)
#pragma unroll
                for (int m = 0; m < 4; ++m) { bf16_t* rowp = base + (unsigned)((row0 + ai * 128 + m * 16) * 1024 + cc0);
#pragma unroll
                    for (int bj = 0; bj < 2; ++bj) { f32x4 v0 = acc[ai][bj][m][0], v1 = acc[ai][bj][m][1];
                        if (region == 3) {
#pragma unroll
                            for (int e = 0; e < 4; ++e) { v0[e] = v0[e] * fast_sigmoid(v0[e]); v1[e] = v1[e] * fast_sigmoid(v1[e]); } }
                        u32x4 o = {pk2(v0[0], v0[1]), pk2(v0[2], v0[3]), pk2(v1[0], v1[1]), pk2(v1[2], v1[3])};
                        *(u32x4*)(rowp + bj * 128) = o; } }
        }
    }
};

template <class Epi> __device__ __forceinline__ void run_gemm(ldsp lds, const bf16_t* A, const bf16_t* Bt, int M, int N, int K, const Epi& E) {
    pg8::Gemm g{A, Bt, M, N, K}; pg8::StaticOrder S; S.init(M, N, (int)gridDim.x, obid());
    pg8::gemm_phase<Epi, pg8::StaticOrder, false>(lds, g, S, E, nullptr);
}

__device__ __forceinline__ int rope_rowmap(int n) { const int head = n / 192, d = n - head * 192; if (d < 128) return n; const int r = d - 128, half = r >> 5, j = r & 31; return head * 192 + 128 + (j >> 4) * 32 + half * 16 + (j & 15); }
__device__ __forceinline__ void tr_tile(const float* src, int srcN, int kt, int nt, bf16_t* dst, int dstK, int koff, int rowoff, int pmode, LAS float* sm, int tid) {
    { const int n = tid & 63, k0 = tid >> 6;
#pragma unroll
      for (int i = 0; i < 8; ++i) { const int k = k0 + 8 * i; sm[n * 65 + k] = src[(size_t)(kt * 64 + k) * srcN + nt * 64 + n]; } }
    __syncthreads();
    { const int kk = (tid & 31) * 2, nr = tid >> 5;
#pragma unroll
      for (int j = 0; j < 4; ++j) { const int n = nr + 16 * j, sn = nt * 64 + n, drow = rowoff + (pmode ? rope_rowmap(sn) : sn);
          *(unsigned*)(dst + (size_t)drow * dstK + koff + kt * 64 + kk) = pk2(sm[n * 65 + kk], sm[n * 65 + kk + 1]); } }
    __syncthreads();
}
struct TrJob { const float* src; int srcN, K, N; bf16_t* dst; int dstK, koff, rowoff, pmode; };
__device__ __forceinline__ void run_trjob(const TrJob J, ldsp lds) {
    LAS float* sm = (LAS float*)lds; const int tid = otid();
    const int nkt = J.K / 64, nnt = J.N / 64, ntile = nkt * nnt;
    for (int t = obid(); t < ntile; t += gridDim.x) { const int kt = t % nkt, nt = t / nkt; tr_tile(J.src, J.srcN, kt, nt, J.dst, J.dstK, J.koff, J.rowoff, J.pmode, sm, tid); }
}
__device__ __forceinline__ void zero_fill(bf16_t* dst, int rows, int cols8, int stride, int gtid, int gthreads) {
    const int n = rows * cols8; unsigned zz = 0u; asm volatile("" : "+v"(zz)); const u32x4 z = {zz, zz, zz, zz};
    for (int i = gtid; i < n; i += gthreads) { const int r = i / cols8, c = i - r * cols8; *(u32x4*)(dst + (size_t)r * stride + c * 8) = z; }
}
__device__ __forceinline__ void prep_layer(KP p, int layer, ldsp lds) {
    bf16_t* WT = (bf16_t*)(p->ws + OFF_WT); const int kind = layer % 3, j = layer / 3;
    const int gtid = obid() * NTHREADS + otid(), gthreads = gridDim.x * NTHREADS;
    { const TrJob J0{p->in[23] + (size_t)layer * 1024 * 5632, 5632, 1024, 5632, WT + WT_FUP, 1024, 0, 0, 0};
      const TrJob J1{p->in[26] + (size_t)layer * 2816 * 1024, 1024, 2816, 1024, WT + WT_FDN, 2816, 0, 0, 0};
      run_trjob(J0, lds); run_trjob(J1, lds); }
    if (kind == 0) {
        const TrJob J0{p->in[7] + (size_t)j * 1024 * 4096, 4096, 1024, 4096, WT + WT_MIXA, 1024, 0, 0, 0};
        const TrJob J1{p->in[12] + (size_t)j * 2048 * 1024, 1024, 2048, 1024, WT + WT_MIXB, 2048, 0, 0, 0};
        run_trjob(J0, lds); run_trjob(J1, lds);
    } else if (kind == 1) {
        const TrJob J0{p->in[13], 448, 1024, 448, WT + WT_MIXA, 1024, 0, 0, 0};
        const TrJob J1{p->in[16], 1536, 256, 1536, WT + WT_MQKV, 256, 0, 0, 1};
        const TrJob J2{p->in[17], 2048, 128, 2048, WT + WT_MQKV + 393216, 256, 0, 0, 0};
        const TrJob J3{p->in[18], 1024, 1024, 1024, WT + WT_MIXB, 1024, 0, 0, 0};
        run_trjob(J0, lds); run_trjob(J1, lds); run_trjob(J2, lds); run_trjob(J3, lds);
        zero_fill(WT + WT_MIXA + (size_t)448 * 1024, 64, 128, 1024, gtid, gthreads);
        zero_fill(WT + WT_MQKV + 393216 + 128, 2048, 16, 256, gtid, gthreads);
    } else {
        const TrJob J0{p->in[20], 4096, 1024, 4096, WT + WT_MIXA, 1024, 0, 0, 0};
        const TrJob J1{p->in[22], 1024, 1024, 1024, WT + WT_MIXB, 1024, 0, 0, 0};
        run_trjob(J0, lds); run_trjob(J1, lds);
    }
}
__device__ __forceinline__ void phase_prologue(KP p, ldsp lds) {
    const int tid = otid();
    float* MOD = (float*)(p->ws + OFF_MOD);
    LAS float* cact = (LAS float*)lds;
    LAS float* red = (LAS float*)(lds + 16384);
    for (int i = tid; i < 4096; i += NTHREADS) { const float c = p->in[1][i]; cact[i] = c * fast_sigmoid(c); }
    __syncthreads();
    const int l16 = tid & 15, kg = tid >> 4;
    for (int item = obid(); item < 4 * 96; item += gridDim.x) {
        const int layer = item / 96, n0 = (item % 96) * 64;
        const float* w = p->in[3] + (size_t)layer * 1024 * 6144 + n0 + 4 * l16;
        f32x4 a[4] = {{0.f, 0.f, 0.f, 0.f}, {0.f, 0.f, 0.f, 0.f}, {0.f, 0.f, 0.f, 0.f}, {0.f, 0.f, 0.f, 0.f}};
#pragma unroll 8
        for (int kk = 0; kk < 32; ++kk) { const int k = kg * 32 + kk; const f32x4 wv = *(const f32x4*)(w + (size_t)k * 6144);
#pragma unroll
            for (int b = 0; b < 4; ++b) a[b] = a[b] + wv * cact[b * 1024 + k]; }
#pragma unroll
        for (int b = 0; b < 4; ++b) *(LAS f32x4*)(red + (kg * 4 + b) * 64 + 4 * l16) = a[b];
        __syncthreads();
        if (tid < 256) { const int b = tid >> 6, col = tid & 63; float s = 0.f;
#pragma unroll 8
            for (int g = 0; g < 32; ++g) s += red[(g * 4 + b) * 64 + col];
            MOD[(size_t)(layer * 4 + b) * 6144 + n0 + col] = s + p->in[4][(size_t)layer * 6144 + n0 + col]; }
        __syncthreads();
    }
    const int gtid = obid() * NTHREADS + tid, gthreads = gridDim.x * NTHREADS;
    float* CSC = (float*)(p->ws + OFF_CSC); float* CSS = (float*)(p->ws + OFF_CSS);
    const int* pos = (const int*)p->in[2];
    for (int i = gtid; i < T * 32; i += gthreads) { const int t = i >> 5, jj = i & 31;
        const float invf = exp2f(-(float)jj * (13.287712379549449f / 32.f));
        const float ang = (float)pos[t] * invf;
        double rev = (double)ang * 0.15915494309189535; rev -= floor(rev);
        const float rf = (float)rev;
        CSC[i] = __builtin_amdgcn_cosf(rf); CSS[i] = __builtin_amdgcn_sinf(rf); }
    float* LB = (float*)(p->ws + OFF_LB);
    for (int i = gtid; i < 1024; i += gthreads) { const float l0 = p->in[19][i], l1 = p->in[19][1024 + i], l2 = p->in[19][2048 + i], l3 = p->in[19][3072 + i];
        const float mx = fmaxf(fmaxf(l0, l1), fmaxf(l2, l3)); const float e0 = __expf(l0 - mx), e1 = __expf(l1 - mx), e2 = __expf(l2 - mx), e3 = __expf(l3 - mx);
        LB[i] = (e1 + e2) / (e0 + e1 + e2 + e3); }
    prep_layer(p, 0, lds);
}
__device__ __forceinline__ void phase_norm(const float* X, const float* g, const float* shift, const float* scale, bf16_t* dst) {
    const int lane = otid() & 63, wave = otid() >> 6;
    for (int rb = obid() * 8 + wave; rb < T / 8; rb += gridDim.x * 8) {
        const int r0 = rb * 8, b = r0 >> 12;
        f32x4 G[4], SH[4];
#pragma unroll
        for (int j = 0; j < 4; ++j) { const int c = 4 * lane + 256 * j; const f32x4 gg = *(const f32x4*)(g + c), sc = *(const f32x4*)(scale + (size_t)b * 6144 + c); G[j] = gg * (sc + 1.f); SH[j] = *(const f32x4*)(shift + (size_t)b * 6144 + c); }
        for (int r = r0; r < r0 + 8; ++r) {
            f32x4 x[4]; float ss = 0.f;
#pragma unroll
            for (int j = 0; j < 4; ++j) { x[j] = *(const f32x4*)(X + (size_t)r * 1024 + 4 * lane + 256 * j); ss += x[j][0] * x[j][0] + x[j][1] * x[j][1] + x[j][2] * x[j][2] + x[j][3] * x[j][3]; }
            ss = wave_sum(ss); const float rstd = rsqrtf(ss * (1.f / 1024.f) + EPS);
#pragma unroll
            for (int j = 0; j < 4; ++j) { const f32x4 h = x[j] * rstd * G[j] + SH[j]; u32x2 o = {pk2(h[0], h[1]), pk2(h[2], h[3])}; *(u32x2*)(dst + (size_t)r * 1024 + 4 * lane + 256 * j) = o; }
        }
    }
}
__device__ __forceinline__ void phase_final(float* X, const float* g) {
    const int lane = otid() & 63, wave = otid() >> 6;
    for (int r = obid() * 8 + wave; r < T; r += gridDim.x * 8) {
        f32x4 x[4]; float ss = 0.f;
#pragma unroll
        for (int j = 0; j < 4; ++j) { x[j] = *(const f32x4*)(X + (size_t)r * 1024 + 4 * lane + 256 * j); ss += x[j][0] * x[j][0] + x[j][1] * x[j][1] + x[j][2] * x[j][2] + x[j][3] * x[j][3]; }
        ss = wave_sum(ss); const float rstd = rsqrtf(ss * (1.f / 1024.f) + EPS);
#pragma unroll
        for (int j = 0; j < 4; ++j) { const f32x4 gg = *(const f32x4*)(g + 4 * lane + 256 * j); *(f32x4*)(X + (size_t)r * 1024 + 4 * lane + 256 * j) = x[j] * rstd * gg; }
    }
}
__device__ __forceinline__ void up8(const u32x4 v, float (&o)[8]) { o[0] = bflo(v[0]); o[1] = bfhi(v[0]); o[2] = bflo(v[1]); o[3] = bfhi(v[1]); o[4] = bflo(v[2]); o[5] = bfhi(v[2]); o[6] = bflo(v[3]); o[7] = bfhi(v[3]); }
__device__ __forceinline__ void phase_fconv(const bf16_t* A, bf16_t* ACT, const float* cw, const float* cb) {
    const int gtid = obid() * NTHREADS + otid(), gthreads = gridDim.x * NTHREADS;
    for (int q = gtid; q < (T / 16) * 352; q += gthreads) {
        const int rb = q / 352, cgp = q - rb * 352, f0 = cgp * 8, t0 = rb * 16;
        float wg[3][8], wv[3][8], bg[8], bv[8];
#pragma unroll
        for (int j = 0; j < 3; ++j) { const f32x4 a0 = *(const f32x4*)(cw + j * 5632 + f0), a1 = *(const f32x4*)(cw + j * 5632 + f0 + 4), c0 = *(const f32x4*)(cw + j * 5632 + 2816 + f0), c1 = *(const f32x4*)(cw + j * 5632 + 2816 + f0 + 4);
#pragma unroll
            for (int e = 0; e < 4; ++e) { wg[j][e] = a0[e]; wg[j][e + 4] = a1[e]; wv[j][e] = c0[e]; wv[j][e + 4] = c1[e]; } }
        { const f32x4 a0 = *(const f32x4*)(cb + f0), a1 = *(const f32x4*)(cb + f0 + 4), c0 = *(const f32x4*)(cb + 2816 + f0), c1 = *(const f32x4*)(cb + 2816 + f0 + 4);
#pragma unroll
          for (int e = 0; e < 4; ++e) { bg[e] = a0[e]; bg[e + 4] = a1[e]; bv[e] = c0[e]; bv[e + 4] = c1[e]; } }
        float g2[8], g1[8], v2[8], v1[8];
        if ((t0 & 4095) == 0) {
#pragma unroll
            for (int e = 0; e < 8; ++e) { g2[e] = 0.f; g1[e] = 0.f; v2[e] = 0.f; v1[e] = 0.f; }
        } else {
            up8(*(const u32x4*)(A + (size_t)(t0 - 2) * 5632 + f0), g2); up8(*(const u32x4*)(A + (size_t)(t0 - 1) * 5632 + f0), g1);
            up8(*(const u32x4*)(A + (size_t)(t0 - 2) * 5632 + 2816 + f0), v2); up8(*(const u32x4*)(A + (size_t)(t0 - 1) * 5632 + 2816 + f0), v1);
        }
#pragma unroll 4
        for (int r = 0; r < 16; ++r) {
            float gc[8], vc[8], o[8];
            up8(*(const u32x4*)(A + (size_t)(t0 + r) * 5632 + f0), gc); up8(*(const u32x4*)(A + (size_t)(t0 + r) * 5632 + 2816 + f0), vc);
#pragma unroll
            for (int e = 0; e < 8; ++e) { const float yg = bg[e] + wg[0][e] * g2[e] + wg[1][e] * g1[e] + wg[2][e] * gc[e]; const float yv = bv[e] + wv[0][e] * v2[e] + wv[1][e] * v1[e] + wv[2][e] * vc[e];
                o[e] = yg * fast_sigmoid(yg) * yv; g2[e] = g1[e]; g1[e] = gc[e]; v2[e] = v1[e]; v1[e] = vc[e]; }
            u32x4 ov = {pk2(o[0], o[1]), pk2(o[2], o[3]), pk2(o[4], o[5]), pk2(o[6], o[7])};
            *(u32x4*)(ACT + (size_t)(t0 + r) * 2816 + f0) = ov;
        }
    }
}

__device__ __forceinline__ void phase_gsp(KP p, int j, ldsp lds) {
    const bf16_t* Z = (const bf16_t*)(p->ws + OFF_R1); bf16_t* Y = (bf16_t*)(p->ws + OFF_R2);
    const float* ws_w = p->in[10] + (size_t)j * 8 * 128 * 128; const float* bs = p->in[11] + (size_t)j * 8 * 128;
    const float* lng = p->in[8] + (size_t)j * 2048; const float* lnb = p->in[9] + (size_t)j * 2048;
    const int tid = otid(), lane = tid & 63, wave = tid >> 6, l15 = lane & 15, g4 = lane >> 4;
    ldsp As = lds, Bs = lds + 34816; LAS float* mu = (LAS float*)(lds + 104448); LAS float* rs = mu + 128;
    for (int unit = obid(); unit < 256; unit += gridDim.x) {
        const int gh = unit & 1, chunk = unit >> 1, t0 = chunk * 128;
        for (int rr = 0; rr < 16; ++rr) { const int r = wave * 16 + rr; const bf16_t* zp = Z + (size_t)(t0 + r) * 4096 + 2048 + lane * 32; float s = 0.f, s2 = 0.f;
#pragma unroll
            for (int i = 0; i < 4; ++i) { float v[8]; up8(*(const u32x4*)(zp + 8 * i), v);
#pragma unroll
                for (int e = 0; e < 8; ++e) { s += v[e]; s2 += v[e] * v[e]; } }
            s = wave_sum(s); s2 = wave_sum(s2);
            if (lane == 0) { const float m = s * (1.f / 2048.f); float var = s2 * (1.f / 2048.f) - m * m; var = fmaxf(var, 0.f); mu[r] = m; rs[r] = rsqrtf(var + EPS); } }
        __syncthreads();
        for (int gi = 0; gi < 4; ++gi) {
            const int g = gh * 4 + gi;
#pragma unroll 2
            for (int i = 0; i < 8; ++i) { const int idx = tid + 512 * i, t = idx >> 5, s4 = (idx & 31) * 4; f32x4 w = *(const f32x4*)(ws_w + (size_t)g * 16384 + t * 128 + s4);
#pragma unroll
                for (int e = 0; e < 4; ++e) w[e] = (s4 + e <= t) ? w[e] : 0.f;
                u32x2 o = {pk2(w[0], w[1]), pk2(w[2], w[3])}; *(LAS u32x2*)(As + t * 272 + s4 * 2) = o; }
#pragma unroll 2
            for (int i = 0; i < 8; ++i) { const int idx = tid + 512 * i, s = idx >> 5, c8 = idx & 31; float v[8]; up8(*(const u32x4*)(Z + (size_t)(t0 + s) * 4096 + 2048 + g * 256 + c8 * 8), v);
                const float m = mu[s], r = rs[s]; const f32x4 ga = *(const f32x4*)(lng + g * 256 + c8 * 8), gb = *(const f32x4*)(lng + g * 256 + c8 * 8 + 4), ba = *(const f32x4*)(lnb + g * 256 + c8 * 8), bb = *(const f32x4*)(lnb + g * 256 + c8 * 8 + 4);
                const int boff = (((s >> 3) ^ (c8 & 15)) << 4) + (s & 7) * 2;
#pragma unroll
                for (int e = 0; e < 8; ++e) { const float gg = e < 4 ? ga[e] : gb[e - 4], bbv = e < 4 ? ba[e] : bb[e - 4]; const float val = (v[e] - m) * r * gg + bbv;
                    *(LAS bf16_t*)(Bs + (c8 * 8 + e) * 272 + boff) = (bf16_t)(pk2(val, 0.f) & 0xffffu); } }
            __syncthreads();
            f32x4 acc[8][2];
#pragma unroll
            for (int tt = 0; tt < 8; ++tt) { acc[tt][0] = zero4(); acc[tt][1] = zero4(); }
#pragma unroll
            for (int tt = 0; tt < 8; ++tt)
#pragma unroll
                for (int ks = 0; ks <= tt / 2; ++ks) { const bf16x8 yf = *(const LAS bf16x8*)(As + (16 * tt + l15) * 272 + (32 * ks + 8 * g4) * 2);
#pragma unroll
                    for (int ct = 0; ct < 2; ++ct) { const int c = 32 * wave + 16 * ct + l15; const bf16x8 xf = *(const LAS bf16x8*)(Bs + c * 272 + (((4 * ks + g4) ^ ((c >> 3) & 15)) << 4));
                        acc[tt][ct] = MFMA16(xf, yf, acc[tt][ct]); } }
#pragma unroll
            for (int tt = 0; tt < 8; ++tt) { const int t = 16 * tt + l15; const float bias = bs[g * 128 + t];
#pragma unroll
                for (int ct = 0; ct < 2; ++ct) { const int c = g * 256 + 32 * wave + 16 * ct + 4 * g4; const u32x2 uu = *(const u32x2*)(Z + (size_t)(t0 + t) * 4096 + c);
                    const f32x4 a = acc[tt][ct]; u32x2 o = {pk2(bflo(uu[0]) * (a[0] + bias), bfhi(uu[0]) * (a[1] + bias)), pk2(bflo(uu[1]) * (a[2] + bias), bfhi(uu[1]) * (a[3] + bias))};
                    *(u32x2*)(Y + (size_t)(t0 + t) * 2048 + c) = o; } }
            __syncthreads();
        }
    }
}

__device__ __forceinline__ void phase_m2(KP p) {
    const float* A1 = (const float*)(p->ws + OFF_R1); bf16_t* CQN = (bf16_t*)(p->ws + OFF_R1 + 32 * MiB); bf16_t* CKVN = (bf16_t*)(p->ws + OFF_R1 + 40 * MiB); bf16_t* KF = (bf16_t*)(p->ws + OFF_R1 + 96 * MiB);
    const float* CSC = (const float*)(p->ws + OFF_CSC); const float* CSS = (const float*)(p->ws + OFF_CSS);
    const int lane = otid() & 63, wave = otid() >> 6;
    const f32x4 qg = *(const f32x4*)(p->in[14] + 4 * lane); const f32x4 kg = *(const f32x4*)(p->in[15] + 4 * (lane & 31));
    for (int r = obid() * 8 + wave; r < T; r += gridDim.x * 8) {
        const float* a = A1 + (size_t)r * 512;
        const f32x4 cq = *(const f32x4*)(a + 4 * lane); float ss = wave_sum(cq[0] * cq[0] + cq[1] * cq[1] + cq[2] * cq[2] + cq[3] * cq[3]);
        const float rq = rsqrtf(ss * (1.f / 256.f) + EPS);
        { const f32x4 h = cq * rq * qg; u32x2 o = {pk2(h[0], h[1]), pk2(h[2], h[3])}; *(u32x2*)(CQN + (size_t)r * 256 + 4 * lane) = o; }
        const f32x4 ck = *(const f32x4*)(a + 256 + 4 * (lane & 31)); float s2 = lane < 32 ? (ck[0] * ck[0] + ck[1] * ck[1] + ck[2] * ck[2] + ck[3] * ck[3]) : 0.f; s2 = wave_sum(s2);
        const float rk = rsqrtf(s2 * (1.f / 128.f) + EPS);
        { const f32x4 h = ck * rk * kg; u32x2 o = {pk2(h[0], h[1]), pk2(h[2], h[3])}; if (lane >= 32) { o[0] = 0u; o[1] = 0u; } *(u32x2*)(CKVN + (size_t)r * 256 + 4 * lane) = o; }
        if (lane < 32) {
            const float x1 = a[384 + lane], x2 = a[416 + lane], c = CSC[(size_t)r * 32 + lane], s = CSS[(size_t)r * 32 + lane];
            const unsigned pr = pk2(x1 * c - x2 * s, x2 * c + x1 * s); const int b = r >> 12, sq = r & 4095;
#pragma unroll
            for (int h8 = 0; h8 < 8; ++h8) { bf16_t* kp = KF + ((size_t)((b * 8 + h8) * 4096 + sq)) * 192 + 128 + lane; kp[0] = (bf16_t)(pr & 0xffffu); kp[32] = (bf16_t)(pr >> 16); } }
    }
}

__device__ __forceinline__ void phase_attn(KP p, ldsp lds) {
    const bf16_t* QF = (const bf16_t*)(p->ws + OFF_R1 + 48 * MiB); const bf16_t* KF = (const bf16_t*)(p->ws + OFF_R1 + 96 * MiB); const bf16_t* VT = (const bf16_t*)(p->ws + OFF_R1 + 144 * MiB);
    bf16_t* O = (bf16_t*)(p->ws + OFF_R2);
    const int tid = otid(), lane = tid & 63, wave = __builtin_amdgcn_readfirstlane(tid >> 6), l15 = lane & 15, g4 = lane >> 4;
    const int G = gridDim.x, bx = obid(), vcu = (G % 8 == 0) ? (bx % 8) * (G / 8) + bx / 8 : bx;
    constexpr int KB = 25600, VB = 18432, BUF = KB + VB;
    for (int unit = vcu; unit < 256; unit += G) {
        const int bh = unit >> 3, pr = unit & 7, b = bh >> 3, h = bh & 7;
        const unsigned char* kbase = (const unsigned char*)(KF + (size_t)bh * 4096 * 192);
        const unsigned char* vbase = (const unsigned char*)(VT + (size_t)bh * 128 * 4096);
        for (int half = 0; half < 2; ++half) {
            const int qb = half == 0 ? 15 - pr : pr, ntile = 4 * qb + 4;
            const int qrow0 = qb * 256 + 32 * wave;
            bf16x8 Qf[2][6];
#pragma unroll
            for (int qt = 0; qt < 2; ++qt)
#pragma unroll
                for (int ks = 0; ks < 6; ++ks) Qf[qt][ks] = *(const bf16x8*)((const unsigned char*)(QF + (size_t)(bh * 4096 + qrow0) * 192) + (unsigned)(((16 * qt + l15) * 192 + 32 * ks + 8 * g4) * 2));
            f32x4 Oa[2][8]; float mrun[2] = {-1e30f, -1e30f}, lsum[2] = {0.f, 0.f};
#pragma unroll
            for (int qt = 0; qt < 2; ++qt)
#pragma unroll
                for (int d = 0; d < 8; ++d) Oa[qt][d] = zero4();
            u32x4 kr[3], vr[2];
#define ATT_LOADK(j) do { _Pragma("unroll") for (int i = 0; i < 3; ++i) kr[i] = *(const u32x4*)(kbase + (size_t)(j) * 24576 + (unsigned)((tid + 512 * i) * 16)); } while (0)
#define ATT_LOADV(j) do { _Pragma("unroll") for (int i = 0; i < 2; ++i) { const int c = tid + 512 * i, dv = c >> 3, k8 = c & 7; vr[i] = *(const u32x4*)(vbase + (size_t)(j) * 128 + (unsigned)(dv * 8192 + k8 * 16)); } } while (0)
#define ATT_WRITEK(bufi) do { ldsp kb_ = lds + (bufi) * BUF; \
                         _Pragma("unroll") for (int i = 0; i < 3; ++i) { const int c = tid + 512 * i, row = c / 24, c16 = c - row * 24; *(LAS u32x4*)(kb_ + row * 400 + c16 * 16) = kr[i]; } } while (0)
#define ATT_WRITEV(bufi) do { ldsp vb_ = lds + (bufi) * BUF + KB; \
                         _Pragma("unroll") for (int i = 0; i < 2; ++i) { const int c = tid + 512 * i, dv = c >> 3, k8 = c & 7; *(LAS u32x4*)(vb_ + dv * 144 + k8 * 16) = vr[i]; } } while (0)
            ATT_LOADK(0); ATT_LOADV(0); ATT_WRITEK(0); ATT_WRITEV(0); __syncthreads();
#pragma unroll 1
            for (int j = 0; j < ntile; ++j) {
                if (j + 1 < ntile) ATT_LOADK(j + 1);
                const int jj = j - 4 * qb; const bool diag = jj >= 0; const bool active = !(diag && 64 * jj > 32 * wave + 31);
                ldsp Kb = lds + (j & 1) * BUF; ldsp Vb = Kb + KB;
#pragma unroll
                for (int hs = 0; hs < 2; ++hs) {
                    if (active) {
                        f32x4 S[2][2];
#pragma unroll
                        for (int qt = 0; qt < 2; ++qt) { S[qt][0] = zero4(); S[qt][1] = zero4(); }
#pragma unroll
                        for (int ks = 0; ks < 6; ++ks)
#pragma unroll
                            for (int sb = 0; sb < 2; ++sb) { const bf16x8 kx = *(const LAS bf16x8*)(Kb + (16 * (2 * hs + sb) + l15) * 400 + (32 * ks + 8 * g4) * 2);
                                S[0][sb] = MFMA16(kx, Qf[0][ks], S[0][sb]); S[1][sb] = MFMA16(kx, Qf[1][ks], S[1][sb]); }
                        bf16x8 Pf[2];
#pragma unroll
                        for (int qt = 0; qt < 2; ++qt) {
                            if (diag) { int dq = 32 * wave + 16 * qt + l15 - 4 * g4 - 64 * jj; asm volatile("" : "+v"(dq));
#pragma unroll
                                for (int sb = 0; sb < 2; ++sb)
#pragma unroll
                                    for (int e = 0; e < 4; ++e) { if (32 * hs + 16 * sb + e > dq) S[qt][sb][e] = -1e30f; } }
                            float tm = -1e30f;
#pragma unroll
                            for (int sb = 0; sb < 2; ++sb)
#pragma unroll
                                for (int e = 0; e < 4; ++e) tm = fmaxf(tm, S[qt][sb][e]);
                            tm = fmaxf(tm, __shfl_xor(tm, 16)); tm = fmaxf(tm, __shfl_xor(tm, 32));
                            const float mn = fmaxf(mrun[qt], tm), sc = __builtin_amdgcn_exp2f(mrun[qt] - mn); mrun[qt] = mn;
                            float ps = 0.f;
#pragma unroll
                            for (int sb = 0; sb < 2; ++sb)
#pragma unroll
                                for (int e = 0; e < 4; ++e) { const float pe = __builtin_amdgcn_exp2f(S[qt][sb][e] - mn); S[qt][sb][e] = pe; ps += pe; }
                            lsum[qt] = lsum[qt] * sc + ps;
#pragma unroll
                            for (int d = 0; d < 8; ++d) Oa[qt][d] = Oa[qt][d] * sc;
                            Pf[qt] = mk8(pk2(S[qt][0][0], S[qt][0][1]), pk2(S[qt][0][2], S[qt][0][3]), pk2(S[qt][1][0], S[qt][1][1]), pk2(S[qt][1][2], S[qt][1][3]));
                        }
#pragma unroll
                        for (int d = 0; d < 8; ++d) { const bf16x4 va = *(const LAS bf16x4*)(Vb + (16 * d + l15) * 144 + (32 * hs + 4 * g4) * 2), vb2 = *(const LAS bf16x4*)(Vb + (16 * d + l15) * 144 + (32 * hs + 16 + 4 * g4) * 2);
                            const bf16x8 vx = __builtin_shufflevector(va, vb2, 0, 1, 2, 3, 4, 5, 6, 7);
                            Oa[0][d] = MFMA16(vx, Pf[0], Oa[0][d]); Oa[1][d] = MFMA16(vx, Pf[1], Oa[1][d]); }
                    }
                    if (j + 1 < ntile) { if (hs == 0) { ATT_WRITEK((j + 1) & 1); ATT_LOADV(j + 1); } else { ATT_WRITEV((j + 1) & 1); } }
                }
                __syncthreads();
            }
#pragma unroll
            for (int qt = 0; qt < 2; ++qt) { float ls = lsum[qt]; ls += __shfl_xor(ls, 16); ls += __shfl_xor(ls, 32); const float inv = 1.f / ls;
                bf16_t* op = (bf16_t*)((unsigned char*)(O + (size_t)(b * 4096 + qrow0) * 1024 + h * 128) + (unsigned)(((16 * qt + l15) * 1024 + 4 * g4) * 2));
#pragma unroll
                for (int d = 0; d < 8; ++d) { const f32x4 v = Oa[qt][d] * inv; u32x2 o = {pk2(v[0], v[1]), pk2(v[2], v[3])}; *(u32x2*)(op + 16 * d) = o; } }
        }
    }
#undef ATT_LOADK
#undef ATT_LOADV
#undef ATT_WRITEK
#undef ATT_WRITEV
}

template <bool TOF32> __device__ __forceinline__ void hg_load_f_v(const float* HF, const bf16_t* HV, int t0, int col0, LAS float* BC, LAS float* K1f, ldsp K1b, ldsp VTl, int tid) {
#pragma unroll
    for (int i = 0; i < 4; ++i) { const int idx = tid + 512 * i, s = idx >> 5, k4 = (idx & 31) * 4; const f32x4 f = *(const f32x4*)(HF + (size_t)(t0 + s) * 1024 + col0 + k4);
#pragma unroll
        for (int e = 0; e < 4; ++e) BC[s * 129 + k4 + e] = __logf(f[e]);
        if (TOF32) {
#pragma unroll
            for (int e = 0; e < 4; ++e) K1f[s * 129 + k4 + e] = 1.f - f[e];
        } else { u32x2 o = {pk2(1.f - f[0], 1.f - f[1]), pk2(1.f - f[2], 1.f - f[3])}; *(LAS u32x2*)(K1b + s * 272 + k4 * 2) = o; } }
#pragma unroll
    for (int i = 0; i < 2; ++i) { const int idx = tid + 512 * i, s = idx >> 4, v8 = idx & 15; const u32x4 vv = *(const u32x4*)(HV + (size_t)(t0 + s) * 1024 + col0 + v8 * 8);
#pragma unroll
        for (int e = 0; e < 4; ++e) { *(LAS bf16_t*)(VTl + (v8 * 8 + 2 * e) * 144 + s * 2) = (bf16_t)(vv[e] & 0xffffu); *(LAS bf16_t*)(VTl + (v8 * 8 + 2 * e + 1) * 144 + s * 2) = (bf16_t)(vv[e] >> 16); } }
}
__device__ __forceinline__ void phase_ha(KP p, ldsp lds) {
    const float* HF = (const float*)(p->ws + OFF_R1 + 32 * MiB); const bf16_t* HV = (const bf16_t*)(p->ws + OFF_R1 + 96 * MiB);
    bf16_t* LCT = (bf16_t*)(p->ws + OFF_R2); float* DEC = (float*)(p->ws + OFF_R2 + 64 * MiB);
    const int tid = otid(), lane = tid & 63, wave = tid >> 6, l15 = lane & 15, g4 = lane >> 4;
    LAS float* BC = (LAS float*)lds; LAS float* K1 = (LAS float*)(lds + 33024); ldsp KT = lds + 66048; ldsp VTl = lds + 84480;
    for (int u = obid(); u < 2048; u += gridDim.x) {
        const int bh = u >> 6, n = u & 63, b = bh >> 3, h = bh & 7, t0 = b * 4096 + n * 64, col0 = h * 128;
        hg_load_f_v<true>(HF, HV, t0, col0, BC, K1, VTl, VTl, tid);
        __syncthreads();
        if (tid < 128) { float run = 0.f;
#pragma unroll 8
            for (int s = 0; s < 64; ++s) { run += BC[s * 129 + tid]; BC[s * 129 + tid] = run; }
            DEC[(size_t)u * 128 + tid] = __expf(run); }
        __syncthreads();
        { const int sp = tid & 31, kk0 = tid >> 5;
#pragma unroll
          for (int it = 0; it < 8; ++it) { const int k = kk0 + 16 * it; const float bl = BC[63 * 129 + k];
              const float a0 = K1[(2 * sp) * 129 + k] * __expf(bl - BC[(2 * sp) * 129 + k]), a1 = K1[(2 * sp + 1) * 129 + k] * __expf(bl - BC[(2 * sp + 1) * 129 + k]);
              *(LAS unsigned*)(KT + k * 144 + sp * 4) = pk2(a0, a1); } }
        __syncthreads();
        f32x4 acc[8];
#pragma unroll
        for (int vt = 0; vt < 8; ++vt) acc[vt] = zero4();
#pragma unroll
        for (int ks = 0; ks < 2; ++ks) { const bf16x8 xf = *(const LAS bf16x8*)(KT + (16 * wave + l15) * 144 + (32 * ks + 8 * g4) * 2);
#pragma unroll
            for (int vt = 0; vt < 8; ++vt) { const bf16x8 yf = *(const LAS bf16x8*)(VTl + (16 * vt + l15) * 144 + (32 * ks + 8 * g4) * 2); acc[vt] = MFMA16(xf, yf, acc[vt]); } }
#pragma unroll
        for (int vt = 0; vt < 8; ++vt) { u32x2 o = {pk2(acc[vt][0], acc[vt][1]), pk2(acc[vt][2], acc[vt][3])}; *(u32x2*)(LCT + ((size_t)u * 128 + 16 * vt + l15) * 128 + 16 * wave + 4 * g4) = o; }
        __syncthreads();
    }
}
__device__ __forceinline__ void phase_hscan(KP p) {
    bf16_t* LCT = (bf16_t*)(p->ws + OFF_R2); const float* DEC = (const float*)(p->ws + OFF_R2 + 64 * MiB);
    const int gtid = obid() * NTHREADS + otid(), gthreads = gridDim.x * NTHREADS;
    for (int id = gtid; id < 32 * 128 * 32; id += gthreads) {
        const int k4 = id & 31, v = (id >> 5) & 127, bh = id >> 12;
        f32x4 st = zero4();
#pragma unroll 4
        for (int n = 0; n < 64; ++n) { const int u = bh * 64 + n; bf16_t* ptr = LCT + ((size_t)u * 128 + v) * 128 + 4 * k4;
            const u32x2 t = *(const u32x2*)ptr; const f32x4 dec = *(const f32x4*)(DEC + (size_t)u * 128 + 4 * k4);
            u32x2 o = {pk2(st[0], st[1]), pk2(st[2], st[3])}; *(u32x2*)ptr = o;
            st[0] = dec[0] * st[0] + bflo(t[0]); st[1] = dec[1] * st[1] + bfhi(t[0]); st[2] = dec[2] * st[2] + bflo(t[1]); st[3] = dec[3] * st[3] + bfhi(t[1]); }
    }
}
__device__ __forceinline__ void phase_hc(KP p, ldsp lds) {
    const bf16_t* HQ = (const bf16_t*)(p->ws + OFF_R1); const float* HF = (const float*)(p->ws + OFF_R1 + 32 * MiB); const bf16_t* HV = (const bf16_t*)(p->ws + OFF_R1 + 96 * MiB); const bf16_t* HG = (const bf16_t*)(p->ws + OFF_R1 + 128 * MiB);
    const bf16_t* SST = (const bf16_t*)(p->ws + OFF_R2); bf16_t* O = (bf16_t*)(p->ws + OFF_HB); const float* ng = p->in[21];
    const int tid = otid(), lane = tid & 63, wave = tid >> 6, l15 = lane & 15, g4 = lane >> 4;
    LAS float* BC = (LAS float*)lds; ldsp QT = lds + 33024; ldsp KTl = lds + 50432; ldsp QH = lds + 67840; ldsp VTl = lds + 85248; ldsp AT = lds + 103680; LAS float* SSQ = (LAS float*)(lds + 112896);
    for (int u = obid(); u < 2048; u += gridDim.x) {
        const int bh = u >> 6, n = u & 63, b = bh >> 3, h = bh & 7, t0 = b * 4096 + n * 64, col0 = h * 128;
        hg_load_f_v<false>(HF, HV, t0, col0, BC, BC, KTl, VTl, tid);
        u32x4 qraw[2];
#pragma unroll
        for (int i = 0; i < 2; ++i) { const int idx = tid + 512 * i, s = idx >> 4, k8 = idx & 15; qraw[i] = *(const u32x4*)(HQ + (size_t)(t0 + s) * 1024 + col0 + k8 * 8); }
        __syncthreads();
        if (tid < 128) { float run = 0.f;
#pragma unroll 8
            for (int s = 0; s < 64; ++s) { run += BC[s * 129 + tid]; BC[s * 129 + tid] = run; } }
        __syncthreads();
#pragma unroll
        for (int i = 0; i < 2; ++i) { const int idx = tid + 512 * i, s = idx >> 4, k8 = idx & 15; float q[8], kk[8], qt[8], qh[8]; up8(qraw[i], q); up8(*(const LAS u32x4*)(KTl + s * 272 + k8 * 16), kk);
#pragma unroll
            for (int e = 0; e < 8; ++e) { const int k = k8 * 8 + e; const float bc = BC[s * 129 + k], bm = BC[31 * 129 + k]; qt[e] = q[e] * __expf(bc - bm); qh[e] = q[e] * __expf(bc); kk[e] = kk[e] * __expf(bm - bc); }
            u32x4 o1 = {pk2(qt[0], qt[1]), pk2(qt[2], qt[3]), pk2(qt[4], qt[5]), pk2(qt[6], qt[7])}, o2 = {pk2(qh[0], qh[1]), pk2(qh[2], qh[3]), pk2(qh[4], qh[5]), pk2(qh[6], qh[7])}, o3 = {pk2(kk[0], kk[1]), pk2(kk[2], kk[3]), pk2(kk[4], kk[5]), pk2(kk[6], kk[7])};
            *(LAS u32x4*)(QT + s * 272 + k8 * 16) = o1; *(LAS u32x4*)(QH + s * 272 + k8 * 16) = o2; *(LAS u32x4*)(KTl + s * 272 + k8 * 16) = o3; }
        __syncthreads();
        { const int st = wave & 3;
#pragma unroll
          for (int ti = 0; ti < 2; ++ti) { const int tt = 2 * (wave >> 2) + ti; f32x4 a = zero4();
              if (st <= tt) {
#pragma unroll
                  for (int ks = 0; ks < 4; ++ks) { const bf16x8 xf = *(const LAS bf16x8*)(KTl + (16 * st + l15) * 272 + (32 * ks + 8 * g4) * 2), yf = *(const LAS bf16x8*)(QT + (16 * tt + l15) * 272 + (32 * ks + 8 * g4) * 2); a = MFMA16(xf, yf, a); }
                  const int t = 16 * tt + l15;
#pragma unroll
                  for (int e = 0; e < 4; ++e) { const int s = 16 * st + 4 * g4 + e; if (s > t) a[e] = 0.f; } }
              u32x2 o = {pk2(a[0], a[1]), pk2(a[2], a[3])}; *(LAS u32x2*)(AT + (16 * tt + l15) * 144 + (16 * st + 4 * g4) * 2) = o; } }
        __syncthreads();
        { const int tt = wave >> 1, vh = wave & 1; f32x4 acc[4];
#pragma unroll
          for (int vi = 0; vi < 4; ++vi) acc[vi] = zero4();
#pragma unroll
          for (int ks = 0; ks < 2; ++ks) if (32 * ks <= 16 * tt + 15) { const bf16x8 yf = *(const LAS bf16x8*)(AT + (16 * tt + l15) * 144 + (32 * ks + 8 * g4) * 2);
#pragma unroll
              for (int vi = 0; vi < 4; ++vi) { const bf16x8 xf = *(const LAS bf16x8*)(VTl + (16 * (4 * vh + vi) + l15) * 144 + (32 * ks + 8 * g4) * 2); acc[vi] = MFMA16(xf, yf, acc[vi]); } }
#pragma unroll
          for (int ks = 0; ks < 4; ++ks) { const bf16x8 yf = *(const LAS bf16x8*)(QH + (16 * tt + l15) * 272 + (32 * ks + 8 * g4) * 2);
#pragma unroll
              for (int vi = 0; vi < 4; ++vi) { const bf16x8 xf = *(const bf16x8*)(SST + ((size_t)u * 128 + 16 * (4 * vh + vi) + l15) * 128 + 32 * ks + 8 * g4); acc[vi] = MFMA16(xf, yf, acc[vi]); } }
          float sq = 0.f;
#pragma unroll
          for (int vi = 0; vi < 4; ++vi)
#pragma unroll
              for (int e = 0; e < 4; ++e) sq += acc[vi][e] * acc[vi][e];
          sq += __shfl_xor(sq, 16); sq += __shfl_xor(sq, 32);
          if (g4 == 0) SSQ[(16 * tt + l15) * 2 + vh] = sq;
          __syncthreads();
          const int t = 16 * tt + l15; const float rstd = rsqrtf((SSQ[t * 2] + SSQ[t * 2 + 1]) * (1.f / 128.f) + EPS);
#pragma unroll
          for (int vi = 0; vi < 4; ++vi) { const int v = 16 * (4 * vh + vi) + 4 * g4; const f32x4 gn = *(const f32x4*)(ng + v); const u32x2 gg = *(const u32x2*)(HG + (size_t)(t0 + t) * 1024 + col0 + v);
              const f32x4 a = acc[vi] * rstd * gn; u32x2 o = {pk2(a[0] * bflo(gg[0]), a[1] * bfhi(gg[0])), pk2(a[2] * bflo(gg[1]), a[3] * bfhi(gg[1]))};
              *(u32x2*)(O + (size_t)(t0 + t) * 1024 + col0 + v) = o; } }
        __syncthreads();
    }
}

__global__ void __launch_bounds__(NTHREADS, 2) fwd_kernel(Params pk) {
    extern __shared__ __attribute__((aligned(16))) unsigned char smem[];
    ldsp lds = (ldsp)smem;
    const int ph_lo = pk.ph_lo, ph_hi = pk.ph_hi;
    for (int ph = ph_lo; ph < ph_hi; ++ph) {
        KP p = (KP)__builtin_amdgcn_kernarg_segment_ptr();
        asm volatile("" : "+s"(p));
        const int op = p->op[ph], layer = p->lay[ph];
        unsigned char* ws = p->ws;
        float* MOD = (float*)(ws + OFF_MOD); bf16_t* WT = (bf16_t*)(ws + OFF_WT); bf16_t* HB = (bf16_t*)(ws + OFF_HB);
        bf16_t* R1 = (bf16_t*)(ws + OFF_R1); bf16_t* R2 = (bf16_t*)(ws + OFF_R2);
        const float* modl = MOD + (size_t)layer * 4 * 6144;
        const float* xcur = (layer == 0 && op <= OP_GOUT) ? p->in[0] : p->out;
        switch (op) {
        case OP_PRO: phase_prologue(p, lds); break;
        case OP_NORM1: phase_norm(xcur, p->in[5] + layer * 1024, modl + 0, modl + 1024, HB); if (layer > 0) prep_layer(p, layer, lds); break;
        case OP_NORM2: phase_norm(p->out, p->in[6] + layer * 1024, modl + 3072, modl + 4096, HB); break;
        case OP_G1: { EpiBf16<1> E{R1, 4096}; run_gemm(lds, HB, WT + WT_MIXA, T, 4096, 1024, E); } break;
        case OP_GSP: phase_gsp(p, layer / 3, lds); break;
        case OP_GOUT: { EpiRes E{xcur, p->out, modl + 2048}; run_gemm(lds, R2, WT + WT_MIXB, T, 1024, 2048, E); } break;
        case OP_M1: { EpiF32 E{(float*)R1, 512}; run_gemm(lds, HB, WT + WT_MIXA, T, 512, 1024, E); } break;
        case OP_M2: phase_m2(p); break;
        case OP_M3: { EpiQ EQ{(bf16_t*)(ws + OFF_R1 + 48 * MiB), (const float*)(ws + OFF_CSC), (const float*)(ws + OFF_CSS), 0.07216878364870322f * 1.4426950408889634f}; run_gemm(lds, (const bf16_t*)(ws + OFF_R1 + 32 * MiB), WT + WT_MQKV, T, 1536, 256, EQ); EpiKV EK{(bf16_t*)(ws + OFF_R1 + 96 * MiB), (bf16_t*)(ws + OFF_R1 + 144 * MiB)}; run_gemm(lds, (const bf16_t*)(ws + OFF_R1 + 40 * MiB), WT + WT_MQKV + 393216, T, 2048, 256, EK); } break;
        case OP_ATT: phase_attn(p, lds); break;
        case OP_MOUT: { EpiRes E{p->out, p->out, modl + 2048}; run_gemm(lds, R2, WT + WT_MIXB, T, 1024, 1024, E); } break;
        case OP_H1: { EpiHg E{ws + OFF_R1, (const float*)(ws + OFF_LB)}; run_gemm(lds, HB, WT + WT_MIXA, T, 4096, 1024, E); } break;
        case OP_HA: phase_ha(p, lds); break;
        case OP_HSCAN: phase_hscan(p); break;
        case OP_HC: phase_hc(p, lds); break;
        case OP_HOUT: { EpiRes E{p->out, p->out, modl + 2048}; run_gemm(lds, HB, WT + WT_MIXB, T, 1024, 1024, E); } break;
        case OP_FUP: { EpiBf16<0> E{R1, 5632}; run_gemm(lds, HB, WT + WT_FUP, T, 5632, 1024, E); } break;
        case OP_FCONV: phase_fconv(R1, R2, p->in[24] + (size_t)layer * 3 * 5632, p->in[25] + (size_t)layer * 5632); break;
        case OP_FDN: { EpiRes E{p->out, p->out, modl + 5120}; run_gemm(lds, R2, WT + WT_FDN, T, 1024, 2816, E); } break;
        case OP_FINAL: phase_final(p->out, p->in[27]); break;
        default: break;
        }
        if (ph + 1 < ph_hi) { __syncthreads(); cg::this_grid().sync(); }
    }
}

#ifndef MULTI_LAUNCH
#define MULTI_LAUNCH 0
#endif
extern "C" void kernel_launch(void* const* d_in, const int* in_sizes, int n_in, void* d_out, int out_size, void* d_ws, size_t ws_size, hipStream_t stream) {
    static int grid = 0;
    if (grid == 0) {
        int dev = 0, cus = 0, per_cu = 0;
        hipGetDevice(&dev); hipDeviceGetAttribute(&cus, hipDeviceAttributeMultiprocessorCount, dev);
        hipFuncSetAttribute((const void*)fwd_kernel, hipFuncAttributeMaxDynamicSharedMemorySize, LDS_BYTES);
        hipOccupancyMaxActiveBlocksPerMultiprocessor(&per_cu, (const void*)fwd_kernel, NTHREADS, LDS_BYTES);
        if (per_cu < 1) per_cu = 1;
        grid = cus * 1; (void)per_cu;
        if (ws_size < WS_END) fprintf(stderr, "kernel_launch: workspace too small: %zu < %zu\n", ws_size, (size_t)WS_END);
        (void)hipGetLastError();
    }
    Params p{};
    for (int i = 0; i < 28; ++i) p.in[i] = (const float*)d_in[i];
    p.out = (float*)d_out; p.ws = (unsigned char*)d_ws;
    int n = 0;
    auto add = [&](int op, int l) { p.op[n] = (unsigned char)op; p.lay[n] = (unsigned char)l; ++n; };
    add(OP_PRO, 0);
    for (int l = 0; l < 4; ++l) {
        add(OP_NORM1, l);
        if (l % 3 == 0) { add(OP_G1, l); add(OP_GSP, l); add(OP_GOUT, l); }
        else if (l % 3 == 1) { add(OP_M1, l); add(OP_M2, l); add(OP_M3, l); add(OP_ATT, l); add(OP_MOUT, l); }
        else { add(OP_H1, l); add(OP_HA, l); add(OP_HSCAN, l); add(OP_HC, l); add(OP_HOUT, l); }
        add(OP_NORM2, l); add(OP_FUP, l); add(OP_FCONV, l); add(OP_FDN, l);
    }
    add(OP_FINAL, 0);
#if MULTI_LAUNCH
    for (int i = 0; i < n; ++i) { p.ph_lo = i; p.ph_hi = i + 1; hipLaunchKernelGGL(fwd_kernel, dim3(grid), dim3(NTHREADS), LDS_BYTES, stream, p); }
#else
    p.ph_lo = 0; p.ph_hi = n;
    void* args[] = {&p};
    hipError_t e = hipLaunchCooperativeKernel((const void*)fwd_kernel, dim3(grid), dim3(NTHREADS), args, LDS_BYTES, stream);
    if (e != hipSuccess) fprintf(stderr, "cooperative launch failed: %s (grid %d)\n", hipGetErrorString(e), grid);
#endif
}
```

```cpp
#include <hip/hip_runtime.h>
#include <hip/hip_cooperative_groups.h>
#include <cstdio>
#include <cstdint>
namespace cg = cooperative_groups;
__device__ __forceinline__ int otid_w(int w) { int l; asm volatile("v_mbcnt_lo_u32_b32 %0, -1, 0\n\tv_mbcnt_hi_u32_b32 %0, -1, %0" : "=v"(l)); return (w << 6) | l; }
#define otid() otid_w(s_wv)
__device__ __forceinline__ int obid() { int t = blockIdx.x; asm volatile("" : "+s"(t)); return t; }
namespace pg8 {
#define PG8_LAS __attribute__((address_space(3)))
typedef unsigned short bf16_t;
typedef short bf16x8 __attribute__((ext_vector_type(8)));
typedef float f32x4 __attribute__((ext_vector_type(4)));
typedef unsigned u32x4 __attribute__((ext_vector_type(4)));
constexpr int BM = 256, BK = 64, HALF = 128, HTB = HALF * BK * 2  , STAGE_BYTES = 8 * HTB, NXCD = 8, WGM = 8;

__host__ __device__ __forceinline__ int lds_byte(int r, int c) { const int st = (r >> 4) * 2 + (c >> 5), rr = r & 15, cc = c & 31, ob = rr * 64 + cc * 2; return st * 1024 + (ob ^ (((ob >> 9) & 1) << 5)); }
__host__ __device__ __forceinline__ void stage_rc(int b, int& R, int& C) { const int st = b / 1024, sb = b % 1024, swz = sb ^ (((sb >> 9) & 1) << 5); R = (st >> 1) * 16 + swz / 64; C = (st & 1) * 32 + (swz % 64) / 2; }
__host__ __device__ __forceinline__ int perm32(int rho) { const int n = rho >> 4, i = rho & 15; return 8 * (i >> 2) + 4 * n + (i & 3); }

struct Unit { int pm, pn; };
struct Gemm { const bf16_t* A; const bf16_t* Bt; int M, N, K; };

struct StaticOrder {
    int nM, nN, nwg, G, c;
    __host__ __device__ void init(int M, int N, int G_, int c_) { nM = M / BM; nN = N / BM; nwg = nM * nN; G = G_; c = c_; }
    __host__ __device__ bool next(int i, Unit& u) const {
        const long L = (long)i * G + c; if (L >= nwg) return false;
        int wgid = (int)L; { const int q = nwg / NXCD, r = nwg % NXCD, xcd = wgid % NXCD, off = wgid / NXCD; wgid = (xcd < r ? xcd * (q + 1) : r * (q + 1) + (xcd - r) * q) + off; }
        const int nig = WGM * nN, gid = wgid / nig, fm = gid * WGM, gsz = (nM - fm) < WGM ? (nM - fm) : WGM;
        u.pm = fm + ((wgid % nig) % gsz); u.pn = (wgid % nig) / gsz; return true;
    }
    __device__ __forceinline__ void a_ready(const Unit&) const {}
    __device__ __forceinline__ void done(const Unit&) const {}
};
__device__ __forceinline__ unsigned cvt_pk_bf16(float lo, float hi) { unsigned r; asm volatile("v_cvt_pk_bf16_f32 %0, %1, %2" : "=v"(r) : "v"(lo), "v"(hi)); return r; }

template <class Epi, class Sched, bool STAMP = false>
__device__ __forceinline__ void gemm_phase(const int s_wv, PG8_LAS unsigned char* lds, const Gemm g, const Sched& S, const Epi& E, unsigned long long* stamps) {
    const int tid = otid(), wid = __builtin_amdgcn_readfirstlane(tid >> 6), lane = tid & 63, wr = wid >> 2, wc = wid & 3, fr = lane & 15, fq = lane >> 4;
    const int K = g.K, nt = K / BK;
    int ts_lo = 0, ts_hi = 0, nts = 0; const unsigned long long rt_entry = STAMP ? (unsigned long long)wall_clock64() : 0ull;
#define PG8_STAMP() do { if (STAMP && wid == 0 && nts < 64) { const unsigned long long _c = (unsigned long long)clock64(); \
        ts_lo = (lane == nts) ? (int)(unsigned)_c : ts_lo; ts_hi = (lane == nts) ? (int)(unsigned)(_c >> 32) : ts_hi; ++nts; } } while (0)
    PG8_STAMP();
    unsigned voffA[2], voffB[2];
#pragma unroll
    for (int i = 0; i < 2; ++i) { int R, C; stage_rc(tid * 16 + i * 8192, R, C); const int Rb = Epi::PERM ? ((R & ~31) + perm32(R & 31)) : R;
        const int Ra = Epi::PERMA ? (62 * (R >> 6) + 4 * (R & 15) + ((R >> 4) & 3)) : R; voffA[i] = (unsigned)(Ra * K + C) * 2u; voffB[i] = (unsigned)(Rb * K + C) * 2u; }
    const size_t kstep = (size_t)(BK * 2);
    const size_t hstep = (size_t)HALF * K * 2;
    const size_t tstep = 2 * hstep;
    const size_t hstepA = Epi::PERMA ? (size_t)124 * K * 2 : hstep, tstepA = Epi::PERMA ? (size_t)248 * K * 2 : tstep;
    const unsigned ldsw = (unsigned)wid * 1024u;
    const int aoff = lds_byte(wr * 64 + fr, fq * 8), boff = lds_byte(wc * 32 + fr, fq * 8);
#define PG8_SA(b, h) (((b) * 2 + (h)) * HTB)
#define PG8_SB(b, h) ((4 + (b) * 2 + (h)) * HTB)
#define PG8_STAGE(bufoff, gbase, voff) do { _Pragma("unroll") for (int _i = 0; _i < 2; ++_i) \
        __builtin_amdgcn_global_load_lds((const unsigned*)((const char*)(gbase) + (voff)[_i]), (PG8_LAS unsigned*)(lds + (bufoff) + ldsw + _i * 8192), 16, 0, 0); } while (0)
#define PG8_LDA(dst, b, h) do { _Pragma("unroll") for (int m = 0; m < 4; ++m) _Pragma("unroll") for (int k = 0; k < 2; ++k) dst[m][k] = *(const PG8_LAS bf16x8*)(lds + PG8_SA(b, h) + aoff + m * 2048 + k * 1024); } while (0)
#define PG8_LDB(dst, b, h) do { _Pragma("unroll") for (int n = 0; n < 2; ++n) _Pragma("unroll") for (int k = 0; k < 2; ++k) dst[n][k] = *(const PG8_LAS bf16x8*)(lds + PG8_SB(b, h) + boff + n * 2048 + k * 1024); } while (0)
#define PG8_MMA(ai, bj, At, Bt) do { __builtin_amdgcn_s_setprio(1); _Pragma("unroll") for (int m = 0; m < 4; ++m) _Pragma("unroll") for (int n = 0; n < 2; ++n) _Pragma("unroll") for (int k = 0; k < 2; ++k) \
        acc[ai][bj][m][n] = __builtin_amdgcn_mfma_f32_16x16x32_bf16(Bt[n][k], At[m][k], acc[ai][bj][m][n], 0, 0, 0); __builtin_amdgcn_s_setprio(0); } while (0)
#define PG8_WAIT_V(n) asm volatile("s_waitcnt vmcnt(" #n ")" ::: "memory")
#define PG8_WAIT_L(n) asm volatile("s_waitcnt lgkmcnt(" #n ")" ::: "memory")
#define PG8_BAR __builtin_amdgcn_s_barrier()
#define PG8_SCHED __builtin_amdgcn_sched_barrier(0)
    Unit cur, nxt; int ui = 0;
    if (!S.next(0, cur)) return;
    f32x4 acc[2][2][4][2];
#pragma unroll
    for (int a = 0; a < 2; ++a)
#pragma unroll
        for (int b = 0; b < 2; ++b)
#pragma unroll
            for (int m = 0; m < 4; ++m)
#pragma unroll
                for (int n = 0; n < 2; ++n) acc[a][b][m][n] = (f32x4){0.f, 0.f, 0.f, 0.f};
    bf16x8 At[4][2], B0[2][2], B1[2][2];
    const char* cA = (const char*)g.A + (size_t)cur.pm * tstepA; const char* cB = (const char*)g.Bt + (size_t)cur.pn * tstep;
    S.a_ready(cur);
    PG8_STAGE(PG8_SB(0, 0), cB, voffB); PG8_STAGE(PG8_SA(0, 0), cA, voffA); PG8_STAGE(PG8_SB(0, 1), cB + hstep, voffB); PG8_STAGE(PG8_SA(0, 1), cA + hstepA, voffA);
    if (wr == 1) PG8_BAR;
    PG8_WAIT_V(4); PG8_BAR;
    PG8_STAGE(PG8_SB(1, 0), cB + kstep, voffB); PG8_STAGE(PG8_SA(1, 0), cA + kstep, voffA); PG8_STAGE(PG8_SB(1, 1), cB + hstep + kstep, voffB);
    PG8_WAIT_V(6); PG8_BAR;
    PG8_STAMP();
    for (;;) {
        const bool has_next = S.next(ui + 1, nxt);
        const char* nA = has_next ? (const char*)g.A + (size_t)nxt.pm * tstepA : cA; const char* nB = has_next ? (const char*)g.Bt + (size_t)nxt.pn * tstep : cB;
        for (int t = 0; t < nt; t += 2) {
            const bool last = (t == nt - 2);
            const char* a1 = cA + (size_t)(t + 1) * kstep;
            const char* a2 = last ? nA : cA + (size_t)(t + 2) * kstep; const char* b2 = last ? nB : cB + (size_t)(t + 2) * kstep;
            const char* a3 = a2 + kstep; const char* b3 = b2 + kstep;
            if (last && has_next) S.a_ready(nxt);
            PG8_LDB(B0, 0, 0); PG8_SCHED; PG8_LDA(At, 0, 0); PG8_STAGE(PG8_SA(1, 1), a1 + hstepA, voffA);
            PG8_WAIT_L(8); PG8_BAR; PG8_WAIT_L(0); PG8_MMA(0, 0, At, B0); PG8_BAR; PG8_SCHED;
            PG8_LDB(B1, 0, 1); PG8_STAGE(PG8_SB(0, 0), b2, voffB);
            PG8_BAR; PG8_WAIT_L(0); PG8_MMA(0, 1, At, B1); PG8_BAR;
            PG8_LDA(At, 0, 1); PG8_STAGE(PG8_SA(0, 0), a2, voffA);
            PG8_BAR; PG8_WAIT_L(0); PG8_MMA(1, 0, At, B0); PG8_BAR; PG8_SCHED;
            PG8_STAGE(PG8_SB(0, 1), b2 + hstep, voffB);
            PG8_WAIT_V(6); PG8_BAR; PG8_MMA(1, 1, At, B1); PG8_BAR;
            PG8_LDB(B0, 1, 0); PG8_SCHED; PG8_LDA(At, 1, 0); PG8_STAGE(PG8_SA(0, 1), a2 + hstepA, voffA);
            PG8_WAIT_L(8); PG8_BAR; PG8_WAIT_L(0); PG8_MMA(0, 0, At, B0); PG8_BAR; PG8_SCHED;
            PG8_LDB(B1, 1, 1); PG8_STAGE(PG8_SB(1, 0), b3, voffB);
            PG8_BAR; PG8_WAIT_L(0); PG8_MMA(0, 1, At, B1); PG8_BAR;
            PG8_LDA(At, 1, 1); PG8_STAGE(PG8_SA(1, 0), a3, voffA);
            PG8_BAR; PG8_WAIT_L(0); PG8_MMA(1, 0, At, B0); PG8_BAR; PG8_SCHED;
            PG8_STAGE(PG8_SB(1, 1), b3 + hstep, voffB);
            PG8_WAIT_V(6); PG8_BAR; PG8_MMA(1, 1, At, B1); PG8_BAR;
        }
        PG8_STAMP();
        if constexpr (!Epi::AFTER_DRAIN) { E(acc, cur, wr, wc, fr, fq); S.done(cur); }
        PG8_STAMP();
        if (!has_next) break;
#pragma unroll
        for (int a = 0; a < 2; ++a)
#pragma unroll
            for (int b = 0; b < 2; ++b)
#pragma unroll
                for (int m = 0; m < 4; ++m)
#pragma unroll
                    for (int n = 0; n < 2; ++n) acc[a][b][m][n] = (f32x4){0.f, 0.f, 0.f, 0.f};
        cur = nxt; cA = nA; cB = nB; ++ui;
    }
    PG8_WAIT_V(0);
    if (wr == 0) PG8_BAR;
    PG8_BAR;
    if constexpr (Epi::AFTER_DRAIN) { E.fused(acc, cur, wr, wc, fr, fq, lds, wid, lane); S.done(cur); }
    PG8_STAMP();
    if (STAMP && wid == 0) { stamps[lane] = lane < nts ? (((unsigned long long)(unsigned)ts_hi << 32) | (unsigned)ts_lo) : 0ull;
        if (lane == 62) stamps[62] = rt_entry; if (lane == 63) stamps[63] = (unsigned long long)wall_clock64(); }
#undef PG8_STAMP
#undef PG8_SA
#undef PG8_SB
#undef PG8_STAGE
#undef PG8_LDA
#undef PG8_LDB
#undef PG8_MMA
#undef PG8_WAIT_V
#undef PG8_WAIT_L
#undef PG8_BAR
#undef PG8_SCHED
}
}

using pg8::bf16_t; using pg8::bf16x8; using pg8::f32x4; using pg8::u32x4; using pg8::Unit;
typedef unsigned u32x2 __attribute__((ext_vector_type(2)));
typedef short bf16x4 __attribute__((ext_vector_type(4)));
#define LAS __attribute__((address_space(3)))
typedef LAS unsigned char* ldsp;
#define XB_TMO      128
#define XB_XCNT(j)  (256  + 64 * (j))
#define XB_XSUB(j)  (1280 + 64 * (j))
#define XB_XGEN(j)  (2304 + 64 * (j))
#define XB_TOP      3328
#define XB_TOPGEN   3392
#define XCD_BAR_WORDS 3456
#define XB_SPIN_CAP (1u << 18)

__device__ __forceinline__ unsigned xb_ld(unsigned* p)              { return __hip_atomic_load(p, __ATOMIC_RELAXED, __HIP_MEMORY_SCOPE_AGENT); }
__device__ __forceinline__ unsigned xb_add(unsigned* p, unsigned v) { return __hip_atomic_fetch_add(p, v, __ATOMIC_RELAXED, __HIP_MEMORY_SCOPE_AGENT); }
__device__ __forceinline__ unsigned xb_xcc_id() { return (unsigned)__builtin_amdgcn_s_getreg((3 << 11) | 20) & 0xFu; }
#define XB_SPIN(cond, bar) do { unsigned _sp = 0; while (cond) { __builtin_amdgcn_s_sleep(1); \
    if ((++_sp & 255u) == 0u) { if (xb_ld(&(bar)[XB_TMO])) break; if (_sp > XB_SPIN_CAP) { atomicAdd(&(bar)[XB_TMO], 1u); break; } } } } while (0)

struct XcdBarrier {
    unsigned* bar; unsigned x;
    volatile LAS unsigned* st;
};

__device__ __forceinline__ XcdBarrier xcd_barrier_post(unsigned* bar, volatile LAS unsigned* st, const int tid0) {
    XcdBarrier b; b.bar = bar; b.x = xb_xcc_id(); b.st = st;
    if (tid0 == 0) (void)xb_add(&bar[XB_XCNT(b.x)], 1u);
    return b;
}
__device__ __forceinline__ void xcd_barrier_complete(unsigned* bar, unsigned x, unsigned& nloc, unsigned& nx) {
    const unsigned G = gridDim.x * gridDim.y * gridDim.z;
    unsigned sum, cnt, mine, sp = 0u;
    for (;;) {
        sum = 0u; cnt = 0u; mine = 0u;
#pragma unroll
        for (unsigned j = 0; j < 16; ++j) { const unsigned c = xb_ld(&bar[XB_XCNT(j)]); sum += c; cnt += (c > 0u) ? 1u : 0u; mine = (j == x) ? c : mine; }
        if (sum == G) break;
        __builtin_amdgcn_s_sleep(1);
        if ((++sp & 255u) == 0u) { if (xb_ld(&bar[XB_TMO])) break; if (sp > XB_SPIN_CAP) { atomicAdd(&bar[XB_TMO], 1u); break; } }
    }
    nloc = mine > 0u ? mine : 1u; nx = cnt > 0u ? cnt : 1u;
}

__device__ __forceinline__ void xcd_barrier(const XcdBarrier& b, const int tid0) {
    asm volatile("s_waitcnt vmcnt(0)" ::: "memory");
    __syncthreads();
    if (tid0 == 0) {
        unsigned* bar = b.bar;
        __builtin_amdgcn_s_waitcnt(0);
        unsigned nloc = b.st[0], nx = b.st[1];
        if (nloc == 0u) { xcd_barrier_complete(bar, b.x, nloc, nx); b.st[0] = nloc; b.st[1] = nx; }
        const unsigned old = xb_add(&bar[XB_XSUB(b.x)], 1u);
        const unsigned gen = old / nloc;
        if (old + 1u == (gen + 1u) * nloc) {
            __builtin_amdgcn_fence(__ATOMIC_RELEASE, "agent");
            asm volatile("s_waitcnt vmcnt(0)" ::: "memory");
            const unsigned og = xb_add(&bar[XB_TOP], 1u);
            const unsigned tg = og / nx;
            if (og + 1u == (tg + 1u) * nx) xb_add(&bar[XB_TOPGEN], 1u);
            else XB_SPIN(xb_ld(&bar[XB_TOPGEN]) == tg, bar);
            __builtin_amdgcn_fence(__ATOMIC_ACQUIRE, "agent");
            xb_add(&bar[XB_XGEN(b.x)], 1u);
            asm volatile("s_waitcnt vmcnt(0)" ::: "memory");
        } else {
            XB_SPIN(xb_ld(&bar[XB_XGEN(b.x)]) == gen, bar);
            __builtin_amdgcn_fence(__ATOMIC_ACQUIRE, "agent");
            asm volatile("s_waitcnt vmcnt(0)" ::: "memory");
        }
    }
    __syncthreads();
}


constexpr int T = 16384, D = 1024, SEQ = 4096, NBATCH = 4, FF = 2816;
constexpr int NTHREADS = 512, LDS_BYTES = 131072 + 16;
constexpr float EPS = 1e-6f;
constexpr size_t MiB = 1024 * 1024;
constexpr size_t OFF_MOD = 0, OFF_LB = 512 * 1024, OFF_CWB = 576 * 1024, OFF_BAR = 768 * 1024, OFF_CSC = 1 * MiB, OFF_CSS = 3 * MiB, OFF_WT = 8 * MiB, OFF_HB = 40 * MiB, OFF_R1 = 72 * MiB, OFF_R2 = 248 * MiB, OFF_XB = 336 * MiB, WS_END = 368 * MiB;
constexpr size_t WT_MIXA = 0, WT_MIXB = 4194304, WT_FUP = 6291456, WT_FDN = 12058624, WT_MQKV = 524288;
enum { OP_PRO = 0, OP_NORM1, OP_G1, OP_GSP, OP_GOUT, OP_M1, OP_M2, OP_M3, OP_ATT, OP_MOUT, OP_H1, OP_HA, OP_HSCAN, OP_HC, OP_HOUT, OP_NORM2, OP_FUP, OP_FCONV, OP_FDN, OP_FINAL };

struct Params;
struct Params {
    const float* in[28];
    float* out;
    unsigned char* ws;
    int ph_lo, ph_hi;
    unsigned char op[48];
    unsigned char lay[48];
};

typedef const __attribute__((address_space(4))) Params* KP;
__device__ __forceinline__ unsigned pk2(float lo, float hi) { return pg8::cvt_pk_bf16(lo, hi); }
__device__ __forceinline__ float bflo(unsigned u) { return __uint_as_float(u << 16); }
__device__ __forceinline__ float bfhi(unsigned u) { return __uint_as_float(u & 0xffff0000u); }
__device__ __forceinline__ float shx(float v, int m, int lane) { return __int_as_float(__builtin_amdgcn_ds_bpermute((lane ^ m) << 2, __float_as_int(v))); }
__device__ __forceinline__ float wave_sum(float v, int lane) {
#pragma unroll
    for (int o = 32; o >= 1; o >>= 1) v += shx(v, o, lane);
    return v;
}
__device__ __forceinline__ float fast_sigmoid(float x) { return __builtin_amdgcn_rcpf(1.f + __builtin_amdgcn_exp2f(-1.4426950408889634f * x)); }
__device__ __forceinline__ float gelu_tanh(float x) { const float u = 0.7978845608028654f * (x + 0.044715f * x * x * x); return x * fast_sigmoid(2.f * u); }
__device__ __forceinline__ bf16x8 mk8(unsigned a, unsigned b, unsigned c, unsigned d) { u32x4 v = {a, b, c, d}; return __builtin_bit_cast(bf16x8, v); }
__device__ __forceinline__ f32x4 zero4() { float z = 0.f; asm volatile("" : "+v"(z)); return (f32x4){z, z, z, z}; }
#define MFMA16(X, Y, C) __builtin_amdgcn_mfma_f32_16x16x32_bf16((X), (Y), (C), 0, 0, 0)

template <int ACT> struct EpiBf16 {
    static constexpr bool PERM = true, AFTER_DRAIN = false, PERMA = false;
    bf16_t* O; int ldc;
    __device__ __forceinline__ void operator()(const f32x4 (&acc)[2][2][4][2], const Unit& u, int wr, int wc, int fr, int fq) const {
        const int row0 = u.pm * 256 + wr * 64 + fr, col0 = u.pn * 256 + wc * 32 + 8 * fq;
#pragma unroll
        for (int ai = 0; ai < 2; ++ai)
#pragma unroll
            for (int m = 0; m < 4; ++m) { bf16_t* rowp = O + (size_t)(row0 + ai * 128 + m * 16) * ldc + col0;
#pragma unroll
                for (int bj = 0; bj < 2; ++bj) { f32x4 v0 = acc[ai][bj][m][0], v1 = acc[ai][bj][m][1];
                    if (ACT == 1) {
#pragma unroll
                        for (int e = 0; e < 4; ++e) { v0[e] = gelu_tanh(v0[e]); v1[e] = gelu_tanh(v1[e]); } }
                    u32x4 o = {pk2(v0[0], v0[1]), pk2(v0[2], v0[3]), pk2(v1[0], v1[1]), pk2(v1[2], v1[3])};
                    *(u32x4*)(rowp + bj * 128) = o; } }
    }
};
struct EpiF32 {
    static constexpr bool PERM = false, AFTER_DRAIN = false, PERMA = false;
    float* C; int ldc;
    __device__ __forceinline__ void operator()(const f32x4 (&acc)[2][2][4][2], const Unit& u, int wr, int wc, int fr, int fq) const {
        const int row0 = u.pm * 256 + wr * 64 + fr, col0 = u.pn * 256 + wc * 32 + 4 * fq;
#pragma unroll
        for (int ai = 0; ai < 2; ++ai)
#pragma unroll
            for (int m = 0; m < 4; ++m) { float* rowp = C + (size_t)(row0 + ai * 128 + m * 16) * ldc + col0;
#pragma unroll
                for (int bj = 0; bj < 2; ++bj)
#pragma unroll
                    for (int n = 0; n < 2; ++n) *(f32x4*)(rowp + bj * 128 + n * 16) = acc[ai][bj][m][n]; }
    }
};
struct EpiRes {
    static constexpr bool PERM = true, AFTER_DRAIN = false, PERMA = false;
    const bf16_t* Xs; bf16_t* Xd; const float* gate;
    __device__ __forceinline__ void operator()(const f32x4 (&acc)[2][2][4][2], const Unit& u, int wr, int wc, int fr, int fq) const {
        const int row0 = u.pm * 256 + wr * 64 + fr, col0 = u.pn * 256 + wc * 32 + 8 * fq;
        const float* gp = gate + (unsigned)((u.pm >> 4) * 6144 + col0);
        f32x4 gv[2][2];
#pragma unroll
        for (int bj = 0; bj < 2; ++bj)
#pragma unroll
            for (int n = 0; n < 2; ++n) { gv[bj][n] = *(const f32x4*)(gp + bj * 128 + n * 4); gv[bj][n] = gv[bj][n] + 1.f; }
#pragma unroll
        for (int ai = 0; ai < 2; ++ai)
#pragma unroll
            for (int m = 0; m < 4; ++m) { const unsigned ro = (unsigned)((row0 + ai * 128 + m * 16) * 1024 + col0);
#pragma unroll
                for (int bj = 0; bj < 2; ++bj) { const u32x4 xs = *(const u32x4*)(Xs + ro + bj * 128);
                    const f32x4 a0 = acc[ai][bj][m][0] * gv[bj][0], a1 = acc[ai][bj][m][1] * gv[bj][1];
                    u32x4 o = {pk2(bflo(xs[0]) + a0[0], bfhi(xs[0]) + a0[1]), pk2(bflo(xs[1]) + a0[2], bfhi(xs[1]) + a0[3]), pk2(bflo(xs[2]) + a1[0], bfhi(xs[2]) + a1[1]), pk2(bflo(xs[3]) + a1[2], bfhi(xs[3]) + a1[3])};
                    *(u32x4*)(Xd + ro + bj * 128) = o; } }
    }
};
struct EpiQ {
    static constexpr bool PERM = false, AFTER_DRAIN = false, PERMA = false;
    bf16_t* QF; const float* CSC; const float* CSS; float qs;
    __device__ __forceinline__ void operator()(const f32x4 (&acc)[2][2][4][2], const Unit& u, int wr, int wc, int fr, int fq) const {
        const int b = u.pm >> 4;
#pragma unroll
        for (int bj = 0; bj < 2; ++bj) {
            const int c0 = u.pn * 256 + bj * 128 + wc * 32;
            const int head = c0 / 192, off = c0 - head * 192;
            if (off < 128) {
#pragma unroll
                for (int ai = 0; ai < 2; ++ai)
#pragma unroll
                    for (int m = 0; m < 4; ++m) { const int r = u.pm * 256 + ai * 128 + wr * 64 + m * 16 + fr, s = r & 4095;
                        bf16_t* qp = QF + (unsigned)(((b * 8 + head) * 4096 + s) * 192 + off + 4 * fq);
#pragma unroll
                        for (int n = 0; n < 2; ++n) { const f32x4 v = acc[ai][bj][m][n] * qs; u32x2 o = {pk2(v[0], v[1]), pk2(v[2], v[3])}; *(u32x2*)(qp + 16 * n) = o; } __builtin_amdgcn_sched_barrier(0); }
            } else {
                const int jb = ((off - 128) >> 5) * 16 + 4 * fq;
#pragma unroll
                for (int ai = 0; ai < 2; ++ai)
#pragma unroll
                    for (int m = 0; m < 4; ++m) { const int r = u.pm * 256 + ai * 128 + wr * 64 + m * 16 + fr, s = r & 4095;
                        const f32x4 cs = *(const f32x4*)(CSC + (unsigned)(r * 32 + jb)), sn = *(const f32x4*)(CSS + (unsigned)(r * 32 + jb));
                        const f32x4 x1 = acc[ai][bj][m][0], x2 = acc[ai][bj][m][1];
                        const f32x4 r1 = (x1 * cs - x2 * sn) * qs, r2 = (x2 * cs + x1 * sn) * qs;
                        bf16_t* qp = QF + (unsigned)(((b * 8 + head) * 4096 + s) * 192 + 128 + jb);
                        u32x2 o1 = {pk2(r1[0], r1[1]), pk2(r1[2], r1[3])}, o2 = {pk2(r2[0], r2[1]), pk2(r2[2], r2[3])};
                        *(u32x2*)(qp) = o1; *(u32x2*)(qp + 32) = o2; __builtin_amdgcn_sched_barrier(0); }
            }
        }
    }
};
struct EpiKV {
    static constexpr bool PERM = false, AFTER_DRAIN = false, PERMA = false;
    bf16_t* KF; bf16_t* VT;
    __device__ __forceinline__ void operator()(const f32x4 (&acc)[2][2][4][2], const Unit& u, int wr, int wc, int fr, int fq) const {
        const int b = u.pm >> 4, head = u.pn;
#pragma unroll
        for (int bj = 0; bj < 2; ++bj) {
            const int off = wc * 32;
            if (bj == 0) {
#pragma unroll
                for (int ai = 0; ai < 2; ++ai)
#pragma unroll
                    for (int m = 0; m < 4; ++m) { const int r = u.pm * 256 + ai * 128 + wr * 64 + m * 16 + fr, s = r & 4095;
                        bf16_t* kp = KF + (unsigned)(((b * 8 + head) * 4096 + s) * 192 + off + 4 * fq);
#pragma unroll
                        for (int n = 0; n < 2; ++n) { const f32x4 v = acc[ai][bj][m][n]; u32x2 o = {pk2(v[0], v[1]), pk2(v[2], v[3])}; *(u32x2*)(kp + 16 * n) = o; } __builtin_amdgcn_sched_barrier(0); }
            } else {
#pragma unroll
                for (int ai = 0; ai < 2; ++ai)
#pragma unroll
                    for (int m = 0; m < 4; ++m) { const int r = u.pm * 256 + ai * 128 + wr * 64 + m * 16 + fr, s = r & 4095;
#pragma unroll
                        for (int n = 0; n < 2; ++n) { const f32x4 v = acc[ai][bj][m][n]; const int dv = off + 16 * n + 4 * fq;
                            bf16_t* vp = VT + (unsigned)(((b * 8 + head) * 128 + dv) * 4096 + s);
                            const unsigned p01 = pk2(v[0], v[1]), p23 = pk2(v[2], v[3]);
                            vp[0] = (bf16_t)(p01 & 0xffffu); vp[4096] = (bf16_t)(p01 >> 16); vp[8192] = (bf16_t)(p23 & 0xffffu); vp[12288] = (bf16_t)(p23 >> 16); } __builtin_amdgcn_sched_barrier(0); }
            }
        }
    }
};
struct EpiHg {
    static constexpr bool PERM = true, AFTER_DRAIN = false, PERMA = false;
    unsigned char* R1b; const float* LB;
    __device__ __forceinline__ void operator()(const f32x4 (&acc)[2][2][4][2], const Unit& u, int wr, int wc, int fr, int fq) const {
        const int region = u.pn >> 2, row0 = u.pm * 256 + wr * 64 + fr, cc0 = (u.pn & 3) * 256 + wc * 32 + 8 * fq;
        if (region == 1) {
#pragma unroll
            for (int bj = 0; bj < 2; ++bj) { const int cc = cc0 + bj * 128;
                const f32x4 l0 = *(const f32x4*)(LB + cc), l1 = *(const f32x4*)(LB + cc + 4);
#pragma unroll
                for (int ai = 0; ai < 2; ++ai)
#pragma unroll
                    for (int m = 0; m < 4; ++m) { float* fp = (float*)(R1b + 32 * MiB) + (unsigned)((row0 + ai * 128 + m * 16) * 1024 + cc);
                        f32x4 v0 = acc[ai][bj][m][0], v1 = acc[ai][bj][m][1];
#pragma unroll
                        for (int e = 0; e < 4; ++e) { v0[e] = l0[e] + (1.f - l0[e]) * fast_sigmoid(v0[e]); v1[e] = l1[e] + (1.f - l1[e]) * fast_sigmoid(v1[e]); }
                        *(f32x4*)fp = v0; *(f32x4*)(fp + 4) = v1; __builtin_amdgcn_sched_barrier(0); } }
        } else {
            bf16_t* base = (bf16_t*)(R1b + (region == 0 ? (size_t)0 : (region == 2 ? 96 * MiB : 128 * MiB)));
#pragma unroll
            for (int ai = 0; ai < 2; ++ai)
#pragma unroll
                for (int m = 0; m < 4; ++m) { bf16_t* rowp = base + (unsigned)((row0 + ai * 128 + m * 16) * 1024 + cc0);
#pragma unroll
                    for (int bj = 0; bj < 2; ++bj) { f32x4 v0 = acc[ai][bj][m][0], v1 = acc[ai][bj][m][1];
                        if (region == 3) {
#pragma unroll
                            for (int e = 0; e < 4; ++e) { v0[e] = v0[e] * fast_sigmoid(v0[e]); v1[e] = v1[e] * fast_sigmoid(v1[e]); } }
                        u32x4 o = {pk2(v0[0], v0[1]), pk2(v0[2], v0[3]), pk2(v1[0], v1[1]), pk2(v1[2], v1[3])};
                        *(u32x4*)(rowp + bj * 128) = o; } }
        }
    }
};

struct EpiFFN {
    static constexpr bool PERM = true, AFTER_DRAIN = false, PERMA = true;
    bf16_t* ACT; const bf16_t* CWB;
    __device__ __forceinline__ static f32x4 shr1(const f32x4 v) { f32x4 r;
#pragma unroll
        for (int e = 0; e < 4; ++e) r[e] = __int_as_float(__builtin_amdgcn_update_dpp(0, __float_as_int(v[e]), 0x111, 0xf, 0xf, true));
        return r; }
    template <bool SPECIAL> __device__ __forceinline__ void group(const f32x4 (&acc)[2][2][4][2], int ai, int n, int tok0, int fr, int fcol,
            const f32x4 wg0, const f32x4 wg1, const f32x4 wg2, const f32x4 bg, const f32x4 wv0, const f32x4 wv1, const f32x4 wv2, const f32x4 bv) const {
        const f32x4 sg3 = shr1(acc[ai][0][3][n]), sg2 = shr1(acc[ai][0][2][n]), sv3 = shr1(acc[ai][1][3][n]), sv2 = shr1(acc[ai][1][2][n]);
#pragma unroll
        for (int m = 0; m < 4; ++m) {
            const f32x4 cg = acc[ai][0][m][n], cv = acc[ai][1][m][n];
            f32x4 p1g = m == 0 ? sg3 : acc[ai][0][m == 0 ? 0 : m - 1][n], p1v = m == 0 ? sv3 : acc[ai][1][m == 0 ? 0 : m - 1][n];
            f32x4 p2g = m == 0 ? sg2 : (m == 1 ? sg3 : acc[ai][0][m < 2 ? 0 : m - 2][n]), p2v = m == 0 ? sv2 : (m == 1 ? sv3 : acc[ai][1][m < 2 ? 0 : m - 2][n]);
            const int tok = tok0 + 4 * fr + m;
            if (SPECIAL) { const int sq = tok & 4095; const f32x4 z4 = {0.f, 0.f, 0.f, 0.f}; if (sq == 0) { p1g = z4; p1v = z4; } if (sq <= 1) { p2g = z4; p2v = z4; } }
            const f32x4 yg = bg + wg0 * p2g + wg1 * p1g + wg2 * cg, yv = bv + wv0 * p2v + wv1 * p1v + wv2 * cv;
            const f32x4 ex = yg * -1.4426950408889634f; f32x4 sg;
#pragma unroll
            for (int e = 0; e < 4; ++e) sg[e] = __builtin_amdgcn_rcpf(1.f + __builtin_amdgcn_exp2f(ex[e]));
            const f32x4 o = yg * sg * yv;
            if ((m >= 2 || fr > 0) && tok < T) { u32x2 ov = {pk2(o[0], o[1]), pk2(o[2], o[3])}; *(u32x2*)(ACT + (unsigned)(tok * 2816 + fcol)) = ov; }
        }
    }
    __device__ __forceinline__ void operator()(const f32x4 (&acc)[2][2][4][2], const Unit& u, int wr, int wc, int fr, int fq) const {
        const int fcol0 = u.pn * 128 + wc * 32 + 8 * fq;
        u32x4 tw[8];
#pragma unroll
        for (int i = 0; i < 8; ++i) tw[i] = *(const u32x4*)(CWB + (unsigned)((fcol0 + i) * 8));
#pragma unroll
        for (int n = 0; n < 2; ++n) {
            const int fcol = fcol0 + 4 * n;
            f32x4 wg0, wg1, wg2, bg, wv0, wv1, wv2, bv;
#pragma unroll
            for (int e = 0; e < 4; ++e) { const u32x4 t = tw[4 * n + e]; wg0[e] = bflo(t[0]); wg1[e] = bfhi(t[0]); wg2[e] = bflo(t[1]); bg[e] = bfhi(t[1]); wv0[e] = bflo(t[2]); wv1[e] = bfhi(t[2]); wv2[e] = bflo(t[3]); bv[e] = bfhi(t[3]); }
#pragma unroll
            for (int ai = 0; ai < 2; ++ai) {
                const int b0 = u.pm * 248 + (2 * ai + wr) * 62;
                const bool special = (((b0 + 61) >> 12) << 12) >= b0 - 1;
                if (special) group<true>(acc, ai, n, b0 - 2, fr, fcol, wg0, wg1, wg2, bg, wv0, wv1, wv2, bv);
                else group<false>(acc, ai, n, b0 - 2, fr, fcol, wg0, wg1, wg2, bg, wv0, wv1, wv2, bv);
                __builtin_amdgcn_sched_barrier(0);
            }
        }
    }
};

template <class Epi> __device__ __forceinline__ void run_gemm(const int s_wv, ldsp lds, const bf16_t* A, const bf16_t* Bt, int M, int N, int K, const Epi& E) {
    pg8::Gemm g{A, Bt, M, N, K}; pg8::StaticOrder S; S.init(M, N, (int)gridDim.x, obid());
    pg8::gemm_phase<Epi, pg8::StaticOrder, false>(s_wv, lds, g, S, E, nullptr);
}

__device__ __forceinline__ int rope_rowmap(int n) { const int head = n / 192, d = n - head * 192; if (d < 128) return n; const int r = d - 128, half = r >> 5, j = r & 31; return head * 192 + 128 + (j >> 4) * 32 + half * 16 + (j & 15); }
__device__ __forceinline__ int ffn_rowmap(int n) { const int half = n >= 2816 ? 1 : 0, f = n - half * 2816, t = f >> 7, i = f & 127; return t * 256 + half * 128 + i; }
struct TrJob { const float* src; int srcN, K, N; bf16_t* dst; int dstK, koff, rowoff, pmode; };
__device__ __forceinline__ void run_trjob(const int s_wv, const TrJob J, ldsp lds) {
    const int tid = otid(), lane = tid & 63, wave = tid >> 6;
    LAS float* sm = (LAS float*)(lds + wave * 8448);
    const int nkt = J.K / 32, nnt = J.N / 64, ntile = nkt * nnt;
    for (int t = obid() * 8 + wave; t < ntile; t += gridDim.x * 8) { const int kt = t % nkt, nt = t / nkt;
        const float* sp = J.src + (size_t)(kt * 32) * J.srcN + nt * 64 + lane;
        float v[32];
#pragma unroll
        for (int k = 0; k < 32; ++k) v[k] = sp[(size_t)k * J.srcN];
#pragma unroll
        for (int k = 0; k < 32; ++k) sm[lane * 33 + k] = v[k];
        const int kk = (lane & 15) * 2, nr = lane >> 4;
#pragma unroll
        for (int j = 0; j < 16; ++j) { const int n = nr + 4 * j, sn = nt * 64 + n, drow = J.rowoff + (J.pmode == 1 ? rope_rowmap(sn) : (J.pmode == 2 ? ffn_rowmap(sn) : sn));
            *(unsigned*)(J.dst + (size_t)drow * J.dstK + J.koff + kt * 32 + kk) = pk2(sm[n * 33 + kk], sm[n * 33 + kk + 1]); }
    }
}
__device__ __forceinline__ void zero_fill(bf16_t* dst, int rows, int cols8, int stride, int gtid, int gthreads) {
    const int n = rows * cols8; unsigned zz = 0u; asm volatile("" : "+v"(zz)); const u32x4 z = {zz, zz, zz, zz};
    for (int i = gtid; i < n; i += gthreads) { const int r = i / cols8, c = i - r * cols8; *(u32x4*)(dst + (size_t)r * stride + c * 8) = z; }
}
__device__ __forceinline__ void prep_layer(const int s_wv, KP p, int layer, ldsp lds) {
    bf16_t* WT = (bf16_t*)(p->ws + OFF_WT); const int kind = layer % 3, j = layer / 3;
    const int gtid = obid() * NTHREADS + otid(), gthreads = gridDim.x * NTHREADS;
    { const TrJob J0{p->in[23] + (size_t)layer * 1024 * 5632, 5632, 1024, 5632, WT + WT_FUP, 1024, 0, 0, 2};
      const TrJob J1{p->in[26] + (size_t)layer * 2816 * 1024, 1024, 2816, 1024, WT + WT_FDN, 2816, 0, 0, 0};
      run_trjob(s_wv, J0, lds); run_trjob(s_wv, J1, lds); }
    if (kind == 0) {
        const TrJob J0{p->in[7] + (size_t)j * 1024 * 4096, 4096, 1024, 4096, WT + WT_MIXA, 1024, 0, 0, 0};
        const TrJob J1{p->in[12] + (size_t)j * 2048 * 1024, 1024, 2048, 1024, WT + WT_MIXB, 2048, 0, 0, 0};
        run_trjob(s_wv, J0, lds); run_trjob(s_wv, J1, lds);
    } else if (kind == 1) {
        const TrJob J0{p->in[13], 448, 1024, 448, WT + WT_MIXA, 1024, 0, 0, 0};
        const TrJob J1{p->in[16], 1536, 256, 1536, WT + WT_MQKV, 256, 0, 0, 1};
        const TrJob J2{p->in[17], 2048, 128, 2048, WT + WT_MQKV + 393216, 256, 0, 0, 0};
        const TrJob J3{p->in[18], 1024, 1024, 1024, WT + WT_MIXB, 1024, 0, 0, 0};
        run_trjob(s_wv, J0, lds); run_trjob(s_wv, J1, lds); run_trjob(s_wv, J2, lds); run_trjob(s_wv, J3, lds);
        zero_fill(WT + WT_MIXA + (size_t)448 * 1024, 64, 128, 1024, gtid, gthreads);
        zero_fill(WT + WT_MQKV + 393216 + 128, 2048, 16, 256, gtid, gthreads);
    } else {
        const TrJob J0{p->in[20], 4096, 1024, 4096, WT + WT_MIXA, 1024, 0, 0, 0};
        const TrJob J1{p->in[22], 1024, 1024, 1024, WT + WT_MIXB, 1024, 0, 0, 0};
        run_trjob(s_wv, J0, lds); run_trjob(s_wv, J1, lds);
    }
}
__device__ __forceinline__ void phase_prologue(const int s_wv, KP p, ldsp lds) {
    const int tid = otid();
    float* MOD = (float*)(p->ws + OFF_MOD);
    LAS float* cact = (LAS float*)lds;
    LAS float* red = (LAS float*)(lds + 16384);
    for (int i = tid; i < 4096; i += NTHREADS) { const float c = p->in[1][i]; cact[i] = c * fast_sigmoid(c); }
    __syncthreads();
    const int l16 = tid & 15, kg = tid >> 4;
    for (int item = obid(); item < 4 * 96; item += gridDim.x) {
        const int layer = item / 96, n0 = (item % 96) * 64;
        const float* w = p->in[3] + (size_t)layer * 1024 * 6144 + n0 + 4 * l16;
        f32x4 a[4] = {{0.f, 0.f, 0.f, 0.f}, {0.f, 0.f, 0.f, 0.f}, {0.f, 0.f, 0.f, 0.f}, {0.f, 0.f, 0.f, 0.f}};
#pragma unroll 8
        for (int kk = 0; kk < 32; ++kk) { const int k = kg * 32 + kk; const f32x4 wv = *(const f32x4*)(w + (size_t)k * 6144);
#pragma unroll
            for (int b = 0; b < 4; ++b) a[b] = a[b] + wv * cact[b * 1024 + k]; }
#pragma unroll
        for (int b = 0; b < 4; ++b) *(LAS f32x4*)(red + (kg * 4 + b) * 64 + 4 * l16) = a[b];
        __syncthreads();
        if (tid < 256) { const int b = tid >> 6, col = tid & 63; float s = 0.f;
#pragma unroll 8
            for (int g = 0; g < 32; ++g) s += red[(g * 4 + b) * 64 + col];
            MOD[(size_t)(layer * 4 + b) * 6144 + n0 + col] = s + p->in[4][(size_t)layer * 6144 + n0 + col]; }
        __syncthreads();
    }
    const int gtid = obid() * NTHREADS + tid, gthreads = gridDim.x * NTHREADS;
    float* CSC = (float*)(p->ws + OFF_CSC); float* CSS = (float*)(p->ws + OFF_CSS);
    const int* pos = (const int*)p->in[2];
    for (int i = gtid; i < T * 32; i += gthreads) { const int t = i >> 5, jj = i & 31;
        const float invf = exp2f(-(float)jj * (13.287712379549449f / 32.f));
        const float ang = (float)pos[t] * invf;
        double rev = (double)ang * 0.15915494309189535; rev -= floor(rev);
        const float rf = (float)rev;
        CSC[i] = __builtin_amdgcn_cosf(rf); CSS[i] = __builtin_amdgcn_sinf(rf); }
    float* LB = (float*)(p->ws + OFF_LB);
    for (int i = gtid; i < 1024; i += gthreads) { const float l0 = p->in[19][i], l1 = p->in[19][1024 + i], l2 = p->in[19][2048 + i], l3 = p->in[19][3072 + i];
        const float mx = fmaxf(fmaxf(l0, l1), fmaxf(l2, l3)); const float e0 = __expf(l0 - mx), e1 = __expf(l1 - mx), e2 = __expf(l2 - mx), e3 = __expf(l3 - mx);
        LB[i] = (e1 + e2) / (e0 + e1 + e2 + e3); }
    prep_layer(s_wv, p, 0, lds);
}
__device__ __forceinline__ void up8(const u32x4 v, float (&o)[8]) { o[0] = bflo(v[0]); o[1] = bfhi(v[0]); o[2] = bflo(v[1]); o[3] = bfhi(v[1]); o[4] = bflo(v[2]); o[5] = bfhi(v[2]); o[6] = bflo(v[3]); o[7] = bfhi(v[3]); }
template <bool SRC32> __device__ __forceinline__ void phase_norm(const int s_wv, const float* X32, bf16_t* XB, const float* g, const float* shift, const float* scale, bf16_t* dst) {
    const int lane = otid() & 63, wave = otid() >> 6;
    for (int rb = obid() * 8 + wave; rb < T / 8; rb += gridDim.x * 8) {
        const int r0 = rb * 8, b = r0 >> 12;
        float G[16], SH[16];
#pragma unroll
        for (int j = 0; j < 2; ++j)
#pragma unroll
            for (int h = 0; h < 2; ++h) { const int c = 8 * lane + 512 * j + 4 * h; const f32x4 gg = *(const f32x4*)(g + c), sc = *(const f32x4*)(scale + (size_t)b * 6144 + c), sh = *(const f32x4*)(shift + (size_t)b * 6144 + c);
#pragma unroll
                for (int e = 0; e < 4; ++e) { G[j * 8 + h * 4 + e] = gg[e] * (sc[e] + 1.f); SH[j * 8 + h * 4 + e] = sh[e]; } }
        for (int r = r0; r < r0 + 8; ++r) {
            float x[16]; float ss = 0.f;
#pragma unroll
            for (int j = 0; j < 2; ++j) { const unsigned off = (unsigned)(r * 1024 + 8 * lane + 512 * j);
                if (SRC32) { const f32x4 a = *(const f32x4*)(X32 + off), c = *(const f32x4*)(X32 + off + 4);
#pragma unroll
                    for (int e = 0; e < 4; ++e) { x[j * 8 + e] = a[e]; x[j * 8 + 4 + e] = c[e]; }
                    u32x4 xo = {pk2(a[0], a[1]), pk2(a[2], a[3]), pk2(c[0], c[1]), pk2(c[2], c[3])}; *(u32x4*)(XB + off) = xo;
                } else { float t[8]; up8(*(const u32x4*)(XB + off), t);
#pragma unroll
                    for (int e = 0; e < 8; ++e) x[j * 8 + e] = t[e]; } }
#pragma unroll
            for (int e = 0; e < 16; ++e) ss += x[e] * x[e];
            ss = wave_sum(ss, lane); const float rstd = rsqrtf(ss * (1.f / 1024.f) + EPS);
#pragma unroll
            for (int j = 0; j < 2; ++j) { float h[8];
#pragma unroll
                for (int e = 0; e < 8; ++e) h[e] = x[j * 8 + e] * rstd * G[j * 8 + e] + SH[j * 8 + e];
                u32x4 o = {pk2(h[0], h[1]), pk2(h[2], h[3]), pk2(h[4], h[5]), pk2(h[6], h[7])}; *(u32x4*)(dst + (unsigned)(r * 1024 + 8 * lane + 512 * j)) = o; }
        }
    }
}
__device__ __forceinline__ void phase_final(const int s_wv, const bf16_t* XB, float* out, const float* g) {
    const int lane = otid() & 63, wave = otid() >> 6;
    for (int r = obid() * 8 + wave; r < T; r += gridDim.x * 8) {
        float x[16]; float ss = 0.f;
#pragma unroll
        for (int j = 0; j < 2; ++j) { float t[8]; up8(*(const u32x4*)(XB + (unsigned)(r * 1024 + 8 * lane + 512 * j)), t);
#pragma unroll
            for (int e = 0; e < 8; ++e) { x[j * 8 + e] = t[e]; ss += t[e] * t[e]; } }
        ss = wave_sum(ss, lane); const float rstd = rsqrtf(ss * (1.f / 1024.f) + EPS);
#pragma unroll
        for (int j = 0; j < 2; ++j)
#pragma unroll
            for (int h = 0; h < 2; ++h) { const int c = 8 * lane + 512 * j + 4 * h; const f32x4 gg = *(const f32x4*)(g + c);
                f32x4 o = {x[j * 8 + h * 4] * rstd * gg[0], x[j * 8 + h * 4 + 1] * rstd * gg[1], x[j * 8 + h * 4 + 2] * rstd * gg[2], x[j * 8 + h * 4 + 3] * rstd * gg[3]};
                *(f32x4*)(out + (size_t)r * 1024 + c) = o; }
    }
}
__device__ __forceinline__ void phase_ffix(const int s_wv, const bf16_t* SIDE, bf16_t* ACT, const float* cw, const float* cb) {
    const int gtid = obid() * NTHREADS + otid(), gthreads = gridDim.x * NTHREADS;
    for (int q = gtid; q < 256 * 2 * 352; q += gthreads) {
        const int cgp = q % 352, gi = q / 352, i = gi & 1, g = gi >> 1, f0 = cgp * 8;
        const bool first = (g & 63) == 0;
        const bf16_t* own = SIDE + (size_t)((g * 4 + 2 + i) * 2) * 2816 + f0;
        const bf16_t* p1 = i == 0 ? SIDE + (size_t)(((g - 1) * 4 + 1) * 2) * 2816 + f0 : SIDE + (size_t)((g * 4 + 2) * 2) * 2816 + f0;
        const bf16_t* p2 = i == 0 ? SIDE + (size_t)(((g - 1) * 4 + 0) * 2) * 2816 + f0 : SIDE + (size_t)(((g - 1) * 4 + 1) * 2) * 2816 + f0;
        float gc[8], vc[8], g1[8], v1[8], g2[8], v2[8];
        up8(*(const u32x4*)own, gc); up8(*(const u32x4*)(own + 2816), vc);
        if (i == 1 || !first) { up8(*(const u32x4*)p1, g1); up8(*(const u32x4*)(p1 + 2816), v1); } else {
#pragma unroll
            for (int e = 0; e < 8; ++e) { g1[e] = 0.f; v1[e] = 0.f; } }
        if (!first) { up8(*(const u32x4*)p2, g2); up8(*(const u32x4*)(p2 + 2816), v2); } else {
#pragma unroll
            for (int e = 0; e < 8; ++e) { g2[e] = 0.f; v2[e] = 0.f; } }
        float o[8];
#pragma unroll
        for (int e = 0; e < 8; ++e) { const int f = f0 + e;
            const float yg = cb[f] + cw[f] * g2[e] + cw[5632 + f] * g1[e] + cw[11264 + f] * gc[e], yv = cb[2816 + f] + cw[2816 + f] * v2[e] + cw[5632 + 2816 + f] * v1[e] + cw[11264 + 2816 + f] * vc[e];
            o[e] = yg * fast_sigmoid(yg) * yv; }
        u32x4 ov = {pk2(o[0], o[1]), pk2(o[2], o[3]), pk2(o[4], o[5]), pk2(o[6], o[7])};
        *(u32x4*)(ACT + (size_t)(g * 64 + i) * 2816 + f0) = ov;
    }
}

__device__ __forceinline__ void phase_gsp(const int s_wv, KP p, int j, ldsp lds) {
    const bf16_t* Z = (const bf16_t*)(p->ws + OFF_R1); bf16_t* Y = (bf16_t*)(p->ws + OFF_R2);
    const float* ws_w = p->in[10] + (size_t)j * 8 * 128 * 128; const float* bs = p->in[11] + (size_t)j * 8 * 128;
    const float* lng = p->in[8] + (size_t)j * 2048; const float* lnb = p->in[9] + (size_t)j * 2048;
    const int tid = otid(), lane = tid & 63, wave = tid >> 6, l15 = lane & 15, g4 = lane >> 4;
    ldsp As = lds, Bs = lds + 34816; LAS float* mu = (LAS float*)(lds + 104448); LAS float* rs = mu + 128;
    for (int unit = obid(); unit < 256; unit += gridDim.x) {
        const int gh = unit & 1, chunk = unit >> 1, t0 = chunk * 128;
        { LAS float* P1 = (LAS float*)Bs; LAS float* P2 = P1 + 64 * 129;
#pragma unroll 4
          for (int rr = 0; rr < 16; ++rr) { const int r = wave * 16 + rr; const bf16_t* zp = Z + (size_t)(t0 + r) * 4096 + 2048 + lane * 32; float s1 = 0.f, s2 = 0.f;
#pragma unroll
              for (int i = 0; i < 4; ++i) { float v[8]; up8(*(const u32x4*)(zp + 8 * i), v);
#pragma unroll
                  for (int e = 0; e < 8; ++e) { s1 += v[e]; s2 += v[e] * v[e]; } }
              P1[lane * 129 + r] = s1; P2[lane * 129 + r] = s2; }
          __syncthreads();
          if (tid < 128) { float s1 = 0.f, s2 = 0.f;
#pragma unroll 8
              for (int i = 0; i < 64; ++i) { s1 += P1[i * 129 + tid]; s2 += P2[i * 129 + tid]; }
              const float m = s1 * (1.f / 2048.f); float var = s2 * (1.f / 2048.f) - m * m; var = fmaxf(var, 0.f); mu[tid] = m; rs[tid] = rsqrtf(var + EPS); } }
        __syncthreads();
        for (int gi = 0; gi < 4; ++gi) {
            const int g = gh * 4 + gi;
#pragma unroll 2
            for (int i = 0; i < 8; ++i) { const int idx = tid + 512 * i, t = idx >> 5, s4 = (idx & 31) * 4; f32x4 w = *(const f32x4*)(ws_w + (size_t)g * 16384 + t * 128 + s4);
#pragma unroll
                for (int e = 0; e < 4; ++e) w[e] = (s4 + e <= t) ? w[e] : 0.f;
                u32x2 o = {pk2(w[0], w[1]), pk2(w[2], w[3])}; *(LAS u32x2*)(As + t * 272 + s4 * 2) = o; }
#pragma unroll 2
            for (int i = 0; i < 8; ++i) { const int idx = tid + 512 * i, s = idx >> 5, c8 = idx & 31; float v[8]; up8(*(const u32x4*)(Z + (size_t)(t0 + s) * 4096 + 2048 + g * 256 + c8 * 8), v);
                const float m = mu[s], r = rs[s]; const f32x4 ga = *(const f32x4*)(lng + g * 256 + c8 * 8), gb = *(const f32x4*)(lng + g * 256 + c8 * 8 + 4), ba = *(const f32x4*)(lnb + g * 256 + c8 * 8), bb = *(const f32x4*)(lnb + g * 256 + c8 * 8 + 4);
                const int boff = (((s >> 3) ^ (c8 & 15)) << 4) + (s & 7) * 2;
#pragma unroll
                for (int e = 0; e < 8; ++e) { const float gg = e < 4 ? ga[e] : gb[e - 4], bbv = e < 4 ? ba[e] : bb[e - 4]; const float val = (v[e] - m) * r * gg + bbv;
                    *(LAS bf16_t*)(Bs + (c8 * 8 + e) * 272 + boff) = (bf16_t)(pk2(val, 0.f) & 0xffffu); } }
            __syncthreads();
            f32x4 acc[8][2];
#pragma unroll
            for (int tt = 0; tt < 8; ++tt) { acc[tt][0] = zero4(); acc[tt][1] = zero4(); }
#pragma unroll
            for (int tt = 0; tt < 8; ++tt)
#pragma unroll
                for (int ks = 0; ks <= tt / 2; ++ks) { const bf16x8 yf = *(const LAS bf16x8*)(As + (16 * tt + l15) * 272 + (32 * ks + 8 * g4) * 2);
#pragma unroll
                    for (int ct = 0; ct < 2; ++ct) { const int c = 32 * wave + 16 * ct + l15; const bf16x8 xf = *(const LAS bf16x8*)(Bs + c * 272 + (((4 * ks + g4) ^ ((c >> 3) & 15)) << 4));
                        acc[tt][ct] = MFMA16(xf, yf, acc[tt][ct]); } }
#pragma unroll
            for (int tt = 0; tt < 8; ++tt) { const int t = 16 * tt + l15; const float bias = bs[g * 128 + t];
#pragma unroll
                for (int ct = 0; ct < 2; ++ct) { const int c = g * 256 + 32 * wave + 16 * ct + 4 * g4; const u32x2 uu = *(const u32x2*)(Z + (size_t)(t0 + t) * 4096 + c);
                    const f32x4 a = acc[tt][ct]; u32x2 o = {pk2(bflo(uu[0]) * (a[0] + bias), bfhi(uu[0]) * (a[1] + bias)), pk2(bflo(uu[1]) * (a[2] + bias), bfhi(uu[1]) * (a[3] + bias))};
                    *(u32x2*)(Y + (size_t)(t0 + t) * 2048 + c) = o; } }
            __syncthreads();
        }
    }
}

__device__ __forceinline__ void phase_m2(const int s_wv, KP p) {
    const float* A1 = (const float*)(p->ws + OFF_R1); bf16_t* CQN = (bf16_t*)(p->ws + OFF_R1 + 32 * MiB); bf16_t* CKVN = (bf16_t*)(p->ws + OFF_R1 + 40 * MiB); bf16_t* KF = (bf16_t*)(p->ws + OFF_R1 + 96 * MiB);
    const float* CSC = (const float*)(p->ws + OFF_CSC); const float* CSS = (const float*)(p->ws + OFF_CSS);
    const int lane = otid() & 63, wave = otid() >> 6;
    const f32x4 qg = *(const f32x4*)(p->in[14] + 4 * lane); const f32x4 kg = *(const f32x4*)(p->in[15] + 4 * (lane & 31));
    for (int r = obid() * 8 + wave; r < T; r += gridDim.x * 8) {
        const float* a = A1 + (size_t)r * 512;
        const f32x4 cq = *(const f32x4*)(a + 4 * lane); float ss = wave_sum(cq[0] * cq[0] + cq[1] * cq[1] + cq[2] * cq[2] + cq[3] * cq[3], lane);
        const float rq = rsqrtf(ss * (1.f / 256.f) + EPS);
        { const f32x4 h = cq * rq * qg; u32x2 o = {pk2(h[0], h[1]), pk2(h[2], h[3])}; *(u32x2*)(CQN + (size_t)r * 256 + 4 * lane) = o; }
        const f32x4 ck = *(const f32x4*)(a + 256 + 4 * (lane & 31)); float s2 = lane < 32 ? (ck[0] * ck[0] + ck[1] * ck[1] + ck[2] * ck[2] + ck[3] * ck[3]) : 0.f; s2 = wave_sum(s2, lane);
        const float rk = rsqrtf(s2 * (1.f / 128.f) + EPS);
        { const f32x4 h = ck * rk * kg; u32x2 o = {pk2(h[0], h[1]), pk2(h[2], h[3])}; if (lane >= 32) { o[0] = 0u; o[1] = 0u; } *(u32x2*)(CKVN + (size_t)r * 256 + 4 * lane) = o; }
        if (lane < 32) {
            const float x1 = a[384 + lane], x2 = a[416 + lane], c = CSC[(size_t)r * 32 + lane], s = CSS[(size_t)r * 32 + lane];
            const unsigned pr = pk2(x1 * c - x2 * s, x2 * c + x1 * s); const int b = r >> 12, sq = r & 4095;
#pragma unroll
            for (int h8 = 0; h8 < 8; ++h8) { bf16_t* kp = KF + ((size_t)((b * 8 + h8) * 4096 + sq)) * 192 + 128 + lane; kp[0] = (bf16_t)(pr & 0xffffu); kp[32] = (bf16_t)(pr >> 16); } }
    }
}

__device__ __forceinline__ void phase_attn(const int s_wv, KP p, ldsp lds) {
    const bf16_t* QF = (const bf16_t*)(p->ws + OFF_R1 + 48 * MiB); const bf16_t* KF = (const bf16_t*)(p->ws + OFF_R1 + 96 * MiB); const bf16_t* VT = (const bf16_t*)(p->ws + OFF_R1 + 144 * MiB);
    bf16_t* O = (bf16_t*)(p->ws + OFF_R2);
    const int tid = otid(), lane = tid & 63, wave = __builtin_amdgcn_readfirstlane(tid >> 6), l15 = lane & 15, g4 = lane >> 4;
    const int G = gridDim.x, bx = obid(), vcu = (G % 8 == 0) ? (bx % 8) * (G / 8) + bx / 8 : bx;
    constexpr int KB = 25600, VB = 18432, BUF = KB + VB;
    for (int unit = vcu; unit < 256; unit += G) {
        const int bh = unit >> 3, pr = unit & 7, b = bh >> 3, h = bh & 7;
        const unsigned char* kbase = (const unsigned char*)(KF + (size_t)bh * 4096 * 192);
        const unsigned char* vbase = (const unsigned char*)(VT + (size_t)bh * 128 * 4096);
        for (int half = 0; half < 2; ++half) {
            const int qb = half == 0 ? 15 - pr : pr, ntile = 4 * qb + 4;
            const int qrow0 = qb * 256 + 32 * wave;
            bf16x8 Qf[2][6];
#pragma unroll
            for (int qt = 0; qt < 2; ++qt)
#pragma unroll
                for (int ks = 0; ks < 6; ++ks) Qf[qt][ks] = *(const bf16x8*)((const unsigned char*)(QF + (size_t)(bh * 4096 + qrow0) * 192) + (unsigned)(((16 * qt + l15) * 192 + 32 * ks + 8 * g4) * 2));
            f32x4 Oa[2][8]; float mrun[2] = {-1e30f, -1e30f}, lsum[2] = {0.f, 0.f};
#pragma unroll
            for (int qt = 0; qt < 2; ++qt)
#pragma unroll
                for (int d = 0; d < 8; ++d) Oa[qt][d] = zero4();
            u32x4 kr[3], vr[2];
#define ATT_LOADK(j) do { _Pragma("unroll") for (int i = 0; i < 3; ++i) kr[i] = *(const u32x4*)(kbase + (size_t)(j) * 24576 + (unsigned)((tid + 512 * i) * 16)); } while (0)
#define ATT_LOADV(j) do { _Pragma("unroll") for (int i = 0; i < 2; ++i) { const int c = tid + 512 * i, dv = c >> 3, k8 = c & 7; vr[i] = *(const u32x4*)(vbase + (size_t)(j) * 128 + (unsigned)(dv * 8192 + k8 * 16)); } } while (0)
#define ATT_WRITEK(bufi) do { ldsp kb_ = lds + (bufi) * BUF; \
                         _Pragma("unroll") for (int i = 0; i < 3; ++i) { const int c = tid + 512 * i, row = c / 24, c16 = c - row * 24; *(LAS u32x4*)(kb_ + row * 400 + c16 * 16) = kr[i]; } } while (0)
#define ATT_WRITEV(bufi) do { ldsp vb_ = lds + (bufi) * BUF + KB; \
                         _Pragma("unroll") for (int i = 0; i < 2; ++i) { const int c = tid + 512 * i, dv = c >> 3, k8 = c & 7; *(LAS u32x4*)(vb_ + dv * 144 + k8 * 16) = vr[i]; } } while (0)
            ATT_LOADK(0); ATT_LOADV(0); ATT_WRITEK(0); ATT_WRITEV(0); __syncthreads();
#pragma unroll 1
            for (int j = 0; j < ntile; ++j) {
                if (j + 1 < ntile) ATT_LOADK(j + 1);
                const int jj = j - 4 * qb; const bool diag = jj >= 0; const bool active = !(diag && 64 * jj > 32 * wave + 31);
                ldsp Kb = lds + (j & 1) * BUF; ldsp Vb = Kb + KB;
#pragma unroll
                for (int hs = 0; hs < 2; ++hs) {
                    if (active) {
                        f32x4 S[2][2];
#pragma unroll
                        for (int qt = 0; qt < 2; ++qt) { S[qt][0] = zero4(); S[qt][1] = zero4(); }
#pragma unroll
                        for (int ks = 0; ks < 6; ++ks)
#pragma unroll
                            for (int sb = 0; sb < 2; ++sb) { const bf16x8 kx = *(const LAS bf16x8*)(Kb + (16 * (2 * hs + sb) + l15) * 400 + (32 * ks + 8 * g4) * 2);
                                S[0][sb] = MFMA16(kx, Qf[0][ks], S[0][sb]); S[1][sb] = MFMA16(kx, Qf[1][ks], S[1][sb]); }
                        bf16x8 Pf[2];
#pragma unroll
                        for (int qt = 0; qt < 2; ++qt) {
                            if (diag) { int dq = 32 * wave + 16 * qt + l15 - 4 * g4 - 64 * jj; asm volatile("" : "+v"(dq));
#pragma unroll
                                for (int sb = 0; sb < 2; ++sb)
#pragma unroll
                                    for (int e = 0; e < 4; ++e) { if (32 * hs + 16 * sb + e > dq) S[qt][sb][e] = -1e30f; } }
                            float tm = -1e30f;
#pragma unroll
                            for (int sb = 0; sb < 2; ++sb)
#pragma unroll
                                for (int e = 0; e < 4; ++e) tm = fmaxf(tm, S[qt][sb][e]);
                            tm = fmaxf(tm, shx(tm, 16, lane)); tm = fmaxf(tm, shx(tm, 32, lane));
                            if (__builtin_amdgcn_ballot_w64(tm > mrun[qt]) != 0ull) {
                                const float mn = fmaxf(mrun[qt], tm), sc = __builtin_amdgcn_exp2f(mrun[qt] - mn); mrun[qt] = mn; lsum[qt] *= sc;
#pragma unroll
                                for (int d = 0; d < 8; ++d) Oa[qt][d] = Oa[qt][d] * sc; }
                            const float mn = mrun[qt];
                            float ps = 0.f;
#pragma unroll
                            for (int sb = 0; sb < 2; ++sb)
#pragma unroll
                                for (int e = 0; e < 4; ++e) { const float pe = __builtin_amdgcn_exp2f(S[qt][sb][e] - mn); S[qt][sb][e] = pe; ps += pe; }
                            lsum[qt] += ps;
                            Pf[qt] = mk8(pk2(S[qt][0][0], S[qt][0][1]), pk2(S[qt][0][2], S[qt][0][3]), pk2(S[qt][1][0], S[qt][1][1]), pk2(S[qt][1][2], S[qt][1][3]));
                        }
#pragma unroll
                        for (int d = 0; d < 8; ++d) { const bf16x4 va = *(const LAS bf16x4*)(Vb + (16 * d + l15) * 144 + (32 * hs + 4 * g4) * 2), vb2 = *(const LAS bf16x4*)(Vb + (16 * d + l15) * 144 + (32 * hs + 16 + 4 * g4) * 2);
                            const bf16x8 vx = __builtin_shufflevector(va, vb2, 0, 1, 2, 3, 4, 5, 6, 7);
                            Oa[0][d] = MFMA16(vx, Pf[0], Oa[0][d]); Oa[1][d] = MFMA16(vx, Pf[1], Oa[1][d]); }
                    }
                    if (j + 1 < ntile) { if (hs == 0) { ATT_WRITEK((j + 1) & 1); ATT_LOADV(j + 1); } else { ATT_WRITEV((j + 1) & 1); } }
                }
                __syncthreads();
            }
#pragma unroll
            for (int qt = 0; qt < 2; ++qt) { float ls = lsum[qt]; ls += shx(ls, 16, lane); ls += shx(ls, 32, lane); const float inv = 1.f / ls;
                bf16_t* op = (bf16_t*)((unsigned char*)(O + (size_t)(b * 4096 + qrow0) * 1024 + h * 128) + (unsigned)(((16 * qt + l15) * 1024 + 4 * g4) * 2));
#pragma unroll
                for (int d = 0; d < 8; ++d) { const f32x4 v = Oa[qt][d] * inv; u32x2 o = {pk2(v[0], v[1]), pk2(v[2], v[3])}; *(u32x2*)(op + 16 * d) = o; } }
        }
    }
#undef ATT_LOADK
#undef ATT_LOADV
#undef ATT_WRITEK
#undef ATT_WRITEV
}

template <bool TOF32> __device__ __forceinline__ void hg_load_f_v(const float* HF, const bf16_t* HV, int t0, int col0, LAS float* BC, LAS float* K1f, ldsp K1b, ldsp VTl, int tid) {
#pragma unroll
    for (int i = 0; i < 4; ++i) { const int idx = tid + 512 * i, s = idx >> 5, k4 = (idx & 31) * 4; const f32x4 f = *(const f32x4*)(HF + (size_t)(t0 + s) * 1024 + col0 + k4);
#pragma unroll
        for (int e = 0; e < 4; ++e) BC[s * 129 + k4 + e] = __logf(f[e]);
        if (TOF32) {
#pragma unroll
            for (int e = 0; e < 4; ++e) K1f[s * 129 + k4 + e] = 1.f - f[e];
        } else { u32x2 o = {pk2(1.f - f[0], 1.f - f[1]), pk2(1.f - f[2], 1.f - f[3])}; *(LAS u32x2*)(K1b + s * 272 + k4 * 2) = o; } }
#pragma unroll
    for (int i = 0; i < 2; ++i) { const int idx = tid + 512 * i, s = idx >> 4, v8 = idx & 15; const u32x4 vv = *(const u32x4*)(HV + (size_t)(t0 + s) * 1024 + col0 + v8 * 8);
#pragma unroll
        for (int e = 0; e < 4; ++e) { *(LAS bf16_t*)(VTl + (v8 * 8 + 2 * e) * 144 + s * 2) = (bf16_t)(vv[e] & 0xffffu); *(LAS bf16_t*)(VTl + (v8 * 8 + 2 * e + 1) * 144 + s * 2) = (bf16_t)(vv[e] >> 16); } }
}
__device__ __forceinline__ void phase_ha(const int s_wv, KP p, ldsp lds) {
    const float* HF = (const float*)(p->ws + OFF_R1 + 32 * MiB); const bf16_t* HV = (const bf16_t*)(p->ws + OFF_R1 + 96 * MiB);
    bf16_t* LCT = (bf16_t*)(p->ws + OFF_R2); float* DEC = (float*)(p->ws + OFF_R2 + 64 * MiB);
    const int tid = otid(), lane = tid & 63, wave = tid >> 6, l15 = lane & 15, g4 = lane >> 4;
    LAS float* BC = (LAS float*)lds; LAS float* K1 = (LAS float*)(lds + 33024); ldsp KT = lds + 66048; ldsp VTl = lds + 84480;
    for (int u = obid(); u < 2048; u += gridDim.x) {
        const int bh = u >> 6, n = u & 63, b = bh >> 3, h = bh & 7, t0 = b * 4096 + n * 64, col0 = h * 128;
        hg_load_f_v<true>(HF, HV, t0, col0, BC, K1, VTl, VTl, tid);
        __syncthreads();
        if (tid < 128) { float run = 0.f;
#pragma unroll 8
            for (int s = 0; s < 64; ++s) { run += BC[s * 129 + tid]; BC[s * 129 + tid] = run; }
            DEC[(size_t)u * 128 + tid] = __expf(run); }
        __syncthreads();
        { const int sp = tid & 31, kk0 = tid >> 5;
#pragma unroll
          for (int it = 0; it < 8; ++it) { const int k = kk0 + 16 * it; const float bl = BC[63 * 129 + k];
              const float a0 = K1[(2 * sp) * 129 + k] * __expf(bl - BC[(2 * sp) * 129 + k]), a1 = K1[(2 * sp + 1) * 129 + k] * __expf(bl - BC[(2 * sp + 1) * 129 + k]);
              *(LAS unsigned*)(KT + k * 144 + sp * 4) = pk2(a0, a1); } }
        __syncthreads();
        f32x4 acc[8];
#pragma unroll
        for (int vt = 0; vt < 8; ++vt) acc[vt] = zero4();
#pragma unroll
        for (int ks = 0; ks < 2; ++ks) { const bf16x8 xf = *(const LAS bf16x8*)(KT + (16 * wave + l15) * 144 + (32 * ks + 8 * g4) * 2);
#pragma unroll
            for (int vt = 0; vt < 8; ++vt) { const bf16x8 yf = *(const LAS bf16x8*)(VTl + (16 * vt + l15) * 144 + (32 * ks + 8 * g4) * 2); acc[vt] = MFMA16(xf, yf, acc[vt]); } }
#pragma unroll
        for (int vt = 0; vt < 8; ++vt) { u32x2 o = {pk2(acc[vt][0], acc[vt][1]), pk2(acc[vt][2], acc[vt][3])}; *(u32x2*)(LCT + ((size_t)u * 128 + 16 * vt + l15) * 128 + 16 * wave + 4 * g4) = o; }
        __syncthreads();
    }
}
__device__ __forceinline__ void phase_hscan(const int s_wv, KP p) {
    bf16_t* LCT = (bf16_t*)(p->ws + OFF_R2); const float* DEC = (const float*)(p->ws + OFF_R2 + 64 * MiB);
    const int gtid = obid() * NTHREADS + otid(), gthreads = gridDim.x * NTHREADS;
    for (int id = gtid; id < 32 * 128 * 32; id += gthreads) {
        const int k4 = id & 31, v = (id >> 5) & 127, bh = id >> 12;
        f32x4 st = zero4();
#pragma unroll 4
        for (int n = 0; n < 64; ++n) { const int u = bh * 64 + n; bf16_t* ptr = LCT + ((size_t)u * 128 + v) * 128 + 4 * k4;
            const u32x2 t = *(const u32x2*)ptr; const f32x4 dec = *(const f32x4*)(DEC + (size_t)u * 128 + 4 * k4);
            u32x2 o = {pk2(st[0], st[1]), pk2(st[2], st[3])}; *(u32x2*)ptr = o;
            st[0] = dec[0] * st[0] + bflo(t[0]); st[1] = dec[1] * st[1] + bfhi(t[0]); st[2] = dec[2] * st[2] + bflo(t[1]); st[3] = dec[3] * st[3] + bfhi(t[1]); }
    }
}
__device__ __forceinline__ void phase_hc(const int s_wv, KP p, ldsp lds) {
    const bf16_t* HQ = (const bf16_t*)(p->ws + OFF_R1); const float* HF = (const float*)(p->ws + OFF_R1 + 32 * MiB); const bf16_t* HV = (const bf16_t*)(p->ws + OFF_R1 + 96 * MiB); const bf16_t* HG = (const bf16_t*)(p->ws + OFF_R1 + 128 * MiB);
    const bf16_t* SST = (const bf16_t*)(p->ws + OFF_R2); bf16_t* O = (bf16_t*)(p->ws + OFF_HB); const float* ng = p->in[21];
    const int tid = otid(), lane = tid & 63, wave = tid >> 6, l15 = lane & 15, g4 = lane >> 4;
    LAS float* BC = (LAS float*)lds; ldsp QT = lds + 33024; ldsp KTl = lds + 50432; ldsp QH = lds + 67840; ldsp VTl = lds + 85248; ldsp AT = lds + 103680; LAS float* SSQ = (LAS float*)(lds + 112896);
    for (int u = obid(); u < 2048; u += gridDim.x) {
        const int bh = u >> 6, n = u & 63, b = bh >> 3, h = bh & 7, t0 = b * 4096 + n * 64, col0 = h * 128;
        hg_load_f_v<false>(HF, HV, t0, col0, BC, BC, KTl, VTl, tid);
        u32x4 qraw[2];
#pragma unroll
        for (int i = 0; i < 2; ++i) { const int idx = tid + 512 * i, s = idx >> 4, k8 = idx & 15; qraw[i] = *(const u32x4*)(HQ + (size_t)(t0 + s) * 1024 + col0 + k8 * 8); }
        __syncthreads();
        if (tid < 128) { float run = 0.f;
#pragma unroll 8
            for (int s = 0; s < 64; ++s) { run += BC[s * 129 + tid]; BC[s * 129 + tid] = run; } }
        __syncthreads();
#pragma unroll
        for (int i = 0; i < 2; ++i) { const int idx = tid + 512 * i, s = idx >> 4, k8 = idx & 15; float q[8], kk[8], qt[8], qh[8]; up8(qraw[i], q); up8(*(const LAS u32x4*)(KTl + s * 272 + k8 * 16), kk);
#pragma unroll
            for (int e = 0; e < 8; ++e) { const int k = k8 * 8 + e; const float bc = BC[s * 129 + k], bm = BC[31 * 129 + k]; qt[e] = q[e] * __expf(bc - bm); qh[e] = q[e] * __expf(bc); kk[e] = kk[e] * __expf(bm - bc); }
            u32x4 o1 = {pk2(qt[0], qt[1]), pk2(qt[2], qt[3]), pk2(qt[4], qt[5]), pk2(qt[6], qt[7])}, o2 = {pk2(qh[0], qh[1]), pk2(qh[2], qh[3]), pk2(qh[4], qh[5]), pk2(qh[6], qh[7])}, o3 = {pk2(kk[0], kk[1]), pk2(kk[2], kk[3]), pk2(kk[4], kk[5]), pk2(kk[6], kk[7])};
            *(LAS u32x4*)(QT + s * 272 + k8 * 16) = o1; *(LAS u32x4*)(QH + s * 272 + k8 * 16) = o2; *(LAS u32x4*)(KTl + s * 272 + k8 * 16) = o3; }
        __syncthreads();
        { const int st = wave & 3;
#pragma unroll
          for (int ti = 0; ti < 2; ++ti) { const int tt = 2 * (wave >> 2) + ti; f32x4 a = zero4();
              if (st <= tt) {
#pragma unroll
                  for (int ks = 0; ks < 4; ++ks) { const bf16x8 xf = *(const LAS bf16x8*)(KTl + (16 * st + l15) * 272 + (32 * ks + 8 * g4) * 2), yf = *(const LAS bf16x8*)(QT + (16 * tt + l15) * 272 + (32 * ks + 8 * g4) * 2); a = MFMA16(xf, yf, a); }
                  const int t = 16 * tt + l15;
#pragma unroll
                  for (int e = 0; e < 4; ++e) { const int s = 16 * st + 4 * g4 + e; if (s > t) a[e] = 0.f; } }
              u32x2 o = {pk2(a[0], a[1]), pk2(a[2], a[3])}; *(LAS u32x2*)(AT + (16 * tt + l15) * 144 + (16 * st + 4 * g4) * 2) = o; } }
        __syncthreads();
        { const int tt = wave >> 1, vh = wave & 1; f32x4 acc[4];
#pragma unroll
          for (int vi = 0; vi < 4; ++vi) acc[vi] = zero4();
#pragma unroll
          for (int ks = 0; ks < 2; ++ks) if (32 * ks <= 16 * tt + 15) { const bf16x8 yf = *(const LAS bf16x8*)(AT + (16 * tt + l15) * 144 + (32 * ks + 8 * g4) * 2);
#pragma unroll
              for (int vi = 0; vi < 4; ++vi) { const bf16x8 xf = *(const LAS bf16x8*)(VTl + (16 * (4 * vh + vi) + l15) * 144 + (32 * ks + 8 * g4) * 2); acc[vi] = MFMA16(xf, yf, acc[vi]); } }
#pragma unroll
          for (int ks = 0; ks < 4; ++ks) { const bf16x8 yf = *(const LAS bf16x8*)(QH + (16 * tt + l15) * 272 + (32 * ks + 8 * g4) * 2);
#pragma unroll
              for (int vi = 0; vi < 4; ++vi) { const bf16x8 xf = *(const bf16x8*)(SST + ((size_t)u * 128 + 16 * (4 * vh + vi) + l15) * 128 + 32 * ks + 8 * g4); acc[vi] = MFMA16(xf, yf, acc[vi]); } }
          float sq = 0.f;
#pragma unroll
          for (int vi = 0; vi < 4; ++vi)
#pragma unroll
              for (int e = 0; e < 4; ++e) sq += acc[vi][e] * acc[vi][e];
          sq += shx(sq, 16, lane); sq += shx(sq, 32, lane);
          if (g4 == 0) SSQ[(16 * tt + l15) * 2 + vh] = sq;
          __syncthreads();
          const int t = 16 * tt + l15; const float rstd = rsqrtf((SSQ[t * 2] + SSQ[t * 2 + 1]) * (1.f / 128.f) + EPS);
#pragma unroll
          for (int vi = 0; vi < 4; ++vi) { const int v = 16 * (4 * vh + vi) + 4 * g4; const f32x4 gn = *(const f32x4*)(ng + v); const u32x2 gg = *(const u32x2*)(HG + (size_t)(t0 + t) * 1024 + col0 + v);
              const f32x4 a = acc[vi] * rstd * gn; u32x2 o = {pk2(a[0] * bflo(gg[0]), a[1] * bfhi(gg[0])), pk2(a[2] * bflo(gg[1]), a[3] * bfhi(gg[1]))};
              *(u32x2*)(O + (size_t)(t0 + t) * 1024 + col0 + v) = o; } }
        __syncthreads();
    }
}

__global__ void __launch_bounds__(NTHREADS, 2) fwd_kernel(Params pk) {
    extern __shared__ __attribute__((aligned(16))) unsigned char smem[];
    ldsp lds = (ldsp)smem;
    const int ph_lo = pk.ph_lo, ph_hi = pk.ph_hi;
    const int s_wv = __builtin_amdgcn_readfirstlane((int)threadIdx.x >> 6);
    if (threadIdx.x < 4) ((LAS unsigned*)(lds + 131072))[threadIdx.x] = 0u;
    __syncthreads();
    XcdBarrier xbar = xcd_barrier_post((unsigned*)(pk.ws + OFF_BAR), (volatile LAS unsigned*)(lds + 131072), (int)threadIdx.x);
    for (int ph = ph_lo; ph < ph_hi; ++ph) {
        KP p = (KP)__builtin_amdgcn_kernarg_segment_ptr();
        asm volatile("" : "+s"(p));
        const int op = p->op[ph], layraw = p->lay[ph], layer = layraw & 3; const bool dummy = (layraw & 4) != 0;
        unsigned char* ws = p->ws; bf16_t* xdst = dummy ? (bf16_t*)(ws + OFF_R1) : (bf16_t*)(ws + OFF_XB);
        float* MOD = (float*)(ws + OFF_MOD); bf16_t* WT = (bf16_t*)(ws + OFF_WT); bf16_t* HB = (bf16_t*)(ws + OFF_HB); bf16_t* XB = (bf16_t*)(ws + OFF_XB);
        bf16_t* R1 = (bf16_t*)(ws + OFF_R1); bf16_t* R2 = (bf16_t*)(ws + OFF_R2);
        const float* modl = MOD + (size_t)layer * 4 * 6144;
        switch (op) {
        case OP_PRO: phase_prologue(s_wv, p, lds); break;
        case OP_NORM1: if (layer == 0) phase_norm<true>(s_wv, p->in[0], XB, p->in[5], modl + 0, modl + 1024, HB); else { phase_norm<false>(s_wv, p->in[0], XB, p->in[5] + layer * 1024, modl + 0, modl + 1024, HB); prep_layer(s_wv, p, layer, lds); } break;
        case OP_NORM2: { const float* cw = p->in[24] + (size_t)layer * 3 * 5632; const float* cb = p->in[25] + (size_t)layer * 5632; bf16_t* CWB = (bf16_t*)(ws + OFF_CWB);
                         for (int f = obid() * NTHREADS + otid(); f < 2816; f += gridDim.x * NTHREADS) { u32x4 o = {pk2(cw[f], cw[5632 + f]), pk2(cw[11264 + f], cb[f]), pk2(cw[2816 + f], cw[5632 + 2816 + f]), pk2(cw[11264 + 2816 + f], cb[2816 + f])}; *(u32x4*)(CWB + f * 8) = o; }
                         phase_norm<false>(s_wv, p->in[0], XB, p->in[6] + layer * 1024, modl + 3072, modl + 4096, HB); } break;
        case OP_G1: { EpiBf16<1> E{R1, 4096}; run_gemm(s_wv, lds, HB, WT + WT_MIXA, T, 4096, 1024, E); } break;
        case OP_GSP: phase_gsp(s_wv, p, layer / 3, lds); break;
        case OP_GOUT: { EpiRes E{XB, xdst, modl + 2048}; run_gemm(s_wv, lds, R2, WT + WT_MIXB, T, 1024, 2048, E); } break;
        case OP_M1: { EpiF32 E{(float*)R1, 512}; run_gemm(s_wv, lds, HB, WT + WT_MIXA, T, 512, 1024, E); } break;
        case OP_M2: phase_m2(s_wv, p); break;
        case OP_M3: { EpiQ EQ{(bf16_t*)(ws + OFF_R1 + 48 * MiB), (const float*)(ws + OFF_CSC), (const float*)(ws + OFF_CSS), 0.07216878364870322f * 1.4426950408889634f}; run_gemm(s_wv, lds, (const bf16_t*)(ws + OFF_R1 + 32 * MiB), WT + WT_MQKV, T, 1536, 256, EQ); EpiKV EK{(bf16_t*)(ws + OFF_R1 + 96 * MiB), (bf16_t*)(ws + OFF_R1 + 144 * MiB)}; run_gemm(s_wv, lds, (const bf16_t*)(ws + OFF_R1 + 40 * MiB), WT + WT_MQKV + 393216, T, 2048, 256, EK); } break;
        case OP_ATT: phase_attn(s_wv, p, lds); break;
        case OP_MOUT: { EpiRes E{XB, XB, modl + 2048}; run_gemm(s_wv, lds, R2, WT + WT_MIXB, T, 1024, 1024, E); } break;
        case OP_H1: { EpiHg E{ws + OFF_R1, (const float*)(ws + OFF_LB)}; run_gemm(s_wv, lds, HB, WT + WT_MIXA, T, 4096, 1024, E); } break;
        case OP_HA: phase_ha(s_wv, p, lds); break;
        case OP_HSCAN: phase_hscan(s_wv, p); break;
        case OP_HC: phase_hc(s_wv, p, lds); break;
        case OP_HOUT: { EpiRes E{XB, XB, modl + 2048}; run_gemm(s_wv, lds, HB, WT + WT_MIXB, T, 1024, 1024, E); } break;
        case OP_FUP: { EpiFFN E{R2, (const bf16_t*)(ws + OFF_CWB)}; run_gemm(s_wv, lds, HB - 2 * 1024, WT + WT_FUP, 67 * 256, 5632, 1024, E); } break;
        case OP_FDN: { EpiRes E{XB, xdst, modl + 5120}; run_gemm(s_wv, lds, R2, WT + WT_FDN, T, 1024, 2816, E); } break;
        case OP_FINAL: phase_final(s_wv, XB, p->out, p->in[27]); break;
        default: break;
        }
        if (ph + 1 < ph_hi) { if (ph == ph_lo) { __syncthreads(); cg::this_grid().sync(); } else xcd_barrier(xbar, otid()); }
    }
}

#ifndef MULTI_LAUNCH
#define MULTI_LAUNCH 0
#endif
extern "C" void kernel_launch(void* const* d_in, const int* in_sizes, int n_in, void* d_out, int out_size, void* d_ws, size_t ws_size, hipStream_t stream) {
    static int grid = 0;
    if (grid == 0) {
        int dev = 0, cus = 0, per_cu = 0;
        hipGetDevice(&dev); hipDeviceGetAttribute(&cus, hipDeviceAttributeMultiprocessorCount, dev);
        hipFuncSetAttribute((const void*)fwd_kernel, hipFuncAttributeMaxDynamicSharedMemorySize, LDS_BYTES);
        hipOccupancyMaxActiveBlocksPerMultiprocessor(&per_cu, (const void*)fwd_kernel, NTHREADS, LDS_BYTES);
        if (per_cu < 1) per_cu = 1;
        grid = cus * 1; (void)per_cu;
        if (ws_size < WS_END) fprintf(stderr, "kernel_launch: workspace too small: %zu < %zu\n", ws_size, (size_t)WS_END);
        (void)hipGetLastError();
    }
    (void)hipMemsetAsync((char*)d_ws + OFF_BAR, 0, XCD_BAR_WORDS * sizeof(unsigned), stream);
    Params p{};
    for (int i = 0; i < 28; ++i) p.in[i] = (const float*)d_in[i];
    p.out = (float*)d_out; p.ws = (unsigned char*)d_ws;
    int n = 0;
    auto add = [&](int op, int l) { p.op[n] = (unsigned char)op; p.lay[n] = (unsigned char)l; ++n; };
    add(OP_PRO, 0);
    for (int l = 0; l < 4; ++l) {
        add(OP_NORM1, l);
        if (l % 3 == 0) { add(OP_G1, l); add(OP_GSP, l); add(OP_GOUT, l); }
        else if (l % 3 == 1) { add(OP_M1, l); add(OP_M2, l); add(OP_M3, l); add(OP_ATT, l); add(OP_MOUT, l); }
        else { add(OP_H1, l); add(OP_HA, l); add(OP_HSCAN, l); add(OP_HC, l); add(OP_HOUT, l); }
        add(OP_NORM2, l); add(OP_FUP, l); add(OP_FDN, l);
    }
    add(OP_FINAL, 0);
#if MULTI_LAUNCH
    for (int i = 0; i < n; ++i) { p.ph_lo = i; p.ph_hi = i + 1; hipLaunchKernelGGL(fwd_kernel, dim3(grid), dim3(NTHREADS), LDS_BYTES, stream, p); }
#else
    p.ph_lo = 0; p.ph_hi = n;
    void* args[] = {&p};
    hipError_t e = hipLaunchCooperativeKernel((const void*)fwd_kernel, dim3(grid), dim3(NTHREADS), args, LDS_BYTES, stream);
    if (e != hipSuccess) fprintf(stderr, "cooperative launch failed: %s (grid %d)\n", hipGetErrorString(e), grid);
#endif
}
```

```cpp
#include <hip/hip_runtime.h>
#include <hip/hip_cooperative_groups.h>
#include <cstdio>
#include <cstdint>
namespace cg = cooperative_groups;
__device__ __forceinline__ int otid_w(int w) { int l; asm volatile("v_mbcnt_lo_u32_b32 %0, -1, 0\n\tv_mbcnt_hi_u32_b32 %0, -1, %0" : "=v"(l)); return (w << 6) | l; }
#define otid() otid_w(s_wv)
__device__ __forceinline__ int obid() { int t = blockIdx.x; asm volatile("" : "+s"(t)); return t; }
namespace pg8 {
#define PG8_LAS __attribute__((address_space(3)))
typedef unsigned short bf16_t;
typedef short bf16x8 __attribute__((ext_vector_type(8)));
typedef float f32x4 __attribute__((ext_vector_type(4)));
typedef unsigned u32x4 __attribute__((ext_vector_type(4)));
constexpr int BM = 256, BK = 64, HALF = 128, HTB = HALF * BK * 2  , STAGE_BYTES = 8 * HTB, NXCD = 8, WGM = 8;

__host__ __device__ __forceinline__ int lds_byte(int r, int c) { const int st = (r >> 4) * 2 + (c >> 5), rr = r & 15, cc = c & 31, ob = rr * 64 + cc * 2; return st * 1024 + (ob ^ (((ob >> 9) & 1) << 5)); }
__host__ __device__ __forceinline__ void stage_rc(int b, int& R, int& C) { const int st = b / 1024, sb = b % 1024, swz = sb ^ (((sb >> 9) & 1) << 5); R = (st >> 1) * 16 + swz / 64; C = (st & 1) * 32 + (swz % 64) / 2; }
__host__ __device__ __forceinline__ int perm32(int rho) { const int n = rho >> 4, i = rho & 15; return 8 * (i >> 2) + 4 * n + (i & 3); }

struct Unit { int pm, pn; };
struct Gemm { const bf16_t* A; const bf16_t* Bt; int M, N, K; };

struct StaticOrder {
    int nM, nN, nwg, G, c;
    __host__ __device__ void init(int M, int N, int G_, int c_) { nM = M / BM; nN = N / BM; nwg = nM * nN; G = G_; c = c_; }
    __host__ __device__ bool next(int i, Unit& u) const {
        const long L = (long)i * G + c; if (L >= nwg) return false;
        int wgid = (int)L; { const int q = nwg / NXCD, r = nwg % NXCD, xcd = wgid % NXCD, off = wgid / NXCD; wgid = (xcd < r ? xcd * (q + 1) : r * (q + 1) + (xcd - r) * q) + off; }
        const int nig = WGM * nN, gid = wgid / nig, fm = gid * WGM, gsz = (nM - fm) < WGM ? (nM - fm) : WGM;
        u.pm = fm + ((wgid % nig) % gsz); u.pn = (wgid % nig) / gsz; return true;
    }
    __device__ __forceinline__ void a_ready(const Unit&) const {}
    __device__ __forceinline__ void done(const Unit&) const {}
};
__device__ __forceinline__ unsigned cvt_pk_bf16(float lo, float hi) { unsigned r; asm volatile("v_cvt_pk_bf16_f32 %0, %1, %2" : "=v"(r) : "v"(lo), "v"(hi)); return r; }

template <class Epi, class Sched, bool STAMP = false>
__device__ __forceinline__ void gemm_phase(const int s_wv, PG8_LAS unsigned char* lds, const Gemm g, const Sched& S, const Epi& E, unsigned long long* stamps) {
    const int tid = otid(), wid = __builtin_amdgcn_readfirstlane(tid >> 6), lane = tid & 63, wr = wid >> 2, wc = wid & 3, fr = lane & 15, fq = lane >> 4;
    const int K = g.K, nt = K / BK;
    int ts_lo = 0, ts_hi = 0, nts = 0; const unsigned long long rt_entry = STAMP ? (unsigned long long)wall_clock64() : 0ull;
#define PG8_STAMP() do { if (STAMP && wid == 0 && nts < 64) { const unsigned long long _c = (unsigned long long)clock64(); \
        ts_lo = (lane == nts) ? (int)(unsigned)_c : ts_lo; ts_hi = (lane == nts) ? (int)(unsigned)(_c >> 32) : ts_hi; ++nts; } } while (0)
    PG8_STAMP();
    unsigned voffA[2], voffB[2];
#pragma unroll
    for (int i = 0; i < 2; ++i) { int R, C; stage_rc(tid * 16 + i * 8192, R, C); const int Rb = Epi::PERM ? ((R & ~31) + perm32(R & 31)) : R;
        const int Ra = Epi::PERMA ? (62 * (R >> 6) + 4 * (R & 15) + ((R >> 4) & 3)) : R; voffA[i] = (unsigned)(Ra * K + C) * 2u; voffB[i] = (unsigned)(Rb * K + C) * 2u; }
    const size_t kstep = (size_t)(BK * 2);
    const size_t hstep = (size_t)HALF * K * 2;
    const size_t tstep = 2 * hstep;
    const size_t hstepA = Epi::PERMA ? (size_t)124 * K * 2 : hstep, tstepA = Epi::PERMA ? (size_t)248 * K * 2 : tstep;
    const unsigned ldsw = (unsigned)wid * 1024u;
    const int aoff = lds_byte(wr * 64 + fr, fq * 8), boff = lds_byte(wc * 32 + fr, fq * 8);
#define PG8_SA(b, h) (((b) * 2 + (h)) * HTB)
#define PG8_SB(b, h) ((4 + (b) * 2 + (h)) * HTB)
#define PG8_STAGE(bufoff, gbase, voff) do { _Pragma("unroll") for (int _i = 0; _i < 2; ++_i) \
        __builtin_amdgcn_global_load_lds((const unsigned*)((const char*)(gbase) + (voff)[_i]), (PG8_LAS unsigned*)(lds + (bufoff) + ldsw + _i * 8192), 16, 0, 0); } while (0)
#define PG8_LDA(dst, b, h) do { _Pragma("unroll") for (int m = 0; m < 4; ++m) _Pragma("unroll") for (int k = 0; k < 2; ++k) dst[m][k] = *(const PG8_LAS bf16x8*)(lds + PG8_SA(b, h) + aoff + m * 2048 + k * 1024); } while (0)
#define PG8_LDB(dst, b, h) do { _Pragma("unroll") for (int n = 0; n < 2; ++n) _Pragma("unroll") for (int k = 0; k < 2; ++k) dst[n][k] = *(const PG8_LAS bf16x8*)(lds + PG8_SB(b, h) + boff + n * 2048 + k * 1024); } while (0)
#define PG8_MMA(ai, bj, At, Bt) do { __builtin_amdgcn_s_setprio(1); _Pragma("unroll") for (int m = 0; m < 4; ++m) _Pragma("unroll") for (int n = 0; n < 2; ++n) _Pragma("unroll") for (int k = 0; k < 2; ++k) \
        acc[ai][bj][m][n] = __builtin_amdgcn_mfma_f32_16x16x32_bf16(Bt[n][k], At[m][k], acc[ai][bj][m][n], 0, 0, 0); __builtin_amdgcn_s_setprio(0); } while (0)
#define PG8_WAIT_V(n) asm volatile("s_waitcnt vmcnt(" #n ")" ::: "memory")
#define PG8_WAIT_L(n) asm volatile("s_waitcnt lgkmcnt(" #n ")" ::: "memory")
#define PG8_BAR __builtin_amdgcn_s_barrier()
#define PG8_SCHED __builtin_amdgcn_sched_barrier(0)
    Unit cur, nxt; int ui = 0;
    if (!S.next(0, cur)) return;
    f32x4 acc[2][2][4][2];
#pragma unroll
    for (int a = 0; a < 2; ++a)
#pragma unroll
        for (int b = 0; b < 2; ++b)
#pragma unroll
            for (int m = 0; m < 4; ++m)
#pragma unroll
                for (int n = 0; n < 2; ++n) acc[a][b][m][n] = (f32x4){0.f, 0.f, 0.f, 0.f};
    bf16x8 At[4][2], B0[2][2], B1[2][2];
    const char* cA = (const char*)g.A + (size_t)cur.pm * tstepA; const char* cB = (const char*)g.Bt + (size_t)cur.pn * tstep;
    S.a_ready(cur);
    PG8_STAGE(PG8_SB(0, 0), cB, voffB); PG8_STAGE(PG8_SA(0, 0), cA, voffA); PG8_STAGE(PG8_SB(0, 1), cB + hstep, voffB); PG8_STAGE(PG8_SA(0, 1), cA + hstepA, voffA);
    if (wr == 1) PG8_BAR;
    PG8_WAIT_V(4); PG8_BAR;
    PG8_STAGE(PG8_SB(1, 0), cB + kstep, voffB); PG8_STAGE(PG8_SA(1, 0), cA + kstep, voffA); PG8_STAGE(PG8_SB(1, 1), cB + hstep + kstep, voffB);
    PG8_WAIT_V(6); PG8_BAR;
    PG8_STAMP();
    for (;;) {
        const bool has_next = S.next(ui + 1, nxt);
        const char* nA = has_next ? (const char*)g.A + (size_t)nxt.pm * tstepA : cA; const char* nB = has_next ? (const char*)g.Bt + (size_t)nxt.pn * tstep : cB;
        for (int t = 0; t < nt; t += 2) {
            const bool last = (t == nt - 2);
            const char* a1 = cA + (size_t)(t + 1) * kstep;
            const char* a2 = last ? nA : cA + (size_t)(t + 2) * kstep; const char* b2 = last ? nB : cB + (size_t)(t + 2) * kstep;
            const char* a3 = a2 + kstep; const char* b3 = b2 + kstep;
            if (last && has_next) S.a_ready(nxt);
            PG8_LDB(B0, 0, 0); PG8_SCHED; PG8_LDA(At, 0, 0); PG8_STAGE(PG8_SA(1, 1), a1 + hstepA, voffA);
            PG8_WAIT_L(8); PG8_BAR; PG8_WAIT_L(0); PG8_MMA(0, 0, At, B0); PG8_BAR; PG8_SCHED;
            PG8_LDB(B1, 0, 1); PG8_STAGE(PG8_SB(0, 0), b2, voffB);
            PG8_BAR; PG8_WAIT_L(0); PG8_MMA(0, 1, At, B1); PG8_BAR;
            PG8_LDA(At, 0, 1); PG8_STAGE(PG8_SA(0, 0), a2, voffA);
            PG8_BAR; PG8_WAIT_L(0); PG8_MMA(1, 0, At, B0); PG8_BAR; PG8_SCHED;
            PG8_STAGE(PG8_SB(0, 1), b2 + hstep, voffB);
            PG8_WAIT_V(6); PG8_BAR; PG8_MMA(1, 1, At, B1); PG8_BAR;
            PG8_LDB(B0, 1, 0); PG8_SCHED; PG8_LDA(At, 1, 0); PG8_STAGE(PG8_SA(0, 1), a2 + hstepA, voffA);
            PG8_WAIT_L(8); PG8_BAR; PG8_WAIT_L(0); PG8_MMA(0, 0, At, B0); PG8_BAR; PG8_SCHED;
            PG8_LDB(B1, 1, 1); PG8_STAGE(PG8_SB(1, 0), b3, voffB);
            PG8_BAR; PG8_WAIT_L(0); PG8_MMA(0, 1, At, B1); PG8_BAR;
            PG8_LDA(At, 1, 1); PG8_STAGE(PG8_SA(1, 0), a3, voffA);
            PG8_BAR; PG8_WAIT_L(0); PG8_MMA(1, 0, At, B0); PG8_BAR; PG8_SCHED;
            PG8_STAGE(PG8_SB(1, 1), b3 + hstep, voffB);
            PG8_WAIT_V(6); PG8_BAR; PG8_MMA(1, 1, At, B1); PG8_BAR;
        }
        PG8_STAMP();
        if constexpr (!Epi::AFTER_DRAIN) { E(acc, cur, wr, wc, fr, fq); S.done(cur); }
        PG8_STAMP();
        if (!has_next) break;
#pragma unroll
        for (int a = 0; a < 2; ++a)
#pragma unroll
            for (int b = 0; b < 2; ++b)
#pragma unroll
                for (int m = 0; m < 4; ++m)
#pragma unroll
                    for (int n = 0; n < 2; ++n) acc[a][b][m][n] = (f32x4){0.f, 0.f, 0.f, 0.f};
        cur = nxt; cA = nA; cB = nB; ++ui;
    }
    PG8_WAIT_V(0);
    if (wr == 0) PG8_BAR;
    PG8_BAR;
    if constexpr (Epi::AFTER_DRAIN) { E.fused(acc, cur, wr, wc, fr, fq, lds, wid, lane); S.done(cur); }
    PG8_STAMP();
    if (STAMP && wid == 0) { stamps[lane] = lane < nts ? (((unsigned long long)(unsigned)ts_hi << 32) | (unsigned)ts_lo) : 0ull;
        if (lane == 62) stamps[62] = rt_entry; if (lane == 63) stamps[63] = (unsigned long long)wall_clock64(); }
#undef PG8_STAMP
#undef PG8_SA
#undef PG8_SB
#undef PG8_STAGE
#undef PG8_LDA
#undef PG8_LDB
#undef PG8_MMA
#undef PG8_WAIT_V
#undef PG8_WAIT_L
#undef PG8_BAR
#undef PG8_SCHED
}
}

using pg8::bf16_t; using pg8::bf16x8; using pg8::f32x4; using pg8::u32x4; using pg8::Unit;
typedef unsigned u32x2 __attribute__((ext_vector_type(2)));
typedef short bf16x4 __attribute__((ext_vector_type(4)));
#define LAS __attribute__((address_space(3)))
typedef LAS unsigned char* ldsp;
#define XB_TMO      128
#define XB_XCNT(j)  (256  + 64 * (j))
#define XB_XSUB(j)  (1280 + 64 * (j))
#define XB_XGEN(j)  (2304 + 64 * (j))
#define XB_TOP      3328
#define XB_TOPGEN   3392
#define XCD_BAR_WORDS 3456
#define XB_SPIN_CAP (1u << 18)

__device__ __forceinline__ unsigned xb_ld(unsigned* p)              { return __hip_atomic_load(p, __ATOMIC_RELAXED, __HIP_MEMORY_SCOPE_AGENT); }
__device__ __forceinline__ unsigned xb_add(unsigned* p, unsigned v) { return __hip_atomic_fetch_add(p, v, __ATOMIC_RELAXED, __HIP_MEMORY_SCOPE_AGENT); }
__device__ __forceinline__ unsigned xb_xcc_id() { return (unsigned)__builtin_amdgcn_s_getreg((3 << 11) | 20) & 0xFu; }
#define XB_SPIN(cond, bar) do { unsigned _sp = 0; while (cond) { __builtin_amdgcn_s_sleep(1); \
    if ((++_sp & 255u) == 0u) { if (xb_ld(&(bar)[XB_TMO])) break; if (_sp > XB_SPIN_CAP) { atomicAdd(&(bar)[XB_TMO], 1u); break; } } } } while (0)

struct XcdBarrier {
    unsigned* bar; unsigned x;
    volatile LAS unsigned* st;
};

__device__ __forceinline__ XcdBarrier xcd_barrier_post(unsigned* bar, volatile LAS unsigned* st, const int tid0) {
    XcdBarrier b; b.bar = bar; b.x = xb_xcc_id(); b.st = st;
    if (tid0 == 0) (void)xb_add(&bar[XB_XCNT(b.x)], 1u);
    return b;
}
__device__ __forceinline__ void xcd_barrier_complete(unsigned* bar, unsigned x, unsigned& nloc, unsigned& nx) {
    const unsigned G = gridDim.x * gridDim.y * gridDim.z;
    unsigned sum, cnt, mine, sp = 0u;
    for (;;) {
        sum = 0u; cnt = 0u; mine = 0u;
#pragma unroll
        for (unsigned j = 0; j < 16; ++j) { const unsigned c = xb_ld(&bar[XB_XCNT(j)]); sum += c; cnt += (c > 0u) ? 1u : 0u; mine = (j == x) ? c : mine; }
        if (sum == G) break;
        __builtin_amdgcn_s_sleep(1);
        if ((++sp & 255u) == 0u) { if (xb_ld(&bar[XB_TMO])) break; if (sp > XB_SPIN_CAP) { atomicAdd(&bar[XB_TMO], 1u); break; } }
    }
    nloc = mine > 0u ? mine : 1u; nx = cnt > 0u ? cnt : 1u;
}

__device__ __forceinline__ void xcd_barrier(const XcdBarrier& b, const int tid0) {
    asm volatile("s_waitcnt vmcnt(0)" ::: "memory");
    __syncthreads();
    if (tid0 == 0) {
        unsigned* bar = b.bar;
        __builtin_amdgcn_s_waitcnt(0);
        unsigned nloc = b.st[0], nx = b.st[1];
        if (nloc == 0u) { xcd_barrier_complete(bar, b.x, nloc, nx); b.st[0] = nloc; b.st[1] = nx; }
        const unsigned old = xb_add(&bar[XB_XSUB(b.x)], 1u);
        const unsigned gen = old / nloc;
        if (old + 1u == (gen + 1u) * nloc) {
            __builtin_amdgcn_fence(__ATOMIC_RELEASE, "agent");
            asm volatile("s_waitcnt vmcnt(0)" ::: "memory");
            const unsigned og = xb_add(&bar[XB_TOP], 1u);
            const unsigned tg = og / nx;
            if (og + 1u == (tg + 1u) * nx) xb_add(&bar[XB_TOPGEN], 1u);
            else XB_SPIN(xb_ld(&bar[XB_TOPGEN]) == tg, bar);
            __builtin_amdgcn_fence(__ATOMIC_ACQUIRE, "agent");
            xb_add(&bar[XB_XGEN(b.x)], 1u);
            asm volatile("s_waitcnt vmcnt(0)" ::: "memory");
        } else {
            XB_SPIN(xb_ld(&bar[XB_XGEN(b.x)]) == gen, bar);
            __builtin_amdgcn_fence(__ATOMIC_ACQUIRE, "agent");
            asm volatile("s_waitcnt vmcnt(0)" ::: "memory");
        }
    }
    __syncthreads();
}


constexpr int T = 16384, D = 1024, SEQ = 4096, NBATCH = 4, FF = 2816;
constexpr int NTHREADS = 512, LDS_BYTES = 131072 + 16;
constexpr float EPS = 1e-6f;
constexpr size_t MiB = 1024 * 1024;
constexpr size_t OFF_MOD = 0, OFF_LB = 512 * 1024, OFF_CWB = 576 * 1024, OFF_BAR = 768 * 1024, OFF_CSC = 1 * MiB, OFF_CSS = 3 * MiB, OFF_WT = 8 * MiB, OFF_HB = 40 * MiB, OFF_R1 = 72 * MiB, OFF_R2 = 248 * MiB, OFF_XB = 336 * MiB, WS_END = 368 * MiB;
constexpr size_t WT_MIXA = 0, WT_MIXB = 4194304, WT_FUP = 6291456, WT_FDN = 12058624, WT_MQKV = 524288;
enum { OP_PRO = 0, OP_NORM1, OP_G1, OP_GSP, OP_GOUT, OP_M1, OP_M2, OP_M3, OP_ATT, OP_MOUT, OP_H1, OP_HA, OP_HSCAN, OP_HC, OP_HOUT, OP_NORM2, OP_FUP, OP_FCONV, OP_FDN, OP_FINAL };

struct Params;
struct Params {
    const float* in[28];
    float* out;
    unsigned char* ws;
    int ph_lo, ph_hi;
    unsigned char op[48];
    unsigned char lay[48];
};

typedef const __attribute__((address_space(4))) Params* KP;
__device__ __forceinline__ unsigned pk2(float lo, float hi) { return pg8::cvt_pk_bf16(lo, hi); }
__device__ __forceinline__ float bflo(unsigned u) { return __uint_as_float(u << 16); }
__device__ __forceinline__ float bfhi(unsigned u) { return __uint_as_float(u & 0xffff0000u); }
__device__ __forceinline__ float shx(float v, int m, int lane) { return __int_as_float(__builtin_amdgcn_ds_bpermute((lane ^ m) << 2, __float_as_int(v))); }
__device__ __forceinline__ float wave_sum(float v, int lane) {
#pragma unroll
    for (int o = 32; o >= 1; o >>= 1) v += shx(v, o, lane);
    return v;
}
__device__ __forceinline__ float fast_sigmoid(float x) { return __builtin_amdgcn_rcpf(1.f + __builtin_amdgcn_exp2f(-1.4426950408889634f * x)); }
__device__ __forceinline__ float gelu_tanh(float x) { const float u = 0.7978845608028654f * (x + 0.044715f * x * x * x); return x * fast_sigmoid(2.f * u); }
__device__ __forceinline__ bf16x8 mk8(unsigned a, unsigned b, unsigned c, unsigned d) { u32x4 v = {a, b, c, d}; return __builtin_bit_cast(bf16x8, v); }
__device__ __forceinline__ f32x4 zero4() { float z = 0.f; asm volatile("" : "+v"(z)); return (f32x4){z, z, z, z}; }
#define MFMA16(X, Y, C) __builtin_amdgcn_mfma_f32_16x16x32_bf16((X), (Y), (C), 0, 0, 0)

template <int ACT> struct EpiBf16 {
    static constexpr bool PERM = true, AFTER_DRAIN = false, PERMA = false;
    bf16_t* O; int ldc;
    __device__ __forceinline__ void operator()(const f32x4 (&acc)[2][2][4][2], const Unit& u, int wr, int wc, int fr, int fq) const {
        const int row0 = u.pm * 256 + wr * 64 + fr, col0 = u.pn * 256 + wc * 32 + 8 * fq;
#pragma unroll
        for (int ai = 0; ai < 2; ++ai)
#pragma unroll
            for (int m = 0; m < 4; ++m) { bf16_t* rowp = O + (size_t)(row0 + ai * 128 + m * 16) * ldc + col0;
#pragma unroll
                for (int bj = 0; bj < 2; ++bj) { f32x4 v0 = acc[ai][bj][m][0], v1 = acc[ai][bj][m][1];
                    if (ACT == 1) {
#pragma unroll
                        for (int e = 0; e < 4; ++e) { v0[e] = gelu_tanh(v0[e]); v1[e] = gelu_tanh(v1[e]); } }
                    u32x4 o = {pk2(v0[0], v0[1]), pk2(v0[2], v0[3]), pk2(v1[0], v1[1]), pk2(v1[2], v1[3])};
                    *(u32x4*)(rowp + bj * 128) = o; } }
    }
};
struct EpiF32 {
    static constexpr bool PERM = false, AFTER_DRAIN = false, PERMA = false;
    float* C; int ldc;
    __device__ __forceinline__ void operator()(const f32x4 (&acc)[2][2][4][2], const Unit& u, int wr, int wc, int fr, int fq) const {
        const int row0 = u.pm * 256 + wr * 64 + fr, col0 = u.pn * 256 + wc * 32 + 4 * fq;
#pragma unroll
        for (int ai = 0; ai < 2; ++ai)
#pragma unroll
            for (int m = 0; m < 4; ++m) { float* rowp = C + (size_t)(row0 + ai * 128 + m * 16) * ldc + col0;
#pragma unroll
                for (int bj = 0; bj < 2; ++bj)
#pragma unroll
                    for (int n = 0; n < 2; ++n) *(f32x4*)(rowp + bj * 128 + n * 16) = acc[ai][bj][m][n]; }
    }
};
struct EpiRes {
    static constexpr bool PERM = true, AFTER_DRAIN = false, PERMA = false;
    const bf16_t* Xs; bf16_t* Xd; const float* gate;
    __device__ __forceinline__ void operator()(const f32x4 (&acc)[2][2][4][2], const Unit& u, int wr, int wc, int fr, int fq) const {
        const int row0 = u.pm * 256 + wr * 64 + fr, col0 = u.pn * 256 + wc * 32 + 8 * fq;
        const float* gp = gate + (unsigned)((u.pm >> 4) * 6144 + col0);
        f32x4 gv[2][2];
#pragma unroll
        for (int bj = 0; bj < 2; ++bj)
#pragma unroll
            for (int n = 0; n < 2; ++n) { gv[bj][n] = *(const f32x4*)(gp + bj * 128 + n * 4); gv[bj][n] = gv[bj][n] + 1.f; }
#pragma unroll
        for (int ai = 0; ai < 2; ++ai)
#pragma unroll
            for (int m = 0; m < 4; ++m) { const unsigned ro = (unsigned)((row0 + ai * 128 + m * 16) * 1024 + col0);
#pragma unroll
                for (int bj = 0; bj < 2; ++bj) { const u32x4 xs = *(const u32x4*)(Xs + ro + bj * 128);
                    const f32x4 a0 = acc[ai][bj][m][0] * gv[bj][0], a1 = acc[ai][bj][m][1] * gv[bj][1];
                    u32x4 o = {pk2(bflo(xs[0]) + a0[0], bfhi(xs[0]) + a0[1]), pk2(bflo(xs[1]) + a0[2], bfhi(xs[1]) + a0[3]), pk2(bflo(xs[2]) + a1[0], bfhi(xs[2]) + a1[1]), pk2(bflo(xs[3]) + a1[2], bfhi(xs[3]) + a1[3])};
                    *(u32x4*)(Xd + ro + bj * 128) = o; } }
    }
};
struct EpiQ {
    static constexpr bool PERM = false, AFTER_DRAIN = false, PERMA = false;
    bf16_t* QF; const float* CSC; const float* CSS; float qs;
    __device__ __forceinline__ void operator()(const f32x4 (&acc)[2][2][4][2], const Unit& u, int wr, int wc, int fr, int fq) const {
        const int b = u.pm >> 4;
#pragma unroll
        for (int bj = 0; bj < 2; ++bj) {
            const int c0 = u.pn * 256 + bj * 128 + wc * 32;
            const int head = c0 / 192, off = c0 - head * 192;
            if (off < 128) {
#pragma unroll
                for (int ai = 0; ai < 2; ++ai)
#pragma unroll
                    for (int m = 0; m < 4; ++m) { const int r = u.pm * 256 + ai * 128 + wr * 64 + m * 16 + fr, s = r & 4095;
                        bf16_t* qp = QF + (unsigned)(((b * 8 + head) * 4096 + s) * 192 + off + 4 * fq);
#pragma unroll
                        for (int n = 0; n < 2; ++n) { const f32x4 v = acc[ai][bj][m][n] * qs; u32x2 o = {pk2(v[0], v[1]), pk2(v[2], v[3])}; *(u32x2*)(qp + 16 * n) = o; } __builtin_amdgcn_sched_barrier(0); }
            } else {
                const int jb = ((off - 128) >> 5) * 16 + 4 * fq;
#pragma unroll
                for (int ai = 0; ai < 2; ++ai)
#pragma unroll
                    for (int m = 0; m < 4; ++m) { const int r = u.pm * 256 + ai * 128 + wr * 64 + m * 16 + fr, s = r & 4095;
                        const f32x4 cs = *(const f32x4*)(CSC + (unsigned)(r * 32 + jb)), sn = *(const f32x4*)(CSS + (unsigned)(r * 32 + jb));
                        const f32x4 x1 = acc[ai][bj][m][0], x2 = acc[ai][bj][m][1];
                        const f32x4 r1 = (x1 * cs - x2 * sn) * qs, r2 = (x2 * cs + x1 * sn) * qs;
                        bf16_t* qp = QF + (unsigned)(((b * 8 + head) * 4096 + s) * 192 + 128 + jb);
                        u32x2 o1 = {pk2(r1[0], r1[1]), pk2(r1[2], r1[3])}, o2 = {pk2(r2[0], r2[1]), pk2(r2[2], r2[3])};
                        *(u32x2*)(qp) = o1; *(u32x2*)(qp + 32) = o2; __builtin_amdgcn_sched_barrier(0); }
            }
        }
    }
};
struct EpiKV {
    static constexpr bool PERM = false, AFTER_DRAIN = false, PERMA = false;
    bf16_t* KF; bf16_t* VT;
    __device__ __forceinline__ void operator()(const f32x4 (&acc)[2][2][4][2], const Unit& u, int wr, int wc, int fr, int fq) const {
        const int b = u.pm >> 4, head = u.pn;
#pragma unroll
        for (int bj = 0; bj < 2; ++bj) {
            const int off = wc * 32;
            if (bj == 0) {
#pragma unroll
                for (int ai = 0; ai < 2; ++ai)
#pragma unroll
                    for (int m = 0; m < 4; ++m) { const int r = u.pm * 256 + ai * 128 + wr * 64 + m * 16 + fr, s = r & 4095;
                        bf16_t* kp = KF + (unsigned)(((b * 8 + head) * 4096 + s) * 192 + off + 4 * fq);
#pragma unroll
                        for (int n = 0; n < 2; ++n) { const f32x4 v = acc[ai][bj][m][n]; u32x2 o = {pk2(v[0], v[1]), pk2(v[2], v[3])}; *(u32x2*)(kp + 16 * n) = o; } __builtin_amdgcn_sched_barrier(0); }
            } else {
#pragma unroll
                for (int ai = 0; ai < 2; ++ai)
#pragma unroll
                    for (int m = 0; m < 4; ++m) { const int r = u.pm * 256 + ai * 128 + wr * 64 + m * 16 + fr, s = r & 4095;
#pragma unroll
                        for (int n = 0; n < 2; ++n) { const f32x4 v = acc[ai][bj][m][n]; const int dv = off + 16 * n + 4 * fq;
                            bf16_t* vp = VT + (unsigned)(((b * 8 + head) * 128 + dv) * 4096 + s);
                            const unsigned p01 = pk2(v[0], v[1]), p23 = pk2(v[2], v[3]);
                            vp[0] = (bf16_t)(p01 & 0xffffu); vp[4096] = (bf16_t)(p01 >> 16); vp[8192] = (bf16_t)(p23 & 0xffffu); vp[12288] = (bf16_t)(p23 >> 16); } __builtin_amdgcn_sched_barrier(0); }
            }
        }
    }
};
struct EpiHg {
    static constexpr bool PERM = true, AFTER_DRAIN = false, PERMA = false;
    unsigned char* R1b; const float* LB;
    __device__ __forceinline__ void operator()(const f32x4 (&acc)[2][2][4][2], const Unit& u, int wr, int wc, int fr, int fq) const {
        const int region = u.pn >> 2, row0 = u.pm * 256 + wr * 64 + fr, cc0 = (u.pn & 3) * 256 + wc * 32 + 8 * fq;
        if (region == 1) {
#pragma unroll
            for (int bj = 0; bj < 2; ++bj) { const int cc = cc0 + bj * 128;
                const f32x4 l0 = *(const f32x4*)(LB + cc), l1 = *(const f32x4*)(LB + cc + 4);
#pragma unroll
                for (int ai = 0; ai < 2; ++ai)
#pragma unroll
                    for (int m = 0; m < 4; ++m) { float* fp = (float*)(R1b + 32 * MiB) + (unsigned)((row0 + ai * 128 + m * 16) * 1024 + cc);
                        f32x4 v0 = acc[ai][bj][m][0], v1 = acc[ai][bj][m][1];
#pragma unroll
                        for (int e = 0; e < 4; ++e) { v0[e] = l0[e] + (1.f - l0[e]) * fast_sigmoid(v0[e]); v1[e] = l1[e] + (1.f - l1[e]) * fast_sigmoid(v1[e]); }
                        *(f32x4*)fp = v0; *(f32x4*)(fp + 4) = v1; __builtin_amdgcn_sched_barrier(0); } }
        } else {
            bf16_t* base = (bf16_t*)(R1b + (region == 0 ? (size_t)0 : (region == 2 ? 96 * MiB : 128 * MiB)));
#pragma unroll
            for (int ai = 0; ai < 2; ++ai)
#pragma unroll
                for (int m = 0; m < 4; ++m) { bf16_t* rowp = base + (unsigned)((row0 + ai * 128 + m * 16) * 1024 + cc0);
#pragma unroll
                    for (int bj = 0; bj < 2; ++bj) { f32x4 v0 = acc[ai][bj][m][0], v1 = acc[ai][bj][m][1];
                        if (region == 3) {
#pragma unroll
                            for (int e = 0; e < 4; ++e) { v0[e] = v0[e] * fast_sigmoid(v0[e]); v1[e] = v1[e] * fast_sigmoid(v1[e]); } }
                        u32x4 o = {pk2(v0[0], v0[1]), pk2(v0[2], v0[3]), pk2(v1[0], v1[1]), pk2(v1[2], v1[3])};
                        *(u32x4*)(rowp + bj * 128) = o; } }
        }
    }
};

struct EpiFFN {
    static constexpr bool PERM = true, AFTER_DRAIN = false, PERMA = true;
    bf16_t* ACT; const bf16_t* CWB;
    __device__ __forceinline__ static f32x4 shr1(const f32x4 v) { f32x4 r;
#pragma unroll
        for (int e = 0; e < 4; ++e) r[e] = __int_as_float(__builtin_amdgcn_update_dpp(0, __float_as_int(v[e]), 0x111, 0xf, 0xf, true));
        return r; }
    template <bool SPECIAL> __device__ __forceinline__ void group(const f32x4 (&acc)[2][2][4][2], int ai, int n, int tok0, int fr, int fcol,
            const f32x4 wg0, const f32x4 wg1, const f32x4 wg2, const f32x4 bg, const f32x4 wv0, const f32x4 wv1, const f32x4 wv2, const f32x4 bv) const {
        const f32x4 sg3 = shr1(acc[ai][0][3][n]), sg2 = shr1(acc[ai][0][2][n]), sv3 = shr1(acc[ai][1][3][n]), sv2 = shr1(acc[ai][1][2][n]);
#pragma unroll
        for (int m = 0; m < 4; ++m) {
            const f32x4 cg = acc[ai][0][m][n], cv = acc[ai][1][m][n];
            f32x4 p1g = m == 0 ? sg3 : acc[ai][0][m == 0 ? 0 : m - 1][n], p1v = m == 0 ? sv3 : acc[ai][1][m == 0 ? 0 : m - 1][n];
            f32x4 p2g = m == 0 ? sg2 : (m == 1 ? sg3 : acc[ai][0][m < 2 ? 0 : m - 2][n]), p2v = m == 0 ? sv2 : (m == 1 ? sv3 : acc[ai][1][m < 2 ? 0 : m - 2][n]);
            const int tok = tok0 + 4 * fr + m;
            if (SPECIAL) { const int sq = tok & 4095; const f32x4 z4 = {0.f, 0.f, 0.f, 0.f}; if (sq == 0) { p1g = z4; p1v = z4; } if (sq <= 1) { p2g = z4; p2v = z4; } }
            const f32x4 yg = bg + wg0 * p2g + wg1 * p1g + wg2 * cg, yv = bv + wv0 * p2v + wv1 * p1v + wv2 * cv;
            const f32x4 ex = yg * -1.4426950408889634f; f32x4 sg;
#pragma unroll
            for (int e = 0; e < 4; ++e) sg[e] = __builtin_amdgcn_rcpf(1.f + __builtin_amdgcn_exp2f(ex[e]));
            const f32x4 o = yg * sg * yv;
            if ((m >= 2 || fr > 0) && tok < T) { u32x2 ov = {pk2(o[0], o[1]), pk2(o[2], o[3])}; *(u32x2*)(ACT + (unsigned)(tok * 2816 + fcol)) = ov; }
        }
    }
    __device__ __forceinline__ void operator()(const f32x4 (&acc)[2][2][4][2], const Unit& u, int wr, int wc, int fr, int fq) const {
        const int fcol0 = u.pn * 128 + wc * 32 + 8 * fq;
        u32x4 tw[8];
#pragma unroll
        for (int i = 0; i < 8; ++i) tw[i] = *(const u32x4*)(CWB + (unsigned)((fcol0 + i) * 8));
#pragma unroll
        for (int n = 0; n < 2; ++n) {
            const int fcol = fcol0 + 4 * n;
            f32x4 wg0, wg1, wg2, bg, wv0, wv1, wv2, bv;
#pragma unroll
            for (int e = 0; e < 4; ++e) { const u32x4 t = tw[4 * n + e]; wg0[e] = bflo(t[0]); wg1[e] = bfhi(t[0]); wg2[e] = bflo(t[1]); bg[e] = bfhi(t[1]); wv0[e] = bflo(t[2]); wv1[e] = bfhi(t[2]); wv2[e] = bflo(t[3]); bv[e] = bfhi(t[3]); }
#pragma unroll
            for (int ai = 0; ai < 2; ++ai) {
                const int b0 = u.pm * 248 + (2 * ai + wr) * 62;
                const bool special = (((b0 + 61) >> 12) << 12) >= b0 - 1;
                if (special) group<true>(acc, ai, n, b0 - 2, fr, fcol, wg0, wg1, wg2, bg, wv0, wv1, wv2, bv);
                else group<false>(acc, ai, n, b0 - 2, fr, fcol, wg0, wg1, wg2, bg, wv0, wv1, wv2, bv);
            }
        }
    }
};

template <class Epi> __device__ __forceinline__ void run_gemm(const int s_wv, ldsp lds, const bf16_t* A, const bf16_t* Bt, int M, int N, int K, const Epi& E) {
    pg8::Gemm g{A, Bt, M, N, K}; pg8::StaticOrder S; S.init(M, N, (int)gridDim.x, obid());
    pg8::gemm_phase<Epi, pg8::StaticOrder, false>(s_wv, lds, g, S, E, nullptr);
}

__device__ __forceinline__ int rope_rowmap(int n) { const int head = n / 192, d = n - head * 192; if (d < 128) return n; const int r = d - 128, half = r >> 5, j = r & 31; return head * 192 + 128 + (j >> 4) * 32 + half * 16 + (j & 15); }
__device__ __forceinline__ int ffn_rowmap(int n) { const int half = n >= 2816 ? 1 : 0, f = n - half * 2816, t = f >> 7, i = f & 127; return t * 256 + half * 128 + i; }
struct TrJob { const float* src; int srcN, K, N; bf16_t* dst; int dstK, koff, rowoff, pmode; };
__device__ __forceinline__ void run_trjob(const int s_wv, const TrJob J, ldsp lds) {
    const int tid = otid(), lane = tid & 63, wave = tid >> 6;
    LAS float* sm = (LAS float*)(lds + wave * 8448);
    const int nkt = J.K / 32, nnt = J.N / 64, ntile = nkt * nnt;
    for (int t = obid() * 8 + wave; t < ntile; t += gridDim.x * 8) { const int kt = t % nkt, nt = t / nkt;
        const float* sp = J.src + (size_t)(kt * 32) * J.srcN + nt * 64 + lane;
        float v[32];
#pragma unroll
        for (int k = 0; k < 32; ++k) v[k] = sp[(size_t)k * J.srcN];
#pragma unroll
        for (int k = 0; k < 32; ++k) sm[lane * 33 + k] = v[k];
        const int kk = (lane & 15) * 2, nr = lane >> 4;
#pragma unroll
        for (int j = 0; j < 16; ++j) { const int n = nr + 4 * j, sn = nt * 64 + n, drow = J.rowoff + (J.pmode == 1 ? rope_rowmap(sn) : (J.pmode == 2 ? ffn_rowmap(sn) : sn));
            *(unsigned*)(J.dst + (size_t)drow * J.dstK + J.koff + kt * 32 + kk) = pk2(sm[n * 33 + kk], sm[n * 33 + kk + 1]); }
    }
}
__device__ __forceinline__ void zero_fill(bf16_t* dst, int rows, int cols8, int stride, int gtid, int gthreads) {
    const int n = rows * cols8; unsigned zz = 0u; asm volatile("" : "+v"(zz)); const u32x4 z = {zz, zz, zz, zz};
    for (int i = gtid; i < n; i += gthreads) { const int r = i / cols8, c = i - r * cols8; *(u32x4*)(dst + (size_t)r * stride + c * 8) = z; }
}
__device__ __forceinline__ void prep_layer(const int s_wv, KP p, int layer, ldsp lds) {
    bf16_t* WT = (bf16_t*)(p->ws + OFF_WT); const int kind = layer % 3, j = layer / 3;
    const int gtid = obid() * NTHREADS + otid(), gthreads = gridDim.x * NTHREADS;
    { const TrJob J0{p->in[23] + (size_t)layer * 1024 * 5632, 5632, 1024, 5632, WT + WT_FUP, 1024, 0, 0, 2};
      const TrJob J1{p->in[26] + (size_t)layer * 2816 * 1024, 1024, 2816, 1024, WT + WT_FDN, 2816, 0, 0, 0};
      run_trjob(s_wv, J0, lds); run_trjob(s_wv, J1, lds); }
    if (kind == 0) {
        const TrJob J0{p->in[7] + (size_t)j * 1024 * 4096, 4096, 1024, 4096, WT + WT_MIXA, 1024, 0, 0, 0};
        const TrJob J1{p->in[12] + (size_t)j * 2048 * 1024, 1024, 2048, 1024, WT + WT_MIXB, 2048, 0, 0, 0};
        run_trjob(s_wv, J0, lds); run_trjob(s_wv, J1, lds);
    } else if (kind == 1) {
        const TrJob J0{p->in[13], 448, 1024, 448, WT + WT_MIXA, 1024, 0, 0, 0};
        const TrJob J1{p->in[16], 1536, 256, 1536, WT + WT_MQKV, 256, 0, 0, 1};
        const TrJob J2{p->in[17], 2048, 128, 2048, WT + WT_MQKV + 393216, 256, 0, 0, 0};
        const TrJob J3{p->in[18], 1024, 1024, 1024, WT + WT_MIXB, 1024, 0, 0, 0};
        run_trjob(s_wv, J0, lds); run_trjob(s_wv, J1, lds); run_trjob(s_wv, J2, lds); run_trjob(s_wv, J3, lds);
        zero_fill(WT + WT_MIXA + (size_t)448 * 1024, 64, 128, 1024, gtid, gthreads);
        zero_fill(WT + WT_MQKV + 393216 + 128, 2048, 16, 256, gtid, gthreads);
    } else {
        const TrJob J0{p->in[20], 4096, 1024, 4096, WT + WT_MIXA, 1024, 0, 0, 0};
        const TrJob J1{p->in[22], 1024, 1024, 1024, WT + WT_MIXB, 1024, 0, 0, 0};
        run_trjob(s_wv, J0, lds); run_trjob(s_wv, J1, lds);
    }
}
__device__ __forceinline__ void phase_prologue(const int s_wv, KP p, ldsp lds) {
    const int tid = otid();
    float* MOD = (float*)(p->ws + OFF_MOD);
    LAS float* cact = (LAS float*)lds;
    LAS float* red = (LAS float*)(lds + 16384);
    for (int i = tid; i < 4096; i += NTHREADS) { const float c = p->in[1][i]; cact[i] = c * fast_sigmoid(c); }
    __syncthreads();
    const int l16 = tid & 15, kg = tid >> 4;
    for (int item = obid(); item < 4 * 96; item += gridDim.x) {
        const int layer = item / 96, n0 = (item % 96) * 64;
        const float* w = p->in[3] + (size_t)layer * 1024 * 6144 + n0 + 4 * l16;
        f32x4 a[4] = {{0.f, 0.f, 0.f, 0.f}, {0.f, 0.f, 0.f, 0.f}, {0.f, 0.f, 0.f, 0.f}, {0.f, 0.f, 0.f, 0.f}};
#pragma unroll 8
        for (int kk = 0; kk < 32; ++kk) { const int k = kg * 32 + kk; const f32x4 wv = *(const f32x4*)(w + (size_t)k * 6144);
#pragma unroll
            for (int b = 0; b < 4; ++b) a[b] = a[b] + wv * cact[b * 1024 + k]; }
#pragma unroll
        for (int b = 0; b < 4; ++b) *(LAS f32x4*)(red + (kg * 4 + b) * 64 + 4 * l16) = a[b];
        __syncthreads();
        if (tid < 256) { const int b = tid >> 6, col = tid & 63; float s = 0.f;
#pragma unroll 8
            for (int g = 0; g < 32; ++g) s += red[(g * 4 + b) * 64 + col];
            MOD[(size_t)(layer * 4 + b) * 6144 + n0 + col] = s + p->in[4][(size_t)layer * 6144 + n0 + col]; }
        __syncthreads();
    }
    const int gtid = obid() * NTHREADS + tid, gthreads = gridDim.x * NTHREADS;
    float* CSC = (float*)(p->ws + OFF_CSC); float* CSS = (float*)(p->ws + OFF_CSS);
    const int* pos = (const int*)p->in[2];
    for (int i = gtid; i < T * 32; i += gthreads) { const int t = i >> 5, jj = i & 31;
        const float invf = exp2f(-(float)jj * (13.287712379549449f / 32.f));
        const float ang = (float)pos[t] * invf;
        double rev = (double)ang * 0.15915494309189535; rev -= floor(rev);
        const float rf = (float)rev;
        CSC[i] = __builtin_amdgcn_cosf(rf); CSS[i] = __builtin_amdgcn_sinf(rf); }
    float* LB = (float*)(p->ws + OFF_LB);
    for (int i = gtid; i < 1024; i += gthreads) { const float l0 = p->in[19][i], l1 = p->in[19][1024 + i], l2 = p->in[19][2048 + i], l3 = p->in[19][3072 + i];
        const float mx = fmaxf(fmaxf(l0, l1), fmaxf(l2, l3)); const float e0 = __expf(l0 - mx), e1 = __expf(l1 - mx), e2 = __expf(l2 - mx), e3 = __expf(l3 - mx);
        LB[i] = (e1 + e2) / (e0 + e1 + e2 + e3); }
    prep_layer(s_wv, p, 0, lds);
}
__device__ __forceinline__ void up8(const u32x4 v, float (&o)[8]) { o[0] = bflo(v[0]); o[1] = bfhi(v[0]); o[2] = bflo(v[1]); o[3] = bfhi(v[1]); o[4] = bflo(v[2]); o[5] = bfhi(v[2]); o[6] = bflo(v[3]); o[7] = bfhi(v[3]); }
template <bool SRC32> __device__ __forceinline__ void phase_norm(const int s_wv, const float* X32, bf16_t* XB, const float* g, const float* shift, const float* scale, bf16_t* dst) {
    const int lane = otid() & 63, wave = otid() >> 6;
    for (int rb = obid() * 8 + wave; rb < T / 8; rb += gridDim.x * 8) {
        const int r0 = rb * 8, b = r0 >> 12;
        float G[16], SH[16];
#pragma unroll
        for (int j = 0; j < 2; ++j)
#pragma unroll
            for (int h = 0; h < 2; ++h) { const int c = 8 * lane + 512 * j + 4 * h; const f32x4 gg = *(const f32x4*)(g + c), sc = *(const f32x4*)(scale + (size_t)b * 6144 + c), sh = *(const f32x4*)(shift + (size_t)b * 6144 + c);
#pragma unroll
                for (int e = 0; e < 4; ++e) { G[j * 8 + h * 4 + e] = gg[e] * (sc[e] + 1.f); SH[j * 8 + h * 4 + e] = sh[e]; } }
        for (int r = r0; r < r0 + 8; ++r) {
            float x[16]; float ss = 0.f;
#pragma unroll
            for (int j = 0; j < 2; ++j) { const unsigned off = (unsigned)(r * 1024 + 8 * lane + 512 * j);
                if (SRC32) { const f32x4 a = *(const f32x4*)(X32 + off), c = *(const f32x4*)(X32 + off + 4);
#pragma unroll
                    for (int e = 0; e < 4; ++e) { x[j * 8 + e] = a[e]; x[j * 8 + 4 + e] = c[e]; }
                    u32x4 xo = {pk2(a[0], a[1]), pk2(a[2], a[3]), pk2(c[0], c[1]), pk2(c[2], c[3])}; *(u32x4*)(XB + off) = xo;
                } else { float t[8]; up8(*(const u32x4*)(XB + off), t);
#pragma unroll
                    for (int e = 0; e < 8; ++e) x[j * 8 + e] = t[e]; } }
#pragma unroll
            for (int e = 0; e < 16; ++e) ss += x[e] * x[e];
            ss = wave_sum(ss, lane); const float rstd = rsqrtf(ss * (1.f / 1024.f) + EPS);
#pragma unroll
            for (int j = 0; j < 2; ++j) { float h[8];
#pragma unroll
                for (int e = 0; e < 8; ++e) h[e] = x[j * 8 + e] * rstd * G[j * 8 + e] + SH[j * 8 + e];
                u32x4 o = {pk2(h[0], h[1]), pk2(h[2], h[3]), pk2(h[4], h[5]), pk2(h[6], h[7])}; *(u32x4*)(dst + (unsigned)(r * 1024 + 8 * lane + 512 * j)) = o; }
        }
    }
}
__device__ __forceinline__ void phase_final(const int s_wv, const bf16_t* XB, float* out, const float* g) {
    const int lane = otid() & 63, wave = otid() >> 6;
    for (int r = obid() * 8 + wave; r < T; r += gridDim.x * 8) {
        float x[16]; float ss = 0.f;
#pragma unroll
        for (int j = 0; j < 2; ++j) { float t[8]; up8(*(const u32x4*)(XB + (unsigned)(r * 1024 + 8 * lane + 512 * j)), t);
#pragma unroll
            for (int e = 0; e < 8; ++e) { x[j * 8 + e] = t[e]; ss += t[e] * t[e]; } }
        ss = wave_sum(ss, lane); const float rstd = rsqrtf(ss * (1.f / 1024.f) + EPS);
#pragma unroll
        for (int j = 0; j < 2; ++j)
#pragma unroll
            for (int h = 0; h < 2; ++h) { const int c = 8 * lane + 512 * j + 4 * h; const f32x4 gg = *(const f32x4*)(g + c);
                f32x4 o = {x[j * 8 + h * 4] * rstd * gg[0], x[j * 8 + h * 4 + 1] * rstd * gg[1], x[j * 8 + h * 4 + 2] * rstd * gg[2], x[j * 8 + h * 4 + 3] * rstd * gg[3]};
                *(f32x4*)(out + (size_t)r * 1024 + c) = o; }
    }
}
__device__ __forceinline__ void phase_ffix(const int s_wv, const bf16_t* SIDE, bf16_t* ACT, const float* cw, const float* cb) {
    const int gtid = obid() * NTHREADS + otid(), gthreads = gridDim.x * NTHREADS;
    for (int q = gtid; q < 256 * 2 * 352; q += gthreads) {
        const int cgp = q % 352, gi = q / 352, i = gi & 1, g = gi >> 1, f0 = cgp * 8;
        const bool first = (g & 63) == 0;
        const bf16_t* own = SIDE + (size_t)((g * 4 + 2 + i) * 2) * 2816 + f0;
        const bf16_t* p1 = i == 0 ? SIDE + (size_t)(((g - 1) * 4 + 1) * 2) * 2816 + f0 : SIDE + (size_t)((g * 4 + 2) * 2) * 2816 + f0;
        const bf16_t* p2 = i == 0 ? SIDE + (size_t)(((g - 1) * 4 + 0) * 2) * 2816 + f0 : SIDE + (size_t)(((g - 1) * 4 + 1) * 2) * 2816 + f0;
        float gc[8], vc[8], g1[8], v1[8], g2[8], v2[8];
        up8(*(const u32x4*)own, gc); up8(*(const u32x4*)(own + 2816), vc);
        if (i == 1 || !first) { up8(*(const u32x4*)p1, g1); up8(*(const u32x4*)(p1 + 2816), v1); } else {
#pragma unroll
            for (int e = 0; e < 8; ++e) { g1[e] = 0.f; v1[e] = 0.f; } }
        if (!first) { up8(*(const u32x4*)p2, g2); up8(*(const u32x4*)(p2 + 2816), v2); } else {
#pragma unroll
            for (int e = 0; e < 8; ++e) { g2[e] = 0.f; v2[e] = 0.f; } }
        float o[8];
#pragma unroll
        for (int e = 0; e < 8; ++e) { const int f = f0 + e;
            const float yg = cb[f] + cw[f] * g2[e] + cw[5632 + f] * g1[e] + cw[11264 + f] * gc[e], yv = cb[2816 + f] + cw[2816 + f] * v2[e] + cw[5632 + 2816 + f] * v1[e] + cw[11264 + 2816 + f] * vc[e];
            o[e] = yg * fast_sigmoid(yg) * yv; }
        u32x4 ov = {pk2(o[0], o[1]), pk2(o[2], o[3]), pk2(o[4], o[5]), pk2(o[6], o[7])};
        *(u32x4*)(ACT + (size_t)(g * 64 + i) * 2816 + f0) = ov;
    }
}

__device__ __forceinline__ void phase_gsp(const int s_wv, KP p, int j, ldsp lds) {
    const bf16_t* Z = (const bf16_t*)(p->ws + OFF_R1); bf16_t* Y = (bf16_t*)(p->ws + OFF_R2);
    const float* ws_w = p->in[10] + (size_t)j * 8 * 128 * 128; const float* bs = p->in[11] + (size_t)j * 8 * 128;
    const float* lng = p->in[8] + (size_t)j * 2048; const float* lnb = p->in[9] + (size_t)j * 2048;
    const int tid = otid(), lane = tid & 63, wave = tid >> 6, l15 = lane & 15, g4 = lane >> 4;
    ldsp As = lds, Bs = lds + 34816; LAS float* mu = (LAS float*)(lds + 104448); LAS float* rs = mu + 128;
    for (int unit = obid(); unit < 256; unit += gridDim.x) {
        const int gh = unit & 1, chunk = unit >> 1, t0 = chunk * 128;
        for (int rr = 0; rr < 16; ++rr) { const int r = wave * 16 + rr; const bf16_t* zp = Z + (size_t)(t0 + r) * 4096 + 2048 + lane * 32; float s = 0.f, s2 = 0.f;
#pragma unroll
            for (int i = 0; i < 4; ++i) { float v[8]; up8(*(const u32x4*)(zp + 8 * i), v);
#pragma unroll
                for (int e = 0; e < 8; ++e) { s += v[e]; s2 += v[e] * v[e]; } }
            s = wave_sum(s, lane); s2 = wave_sum(s2, lane);
            if (lane == 0) { const float m = s * (1.f / 2048.f); float var = s2 * (1.f / 2048.f) - m * m; var = fmaxf(var, 0.f); mu[r] = m; rs[r] = rsqrtf(var + EPS); } }
        __syncthreads();
        for (int gi = 0; gi < 4; ++gi) {
            const int g = gh * 4 + gi;
#pragma unroll 2
            for (int i = 0; i < 8; ++i) { const int idx = tid + 512 * i, t = idx >> 5, s4 = (idx & 31) * 4; f32x4 w = *(const f32x4*)(ws_w + (size_t)g * 16384 + t * 128 + s4);
#pragma unroll
                for (int e = 0; e < 4; ++e) w[e] = (s4 + e <= t) ? w[e] : 0.f;
                u32x2 o = {pk2(w[0], w[1]), pk2(w[2], w[3])}; *(LAS u32x2*)(As + t * 272 + s4 * 2) = o; }
#pragma unroll 2
            for (int i = 0; i < 8; ++i) { const int idx = tid + 512 * i, s = idx >> 5, c8 = idx & 31; float v[8]; up8(*(const u32x4*)(Z + (size_t)(t0 + s) * 4096 + 2048 + g * 256 + c8 * 8), v);
                const float m = mu[s], r = rs[s]; const f32x4 ga = *(const f32x4*)(lng + g * 256 + c8 * 8), gb = *(const f32x4*)(lng + g * 256 + c8 * 8 + 4), ba = *(const f32x4*)(lnb + g * 256 + c8 * 8), bb = *(const f32x4*)(lnb + g * 256 + c8 * 8 + 4);
                const int boff = (((s >> 3) ^ (c8 & 15)) << 4) + (s & 7) * 2;
#pragma unroll
                for (int e = 0; e < 8; ++e) { const float gg = e < 4 ? ga[e] : gb[e - 4], bbv = e < 4 ? ba[e] : bb[e - 4]; const float val = (v[e] - m) * r * gg + bbv;
                    *(LAS bf16_t*)(Bs + (c8 * 8 + e) * 272 + boff) = (bf16_t)(pk2(val, 0.f) & 0xffffu); } }
            __syncthreads();
            f32x4 acc[8][2];
#pragma unroll
            for (int tt = 0; tt < 8; ++tt) { acc[tt][0] = zero4(); acc[tt][1] = zero4(); }
#pragma unroll
            for (int tt = 0; tt < 8; ++tt)
#pragma unroll
                for (int ks = 0; ks <= tt / 2; ++ks) { const bf16x8 yf = *(const LAS bf16x8*)(As + (16 * tt + l15) * 272 + (32 * ks + 8 * g4) * 2);
#pragma unroll
                    for (int ct = 0; ct < 2; ++ct) { const int c = 32 * wave + 16 * ct + l15; const bf16x8 xf = *(const LAS bf16x8*)(Bs + c * 272 + (((4 * ks + g4) ^ ((c >> 3) & 15)) << 4));
                        acc[tt][ct] = MFMA16(xf, yf, acc[tt][ct]); } }
#pragma unroll
            for (int tt = 0; tt < 8; ++tt) { const int t = 16 * tt + l15; const float bias = bs[g * 128 + t];
#pragma unroll
                for (int ct = 0; ct < 2; ++ct) { const int c = g * 256 + 32 * wave + 16 * ct + 4 * g4; const u32x2 uu = *(const u32x2*)(Z + (size_t)(t0 + t) * 4096 + c);
                    const f32x4 a = acc[tt][ct]; u32x2 o = {pk2(bflo(uu[0]) * (a[0] + bias), bfhi(uu[0]) * (a[1] + bias)), pk2(bflo(uu[1]) * (a[2] + bias), bfhi(uu[1]) * (a[3] + bias))};
                    *(u32x2*)(Y + (size_t)(t0 + t) * 2048 + c) = o; } }
            __syncthreads();
        }
    }
}

__device__ __forceinline__ void phase_m2(const int s_wv, KP p) {
    const float* A1 = (const float*)(p->ws + OFF_R1); bf16_t* CQN = (bf16_t*)(p->ws + OFF_R1 + 32 * MiB); bf16_t* CKVN = (bf16_t*)(p->ws + OFF_R1 + 40 * MiB); bf16_t* KF = (bf16_t*)(p->ws + OFF_R1 + 96 * MiB);
    const float* CSC = (const float*)(p->ws + OFF_CSC); const float* CSS = (const float*)(p->ws + OFF_CSS);
    const int lane = otid() & 63, wave = otid() >> 6;
    const f32x4 qg = *(const f32x4*)(p->in[14] + 4 * lane); const f32x4 kg = *(const f32x4*)(p->in[15] + 4 * (lane & 31));
    for (int r = obid() * 8 + wave; r < T; r += gridDim.x * 8) {
        const float* a = A1 + (size_t)r * 512;
        const f32x4 cq = *(const f32x4*)(a + 4 * lane); float ss = wave_sum(cq[0] * cq[0] + cq[1] * cq[1] + cq[2] * cq[2] + cq[3] * cq[3], lane);
        const float rq = rsqrtf(ss * (1.f / 256.f) + EPS);
        { const f32x4 h = cq * rq * qg; u32x2 o = {pk2(h[0], h[1]), pk2(h[2], h[3])}; *(u32x2*)(CQN + (size_t)r * 256 + 4 * lane) = o; }
        const f32x4 ck = *(const f32x4*)(a + 256 + 4 * (lane & 31)); float s2 = lane < 32 ? (ck[0] * ck[0] + ck[1] * ck[1] + ck[2] * ck[2] + ck[3] * ck[3]) : 0.f; s2 = wave_sum(s2, lane);
        const float rk = rsqrtf(s2 * (1.f / 128.f) + EPS);
        { const f32x4 h = ck * rk * kg; u32x2 o = {pk2(h[0], h[1]), pk2(h[2], h[3])}; if (lane >= 32) { o[0] = 0u; o[1] = 0u; } *(u32x2*)(CKVN + (size_t)r * 256 + 4 * lane) = o; }
        if (lane < 32) {
            const float x1 = a[384 + lane], x2 = a[416 + lane], c = CSC[(size_t)r * 32 + lane], s = CSS[(size_t)r * 32 + lane];
            const unsigned pr = pk2(x1 * c - x2 * s, x2 * c + x1 * s); const int b = r >> 12, sq = r & 4095;
#pragma unroll
            for (int h8 = 0; h8 < 8; ++h8) { bf16_t* kp = KF + ((size_t)((b * 8 + h8) * 4096 + sq)) * 192 + 128 + lane; kp[0] = (bf16_t)(pr & 0xffffu); kp[32] = (bf16_t)(pr >> 16); } }
    }
}

__device__ __forceinline__ void phase_attn(const int s_wv, KP p, ldsp lds) {
    const bf16_t* QF = (const bf16_t*)(p->ws + OFF_R1 + 48 * MiB); const bf16_t* KF = (const bf16_t*)(p->ws + OFF_R1 + 96 * MiB); const bf16_t* VT = (const bf16_t*)(p->ws + OFF_R1 + 144 * MiB);
    bf16_t* O = (bf16_t*)(p->ws + OFF_R2);
    const int tid = otid(), lane = tid & 63, wave = __builtin_amdgcn_readfirstlane(tid >> 6), l15 = lane & 15, g4 = lane >> 4;
    const int G = gridDim.x, bx = obid(), vcu = (G % 8 == 0) ? (bx % 8) * (G / 8) + bx / 8 : bx;
    constexpr int KB = 25600, VB = 18432, BUF = KB + VB;
    for (int unit = vcu; unit < 256; unit += G) {
        const int bh = unit >> 3, pr = unit & 7, b = bh >> 3, h = bh & 7;
        const unsigned char* kbase = (const unsigned char*)(KF + (size_t)bh * 4096 * 192);
        const unsigned char* vbase = (const unsigned char*)(VT + (size_t)bh * 128 * 4096);
        for (int half = 0; half < 2; ++half) {
            const int qb = half == 0 ? 15 - pr : pr, ntile = 4 * qb + 4;
            const int qrow0 = qb * 256 + 32 * wave;
            bf16x8 Qf[2][6];
#pragma unroll
            for (int qt = 0; qt < 2; ++qt)
#pragma unroll
                for (int ks = 0; ks < 6; ++ks) Qf[qt][ks] = *(const bf16x8*)((const unsigned char*)(QF + (size_t)(bh * 4096 + qrow0) * 192) + (unsigned)(((16 * qt + l15) * 192 + 32 * ks + 8 * g4) * 2));
            f32x4 Oa[2][8]; float mrun[2] = {-1e30f, -1e30f}, lsum[2] = {0.f, 0.f};
#pragma unroll
            for (int qt = 0; qt < 2; ++qt)
#pragma unroll
                for (int d = 0; d < 8; ++d) Oa[qt][d] = zero4();
            u32x4 kr[3], vr[2];
#define ATT_LOADK(j) do { _Pragma("unroll") for (int i = 0; i < 3; ++i) kr[i] = *(const u32x4*)(kbase + (size_t)(j) * 24576 + (unsigned)((tid + 512 * i) * 16)); } while (0)
#define ATT_LOADV(j) do { _Pragma("unroll") for (int i = 0; i < 2; ++i) { const int c = tid + 512 * i, dv = c >> 3, k8 = c & 7; vr[i] = *(const u32x4*)(vbase + (size_t)(j) * 128 + (unsigned)(dv * 8192 + k8 * 16)); } } while (0)
#define ATT_WRITEK(bufi) do { ldsp kb_ = lds + (bufi) * BUF; \
                         _Pragma("unroll") for (int i = 0; i < 3; ++i) { const int c = tid + 512 * i, row = c / 24, c16 = c - row * 24; *(LAS u32x4*)(kb_ + row * 400 + c16 * 16) = kr[i]; } } while (0)
#define ATT_WRITEV(bufi) do { ldsp vb_ = lds + (bufi) * BUF + KB; \
                         _Pragma("unroll") for (int i = 0; i < 2; ++i) { const int c = tid + 512 * i, dv = c >> 3, k8 = c & 7; *(LAS u32x4*)(vb_ + dv * 144 + k8 * 16) = vr[i]; } } while (0)
            ATT_LOADK(0); ATT_LOADV(0); ATT_WRITEK(0); ATT_WRITEV(0); __syncthreads();
#pragma unroll 1
            for (int j = 0; j < ntile; ++j) {
                if (j + 1 < ntile) ATT_LOADK(j + 1);
                const int jj = j - 4 * qb; const bool diag = jj >= 0; const bool active = !(diag && 64 * jj > 32 * wave + 31);
                ldsp Kb = lds + (j & 1) * BUF; ldsp Vb = Kb + KB;
#pragma unroll
                for (int hs = 0; hs < 2; ++hs) {
                    if (active) {
                        f32x4 S[2][2];
#pragma unroll
                        for (int qt = 0; qt < 2; ++qt) { S[qt][0] = zero4(); S[qt][1] = zero4(); }
#pragma unroll
                        for (int ks = 0; ks < 6; ++ks)
#pragma unroll
                            for (int sb = 0; sb < 2; ++sb) { const bf16x8 kx = *(const LAS bf16x8*)(Kb + (16 * (2 * hs + sb) + l15) * 400 + (32 * ks + 8 * g4) * 2);
                                S[0][sb] = MFMA16(kx, Qf[0][ks], S[0][sb]); S[1][sb] = MFMA16(kx, Qf[1][ks], S[1][sb]); }
                        bf16x8 Pf[2];
#pragma unroll
                        for (int qt = 0; qt < 2; ++qt) {
                            if (diag) { int dq = 32 * wave + 16 * qt + l15 - 4 * g4 - 64 * jj; asm volatile("" : "+v"(dq));
#pragma unroll
                                for (int sb = 0; sb < 2; ++sb)
#pragma unroll
                                    for (int e = 0; e < 4; ++e) { if (32 * hs + 16 * sb + e > dq) S[qt][sb][e] = -1e30f; } }
                            float tm = -1e30f;
#pragma unroll
                            for (int sb = 0; sb < 2; ++sb)
#pragma unroll
                                for (int e = 0; e < 4; ++e) tm = fmaxf(tm, S[qt][sb][e]);
                            tm = fmaxf(tm, shx(tm, 16, lane)); tm = fmaxf(tm, shx(tm, 32, lane));
                            if (__builtin_amdgcn_ballot_w64(tm > mrun[qt]) != 0ull) {
                                const float mn = fmaxf(mrun[qt], tm), sc = __builtin_amdgcn_exp2f(mrun[qt] - mn); mrun[qt] = mn; lsum[qt] *= sc;
#pragma unroll
                                for (int d = 0; d < 8; ++d) Oa[qt][d] = Oa[qt][d] * sc; }
                            const float mn = mrun[qt];
                            float ps = 0.f;
#pragma unroll
                            for (int sb = 0; sb < 2; ++sb)
#pragma unroll
                                for (int e = 0; e < 4; ++e) { const float pe = __builtin_amdgcn_exp2f(S[qt][sb][e] - mn); S[qt][sb][e] = pe; ps += pe; }
                            lsum[qt] += ps;
                            Pf[qt] = mk8(pk2(S[qt][0][0], S[qt][0][1]), pk2(S[qt][0][2], S[qt][0][3]), pk2(S[qt][1][0], S[qt][1][1]), pk2(S[qt][1][2], S[qt][1][3]));
                        }
#pragma unroll
                        for (int d = 0; d < 8; ++d) { const bf16x4 va = *(const LAS bf16x4*)(Vb + (16 * d + l15) * 144 + (32 * hs + 4 * g4) * 2), vb2 = *(const LAS bf16x4*)(Vb + (16 * d + l15) * 144 + (32 * hs + 16 + 4 * g4) * 2);
                            const bf16x8 vx = __builtin_shufflevector(va, vb2, 0, 1, 2, 3, 4, 5, 6, 7);
                            Oa[0][d] = MFMA16(vx, Pf[0], Oa[0][d]); Oa[1][d] = MFMA16(vx, Pf[1], Oa[1][d]); }
                    }
                    if (j + 1 < ntile) { if (hs == 0) { ATT_WRITEK((j + 1) & 1); ATT_LOADV(j + 1); } else { ATT_WRITEV((j + 1) & 1); } }
                }
                __syncthreads();
            }
#pragma unroll
            for (int qt = 0; qt < 2; ++qt) { float ls = lsum[qt]; ls += shx(ls, 16, lane); ls += shx(ls, 32, lane); const float inv = 1.f / ls;
                bf16_t* op = (bf16_t*)((unsigned char*)(O + (size_t)(b * 4096 + qrow0) * 1024 + h * 128) + (unsigned)(((16 * qt + l15) * 1024 + 4 * g4) * 2));
#pragma unroll
                for (int d = 0; d < 8; ++d) { const f32x4 v = Oa[qt][d] * inv; u32x2 o = {pk2(v[0], v[1]), pk2(v[2], v[3])}; *(u32x2*)(op + 16 * d) = o; } }
        }
    }
#undef ATT_LOADK
#undef ATT_LOADV
#undef ATT_WRITEK
#undef ATT_WRITEV
}

template <bool TOF32> __device__ __forceinline__ void hg_load_f_v(const float* HF, const bf16_t* HV, int t0, int col0, LAS float* BC, LAS float* K1f, ldsp K1b, ldsp VTl, int tid) {
#pragma unroll
    for (int i = 0; i < 4; ++i) { const int idx = tid + 512 * i, s = idx >> 5, k4 = (idx & 31) * 4; const f32x4 f = *(const f32x4*)(HF + (size_t)(t0 + s) * 1024 + col0 + k4);
#pragma unroll
        for (int e = 0; e < 4; ++e) BC[s * 129 + k4 + e] = __logf(f[e]);
        if (TOF32) {
#pragma unroll
            for (int e = 0; e < 4; ++e) K1f[s * 129 + k4 + e] = 1.f - f[e];
        } else { u32x2 o = {pk2(1.f - f[0], 1.f - f[1]), pk2(1.f - f[2], 1.f - f[3])}; *(LAS u32x2*)(K1b + s * 272 + k4 * 2) = o; } }
#pragma unroll
    for (int i = 0; i < 2; ++i) { const int idx = tid + 512 * i, s = idx >> 4, v8 = idx & 15; const u32x4 vv = *(const u32x4*)(HV + (size_t)(t0 + s) * 1024 + col0 + v8 * 8);
#pragma unroll
        for (int e = 0; e < 4; ++e) { *(LAS bf16_t*)(VTl + (v8 * 8 + 2 * e) * 144 + s * 2) = (bf16_t)(vv[e] & 0xffffu); *(LAS bf16_t*)(VTl + (v8 * 8 + 2 * e + 1) * 144 + s * 2) = (bf16_t)(vv[e] >> 16); } }
}
__device__ __forceinline__ void phase_ha(const int s_wv, KP p, ldsp lds) {
    const float* HF = (const float*)(p->ws + OFF_R1 + 32 * MiB); const bf16_t* HV = (const bf16_t*)(p->ws + OFF_R1 + 96 * MiB);
    bf16_t* LCT = (bf16_t*)(p->ws + OFF_R2); float* DEC = (float*)(p->ws + OFF_R2 + 64 * MiB);
    const int tid = otid(), lane = tid & 63, wave = tid >> 6, l15 = lane & 15, g4 = lane >> 4;
    LAS float* BC = (LAS float*)lds; LAS float* K1 = (LAS float*)(lds + 33024); ldsp KT = lds + 66048; ldsp VTl = lds + 84480;
    for (int u = obid(); u < 2048; u += gridDim.x) {
        const int bh = u >> 6, n = u & 63, b = bh >> 3, h = bh & 7, t0 = b * 4096 + n * 64, col0 = h * 128;
        hg_load_f_v<true>(HF, HV, t0, col0, BC, K1, VTl, VTl, tid);
        __syncthreads();
        if (tid < 128) { float run = 0.f;
#pragma unroll 8
            for (int s = 0; s < 64; ++s) { run += BC[s * 129 + tid]; BC[s * 129 + tid] = run; }
            DEC[(size_t)u * 128 + tid] = __expf(run); }
        __syncthreads();
        { const int sp = tid & 31, kk0 = tid >> 5;
#pragma unroll
          for (int it = 0; it < 8; ++it) { const int k = kk0 + 16 * it; const float bl = BC[63 * 129 + k];
              const float a0 = K1[(2 * sp) * 129 + k] * __expf(bl - BC[(2 * sp) * 129 + k]), a1 = K1[(2 * sp + 1) * 129 + k] * __expf(bl - BC[(2 * sp + 1) * 129 + k]);
              *(LAS unsigned*)(KT + k * 144 + sp * 4) = pk2(a0, a1); } }
        __syncthreads();
        f32x4 acc[8];
#pragma unroll
        for (int vt = 0; vt < 8; ++vt) acc[vt] = zero4();
#pragma unroll
        for (int ks = 0; ks < 2; ++ks) { const bf16x8 xf = *(const LAS bf16x8*)(KT + (16 * wave + l15) * 144 + (32 * ks + 8 * g4) * 2);
#pragma unroll
            for (int vt = 0; vt < 8; ++vt) { const bf16x8 yf = *(const LAS bf16x8*)(VTl + (16 * vt + l15) * 144 + (32 * ks + 8 * g4) * 2); acc[vt] = MFMA16(xf, yf, acc[vt]); } }
#pragma unroll
        for (int vt = 0; vt < 8; ++vt) { u32x2 o = {pk2(acc[vt][0], acc[vt][1]), pk2(acc[vt][2], acc[vt][3])}; *(u32x2*)(LCT + ((size_t)u * 128 + 16 * vt + l15) * 128 + 16 * wave + 4 * g4) = o; }
        __syncthreads();
    }
}
__device__ __forceinline__ void phase_hscan(const int s_wv, KP p) {
    bf16_t* LCT = (bf16_t*)(p->ws + OFF_R2); const float* DEC = (const float*)(p->ws + OFF_R2 + 64 * MiB);
    const int gtid = obid() * NTHREADS + otid(), gthreads = gridDim.x * NTHREADS;
    for (int id = gtid; id < 32 * 128 * 32; id += gthreads) {
        const int k4 = id & 31, v = (id >> 5) & 127, bh = id >> 12;
        f32x4 st = zero4();
#pragma unroll 4
        for (int n = 0; n < 64; ++n) { const int u = bh * 64 + n; bf16_t* ptr = LCT + ((size_t)u * 128 + v) * 128 + 4 * k4;
            const u32x2 t = *(const u32x2*)ptr; const f32x4 dec = *(const f32x4*)(DEC + (size_t)u * 128 + 4 * k4);
            u32x2 o = {pk2(st[0], st[1]), pk2(st[2], st[3])}; *(u32x2*)ptr = o;
            st[0] = dec[0] * st[0] + bflo(t[0]); st[1] = dec[1] * st[1] + bfhi(t[0]); st[2] = dec[2] * st[2] + bflo(t[1]); st[3] = dec[3] * st[3] + bfhi(t[1]); }
    }
}
__device__ __forceinline__ void phase_hc(const int s_wv, KP p, ldsp lds) {
    const bf16_t* HQ = (const bf16_t*)(p->ws + OFF_R1); const float* HF = (const float*)(p->ws + OFF_R1 + 32 * MiB); const bf16_t* HV = (const bf16_t*)(p->ws + OFF_R1 + 96 * MiB); const bf16_t* HG = (const bf16_t*)(p->ws + OFF_R1 + 128 * MiB);
    const bf16_t* SST = (const bf16_t*)(p->ws + OFF_R2); bf16_t* O = (bf16_t*)(p->ws + OFF_HB); const float* ng = p->in[21];
    const int tid = otid(), lane = tid & 63, wave = tid >> 6, l15 = lane & 15, g4 = lane >> 4;
    LAS float* BC = (LAS float*)lds; ldsp QT = lds + 33024; ldsp KTl = lds + 50432; ldsp QH = lds + 67840; ldsp VTl = lds + 85248; ldsp AT = lds + 103680; LAS float* SSQ = (LAS float*)(lds + 112896);
    for (int u = obid(); u < 2048; u += gridDim.x) {
        const int bh = u >> 6, n = u & 63, b = bh >> 3, h = bh & 7, t0 = b * 4096 + n * 64, col0 = h * 128;
        hg_load_f_v<false>(HF, HV, t0, col0, BC, BC, KTl, VTl, tid);
        u32x4 qraw[2];
#pragma unroll
        for (int i = 0; i < 2; ++i) { const int idx = tid + 512 * i, s = idx >> 4, k8 = idx & 15; qraw[i] = *(const u32x4*)(HQ + (size_t)(t0 + s) * 1024 + col0 + k8 * 8); }
        __syncthreads();
        if (tid < 128) { float run = 0.f;
#pragma unroll 8
            for (int s = 0; s < 64; ++s) { run += BC[s * 129 + tid]; BC[s * 129 + tid] = run; } }
        __syncthreads();
#pragma unroll
        for (int i = 0; i < 2; ++i) { const int idx = tid + 512 * i, s = idx >> 4, k8 = idx & 15; float q[8], kk[8], qt[8], qh[8]; up8(qraw[i], q); up8(*(const LAS u32x4*)(KTl + s * 272 + k8 * 16), kk);
#pragma unroll
            for (int e = 0; e < 8; ++e) { const int k = k8 * 8 + e; const float bc = BC[s * 129 + k], bm = BC[31 * 129 + k]; qt[e] = q[e] * __expf(bc - bm); qh[e] = q[e] * __expf(bc); kk[e] = kk[e] * __expf(bm - bc); }
            u32x4 o1 = {pk2(qt[0], qt[1]), pk2(qt[2], qt[3]), pk2(qt[4], qt[5]), pk2(qt[6], qt[7])}, o2 = {pk2(qh[0], qh[1]), pk2(qh[2], qh[3]), pk2(qh[4], qh[5]), pk2(qh[6], qh[7])}, o3 = {pk2(kk[0], kk[1]), pk2(kk[2], kk[3]), pk2(kk[4], kk[5]), pk2(kk[6], kk[7])};
            *(LAS u32x4*)(QT + s * 272 + k8 * 16) = o1; *(LAS u32x4*)(QH + s * 272 + k8 * 16) = o2; *(LAS u32x4*)(KTl + s * 272 + k8 * 16) = o3; }
        __syncthreads();
        { const int st = wave & 3;
#pragma unroll
          for (int ti = 0; ti < 2; ++ti) { const int tt = 2 * (wave >> 2) + ti; f32x4 a = zero4();
              if (st <= tt) {
#pragma unroll
                  for (int ks = 0; ks < 4; ++ks) { const bf16x8 xf = *(const LAS bf16x8*)(KTl + (16 * st + l15) * 272 + (32 * ks + 8 * g4) * 2), yf = *(const LAS bf16x8*)(QT + (16 * tt + l15) * 272 + (32 * ks + 8 * g4) * 2); a = MFMA16(xf, yf, a); }
                  const int t = 16 * tt + l15;
#pragma unroll
                  for (int e = 0; e < 4; ++e) { const int s = 16 * st + 4 * g4 + e; if (s > t) a[e] = 0.f; } }
              u32x2 o = {pk2(a[0], a[1]), pk2(a[2], a[3])}; *(LAS u32x2*)(AT + (16 * tt + l15) * 144 + (16 * st + 4 * g4) * 2) = o; } }
        __syncthreads();
        { const int tt = wave >> 1, vh = wave & 1; f32x4 acc[4];
#pragma unroll
          for (int vi = 0; vi < 4; ++vi) acc[vi] = zero4();
#pragma unroll
          for (int ks = 0; ks < 2; ++ks) if (32 * ks <= 16 * tt + 15) { const bf16x8 yf = *(const LAS bf16x8*)(AT + (16 * tt + l15) * 144 + (32 * ks + 8 * g4) * 2);
#pragma unroll
              for (int vi = 0; vi < 4; ++vi) { const bf16x8 xf = *(const LAS bf16x8*)(VTl + (16 * (4 * vh + vi) + l15) * 144 + (32 * ks + 8 * g4) * 2); acc[vi] = MFMA16(xf, yf, acc[vi]); } }
#pragma unroll
          for (int ks = 0; ks < 4; ++ks) { const bf16x8 yf = *(const LAS bf16x8*)(QH + (16 * tt + l15) * 272 + (32 * ks + 8 * g4) * 2);
#pragma unroll
              for (int vi = 0; vi < 4; ++vi) { const bf16x8 xf = *(const bf16x8*)(SST + ((size_t)u * 128 + 16 * (4 * vh + vi) + l15) * 128 + 32 * ks + 8 * g4); acc[vi] = MFMA16(xf, yf, acc[vi]); } }
          float sq = 0.f;
#pragma unroll
          for (int vi = 0; vi < 4; ++vi)
#pragma unroll
              for (int e = 0; e < 4; ++e) sq += acc[vi][e] * acc[vi][e];
          sq += shx(sq, 16, lane); sq += shx(sq, 32, lane);
          if (g4 == 0) SSQ[(16 * tt + l15) * 2 + vh] = sq;
          __syncthreads();
          const int t = 16 * tt + l15; const float rstd = rsqrtf((SSQ[t * 2] + SSQ[t * 2 + 1]) * (1.f / 128.f) + EPS);
#pragma unroll
          for (int vi = 0; vi < 4; ++vi) { const int v = 16 * (4 * vh + vi) + 4 * g4; const f32x4 gn = *(const f32x4*)(ng + v); const u32x2 gg = *(const u32x2*)(HG + (size_t)(t0 + t) * 1024 + col0 + v);
              const f32x4 a = acc[vi] * rstd * gn; u32x2 o = {pk2(a[0] * bflo(gg[0]), a[1] * bfhi(gg[0])), pk2(a[2] * bflo(gg[1]), a[3] * bfhi(gg[1]))};
              *(u32x2*)(O + (size_t)(t0 + t) * 1024 + col0 + v) = o; } }
        __syncthreads();
    }
}

__global__ void __launch_bounds__(NTHREADS, 2) fwd_kernel(Params pk) {
    extern __shared__ __attribute__((aligned(16))) unsigned char smem[];
    ldsp lds = (ldsp)smem;
    const int ph_lo = pk.ph_lo, ph_hi = pk.ph_hi;
    const int s_wv = __builtin_amdgcn_readfirstlane((int)threadIdx.x >> 6);
    if (threadIdx.x < 4) ((LAS unsigned*)(lds + 131072))[threadIdx.x] = 0u;
    __syncthreads();
    XcdBarrier xbar = xcd_barrier_post((unsigned*)(pk.ws + OFF_BAR), (volatile LAS unsigned*)(lds + 131072), (int)threadIdx.x);
    for (int ph = ph_lo; ph < ph_hi; ++ph) {
        KP p = (KP)__builtin_amdgcn_kernarg_segment_ptr();
        asm volatile("" : "+s"(p));
        const int op = p->op[ph], layraw = p->lay[ph], layer = layraw & 3; const bool dummy = (layraw & 4) != 0;
        unsigned char* ws = p->ws; bf16_t* xdst = dummy ? (bf16_t*)(ws + OFF_R1) : (bf16_t*)(ws + OFF_XB);
        float* MOD = (float*)(ws + OFF_MOD); bf16_t* WT = (bf16_t*)(ws + OFF_WT); bf16_t* HB = (bf16_t*)(ws + OFF_HB); bf16_t* XB = (bf16_t*)(ws + OFF_XB);
        bf16_t* R1 = (bf16_t*)(ws + OFF_R1); bf16_t* R2 = (bf16_t*)(ws + OFF_R2);
        const float* modl = MOD + (size_t)layer * 4 * 6144;
        switch (op) {
        case OP_PRO: phase_prologue(s_wv, p, lds); break;
        case OP_NORM1: if (layer == 0) phase_norm<true>(s_wv, p->in[0], XB, p->in[5], modl + 0, modl + 1024, HB); else { phase_norm<false>(s_wv, p->in[0], XB, p->in[5] + layer * 1024, modl + 0, modl + 1024, HB); prep_layer(s_wv, p, layer, lds); } break;
        case OP_NORM2: { const float* cw = p->in[24] + (size_t)layer * 3 * 5632; const float* cb = p->in[25] + (size_t)layer * 5632; bf16_t* CWB = (bf16_t*)(ws + OFF_CWB);
                         for (int f = obid() * NTHREADS + otid(); f < 2816; f += gridDim.x * NTHREADS) { u32x4 o = {pk2(cw[f], cw[5632 + f]), pk2(cw[11264 + f], cb[f]), pk2(cw[2816 + f], cw[5632 + 2816 + f]), pk2(cw[11264 + 2816 + f], cb[2816 + f])}; *(u32x4*)(CWB + f * 8) = o; }
                         phase_norm<false>(s_wv, p->in[0], XB, p->in[6] + layer * 1024, modl + 3072, modl + 4096, HB); } break;
        case OP_G1: { EpiBf16<1> E{R1, 4096}; run_gemm(s_wv, lds, HB, WT + WT_MIXA, T, 4096, 1024, E); } break;
        case OP_GSP: phase_gsp(s_wv, p, layer / 3, lds); break;
        case OP_GOUT: { EpiRes E{XB, xdst, modl + 2048}; run_gemm(s_wv, lds, R2, WT + WT_MIXB, T, 1024, 2048, E); } break;
        case OP_M1: { EpiF32 E{(float*)R1, 512}; run_gemm(s_wv, lds, HB, WT + WT_MIXA, T, 512, 1024, E); } break;
        case OP_M2: phase_m2(s_wv, p); break;
        case OP_M3: { EpiQ EQ{(bf16_t*)(ws + OFF_R1 + 48 * MiB), (const float*)(ws + OFF_CSC), (const float*)(ws + OFF_CSS), 0.07216878364870322f * 1.4426950408889634f}; run_gemm(s_wv, lds, (const bf16_t*)(ws + OFF_R1 + 32 * MiB), WT + WT_MQKV, T, 1536, 256, EQ); EpiKV EK{(bf16_t*)(ws + OFF_R1 + 96 * MiB), (bf16_t*)(ws + OFF_R1 + 144 * MiB)}; run_gemm(s_wv, lds, (const bf16_t*)(ws + OFF_R1 + 40 * MiB), WT + WT_MQKV + 393216, T, 2048, 256, EK); } break;
        case OP_ATT: phase_attn(s_wv, p, lds); break;
        case OP_MOUT: { EpiRes E{XB, XB, modl + 2048}; run_gemm(s_wv, lds, R2, WT + WT_MIXB, T, 1024, 1024, E); } break;
        case OP_H1: { EpiHg E{ws + OFF_R1, (const float*)(ws + OFF_LB)}; run_gemm(s_wv, lds, HB, WT + WT_MIXA, T, 4096, 1024, E); } break;
        case OP_HA: phase_ha(s_wv, p, lds); break;
        case OP_HSCAN: phase_hscan(s_wv, p); break;
        case OP_HC: phase_hc(s_wv, p, lds); break;
        case OP_HOUT: { EpiRes E{XB, XB, modl + 2048}; run_gemm(s_wv, lds, HB, WT + WT_MIXB, T, 1024, 1024, E); } break;
        case OP_FUP: { EpiFFN E{R2, (const bf16_t*)(ws + OFF_CWB)}; run_gemm(s_wv, lds, HB - 2 * 1024, WT + WT_FUP, 67 * 256, 5632, 1024, E); } break;
        case OP_FDN: { EpiRes E{XB, xdst, modl + 5120}; run_gemm(s_wv, lds, R2, WT + WT_FDN, T, 1024, 2816, E); } break;
        case OP_FINAL: phase_final(s_wv, XB, p->out, p->in[27]); break;
        default: break;
        }
        if (ph + 1 < ph_hi) { if (ph == ph_lo) { __syncthreads(); cg::this_grid().sync(); } else xcd_barrier(xbar, otid()); }
    }
}

#ifndef MULTI_LAUNCH
#define MULTI_LAUNCH 0
#endif
extern "C" void kernel_launch(void* const* d_in, const int* in_sizes, int n_in, void* d_out, int out_size, void* d_ws, size_t ws_size, hipStream_t stream) {
    static int grid = 0;
    if (grid == 0) {
        int dev = 0, cus = 0, per_cu = 0;
        hipGetDevice(&dev); hipDeviceGetAttribute(&cus, hipDeviceAttributeMultiprocessorCount, dev);
        hipFuncSetAttribute((const void*)fwd_kernel, hipFuncAttributeMaxDynamicSharedMemorySize, LDS_BYTES);
        hipOccupancyMaxActiveBlocksPerMultiprocessor(&per_cu, (const void*)fwd_kernel, NTHREADS, LDS_BYTES);
        if (per_cu < 1) per_cu = 1;
        grid = cus * 1; (void)per_cu;
        if (ws_size < WS_END) fprintf(stderr, "kernel_launch: workspace too small: %zu < %zu\n", ws_size, (size_t)WS_END);
        (void)hipGetLastError();
    }
    (void)hipMemsetAsync((char*)d_ws + OFF_BAR, 0, XCD_BAR_WORDS * sizeof(unsigned), stream);
    Params p{};
    for (int i = 0; i < 28; ++i) p.in[i] = (const float*)d_in[i];
    p.out = (float*)d_out; p.ws = (unsigned char*)d_ws;
    int n = 0;
    auto add = [&](int op, int l) { p.op[n] = (unsigned char)op; p.lay[n] = (unsigned char)l; ++n; };
    add(OP_PRO, 0);
    for (int l = 0; l < 4; ++l) {
        add(OP_NORM1, l);
        if (l % 3 == 0) { add(OP_G1, l); add(OP_GSP, l); add(OP_GOUT, l); }
        else if (l % 3 == 1) { add(OP_M1, l); add(OP_M2, l); add(OP_M3, l); add(OP_ATT, l); add(OP_MOUT, l); }
        else { add(OP_H1, l); add(OP_HA, l); add(OP_HSCAN, l); add(OP_HC, l); add(OP_HOUT, l); }
        add(OP_NORM2, l); add(OP_FUP, l); add(OP_FDN, l);
    }
    add(OP_FINAL, 0);
#if MULTI_LAUNCH
    for (int i = 0; i < n; ++i) { p.ph_lo = i; p.ph_hi = i + 1; hipLaunchKernelGGL(fwd_kernel, dim3(grid), dim3(NTHREADS), LDS_BYTES, stream, p); }
#else
    p.ph_lo = 0; p.ph_hi = n;
    void* args[] = {&p};
    hipError_t e = hipLaunchCooperativeKernel((const void*)fwd_kernel, dim3(grid), dim3(NTHREADS), args, LDS_BYTES, stream);
    if (e != hipSuccess) fprintf(stderr, "cooperative launch failed: %s (grid %d)\n", hipGetErrorString(e), grid);
#endif
}
```

```cpp
#include <hip/hip_runtime.h>
#include <hip/hip_cooperative_groups.h>
#include <cstdio>
#include <cstdint>
namespace cg = cooperative_groups;
__device__ __forceinline__ int otid_w(int w) { int l; asm volatile("v_mbcnt_lo_u32_b32 %0, -1, 0\n\tv_mbcnt_hi_u32_b32 %0, -1, %0" : "=v"(l)); return (w << 6) | l; }
#define otid() otid_w(s_wv)
__device__ __forceinline__ int obid() { int t = blockIdx.x; asm volatile("" : "+s"(t)); return t; }
namespace pg8 {
#define PG8_LAS __attribute__((address_space(3)))
typedef unsigned short bf16_t;
typedef short bf16x8 __attribute__((ext_vector_type(8)));
typedef float f32x4 __attribute__((ext_vector_type(4)));
typedef unsigned u32x4 __attribute__((ext_vector_type(4)));
constexpr int BM = 256, BK = 64, HALF = 128, HTB = HALF * BK * 2  , STAGE_BYTES = 8 * HTB, NXCD = 8, WGM = 8;

__host__ __device__ __forceinline__ int lds_byte(int r, int c) { const int st = (r >> 4) * 2 + (c >> 5), rr = r & 15, cc = c & 31, ob = rr * 64 + cc * 2; return st * 1024 + (ob ^ (((ob >> 9) & 1) << 5)); }
__host__ __device__ __forceinline__ void stage_rc(int b, int& R, int& C) { const int st = b / 1024, sb = b % 1024, swz = sb ^ (((sb >> 9) & 1) << 5); R = (st >> 1) * 16 + swz / 64; C = (st & 1) * 32 + (swz % 64) / 2; }
__host__ __device__ __forceinline__ int perm32(int rho) { const int n = rho >> 4, i = rho & 15; return 8 * (i >> 2) + 4 * n + (i & 3); }

struct Unit { int pm, pn; };
struct Gemm { const bf16_t* A; const bf16_t* Bt; int M, N, K; };

struct StaticOrder {
    int nM, nN, nwg, G, c;
    __host__ __device__ void init(int M, int N, int G_, int c_) { nM = M / BM; nN = N / BM; nwg = nM * nN; G = G_; c = c_; }
    __host__ __device__ bool next(int i, Unit& u) const {
        const long L = (long)i * G + c; if (L >= nwg) return false;
        int wgid = (int)L; { const int q = nwg / NXCD, r = nwg % NXCD, xcd = wgid % NXCD, off = wgid / NXCD; wgid = (xcd < r ? xcd * (q + 1) : r * (q + 1) + (xcd - r) * q) + off; }
        const int nig = WGM * nN, gid = wgid / nig, fm = gid * WGM, gsz = (nM - fm) < WGM ? (nM - fm) : WGM;
        u.pm = fm + ((wgid % nig) % gsz); u.pn = (wgid % nig) / gsz; return true;
    }
    __device__ __forceinline__ void a_ready(const Unit&) const {}
    __device__ __forceinline__ void done(const Unit&) const {}
};
__device__ __forceinline__ unsigned cvt_pk_bf16(float lo, float hi) { unsigned r; asm volatile("v_cvt_pk_bf16_f32 %0, %1, %2" : "=v"(r) : "v"(lo), "v"(hi)); return r; }

template <class Epi, class Sched, bool STAMP = false>
__device__ __forceinline__ void gemm_phase(const int s_wv, PG8_LAS unsigned char* lds, const Gemm g, const Sched& S, const Epi& E, unsigned long long* stamps) {
    const int tid = otid(), wid = __builtin_amdgcn_readfirstlane(tid >> 6), lane = tid & 63, wr = wid >> 2, wc = wid & 3, fr = lane & 15, fq = lane >> 4;
    const int K = g.K, nt = K / BK;
    int ts_lo = 0, ts_hi = 0, nts = 0; const unsigned long long rt_entry = STAMP ? (unsigned long long)wall_clock64() : 0ull;
#define PG8_STAMP() do { if (STAMP && wid == 0 && nts < 64) { const unsigned long long _c = (unsigned long long)clock64(); \
        ts_lo = (lane == nts) ? (int)(unsigned)_c : ts_lo; ts_hi = (lane == nts) ? (int)(unsigned)(_c >> 32) : ts_hi; ++nts; } } while (0)
    PG8_STAMP();
    unsigned voffA[2], voffB[2];
#pragma unroll
    for (int i = 0; i < 2; ++i) { int R, C; stage_rc(tid * 16 + i * 8192, R, C); const int Rb = Epi::PERM ? ((R & ~31) + perm32(R & 31)) : R;
        const int Ra = Epi::PERMA ? (62 * (R >> 6) + 4 * (R & 15) + ((R >> 4) & 3)) : R; voffA[i] = (unsigned)(Ra * K + C) * 2u; voffB[i] = (unsigned)(Rb * K + C) * 2u; }
    const size_t kstep = (size_t)(BK * 2);
    const size_t hstep = (size_t)HALF * K * 2;
    const size_t tstep = 2 * hstep;
    const size_t hstepA = Epi::PERMA ? (size_t)124 * K * 2 : hstep, tstepA = Epi::PERMA ? (size_t)248 * K * 2 : tstep;
    const unsigned ldsw = (unsigned)wid * 1024u;
    const int aoff = lds_byte(wr * 64 + fr, fq * 8), boff = lds_byte(wc * 32 + fr, fq * 8);
#define PG8_SA(b, h) (((b) * 2 + (h)) * HTB)
#define PG8_SB(b, h) ((4 + (b) * 2 + (h)) * HTB)
#define PG8_STAGE(bufoff, gbase, voff) do { _Pragma("unroll") for (int _i = 0; _i < 2; ++_i) \
        __builtin_amdgcn_global_load_lds((const unsigned*)((const char*)(gbase) + (voff)[_i]), (PG8_LAS unsigned*)(lds + (bufoff) + ldsw + _i * 8192), 16, 0, 0); } while (0)
#define PG8_LDA(dst, b, h) do { _Pragma("unroll") for (int m = 0; m < 4; ++m) _Pragma("unroll") for (int k = 0; k < 2; ++k) dst[m][k] = *(const PG8_LAS bf16x8*)(lds + PG8_SA(b, h) + aoff + m * 2048 + k * 1024); } while (0)
#define PG8_LDB(dst, b, h) do { _Pragma("unroll") for (int n = 0; n < 2; ++n) _Pragma("unroll") for (int k = 0; k < 2; ++k) dst[n][k] = *(const PG8_LAS bf16x8*)(lds + PG8_SB(b, h) + boff + n * 2048 + k * 1024); } while (0)
#define PG8_MMA(ai, bj, At, Bt) do { __builtin_amdgcn_s_setprio(1); _Pragma("unroll") for (int m = 0; m < 4; ++m) _Pragma("unroll") for (int n = 0; n < 2; ++n) _Pragma("unroll") for (int k = 0; k < 2; ++k) \
        acc[ai][bj][m][n] = __builtin_amdgcn_mfma_f32_16x16x32_bf16(Bt[n][k], At[m][k], acc[ai][bj][m][n], 0, 0, 0); __builtin_amdgcn_s_setprio(0); } while (0)
#define PG8_WAIT_V(n) asm volatile("s_waitcnt vmcnt(" #n ")" ::: "memory")
#define PG8_WAIT_L(n) asm volatile("s_waitcnt lgkmcnt(" #n ")" ::: "memory")
#define PG8_BAR __builtin_amdgcn_s_barrier()
#define PG8_SCHED __builtin_amdgcn_sched_barrier(0)
    Unit cur, nxt; int ui = 0;
    if (!S.next(0, cur)) return;
    f32x4 acc[2][2][4][2];
#pragma unroll
    for (int a = 0; a < 2; ++a)
#pragma unroll
        for (int b = 0; b < 2; ++b)
#pragma unroll
            for (int m = 0; m < 4; ++m)
#pragma unroll
                for (int n = 0; n < 2; ++n) acc[a][b][m][n] = (f32x4){0.f, 0.f, 0.f, 0.f};
    bf16x8 At[4][2], B0[2][2], B1[2][2];
    const char* cA = (const char*)g.A + (size_t)cur.pm * tstepA; const char* cB = (const char*)g.Bt + (size_t)cur.pn * tstep;
    S.a_ready(cur);
    PG8_STAGE(PG8_SB(0, 0), cB, voffB); PG8_STAGE(PG8_SA(0, 0), cA, voffA); PG8_STAGE(PG8_SB(0, 1), cB + hstep, voffB); PG8_STAGE(PG8_SA(0, 1), cA + hstepA, voffA);
    if (wr == 1) PG8_BAR;
    PG8_WAIT_V(4); PG8_BAR;
    PG8_STAGE(PG8_SB(1, 0), cB + kstep, voffB); PG8_STAGE(PG8_SA(1, 0), cA + kstep, voffA); PG8_STAGE(PG8_SB(1, 1), cB + hstep + kstep, voffB);
    PG8_WAIT_V(6); PG8_BAR;
    PG8_STAMP();
    for (;;) {
        const bool has_next = S.next(ui + 1, nxt);
        const char* nA = has_next ? (const char*)g.A + (size_t)nxt.pm * tstepA : cA; const char* nB = has_next ? (const char*)g.Bt + (size_t)nxt.pn * tstep : cB;
        for (int t = 0; t < nt; t += 2) {
            const bool last = (t == nt - 2);
            const char* a1 = cA + (size_t)(t + 1) * kstep;
            const char* a2 = last ? nA : cA + (size_t)(t + 2) * kstep; const char* b2 = last ? nB : cB + (size_t)(t + 2) * kstep;
            const char* a3 = a2 + kstep; const char* b3 = b2 + kstep;
            if (last && has_next) S.a_ready(nxt);
            PG8_LDB(B0, 0, 0); PG8_SCHED; PG8_LDA(At, 0, 0); PG8_STAGE(PG8_SA(1, 1), a1 + hstepA, voffA);
            PG8_WAIT_L(8); PG8_BAR; PG8_WAIT_L(0); PG8_MMA(0, 0, At, B0); PG8_BAR; PG8_SCHED;
            PG8_LDB(B1, 0, 1); PG8_STAGE(PG8_SB(0, 0), b2, voffB);
            PG8_BAR; PG8_WAIT_L(0); PG8_MMA(0, 1, At, B1); PG8_BAR;
            PG8_LDA(At, 0, 1); PG8_STAGE(PG8_SA(0, 0), a2, voffA);
            PG8_BAR; PG8_WAIT_L(0); PG8_MMA(1, 0, At, B0); PG8_BAR; PG8_SCHED;
            PG8_STAGE(PG8_SB(0, 1), b2 + hstep, voffB);
            PG8_WAIT_V(6); PG8_BAR; PG8_MMA(1, 1, At, B1); PG8_BAR;
            PG8_LDB(B0, 1, 0); PG8_SCHED; PG8_LDA(At, 1, 0); PG8_STAGE(PG8_SA(0, 1), a2 + hstepA, voffA);
            PG8_WAIT_L(8); PG8_BAR; PG8_WAIT_L(0); PG8_MMA(0, 0, At, B0); PG8_BAR; PG8_SCHED;
            PG8_LDB(B1, 1, 1); PG8_STAGE(PG8_SB(1, 0), b3, voffB);
            PG8_BAR; PG8_WAIT_L(0); PG8_MMA(0, 1, At, B1); PG8_BAR;
            PG8_LDA(At, 1, 1); PG8_STAGE(PG8_SA(1, 0), a3, voffA);
            PG8_BAR; PG8_WAIT_L(0); PG8_MMA(1, 0, At, B0); PG8_BAR; PG8_SCHED;
            PG8_STAGE(PG8_SB(1, 1), b3 + hstep, voffB);
            PG8_WAIT_V(6); PG8_BAR; PG8_MMA(1, 1, At, B1); PG8_BAR;
        }
        PG8_STAMP();
        if constexpr (!Epi::AFTER_DRAIN) { E(acc, cur, wr, wc, fr, fq); S.done(cur); }
        PG8_STAMP();
        if (!has_next) break;
#pragma unroll
        for (int a = 0; a < 2; ++a)
#pragma unroll
            for (int b = 0; b < 2; ++b)
#pragma unroll
                for (int m = 0; m < 4; ++m)
#pragma unroll
                    for (int n = 0; n < 2; ++n) acc[a][b][m][n] = (f32x4){0.f, 0.f, 0.f, 0.f};
        cur = nxt; cA = nA; cB = nB; ++ui;
    }
    PG8_WAIT_V(0);
    if (wr == 0) PG8_BAR;
    PG8_BAR;
    if constexpr (Epi::AFTER_DRAIN) { E.fused(acc, cur, wr, wc, fr, fq, lds, wid, lane); S.done(cur); }
    PG8_STAMP();
    if (STAMP && wid == 0) { stamps[lane] = lane < nts ? (((unsigned long long)(unsigned)ts_hi << 32) | (unsigned)ts_lo) : 0ull;
        if (lane == 62) stamps[62] = rt_entry; if (lane == 63) stamps[63] = (unsigned long long)wall_clock64(); }
#undef PG8_STAMP
#undef PG8_SA
#undef PG8_SB
#undef PG8_STAGE
#undef PG8_LDA
#undef PG8_LDB
#undef PG8_MMA
#undef PG8_WAIT_V
#undef PG8_WAIT_L
#undef PG8_BAR
#undef PG8_SCHED
}
}

using pg8::bf16_t; using pg8::bf16x8; using pg8::f32x4; using pg8::u32x4; using pg8::Unit;
typedef unsigned u32x2 __attribute__((ext_vector_type(2)));
typedef short bf16x4 __attribute__((ext_vector_type(4)));
#define LAS __attribute__((address_space(3)))
typedef LAS unsigned char* ldsp;
#define XB_TMO      128
#define XB_XCNT(j)  (256  + 64 * (j))
#define XB_XSUB(j)  (1280 + 64 * (j))
#define XB_XGEN(j)  (2304 + 64 * (j))
#define XB_TOP      3328
#define XB_TOPGEN   3392
#define XCD_BAR_WORDS 3456
#define XB_SPIN_CAP (1u << 18)

__device__ __forceinline__ unsigned xb_ld(unsigned* p)              { return __hip_atomic_load(p, __ATOMIC_RELAXED, __HIP_MEMORY_SCOPE_AGENT); }
__device__ __forceinline__ unsigned xb_add(unsigned* p, unsigned v) { return __hip_atomic_fetch_add(p, v, __ATOMIC_RELAXED, __HIP_MEMORY_SCOPE_AGENT); }
__device__ __forceinline__ unsigned xb_xcc_id() { return (unsigned)__builtin_amdgcn_s_getreg((3 << 11) | 20) & 0xFu; }
#define XB_SPIN(cond, bar) do { unsigned _sp = 0; while (cond) { __builtin_amdgcn_s_sleep(1); \
    if ((++_sp & 255u) == 0u) { if (xb_ld(&(bar)[XB_TMO])) break; if (_sp > XB_SPIN_CAP) { atomicAdd(&(bar)[XB_TMO], 1u); break; } } } } while (0)

struct XcdBarrier {
    unsigned* bar; unsigned x;
    volatile LAS unsigned* st;
};

__device__ __forceinline__ XcdBarrier xcd_barrier_post(unsigned* bar, volatile LAS unsigned* st, const int tid0) {
    XcdBarrier b; b.bar = bar; b.x = xb_xcc_id(); b.st = st;
    if (tid0 == 0) (void)xb_add(&bar[XB_XCNT(b.x)], 1u);
    return b;
}
__device__ __forceinline__ void xcd_barrier_complete(unsigned* bar, unsigned x, unsigned& nloc, unsigned& nx) {
    const unsigned G = gridDim.x * gridDim.y * gridDim.z;
    unsigned sum, cnt, mine, sp = 0u;
    for (;;) {
        sum = 0u; cnt = 0u; mine = 0u;
#pragma unroll
        for (unsigned j = 0; j < 16; ++j) { const unsigned c = xb_ld(&bar[XB_XCNT(j)]); sum += c; cnt += (c > 0u) ? 1u : 0u; mine = (j == x) ? c : mine; }
        if (sum == G) break;
        __builtin_amdgcn_s_sleep(1);
        if ((++sp & 255u) == 0u) { if (xb_ld(&bar[XB_TMO])) break; if (sp > XB_SPIN_CAP) { atomicAdd(&bar[XB_TMO], 1u); break; } }
    }
    nloc = mine > 0u ? mine : 1u; nx = cnt > 0u ? cnt : 1u;
}

__device__ __forceinline__ void xcd_barrier(const XcdBarrier& b, const int tid0) {
    asm volatile("s_waitcnt vmcnt(0)" ::: "memory");
    __syncthreads();
    if (tid0 == 0) {
        unsigned* bar = b.bar;
        __builtin_amdgcn_s_waitcnt(0);
        unsigned nloc = b.st[0], nx = b.st[1];
        if (nloc == 0u) { xcd_barrier_complete(bar, b.x, nloc, nx); b.st[0] = nloc; b.st[1] = nx; }
        const unsigned old = xb_add(&bar[XB_XSUB(b.x)], 1u);
        const unsigned gen = old / nloc;
        if (old + 1u == (gen + 1u) * nloc) {
            __builtin_amdgcn_fence(__ATOMIC_RELEASE, "agent");
            asm volatile("s_waitcnt vmcnt(0)" ::: "memory");
            const unsigned og = xb_add(&bar[XB_TOP], 1u);
            const unsigned tg = og / nx;
            if (og + 1u == (tg + 1u) * nx) xb_add(&bar[XB_TOPGEN], 1u);
            else XB_SPIN(xb_ld(&bar[XB_TOPGEN]) == tg, bar);
            __builtin_amdgcn_fence(__ATOMIC_ACQUIRE, "agent");
            xb_add(&bar[XB_XGEN(b.x)], 1u);
            asm volatile("s_waitcnt vmcnt(0)" ::: "memory");
        } else {
            XB_SPIN(xb_ld(&bar[XB_XGEN(b.x)]) == gen, bar);
            __builtin_amdgcn_fence(__ATOMIC_ACQUIRE, "agent");
            asm volatile("s_waitcnt vmcnt(0)" ::: "memory");
        }
    }
    __syncthreads();
}


constexpr int T = 16384, D = 1024, SEQ = 4096, NBATCH = 4, FF = 2816;
constexpr int NTHREADS = 512, LDS_BYTES = 131072 + 16;
constexpr float EPS = 1e-6f;
constexpr size_t MiB = 1024 * 1024;
constexpr size_t OFF_MOD = 0, OFF_LB = 512 * 1024, OFF_CWB = 576 * 1024, OFF_BAR = 768 * 1024, OFF_CSC = 1 * MiB, OFF_CSS = 3 * MiB, OFF_WT = 8 * MiB, OFF_HB = 40 * MiB, OFF_R1 = 72 * MiB, OFF_R2 = 248 * MiB, OFF_XB = 336 * MiB, WS_END = 368 * MiB;
constexpr size_t WT_MIXA = 0, WT_MIXB = 4194304, WT_FUP = 6291456, WT_FDN = 12058624, WT_MQKV = 524288;
enum { OP_PRO = 0, OP_NORM1, OP_G1, OP_GSP, OP_GOUT, OP_M1, OP_M2, OP_M3, OP_ATT, OP_MOUT, OP_H1, OP_HA, OP_HSCAN, OP_HC, OP_HOUT, OP_NORM2, OP_FUP, OP_FCONV, OP_FDN, OP_FINAL };

struct Params;
struct Params {
    const float* in[28];
    float* out;
    unsigned char* ws;
    int ph_lo, ph_hi;
    unsigned char op[48];
    unsigned char lay[48];
};

typedef const __attribute__((address_space(4))) Params* KP;
__device__ __forceinline__ unsigned pk2(float lo, float hi) { return pg8::cvt_pk_bf16(lo, hi); }
__device__ __forceinline__ float bflo(unsigned u) { return __uint_as_float(u << 16); }
__device__ __forceinline__ float bfhi(unsigned u) { return __uint_as_float(u & 0xffff0000u); }
__device__ __forceinline__ float shx(float v, int m, int lane) { return __int_as_float(__builtin_amdgcn_ds_bpermute((lane ^ m) << 2, __float_as_int(v))); }
__device__ __forceinline__ float wave_sum(float v, int lane) {
#pragma unroll
    for (int o = 32; o >= 1; o >>= 1) v += shx(v, o, lane);
    return v;
}
__device__ __forceinline__ float fast_sigmoid(float x) { return __builtin_amdgcn_rcpf(1.f + __builtin_amdgcn_exp2f(-1.4426950408889634f * x)); }
__device__ __forceinline__ float gelu_tanh(float x) { const float u = 0.7978845608028654f * (x + 0.044715f * x * x * x); return x * fast_sigmoid(2.f * u); }
__device__ __forceinline__ bf16x8 mk8(unsigned a, unsigned b, unsigned c, unsigned d) { u32x4 v = {a, b, c, d}; return __builtin_bit_cast(bf16x8, v); }
__device__ __forceinline__ f32x4 zero4() { float z = 0.f; asm volatile("" : "+v"(z)); return (f32x4){z, z, z, z}; }
#define MFMA16(X, Y, C) __builtin_amdgcn_mfma_f32_16x16x32_bf16((X), (Y), (C), 0, 0, 0)

template <int ACT> struct EpiBf16 {
    static constexpr bool PERM = true, AFTER_DRAIN = false, PERMA = false;
    bf16_t* O; int ldc;
    __device__ __forceinline__ void operator()(const f32x4 (&acc)[2][2][4][2], const Unit& u, int wr, int wc, int fr, int fq) const {
        const int row0 = u.pm * 256 + wr * 64 + fr, col0 = u.pn * 256 + wc * 32 + 8 * fq;
#pragma unroll
        for (int ai = 0; ai < 2; ++ai)
#pragma unroll
            for (int m = 0; m < 4; ++m) { bf16_t* rowp = O + (size_t)(row0 + ai * 128 + m * 16) * ldc + col0;
#pragma unroll
                for (int bj = 0; bj < 2; ++bj) { f32x4 v0 = acc[ai][bj][m][0], v1 = acc[ai][bj][m][1];
                    if (ACT == 1) {
#pragma unroll
                        for (int e = 0; e < 4; ++e) { v0[e] = gelu_tanh(v0[e]); v1[e] = gelu_tanh(v1[e]); } }
                    u32x4 o = {pk2(v0[0], v0[1]), pk2(v0[2], v0[3]), pk2(v1[0], v1[1]), pk2(v1[2], v1[3])};
                    *(u32x4*)(rowp + bj * 128) = o; } }
    }
};
struct EpiF32 {
    static constexpr bool PERM = false, AFTER_DRAIN = false, PERMA = false;
    float* C; int ldc;
    __device__ __forceinline__ void operator()(const f32x4 (&acc)[2][2][4][2], const Unit& u, int wr, int wc, int fr, int fq) const {
        const int row0 = u.pm * 256 + wr * 64 + fr, col0 = u.pn * 256 + wc * 32 + 4 * fq;
#pragma unroll
        for (int ai = 0; ai < 2; ++ai)
#pragma unroll
            for (int m = 0; m < 4; ++m) { float* rowp = C + (size_t)(row0 + ai * 128 + m * 16) * ldc + col0;
#pragma unroll
                for (int bj = 0; bj < 2; ++bj)
#pragma unroll
                    for (int n = 0; n < 2; ++n) *(f32x4*)(rowp + bj * 128 + n * 16) = acc[ai][bj][m][n]; }
    }
};
struct EpiRes {
    static constexpr bool PERM = true, AFTER_DRAIN = false, PERMA = false;
    const bf16_t* Xs; bf16_t* Xd; const float* gate;
    __device__ __forceinline__ void operator()(const f32x4 (&acc)[2][2][4][2], const Unit& u, int wr, int wc, int fr, int fq) const {
        const int row0 = u.pm * 256 + wr * 64 + fr, col0 = u.pn * 256 + wc * 32 + 8 * fq;
        const float* gp = gate + (unsigned)((u.pm >> 4) * 6144 + col0);
        f32x4 gv[2][2];
#pragma unroll
        for (int bj = 0; bj < 2; ++bj)
#pragma unroll
            for (int n = 0; n < 2; ++n) { gv[bj][n] = *(const f32x4*)(gp + bj * 128 + n * 4); gv[bj][n] = gv[bj][n] + 1.f; }
#pragma unroll
        for (int ai = 0; ai < 2; ++ai)
#pragma unroll
            for (int m = 0; m < 4; ++m) { const unsigned ro = (unsigned)((row0 + ai * 128 + m * 16) * 1024 + col0);
#pragma unroll
                for (int bj = 0; bj < 2; ++bj) { const u32x4 xs = *(const u32x4*)(Xs + ro + bj * 128);
                    const f32x4 a0 = acc[ai][bj][m][0] * gv[bj][0], a1 = acc[ai][bj][m][1] * gv[bj][1];
                    u32x4 o = {pk2(bflo(xs[0]) + a0[0], bfhi(xs[0]) + a0[1]), pk2(bflo(xs[1]) + a0[2], bfhi(xs[1]) + a0[3]), pk2(bflo(xs[2]) + a1[0], bfhi(xs[2]) + a1[1]), pk2(bflo(xs[3]) + a1[2], bfhi(xs[3]) + a1[3])};
                    *(u32x4*)(Xd + ro + bj * 128) = o; } }
    }
};
struct EpiQ {
    static constexpr bool PERM = false, AFTER_DRAIN = false, PERMA = false;
    bf16_t* QF; const float* CSC; const float* CSS; float qs;
    __device__ __forceinline__ void operator()(const f32x4 (&acc)[2][2][4][2], const Unit& u, int wr, int wc, int fr, int fq) const {
        const int b = u.pm >> 4;
#pragma unroll
        for (int bj = 0; bj < 2; ++bj) {
            const int c0 = u.pn * 256 + bj * 128 + wc * 32;
            const int head = c0 / 192, off = c0 - head * 192;
            if (off < 128) {
#pragma unroll
                for (int ai = 0; ai < 2; ++ai)
#pragma unroll
                    for (int m = 0; m < 4; ++m) { const int r = u.pm * 256 + ai * 128 + wr * 64 + m * 16 + fr, s = r & 4095;
                        bf16_t* qp = QF + (unsigned)(((b * 8 + head) * 4096 + s) * 192 + off + 4 * fq);
#pragma unroll
                        for (int n = 0; n < 2; ++n) { const f32x4 v = acc[ai][bj][m][n] * qs; u32x2 o = {pk2(v[0], v[1]), pk2(v[2], v[3])}; *(u32x2*)(qp + 16 * n) = o; } __builtin_amdgcn_sched_barrier(0); }
            } else {
                const int jb = ((off - 128) >> 5) * 16 + 4 * fq;
#pragma unroll
                for (int ai = 0; ai < 2; ++ai)
#pragma unroll
                    for (int m = 0; m < 4; ++m) { const int r = u.pm * 256 + ai * 128 + wr * 64 + m * 16 + fr, s = r & 4095;
                        const f32x4 cs = *(const f32x4*)(CSC + (unsigned)(r * 32 + jb)), sn = *(const f32x4*)(CSS + (unsigned)(r * 32 + jb));
                        const f32x4 x1 = acc[ai][bj][m][0], x2 = acc[ai][bj][m][1];
                        const f32x4 r1 = (x1 * cs - x2 * sn) * qs, r2 = (x2 * cs + x1 * sn) * qs;
                        bf16_t* qp = QF + (unsigned)(((b * 8 + head) * 4096 + s) * 192 + 128 + jb);
                        u32x2 o1 = {pk2(r1[0], r1[1]), pk2(r1[2], r1[3])}, o2 = {pk2(r2[0], r2[1]), pk2(r2[2], r2[3])};
                        *(u32x2*)(qp) = o1; *(u32x2*)(qp + 32) = o2; __builtin_amdgcn_sched_barrier(0); }
            }
        }
    }
};
struct EpiKV {
    static constexpr bool PERM = false, AFTER_DRAIN = false, PERMA = false;
    bf16_t* KF; bf16_t* VT;
    __device__ __forceinline__ void operator()(const f32x4 (&acc)[2][2][4][2], const Unit& u, int wr, int wc, int fr, int fq) const {
        const int b = u.pm >> 4, head = u.pn;
#pragma unroll
        for (int bj = 0; bj < 2; ++bj) {
            const int off = wc * 32;
            if (bj == 0) {
#pragma unroll
                for (int ai = 0; ai < 2; ++ai)
#pragma unroll
                    for (int m = 0; m < 4; ++m) { const int r = u.pm * 256 + ai * 128 + wr * 64 + m * 16 + fr, s = r & 4095;
                        bf16_t* kp = KF + (unsigned)(((b * 8 + head) * 4096 + s) * 192 + off + 4 * fq);
#pragma unroll
                        for (int n = 0; n < 2; ++n) { const f32x4 v = acc[ai][bj][m][n]; u32x2 o = {pk2(v[0], v[1]), pk2(v[2], v[3])}; *(u32x2*)(kp + 16 * n) = o; } __builtin_amdgcn_sched_barrier(0); }
            } else {
#pragma unroll
                for (int ai = 0; ai < 2; ++ai)
#pragma unroll
                    for (int m = 0; m < 4; ++m) { const int r = u.pm * 256 + ai * 128 + wr * 64 + m * 16 + fr, s = r & 4095;
#pragma unroll
                        for (int n = 0; n < 2; ++n) { const f32x4 v = acc[ai][bj][m][n]; const int dv = off + 16 * n + 4 * fq;
                            bf16_t* vp = VT + (unsigned)(((b * 8 + head) * 128 + dv) * 4096 + s);
                            const unsigned p01 = pk2(v[0], v[1]), p23 = pk2(v[2], v[3]);
                            vp[0] = (bf16_t)(p01 & 0xffffu); vp[4096] = (bf16_t)(p01 >> 16); vp[8192] = (bf16_t)(p23 & 0xffffu); vp[12288] = (bf16_t)(p23 >> 16); } __builtin_amdgcn_sched_barrier(0); }
            }
        }
    }
};
struct EpiHg {
    static constexpr bool PERM = true, AFTER_DRAIN = false, PERMA = false;
    unsigned char* R1b; const float* LB;
    __device__ __forceinline__ void operator()(const f32x4 (&acc)[2][2][4][2], const Unit& u, int wr, int wc, int fr, int fq) const {
        const int region = u.pn >> 2, row0 = u.pm * 256 + wr * 64 + fr, cc0 = (u.pn & 3) * 256 + wc * 32 + 8 * fq;
        if (region == 1) {
#pragma unroll
            for (int bj = 0; bj < 2; ++bj) { const int cc = cc0 + bj * 128;
                const f32x4 l0 = *(const f32x4*)(LB + cc), l1 = *(const f32x4*)(LB + cc + 4);
#pragma unroll
                for (int ai = 0; ai < 2; ++ai)
#pragma unroll
                    for (int m = 0; m < 4; ++m) { float* fp = (float*)(R1b + 32 * MiB) + (unsigned)((row0 + ai * 128 + m * 16) * 1024 + cc);
                        f32x4 v0 = acc[ai][bj][m][0], v1 = acc[ai][bj][m][1];
#pragma unroll
                        for (int e = 0; e < 4; ++e) { v0[e] = l0[e] + (1.f - l0[e]) * fast_sigmoid(v0[e]); v1[e] = l1[e] + (1.f - l1[e]) * fast_sigmoid(v1[e]); }
                        *(f32x4*)fp = v0; *(f32x4*)(fp + 4) = v1; __builtin_amdgcn_sched_barrier(0); } }
        } else {
            bf16_t* base = (bf16_t*)(R1b + (region == 0 ? (size_t)0 : (region == 2 ? 96 * MiB : 128 * MiB)));
#pragma unroll
            for (int ai = 0; ai < 2; ++ai)
#pragma unroll
                for (int m = 0; m < 4; ++m) { bf16_t* rowp = base + (unsigned)((row0 + ai * 128 + m * 16) * 1024 + cc0);
#pragma unroll
                    for (int bj = 0; bj < 2; ++bj) { f32x4 v0 = acc[ai][bj][m][0], v1 = acc[ai][bj][m][1];
                        if (region == 3) {
#pragma unroll
                            for (int e = 0; e < 4; ++e) { v0[e] = v0[e] * fast_sigmoid(v0[e]); v1[e] = v1[e] * fast_sigmoid(v1[e]); } }
                        u32x4 o = {pk2(v0[0], v0[1]), pk2(v0[2], v0[3]), pk2(v1[0], v1[1]), pk2(v1[2], v1[3])};
                        *(u32x4*)(rowp + bj * 128) = o; } }
        }
    }
};

struct EpiFFN {
    static constexpr bool PERM = true, AFTER_DRAIN = false, PERMA = true;
    bf16_t* ACT; const bf16_t* CWB;
    __device__ __forceinline__ static f32x4 shr1(const f32x4 v) { f32x4 r;
#pragma unroll
        for (int e = 0; e < 4; ++e) r[e] = __int_as_float(__builtin_amdgcn_update_dpp(0, __float_as_int(v[e]), 0x111, 0xf, 0xf, true));
        return r; }
    template <bool SPECIAL> __device__ __forceinline__ void group(const f32x4 (&acc)[2][2][4][2], int ai, int n, int tok0, int fr, int fcol,
            const f32x4 wg0, const f32x4 wg1, const f32x4 wg2, const f32x4 bg, const f32x4 wv0, const f32x4 wv1, const f32x4 wv2, const f32x4 bv) const {
        const f32x4 sg3 = shr1(acc[ai][0][3][n]), sg2 = shr1(acc[ai][0][2][n]), sv3 = shr1(acc[ai][1][3][n]), sv2 = shr1(acc[ai][1][2][n]);
#pragma unroll
        for (int m = 0; m < 4; ++m) {
            const f32x4 cg = acc[ai][0][m][n], cv = acc[ai][1][m][n];
            f32x4 p1g = m == 0 ? sg3 : acc[ai][0][m == 0 ? 0 : m - 1][n], p1v = m == 0 ? sv3 : acc[ai][1][m == 0 ? 0 : m - 1][n];
            f32x4 p2g = m == 0 ? sg2 : (m == 1 ? sg3 : acc[ai][0][m < 2 ? 0 : m - 2][n]), p2v = m == 0 ? sv2 : (m == 1 ? sv3 : acc[ai][1][m < 2 ? 0 : m - 2][n]);
            const int tok = tok0 + 4 * fr + m;
            if (SPECIAL) { const int sq = tok & 4095; const f32x4 z4 = {0.f, 0.f, 0.f, 0.f}; if (sq == 0) { p1g = z4; p1v = z4; } if (sq <= 1) { p2g = z4; p2v = z4; } }
            const f32x4 yg = bg + wg0 * p2g + wg1 * p1g + wg2 * cg, yv = bv + wv0 * p2v + wv1 * p1v + wv2 * cv;
            const f32x4 ex = yg * -1.4426950408889634f; f32x4 sg;
#pragma unroll
            for (int e = 0; e < 4; ++e) sg[e] = __builtin_amdgcn_rcpf(1.f + __builtin_amdgcn_exp2f(ex[e]));
            const f32x4 o = yg * sg * yv;
            if ((m >= 2 || fr > 0) && tok < T) { u32x2 ov = {pk2(o[0], o[1]), pk2(o[2], o[3])}; *(u32x2*)(ACT + (unsigned)(tok * 2816 + fcol)) = ov; }
        }
    }
    __device__ __forceinline__ void operator()(const f32x4 (&acc)[2][2][4][2], const Unit& u, int wr, int wc, int fr, int fq) const {
        const int fcol0 = u.pn * 128 + wc * 32 + 8 * fq;
        u32x4 tw[8];
#pragma unroll
        for (int i = 0; i < 8; ++i) tw[i] = *(const u32x4*)(CWB + (unsigned)((fcol0 + i) * 8));
#pragma unroll
        for (int n = 0; n < 2; ++n) {
            const int fcol = fcol0 + 4 * n;
            f32x4 wg0, wg1, wg2, bg, wv0, wv1, wv2, bv;
#pragma unroll
            for (int e = 0; e < 4; ++e) { const u32x4 t = tw[4 * n + e]; wg0[e] = bflo(t[0]); wg1[e] = bfhi(t[0]); wg2[e] = bflo(t[1]); bg[e] = bfhi(t[1]); wv0[e] = bflo(t[2]); wv1[e] = bfhi(t[2]); wv2[e] = bflo(t[3]); bv[e] = bfhi(t[3]); }
#pragma unroll
            for (int ai = 0; ai < 2; ++ai) {
                const int b0 = u.pm * 248 + (2 * ai + wr) * 62;
                const bool special = (((b0 + 61) >> 12) << 12) >= b0 - 1;
                if (special) group<true>(acc, ai, n, b0 - 2, fr, fcol, wg0, wg1, wg2, bg, wv0, wv1, wv2, bv);
                else group<false>(acc, ai, n, b0 - 2, fr, fcol, wg0, wg1, wg2, bg, wv0, wv1, wv2, bv);
                __builtin_amdgcn_sched_barrier(0);
            }
        }
    }
};

template <class Epi> __device__ __forceinline__ void run_gemm(const int s_wv, ldsp lds, const bf16_t* A, const bf16_t* Bt, int M, int N, int K, const Epi& E) {
    pg8::Gemm g{A, Bt, M, N, K}; pg8::StaticOrder S; S.init(M, N, (int)gridDim.x, obid());
    pg8::gemm_phase<Epi, pg8::StaticOrder, false>(s_wv, lds, g, S, E, nullptr);
}

__device__ __forceinline__ int rope_rowmap(int n) { const int head = n / 192, d = n - head * 192; if (d < 128) return n; const int r = d - 128, half = r >> 5, j = r & 31; return head * 192 + 128 + (j >> 4) * 32 + half * 16 + (j & 15); }
__device__ __forceinline__ int ffn_rowmap(int n) { const int half = n >= 2816 ? 1 : 0, f = n - half * 2816, t = f >> 7, i = f & 127; return t * 256 + half * 128 + i; }
struct TrJob { const float* src; int srcN, K, N; bf16_t* dst; int dstK, koff, rowoff, pmode; };
__device__ __forceinline__ void run_trjob(const int s_wv, const TrJob J, ldsp lds) {
    const int tid = otid(), lane = tid & 63, wave = tid >> 6;
    LAS float* sm = (LAS float*)(lds + wave * 8448);
    const int nkt = J.K / 32, nnt = J.N / 64, ntile = nkt * nnt;
    for (int t = obid() * 8 + wave; t < ntile; t += gridDim.x * 8) { const int kt = t % nkt, nt = t / nkt;
        const float* sp = J.src + (size_t)(kt * 32) * J.srcN + nt * 64 + lane;
        float v[32];
#pragma unroll
        for (int k = 0; k < 32; ++k) v[k] = sp[(size_t)k * J.srcN];
#pragma unroll
        for (int k = 0; k < 32; ++k) sm[lane * 33 + k] = v[k];
        const int kk = (lane & 15) * 2, nr = lane >> 4;
#pragma unroll
        for (int j = 0; j < 16; ++j) { const int n = nr + 4 * j, sn = nt * 64 + n, drow = J.rowoff + (J.pmode == 1 ? rope_rowmap(sn) : (J.pmode == 2 ? ffn_rowmap(sn) : sn));
            *(unsigned*)(J.dst + (size_t)drow * J.dstK + J.koff + kt * 32 + kk) = pk2(sm[n * 33 + kk], sm[n * 33 + kk + 1]); }
    }
}
__device__ __forceinline__ void zero_fill(bf16_t* dst, int rows, int cols8, int stride, int gtid, int gthreads) {
    const int n = rows * cols8; unsigned zz = 0u; asm volatile("" : "+v"(zz)); const u32x4 z = {zz, zz, zz, zz};
    for (int i = gtid; i < n; i += gthreads) { const int r = i / cols8, c = i - r * cols8; *(u32x4*)(dst + (size_t)r * stride + c * 8) = z; }
}
__device__ __forceinline__ void prep_layer(const int s_wv, KP p, int layer, ldsp lds) {
    bf16_t* WT = (bf16_t*)(p->ws + OFF_WT); const int kind = layer % 3, j = layer / 3;
    const int gtid = obid() * NTHREADS + otid(), gthreads = gridDim.x * NTHREADS;
    { const TrJob J0{p->in[23] + (size_t)layer * 1024 * 5632, 5632, 1024, 5632, WT + WT_FUP, 1024, 0, 0, 2};
      const TrJob J1{p->in[26] + (size_t)layer * 2816 * 1024, 1024, 2816, 1024, WT + WT_FDN, 2816, 0, 0, 0};
      run_trjob(s_wv, J0, lds); run_trjob(s_wv, J1, lds); }
    if (kind == 0) {
        const TrJob J0{p->in[7] + (size_t)j * 1024 * 4096, 4096, 1024, 4096, WT + WT_MIXA, 1024, 0, 0, 0};
        const TrJob J1{p->in[12] + (size_t)j * 2048 * 1024, 1024, 2048, 1024, WT + WT_MIXB, 2048, 0, 0, 0};
        run_trjob(s_wv, J0, lds); run_trjob(s_wv, J1, lds);
    } else if (kind == 1) {
        const TrJob J0{p->in[13], 448, 1024, 448, WT + WT_MIXA, 1024, 0, 0, 0};
        const TrJob J1{p->in[16], 1536, 256, 1536, WT + WT_MQKV, 256, 0, 0, 1};
        const TrJob J2{p->in[17], 2048, 128, 2048, WT + WT_MQKV + 393216, 256, 0, 0, 0};
        const TrJob J3{p->in[18], 1024, 1024, 1024, WT + WT_MIXB, 1024, 0, 0, 0};
        run_trjob(s_wv, J0, lds); run_trjob(s_wv, J1, lds); run_trjob(s_wv, J2, lds); run_trjob(s_wv, J3, lds);
        zero_fill(WT + WT_MIXA + (size_t)448 * 1024, 64, 128, 1024, gtid, gthreads);
        zero_fill(WT + WT_MQKV + 393216 + 128, 2048, 16, 256, gtid, gthreads);
    } else {
        const TrJob J0{p->in[20], 4096, 1024, 4096, WT + WT_MIXA, 1024, 0, 0, 0};
        const TrJob J1{p->in[22], 1024, 1024, 1024, WT + WT_MIXB, 1024, 0, 0, 0};
        run_trjob(s_wv, J0, lds); run_trjob(s_wv, J1, lds);
    }
}
__device__ __forceinline__ void phase_prologue(const int s_wv, KP p, ldsp lds) {
    const int tid = otid();
    float* MOD = (float*)(p->ws + OFF_MOD);
    LAS float* cact = (LAS float*)lds;
    LAS float* red = (LAS float*)(lds + 16384);
    for (int i = tid; i < 4096; i += NTHREADS) { const float c = p->in[1][i]; cact[i] = c * fast_sigmoid(c); }
    __syncthreads();
    const int l16 = tid & 15, kg = tid >> 4;
    for (int item = obid(); item < 4 * 96; item += gridDim.x) {
        const int layer = item / 96, n0 = (item % 96) * 64;
        const float* w = p->in[3] + (size_t)layer * 1024 * 6144 + n0 + 4 * l16;
        f32x4 a[4] = {{0.f, 0.f, 0.f, 0.f}, {0.f, 0.f, 0.f, 0.f}, {0.f, 0.f, 0.f, 0.f}, {0.f, 0.f, 0.f, 0.f}};
#pragma unroll 8
        for (int kk = 0; kk < 32; ++kk) { const int k = kg * 32 + kk; const f32x4 wv = *(const f32x4*)(w + (size_t)k * 6144);
#pragma unroll
            for (int b = 0; b < 4; ++b) a[b] = a[b] + wv * cact[b * 1024 + k]; }
#pragma unroll
        for (int b = 0; b < 4; ++b) *(LAS f32x4*)(red + (kg * 4 + b) * 64 + 4 * l16) = a[b];
        __syncthreads();
        if (tid < 256) { const int b = tid >> 6, col = tid & 63; float s = 0.f;
#pragma unroll 8
            for (int g = 0; g < 32; ++g) s += red[(g * 4 + b) * 64 + col];
            MOD[(size_t)(layer * 4 + b) * 6144 + n0 + col] = s + p->in[4][(size_t)layer * 6144 + n0 + col]; }
        __syncthreads();
    }
    const int gtid = obid() * NTHREADS + tid, gthreads = gridDim.x * NTHREADS;
    float* CSC = (float*)(p->ws + OFF_CSC); float* CSS = (float*)(p->ws + OFF_CSS);
    const int* pos = (const int*)p->in[2];
    for (int i = gtid; i < T * 32; i += gthreads) { const int t = i >> 5, jj = i & 31;
        const float invf = exp2f(-(float)jj * (13.287712379549449f / 32.f));
        const float ang = (float)pos[t] * invf;
        double rev = (double)ang * 0.15915494309189535; rev -= floor(rev);
        const float rf = (float)rev;
        CSC[i] = __builtin_amdgcn_cosf(rf); CSS[i] = __builtin_amdgcn_sinf(rf); }
    float* LB = (float*)(p->ws + OFF_LB);
    for (int i = gtid; i < 1024; i += gthreads) { const float l0 = p->in[19][i], l1 = p->in[19][1024 + i], l2 = p->in[19][2048 + i], l3 = p->in[19][3072 + i];
        const float mx = fmaxf(fmaxf(l0, l1), fmaxf(l2, l3)); const float e0 = __expf(l0 - mx), e1 = __expf(l1 - mx), e2 = __expf(l2 - mx), e3 = __expf(l3 - mx);
        LB[i] = (e1 + e2) / (e0 + e1 + e2 + e3); }
    prep_layer(s_wv, p, 0, lds);
}
__device__ __forceinline__ void up8(const u32x4 v, float (&o)[8]) { o[0] = bflo(v[0]); o[1] = bfhi(v[0]); o[2] = bflo(v[1]); o[3] = bfhi(v[1]); o[4] = bflo(v[2]); o[5] = bfhi(v[2]); o[6] = bflo(v[3]); o[7] = bfhi(v[3]); }
template <bool SRC32> __device__ __forceinline__ void phase_norm(const int s_wv, const float* X32, bf16_t* XB, const float* g, const float* shift, const float* scale, bf16_t* dst) {
    const int lane = otid() & 63, wave = otid() >> 6;
    for (int rb = obid() * 8 + wave; rb < T / 8; rb += gridDim.x * 8) {
        const int r0 = rb * 8, b = r0 >> 12;
        float G[16], SH[16];
#pragma unroll
        for (int j = 0; j < 2; ++j)
#pragma unroll
            for (int h = 0; h < 2; ++h) { const int c = 8 * lane + 512 * j + 4 * h; const f32x4 gg = *(const f32x4*)(g + c), sc = *(const f32x4*)(scale + (size_t)b * 6144 + c), sh = *(const f32x4*)(shift + (size_t)b * 6144 + c);
#pragma unroll
                for (int e = 0; e < 4; ++e) { G[j * 8 + h * 4 + e] = gg[e] * (sc[e] + 1.f); SH[j * 8 + h * 4 + e] = sh[e]; } }
        for (int r = r0; r < r0 + 8; ++r) {
            float x[16]; float ss = 0.f;
#pragma unroll
            for (int j = 0; j < 2; ++j) { const unsigned off = (unsigned)(r * 1024 + 8 * lane + 512 * j);
                if (SRC32) { const f32x4 a = *(const f32x4*)(X32 + off), c = *(const f32x4*)(X32 + off + 4);
#pragma unroll
                    for (int e = 0; e < 4; ++e) { x[j * 8 + e] = a[e]; x[j * 8 + 4 + e] = c[e]; }
                    u32x4 xo = {pk2(a[0], a[1]), pk2(a[2], a[3]), pk2(c[0], c[1]), pk2(c[2], c[3])}; *(u32x4*)(XB + off) = xo;
                } else { float t[8]; up8(*(const u32x4*)(XB + off), t);
#pragma unroll
                    for (int e = 0; e < 8; ++e) x[j * 8 + e] = t[e]; } }
#pragma unroll
            for (int e = 0; e < 16; ++e) ss += x[e] * x[e];
            ss = wave_sum(ss, lane); const float rstd = rsqrtf(ss * (1.f / 1024.f) + EPS);
#pragma unroll
            for (int j = 0; j < 2; ++j) { float h[8];
#pragma unroll
                for (int e = 0; e < 8; ++e) h[e] = x[j * 8 + e] * rstd * G[j * 8 + e] + SH[j * 8 + e];
                u32x4 o = {pk2(h[0], h[1]), pk2(h[2], h[3]), pk2(h[4], h[5]), pk2(h[6], h[7])}; *(u32x4*)(dst + (unsigned)(r * 1024 + 8 * lane + 512 * j)) = o; }
        }
    }
}
__device__ __forceinline__ void phase_final(const int s_wv, const bf16_t* XB, float* out, const float* g) {
    const int lane = otid() & 63, wave = otid() >> 6;
    for (int r = obid() * 8 + wave; r < T; r += gridDim.x * 8) {
        float x[16]; float ss = 0.f;
#pragma unroll
        for (int j = 0; j < 2; ++j) { float t[8]; up8(*(const u32x4*)(XB + (unsigned)(r * 1024 + 8 * lane + 512 * j)), t);
#pragma unroll
            for (int e = 0; e < 8; ++e) { x[j * 8 + e] = t[e]; ss += t[e] * t[e]; } }
        ss = wave_sum(ss, lane); const float rstd = rsqrtf(ss * (1.f / 1024.f) + EPS);
#pragma unroll
        for (int j = 0; j < 2; ++j)
#pragma unroll
            for (int h = 0; h < 2; ++h) { const int c = 8 * lane + 512 * j + 4 * h; const f32x4 gg = *(const f32x4*)(g + c);
                f32x4 o = {x[j * 8 + h * 4] * rstd * gg[0], x[j * 8 + h * 4 + 1] * rstd * gg[1], x[j * 8 + h * 4 + 2] * rstd * gg[2], x[j * 8 + h * 4 + 3] * rstd * gg[3]};
                *(f32x4*)(out + (size_t)r * 1024 + c) = o; }
    }
}
__device__ __forceinline__ void phase_ffix(const int s_wv, const bf16_t* SIDE, bf16_t* ACT, const float* cw, const float* cb) {
    const int gtid = obid() * NTHREADS + otid(), gthreads = gridDim.x * NTHREADS;
    for (int q = gtid; q < 256 * 2 * 352; q += gthreads) {
        const int cgp = q % 352, gi = q / 352, i = gi & 1, g = gi >> 1, f0 = cgp * 8;
        const bool first = (g & 63) == 0;
        const bf16_t* own = SIDE + (size_t)((g * 4 + 2 + i) * 2) * 2816 + f0;
        const bf16_t* p1 = i == 0 ? SIDE + (size_t)(((g - 1) * 4 + 1) * 2) * 2816 + f0 : SIDE + (size_t)((g * 4 + 2) * 2) * 2816 + f0;
        const bf16_t* p2 = i == 0 ? SIDE + (size_t)(((g - 1) * 4 + 0) * 2) * 2816 + f0 : SIDE + (size_t)(((g - 1) * 4 + 1) * 2) * 2816 + f0;
        float gc[8], vc[8], g1[8], v1[8], g2[8], v2[8];
        up8(*(const u32x4*)own, gc); up8(*(const u32x4*)(own + 2816), vc);
        if (i == 1 || !first) { up8(*(const u32x4*)p1, g1); up8(*(const u32x4*)(p1 + 2816), v1); } else {
#pragma unroll
            for (int e = 0; e < 8; ++e) { g1[e] = 0.f; v1[e] = 0.f; } }
        if (!first) { up8(*(const u32x4*)p2, g2); up8(*(const u32x4*)(p2 + 2816), v2); } else {
#pragma unroll
            for (int e = 0; e < 8; ++e) { g2[e] = 0.f; v2[e] = 0.f; } }
        float o[8];
#pragma unroll
        for (int e = 0; e < 8; ++e) { const int f = f0 + e;
            const float yg = cb[f] + cw[f] * g2[e] + cw[5632 + f] * g1[e] + cw[11264 + f] * gc[e], yv = cb[2816 + f] + cw[2816 + f] * v2[e] + cw[5632 + 2816 + f] * v1[e] + cw[11264 + 2816 + f] * vc[e];
            o[e] = yg * fast_sigmoid(yg) * yv; }
        u32x4 ov = {pk2(o[0], o[1]), pk2(o[2], o[3]), pk2(o[4], o[5]), pk2(o[6], o[7])};
        *(u32x4*)(ACT + (size_t)(g * 64 + i) * 2816 + f0) = ov;
    }
}

__device__ __forceinline__ void phase_gsp(const int s_wv, KP p, int j, ldsp lds) {
    const bf16_t* Z = (const bf16_t*)(p->ws + OFF_R1); bf16_t* Y = (bf16_t*)(p->ws + OFF_R2);
    const float* ws_w = p->in[10] + (size_t)j * 8 * 128 * 128; const float* bs = p->in[11] + (size_t)j * 8 * 128;
    const float* lng = p->in[8] + (size_t)j * 2048; const float* lnb = p->in[9] + (size_t)j * 2048;
    const int tid = otid(), lane = tid & 63, wave = tid >> 6, l15 = lane & 15, g4 = lane >> 4;
    ldsp As = lds, Bs = lds + 34816; LAS float* mu = (LAS float*)(lds + 104448); LAS float* rs = mu + 128;
    for (int unit = obid(); unit < 256; unit += gridDim.x) {
        const int gh = unit & 1, chunk = unit >> 1, t0 = chunk * 128;
        for (int rr = 0; rr < 16; ++rr) { const int r = wave * 16 + rr; const bf16_t* zp = Z + (size_t)(t0 + r) * 4096 + 2048 + lane * 32; float s = 0.f, s2 = 0.f;
#pragma unroll
            for (int i = 0; i < 4; ++i) { float v[8]; up8(*(const u32x4*)(zp + 8 * i), v);
#pragma unroll
                for (int e = 0; e < 8; ++e) { s += v[e]; s2 += v[e] * v[e]; } }
            s = wave_sum(s, lane); s2 = wave_sum(s2, lane);
            if (lane == 0) { const float m = s * (1.f / 2048.f); float var = s2 * (1.f / 2048.f) - m * m; var = fmaxf(var, 0.f); mu[r] = m; rs[r] = rsqrtf(var + EPS); } }
        __syncthreads();
        for (int gi = 0; gi < 4; ++gi) {
            const int g = gh * 4 + gi;
#pragma unroll 2
            for (int i = 0; i < 8; ++i) { const int idx = tid + 512 * i, t = idx >> 5, s4 = (idx & 31) * 4; f32x4 w = *(const f32x4*)(ws_w + (size_t)g * 16384 + t * 128 + s4);
#pragma unroll
                for (int e = 0; e < 4; ++e) w[e] = (s4 + e <= t) ? w[e] : 0.f;
                u32x2 o = {pk2(w[0], w[1]), pk2(w[2], w[3])}; *(LAS u32x2*)(As + t * 272 + s4 * 2) = o; }
#pragma unroll 2
            for (int i = 0; i < 8; ++i) { const int idx = tid + 512 * i, s = idx >> 5, c8 = idx & 31; float v[8]; up8(*(const u32x4*)(Z + (size_t)(t0 + s) * 4096 + 2048 + g * 256 + c8 * 8), v);
                const float m = mu[s], r = rs[s]; const f32x4 ga = *(const f32x4*)(lng + g * 256 + c8 * 8), gb = *(const f32x4*)(lng + g * 256 + c8 * 8 + 4), ba = *(const f32x4*)(lnb + g * 256 + c8 * 8), bb = *(const f32x4*)(lnb + g * 256 + c8 * 8 + 4);
                const int boff = (((s >> 3) ^ (c8 & 15)) << 4) + (s & 7) * 2;
#pragma unroll
                for (int e = 0; e < 8; ++e) { const float gg = e < 4 ? ga[e] : gb[e - 4], bbv = e < 4 ? ba[e] : bb[e - 4]; const float val = (v[e] - m) * r * gg + bbv;
                    *(LAS bf16_t*)(Bs + (c8 * 8 + e) * 272 + boff) = (bf16_t)(pk2(val, 0.f) & 0xffffu); } }
            __syncthreads();
            f32x4 acc[8][2];
#pragma unroll
            for (int tt = 0; tt < 8; ++tt) { acc[tt][0] = zero4(); acc[tt][1] = zero4(); }
#pragma unroll
            for (int tt = 0; tt < 8; ++tt)
#pragma unroll
                for (int ks = 0; ks <= tt / 2; ++ks) { const bf16x8 yf = *(const LAS bf16x8*)(As + (16 * tt + l15) * 272 + (32 * ks + 8 * g4) * 2);
#pragma unroll
                    for (int ct = 0; ct < 2; ++ct) { const int c = 32 * wave + 16 * ct + l15; const bf16x8 xf = *(const LAS bf16x8*)(Bs + c * 272 + (((4 * ks + g4) ^ ((c >> 3) & 15)) << 4));
                        acc[tt][ct] = MFMA16(xf, yf, acc[tt][ct]); } }
#pragma unroll
            for (int tt = 0; tt < 8; ++tt) { const int t = 16 * tt + l15; const float bias = bs[g * 128 + t];
#pragma unroll
                for (int ct = 0; ct < 2; ++ct) { const int c = g * 256 + 32 * wave + 16 * ct + 4 * g4; const u32x2 uu = *(const u32x2*)(Z + (size_t)(t0 + t) * 4096 + c);
                    const f32x4 a = acc[tt][ct]; u32x2 o = {pk2(bflo(uu[0]) * (a[0] + bias), bfhi(uu[0]) * (a[1] + bias)), pk2(bflo(uu[1]) * (a[2] + bias), bfhi(uu[1]) * (a[3] + bias))};
                    *(u32x2*)(Y + (size_t)(t0 + t) * 2048 + c) = o; } }
            __syncthreads();
        }
    }
}

__device__ __forceinline__ void phase_m2(const int s_wv, KP p) {
    const float* A1 = (const float*)(p->ws + OFF_R1); bf16_t* CQN = (bf16_t*)(p->ws + OFF_R1 + 32 * MiB); bf16_t* CKVN = (bf16_t*)(p->ws + OFF_R1 + 40 * MiB); bf16_t* KF = (bf16_t*)(p->ws + OFF_R1 + 96 * MiB);
    const float* CSC = (const float*)(p->ws + OFF_CSC); const float* CSS = (const float*)(p->ws + OFF_CSS);
    const int lane = otid() & 63, wave = otid() >> 6;
    const f32x4 qg = *(const f32x4*)(p->in[14] + 4 * lane); const f32x4 kg = *(const f32x4*)(p->in[15] + 4 * (lane & 31));
    for (int r = obid() * 8 + wave; r < T; r += gridDim.x * 8) {
        const float* a = A1 + (size_t)r * 512;
        const f32x4 cq = *(const f32x4*)(a + 4 * lane); float ss = wave_sum(cq[0] * cq[0] + cq[1] * cq[1] + cq[2] * cq[2] + cq[3] * cq[3], lane);
        const float rq = rsqrtf(ss * (1.f / 256.f) + EPS);
        { const f32x4 h = cq * rq * qg; u32x2 o = {pk2(h[0], h[1]), pk2(h[2], h[3])}; *(u32x2*)(CQN + (size_t)r * 256 + 4 * lane) = o; }
        const f32x4 ck = *(const f32x4*)(a + 256 + 4 * (lane & 31)); float s2 = lane < 32 ? (ck[0] * ck[0] + ck[1] * ck[1] + ck[2] * ck[2] + ck[3] * ck[3]) : 0.f; s2 = wave_sum(s2, lane);
        const float rk = rsqrtf(s2 * (1.f / 128.f) + EPS);
        { const f32x4 h = ck * rk * kg; u32x2 o = {pk2(h[0], h[1]), pk2(h[2], h[3])}; if (lane >= 32) { o[0] = 0u; o[1] = 0u; } *(u32x2*)(CKVN + (size_t)r * 256 + 4 * lane) = o; }
        if (lane < 32) {
            const float x1 = a[384 + lane], x2 = a[416 + lane], c = CSC[(size_t)r * 32 + lane], s = CSS[(size_t)r * 32 + lane];
            const unsigned pr = pk2(x1 * c - x2 * s, x2 * c + x1 * s); const int b = r >> 12, sq = r & 4095;
#pragma unroll
            for (int h8 = 0; h8 < 8; ++h8) { bf16_t* kp = KF + ((size_t)((b * 8 + h8) * 4096 + sq)) * 192 + 128 + lane; kp[0] = (bf16_t)(pr & 0xffffu); kp[32] = (bf16_t)(pr >> 16); } }
    }
}

__device__ __forceinline__ void phase_attn(const int s_wv, KP p, ldsp lds) {
    const bf16_t* QF = (const bf16_t*)(p->ws + OFF_R1 + 48 * MiB); const bf16_t* KF = (const bf16_t*)(p->ws + OFF_R1 + 96 * MiB); const bf16_t* VT = (const bf16_t*)(p->ws + OFF_R1 + 144 * MiB);
    bf16_t* O = (bf16_t*)(p->ws + OFF_R2);
    const int tid = otid(), lane = tid & 63, wave = __builtin_amdgcn_readfirstlane(tid >> 6), l15 = lane & 15, g4 = lane >> 4;
    const int G = gridDim.x, bx = obid(), vcu = (G % 8 == 0) ? (bx % 8) * (G / 8) + bx / 8 : bx;
    constexpr int KB = 25600, VB = 18432, BUF = KB + VB;
    for (int unit = vcu; unit < 256; unit += G) {
        const int bh = unit >> 3, pr = unit & 7, b = bh >> 3, h = bh & 7;
        const unsigned char* kbase = (const unsigned char*)(KF + (size_t)bh * 4096 * 192);
        const unsigned char* vbase = (const unsigned char*)(VT + (size_t)bh * 128 * 4096);
        for (int half = 0; half < 2; ++half) {
            const int qb = half == 0 ? 15 - pr : pr, ntile = 4 * qb + 4;
            const int qrow0 = qb * 256 + 32 * wave;
            bf16x8 Qf[2][6];
#pragma unroll
            for (int qt = 0; qt < 2; ++qt)
#pragma unroll
                for (int ks = 0; ks < 6; ++ks) Qf[qt][ks] = *(const bf16x8*)((const unsigned char*)(QF + (size_t)(bh * 4096 + qrow0) * 192) + (unsigned)(((16 * qt + l15) * 192 + 32 * ks + 8 * g4) * 2));
            f32x4 Oa[2][8]; float mrun[2] = {-1e30f, -1e30f}, lsum[2] = {0.f, 0.f};
#pragma unroll
            for (int qt = 0; qt < 2; ++qt)
#pragma unroll
                for (int d = 0; d < 8; ++d) Oa[qt][d] = zero4();
#define ATT_DMA(j, bufi) do { ldsp kb_ = lds + (bufi) * BUF; \
                for (int c = wave; c < 25; c += 8) { const int q_ = c * 64 + lane, row = q_ / 25, c16 = min(q_ - row * 25, 23); \
                    __builtin_amdgcn_global_load_lds((const unsigned*)(kbase + (size_t)(j) * 24576 + (unsigned)(row * 384 + c16 * 16)), (LAS unsigned*)(kb_ + c * 1024), 16, 0, 0); } \
                for (int c = wave; c < 18; c += 8) { const int q_ = c * 64 + lane, dv = q_ / 9, k8 = min(q_ - dv * 9, 7); \
                    __builtin_amdgcn_global_load_lds((const unsigned*)(vbase + (size_t)(j) * 128 + (unsigned)(dv * 8192 + k8 * 16)), (LAS unsigned*)(kb_ + KB + c * 1024), 16, 0, 0); } } while (0)
            ATT_DMA(0, 0); asm volatile("s_waitcnt vmcnt(0)" ::: "memory"); __syncthreads();
#pragma unroll 1
            for (int j = 0; j < ntile; ++j) {
                if (j + 1 < ntile) ATT_DMA(j + 1, (j + 1) & 1);
                if (wave >= 4) __builtin_amdgcn_s_sleep(8);
                const int jj = j - 4 * qb; const bool diag = jj >= 0; const bool active = !(diag && 64 * jj > 32 * wave + 31);
                ldsp Kb = lds + (j & 1) * BUF; ldsp Vb = Kb + KB;
#pragma unroll
                for (int hs = 0; hs < 2; ++hs) {
                    if (active) {
                        f32x4 S[2][2];
#pragma unroll
                        for (int qt = 0; qt < 2; ++qt) { S[qt][0] = zero4(); S[qt][1] = zero4(); }
                        {
#define ATT_KLD(i) (*(const LAS bf16x8*)(Kb + (16 * (2 * hs + ((i) & 1)) + l15) * 400 + (32 * ((i) >> 1) + 8 * g4) * 2))
                            bf16x8 kq[3]; kq[0] = ATT_KLD(0); kq[1] = ATT_KLD(1);
#pragma unroll
                            for (int i = 0; i < 12; ++i) { if (i + 2 < 12) kq[(i + 2) % 3] = ATT_KLD(i + 2);
                                __builtin_amdgcn_sched_barrier(0);
                                S[0][i & 1] = MFMA16(kq[i % 3], Qf[0][i >> 1], S[0][i & 1]); S[1][i & 1] = MFMA16(kq[i % 3], Qf[1][i >> 1], S[1][i & 1]);
                                __builtin_amdgcn_sched_barrier(0); }
#undef ATT_KLD
                        }
                        bf16x8 Pf[2];
#pragma unroll
                        for (int qt = 0; qt < 2; ++qt) {
                            if (diag) { int dq = 32 * wave + 16 * qt + l15 - 4 * g4 - 64 * jj; asm volatile("" : "+v"(dq));
#pragma unroll
                                for (int sb = 0; sb < 2; ++sb)
#pragma unroll
                                    for (int e = 0; e < 4; ++e) { if (32 * hs + 16 * sb + e > dq) S[qt][sb][e] = -1e30f; } }
                            float tm = -1e30f;
#pragma unroll
                            for (int sb = 0; sb < 2; ++sb)
#pragma unroll
                                for (int e = 0; e < 4; ++e) tm = fmaxf(tm, S[qt][sb][e]);
                            tm = fmaxf(tm, shx(tm, 16, lane)); tm = fmaxf(tm, shx(tm, 32, lane));
                            if (__builtin_amdgcn_ballot_w64(tm > mrun[qt]) != 0ull) {
                                const float mn = fmaxf(mrun[qt], tm), sc = __builtin_amdgcn_exp2f(mrun[qt] - mn); mrun[qt] = mn; lsum[qt] *= sc;
#pragma unroll
                                for (int d = 0; d < 8; ++d) Oa[qt][d] = Oa[qt][d] * sc; }
                            const float mn = mrun[qt];
                            float ps = 0.f;
#pragma unroll
                            for (int sb = 0; sb < 2; ++sb)
#pragma unroll
                                for (int e = 0; e < 4; ++e) { const float pe = __builtin_amdgcn_exp2f(S[qt][sb][e] - mn); S[qt][sb][e] = pe; ps += pe; }
                            lsum[qt] += ps;
                            Pf[qt] = mk8(pk2(S[qt][0][0], S[qt][0][1]), pk2(S[qt][0][2], S[qt][0][3]), pk2(S[qt][1][0], S[qt][1][1]), pk2(S[qt][1][2], S[qt][1][3]));
                        }
                        {
#define ATT_VLD(d) __builtin_shufflevector(*(const LAS bf16x4*)(Vb + (16 * (d) + l15) * 144 + (32 * hs + 4 * g4) * 2), *(const LAS bf16x4*)(Vb + (16 * (d) + l15) * 144 + (32 * hs + 16 + 4 * g4) * 2), 0, 1, 2, 3, 4, 5, 6, 7)
                            bf16x8 vq[3]; vq[0] = ATT_VLD(0); vq[1] = ATT_VLD(1);
#pragma unroll
                            for (int d = 0; d < 8; ++d) { if (d + 2 < 8) vq[(d + 2) % 3] = ATT_VLD(d + 2);
                                __builtin_amdgcn_sched_barrier(0);
                                Oa[0][d] = MFMA16(vq[d % 3], Pf[0], Oa[0][d]); Oa[1][d] = MFMA16(vq[d % 3], Pf[1], Oa[1][d]);
                                __builtin_amdgcn_sched_barrier(0); }
#undef ATT_VLD
                        }
                    }
                }
                asm volatile("s_waitcnt vmcnt(0)" ::: "memory"); __syncthreads();
            }
#pragma unroll
            for (int qt = 0; qt < 2; ++qt) { float ls = lsum[qt]; ls += shx(ls, 16, lane); ls += shx(ls, 32, lane); const float inv = 1.f / ls;
                bf16_t* op = (bf16_t*)((unsigned char*)(O + (size_t)(b * 4096 + qrow0) * 1024 + h * 128) + (unsigned)(((16 * qt + l15) * 1024 + 4 * g4) * 2));
#pragma unroll
                for (int d = 0; d < 8; ++d) { const f32x4 v = Oa[qt][d] * inv; u32x2 o = {pk2(v[0], v[1]), pk2(v[2], v[3])}; *(u32x2*)(op + 16 * d) = o; } }
        }
    }
#undef ATT_DMA
}

template <bool TOF32> __device__ __forceinline__ void hg_load_f_v(const float* HF, const bf16_t* HV, int t0, int col0, LAS float* BC, LAS float* K1f, ldsp K1b, ldsp VTl, int tid) {
#pragma unroll
    for (int i = 0; i < 4; ++i) { const int idx = tid + 512 * i, s = idx >> 5, k4 = (idx & 31) * 4; const f32x4 f = *(const f32x4*)(HF + (size_t)(t0 + s) * 1024 + col0 + k4);
#pragma unroll
        for (int e = 0; e < 4; ++e) BC[s * 129 + k4 + e] = __logf(f[e]);
        if (TOF32) {
#pragma unroll
            for (int e = 0; e < 4; ++e) K1f[s * 129 + k4 + e] = 1.f - f[e];
        } else { u32x2 o = {pk2(1.f - f[0], 1.f - f[1]), pk2(1.f - f[2], 1.f - f[3])}; *(LAS u32x2*)(K1b + s * 272 + k4 * 2) = o; } }
#pragma unroll
    for (int i = 0; i < 2; ++i) { const int idx = tid + 512 * i, s = idx >> 4, v8 = idx & 15; const u32x4 vv = *(const u32x4*)(HV + (size_t)(t0 + s) * 1024 + col0 + v8 * 8);
#pragma unroll
        for (int e = 0; e < 4; ++e) { *(LAS bf16_t*)(VTl + (v8 * 8 + 2 * e) * 144 + s * 2) = (bf16_t)(vv[e] & 0xffffu); *(LAS bf16_t*)(VTl + (v8 * 8 + 2 * e + 1) * 144 + s * 2) = (bf16_t)(vv[e] >> 16); } }
}
__device__ __forceinline__ void phase_ha(const int s_wv, KP p, ldsp lds) {
    const float* HF = (const float*)(p->ws + OFF_R1 + 32 * MiB); const bf16_t* HV = (const bf16_t*)(p->ws + OFF_R1 + 96 * MiB);
    bf16_t* LCT = (bf16_t*)(p->ws + OFF_R2); float* DEC = (float*)(p->ws + OFF_R2 + 64 * MiB);
    const int tid = otid(), lane = tid & 63, wave = tid >> 6, l15 = lane & 15, g4 = lane >> 4;
    LAS float* BC = (LAS float*)lds; LAS float* K1 = (LAS float*)(lds + 33024); ldsp KT = lds + 66048; ldsp VTl = lds + 84480;
    for (int u = obid(); u < 2048; u += gridDim.x) {
        const int bh = u >> 6, n = u & 63, b = bh >> 3, h = bh & 7, t0 = b * 4096 + n * 64, col0 = h * 128;
        hg_load_f_v<true>(HF, HV, t0, col0, BC, K1, VTl, VTl, tid);
        __syncthreads();
        if (tid < 128) { float run = 0.f;
#pragma unroll 8
            for (int s = 0; s < 64; ++s) { run += BC[s * 129 + tid]; BC[s * 129 + tid] = run; }
            DEC[(size_t)u * 128 + tid] = __expf(run); }
        __syncthreads();
        { const int sp = tid & 31, kk0 = tid >> 5;
#pragma unroll
          for (int it = 0; it < 8; ++it) { const int k = kk0 + 16 * it; const float bl = BC[63 * 129 + k];
              const float a0 = K1[(2 * sp) * 129 + k] * __expf(bl - BC[(2 * sp) * 129 + k]), a1 = K1[(2 * sp + 1) * 129 + k] * __expf(bl - BC[(2 * sp + 1) * 129 + k]);
              *(LAS unsigned*)(KT + k * 144 + sp * 4) = pk2(a0, a1); } }
        __syncthreads();
        f32x4 acc[8];
#pragma unroll
        for (int vt = 0; vt < 8; ++vt) acc[vt] = zero4();
#pragma unroll
        for (int ks = 0; ks < 2; ++ks) { const bf16x8 xf = *(const LAS bf16x8*)(KT + (16 * wave + l15) * 144 + (32 * ks + 8 * g4) * 2);
#pragma unroll
            for (int vt = 0; vt < 8; ++vt) { const bf16x8 yf = *(const LAS bf16x8*)(VTl + (16 * vt + l15) * 144 + (32 * ks + 8 * g4) * 2); acc[vt] = MFMA16(xf, yf, acc[vt]); } }
#pragma unroll
        for (int vt = 0; vt < 8; ++vt) { u32x2 o = {pk2(acc[vt][0], acc[vt][1]), pk2(acc[vt][2], acc[vt][3])}; *(u32x2*)(LCT + ((size_t)u * 128 + 16 * vt + l15) * 128 + 16 * wave + 4 * g4) = o; }
        __syncthreads();
    }
}
__device__ __forceinline__ void phase_hscan(const int s_wv, KP p) {
    bf16_t* LCT = (bf16_t*)(p->ws + OFF_R2); const float* DEC = (const float*)(p->ws + OFF_R2 + 64 * MiB);
    const int gtid = obid() * NTHREADS + otid(), gthreads = gridDim.x * NTHREADS;
    for (int id = gtid; id < 32 * 128 * 32; id += gthreads) {
        const int k4 = id & 31, v = (id >> 5) & 127, bh = id >> 12;
        f32x4 st = zero4();
#pragma unroll 4
        for (int n = 0; n < 64; ++n) { const int u = bh * 64 + n; bf16_t* ptr = LCT + ((size_t)u * 128 + v) * 128 + 4 * k4;
            const u32x2 t = *(const u32x2*)ptr; const f32x4 dec = *(const f32x4*)(DEC + (size_t)u * 128 + 4 * k4);
            u32x2 o = {pk2(st[0], st[1]), pk2(st[2], st[3])}; *(u32x2*)ptr = o;
            st[0] = dec[0] * st[0] + bflo(t[0]); st[1] = dec[1] * st[1] + bfhi(t[0]); st[2] = dec[2] * st[2] + bflo(t[1]); st[3] = dec[3] * st[3] + bfhi(t[1]); }
    }
}
__device__ __forceinline__ void phase_hc(const int s_wv, KP p, ldsp lds) {
    const bf16_t* HQ = (const bf16_t*)(p->ws + OFF_R1); const float* HF = (const float*)(p->ws + OFF_R1 + 32 * MiB); const bf16_t* HV = (const bf16_t*)(p->ws + OFF_R1 + 96 * MiB); const bf16_t* HG = (const bf16_t*)(p->ws + OFF_R1 + 128 * MiB);
    const bf16_t* SST = (const bf16_t*)(p->ws + OFF_R2); bf16_t* O = (bf16_t*)(p->ws + OFF_HB); const float* ng = p->in[21];
    const int tid = otid(), lane = tid & 63, wave = tid >> 6, l15 = lane & 15, g4 = lane >> 4;
    LAS float* BC = (LAS float*)lds; ldsp QT = lds + 33024; ldsp KTl = lds + 50432; ldsp QH = lds + 67840; ldsp VTl = lds + 85248; ldsp AT = lds + 103680; LAS float* SSQ = (LAS float*)(lds + 112896);
    for (int u = obid(); u < 2048; u += gridDim.x) {
        const int bh = u >> 6, n = u & 63, b = bh >> 3, h = bh & 7, t0 = b * 4096 + n * 64, col0 = h * 128;
        hg_load_f_v<false>(HF, HV, t0, col0, BC, BC, KTl, VTl, tid);
        u32x4 qraw[2];
#pragma unroll
        for (int i = 0; i < 2; ++i) { const int idx = tid + 512 * i, s = idx >> 4, k8 = idx & 15; qraw[i] = *(const u32x4*)(HQ + (size_t)(t0 + s) * 1024 + col0 + k8 * 8); }
        __syncthreads();
        if (tid < 128) { float run = 0.f;
#pragma unroll 8
            for (int s = 0; s < 64; ++s) { run += BC[s * 129 + tid]; BC[s * 129 + tid] = run; } }
        __syncthreads();
#pragma unroll
        for (int i = 0; i < 2; ++i) { const int idx = tid + 512 * i, s = idx >> 4, k8 = idx & 15; float q[8], kk[8], qt[8], qh[8]; up8(qraw[i], q); up8(*(const LAS u32x4*)(KTl + s * 272 + k8 * 16), kk);
#pragma unroll
            for (int e = 0; e < 8; ++e) { const int k = k8 * 8 + e; const float bc = BC[s * 129 + k], bm = BC[31 * 129 + k]; qt[e] = q[e] * __expf(bc - bm); qh[e] = q[e] * __expf(bc); kk[e] = kk[e] * __expf(bm - bc); }
            u32x4 o1 = {pk2(qt[0], qt[1]), pk2(qt[2], qt[3]), pk2(qt[4], qt[5]), pk2(qt[6], qt[7])}, o2 = {pk2(qh[0], qh[1]), pk2(qh[2], qh[3]), pk2(qh[4], qh[5]), pk2(qh[6], qh[7])}, o3 = {pk2(kk[0], kk[1]), pk2(kk[2], kk[3]), pk2(kk[4], kk[5]), pk2(kk[6], kk[7])};
            *(LAS u32x4*)(QT + s * 272 + k8 * 16) = o1; *(LAS u32x4*)(QH + s * 272 + k8 * 16) = o2; *(LAS u32x4*)(KTl + s * 272 + k8 * 16) = o3; }
        __syncthreads();
        { const int st = wave & 3;
#pragma unroll
          for (int ti = 0; ti < 2; ++ti) { const int tt = 2 * (wave >> 2) + ti; f32x4 a = zero4();
              if (st <= tt) {
#pragma unroll
                  for (int ks = 0; ks < 4; ++ks) { const bf16x8 xf = *(const LAS bf16x8*)(KTl + (16 * st + l15) * 272 + (32 * ks + 8 * g4) * 2), yf = *(const LAS bf16x8*)(QT + (16 * tt + l15) * 272 + (32 * ks + 8 * g4) * 2); a = MFMA16(xf, yf, a); }
                  const int t = 16 * tt + l15;
#pragma unroll
                  for (int e = 0; e < 4; ++e) { const int s = 16 * st + 4 * g4 + e; if (s > t) a[e] = 0.f; } }
              u32x2 o = {pk2(a[0], a[1]), pk2(a[2], a[3])}; *(LAS u32x2*)(AT + (16 * tt + l15) * 144 + (16 * st + 4 * g4) * 2) = o; } }
        __syncthreads();
        { const int tt = wave >> 1, vh = wave & 1; f32x4 acc[4];
#pragma unroll
          for (int vi = 0; vi < 4; ++vi) acc[vi] = zero4();
#pragma unroll
          for (int ks = 0; ks < 2; ++ks) if (32 * ks <= 16 * tt + 15) { const bf16x8 yf = *(const LAS bf16x8*)(AT + (16 * tt + l15) * 144 + (32 * ks + 8 * g4) * 2);
#pragma unroll
              for (int vi = 0; vi < 4; ++vi) { const bf16x8 xf = *(const LAS bf16x8*)(VTl + (16 * (4 * vh + vi) + l15) * 144 + (32 * ks + 8 * g4) * 2); acc[vi] = MFMA16(xf, yf, acc[vi]); } }
#pragma unroll
          for (int ks = 0; ks < 4; ++ks) { const bf16x8 yf = *(const LAS bf16x8*)(QH + (16 * tt + l15) * 272 + (32 * ks + 8 * g4) * 2);
#pragma unroll
              for (int vi = 0; vi < 4; ++vi) { const bf16x8 xf = *(const bf16x8*)(SST + ((size_t)u * 128 + 16 * (4 * vh + vi) + l15) * 128 + 32 * ks + 8 * g4); acc[vi] = MFMA16(xf, yf, acc[vi]); } }
          float sq = 0.f;
#pragma unroll
          for (int vi = 0; vi < 4; ++vi)
#pragma unroll
              for (int e = 0; e < 4; ++e) sq += acc[vi][e] * acc[vi][e];
          sq += shx(sq, 16, lane); sq += shx(sq, 32, lane);
          if (g4 == 0) SSQ[(16 * tt + l15) * 2 + vh] = sq;
          __syncthreads();
          const int t = 16 * tt + l15; const float rstd = rsqrtf((SSQ[t * 2] + SSQ[t * 2 + 1]) * (1.f / 128.f) + EPS);
#pragma unroll
          for (int vi = 0; vi < 4; ++vi) { const int v = 16 * (4 * vh + vi) + 4 * g4; const f32x4 gn = *(const f32x4*)(ng + v); const u32x2 gg = *(const u32x2*)(HG + (size_t)(t0 + t) * 1024 + col0 + v);
              const f32x4 a = acc[vi] * rstd * gn; u32x2 o = {pk2(a[0] * bflo(gg[0]), a[1] * bfhi(gg[0])), pk2(a[2] * bflo(gg[1]), a[3] * bfhi(gg[1]))};
              *(u32x2*)(O + (size_t)(t0 + t) * 1024 + col0 + v) = o; } }
        __syncthreads();
    }
}

__global__ void __launch_bounds__(NTHREADS, 2) fwd_kernel(Params pk) {
    extern __shared__ __attribute__((aligned(16))) unsigned char smem[];
    ldsp lds = (ldsp)smem;
    const int ph_lo = pk.ph_lo, ph_hi = pk.ph_hi;
    const int s_wv = __builtin_amdgcn_readfirstlane((int)threadIdx.x >> 6);
    if (threadIdx.x < 4) ((LAS unsigned*)(lds + 131072))[threadIdx.x] = 0u;
    __syncthreads();
    XcdBarrier xbar = xcd_barrier_post((unsigned*)(pk.ws + OFF_BAR), (volatile LAS unsigned*)(lds + 131072), (int)threadIdx.x);
    for (int ph = ph_lo; ph < ph_hi; ++ph) {
        KP p = (KP)__builtin_amdgcn_kernarg_segment_ptr();
        asm volatile("" : "+s"(p));
        const int op = p->op[ph], layraw = p->lay[ph], layer = layraw & 3; const bool dummy = (layraw & 4) != 0;
        unsigned char* ws = p->ws; bf16_t* xdst = dummy ? (bf16_t*)(ws + OFF_R1) : (bf16_t*)(ws + OFF_XB);
        float* MOD = (float*)(ws + OFF_MOD); bf16_t* WT = (bf16_t*)(ws + OFF_WT); bf16_t* HB = (bf16_t*)(ws + OFF_HB); bf16_t* XB = (bf16_t*)(ws + OFF_XB);
        bf16_t* R1 = (bf16_t*)(ws + OFF_R1); bf16_t* R2 = (bf16_t*)(ws + OFF_R2);
        const float* modl = MOD + (size_t)layer * 4 * 6144;
        switch (op) {
        case OP_PRO: phase_prologue(s_wv, p, lds); break;
        case OP_NORM1: if (layer == 0) phase_norm<true>(s_wv, p->in[0], XB, p->in[5], modl + 0, modl + 1024, HB); else { phase_norm<false>(s_wv, p->in[0], XB, p->in[5] + layer * 1024, modl + 0, modl + 1024, HB); prep_layer(s_wv, p, layer, lds); } break;
        case OP_NORM2: { const float* cw = p->in[24] + (size_t)layer * 3 * 5632; const float* cb = p->in[25] + (size_t)layer * 5632; bf16_t* CWB = (bf16_t*)(ws + OFF_CWB);
                         for (int f = obid() * NTHREADS + otid(); f < 2816; f += gridDim.x * NTHREADS) { u32x4 o = {pk2(cw[f], cw[5632 + f]), pk2(cw[11264 + f], cb[f]), pk2(cw[2816 + f], cw[5632 + 2816 + f]), pk2(cw[11264 + 2816 + f], cb[2816 + f])}; *(u32x4*)(CWB + f * 8) = o; }
                         phase_norm<false>(s_wv, p->in[0], XB, p->in[6] + layer * 1024, modl + 3072, modl + 4096, HB); } break;
        case OP_G1: { EpiBf16<1> E{R1, 4096}; run_gemm(s_wv, lds, HB, WT + WT_MIXA, T, 4096, 1024, E); } break;
        case OP_GSP: phase_gsp(s_wv, p, layer / 3, lds); break;
        case OP_GOUT: { EpiRes E{XB, xdst, modl + 2048}; run_gemm(s_wv, lds, R2, WT + WT_MIXB, T, 1024, 2048, E); } break;
        case OP_M1: { EpiF32 E{(float*)R1, 512}; run_gemm(s_wv, lds, HB, WT + WT_MIXA, T, 512, 1024, E); } break;
        case OP_M2: phase_m2(s_wv, p); break;
        case OP_M3: { EpiQ EQ{(bf16_t*)(ws + OFF_R1 + 48 * MiB), (const float*)(ws + OFF_CSC), (const float*)(ws + OFF_CSS), 0.07216878364870322f * 1.4426950408889634f}; run_gemm(s_wv, lds, (const bf16_t*)(ws + OFF_R1 + 32 * MiB), WT + WT_MQKV, T, 1536, 256, EQ); EpiKV EK{(bf16_t*)(ws + OFF_R1 + 96 * MiB), (bf16_t*)(ws + OFF_R1 + 144 * MiB)}; run_gemm(s_wv, lds, (const bf16_t*)(ws + OFF_R1 + 40 * MiB), WT + WT_MQKV + 393216, T, 2048, 256, EK); } break;
        case OP_ATT: phase_attn(s_wv, p, lds); break;
        case OP_MOUT: { EpiRes E{XB, XB, modl + 2048}; run_gemm(s_wv, lds, R2, WT + WT_MIXB, T, 1024, 1024, E); } break;
        case OP_H1: { EpiHg E{ws + OFF_R1, (const float*)(ws + OFF_LB)}; run_gemm(s_wv, lds, HB, WT + WT_MIXA, T, 4096, 1024, E); } break;
        case OP_HA: phase_ha(s_wv, p, lds); break;
        case OP_HSCAN: phase_hscan(s_wv, p); break;
        case OP_HC: phase_hc(s_wv, p, lds); break;
        case OP_HOUT: { EpiRes E{XB, XB, modl + 2048}; run_gemm(s_wv, lds, HB, WT + WT_MIXB, T, 1024, 1024, E); } break;
        case OP_FUP: { EpiFFN E{R2, (const bf16_t*)(ws + OFF_CWB)}; run_gemm(s_wv, lds, HB - 2 * 1024, WT + WT_FUP, 67 * 256, 5632, 1024, E); } break;
        case OP_FDN: { EpiRes E{XB, xdst, modl + 5120}; run_gemm(s_wv, lds, R2, WT + WT_FDN, T, 1024, 2816, E); } break;
        case OP_FINAL: phase_final(s_wv, XB, p->out, p->in[27]); break;
        default: break;
        }
        if (ph + 1 < ph_hi) { if (ph == ph_lo) { __syncthreads(); cg::this_grid().sync(); } else xcd_barrier(xbar, otid()); }
    }
}

#ifndef MULTI_LAUNCH
#define MULTI_LAUNCH 0
#endif
extern "C" void kernel_launch(void* const* d_in, const int* in_sizes, int n_in, void* d_out, int out_size, void* d_ws, size_t ws_size, hipStream_t stream) {
    static int grid = 0;
    if (grid == 0) {
        int dev = 0, cus = 0, per_cu = 0;
        hipGetDevice(&dev); hipDeviceGetAttribute(&cus, hipDeviceAttributeMultiprocessorCount, dev);
        hipFuncSetAttribute((const void*)fwd_kernel, hipFuncAttributeMaxDynamicSharedMemorySize, LDS_BYTES);
        hipOccupancyMaxActiveBlocksPerMultiprocessor(&per_cu, (const void*)fwd_kernel, NTHREADS, LDS_BYTES);
        if (per_cu < 1) per_cu = 1;
        grid = cus * 1; (void)per_cu;
        if (ws_size < WS_END) fprintf(stderr, "kernel_launch: workspace too small: %zu < %zu\n", ws_size, (size_t)WS_END);
        (void)hipGetLastError();
    }
    (void)hipMemsetAsync((char*)d_ws + OFF_BAR, 0, XCD_BAR_WORDS * sizeof(unsigned), stream);
    Params p{};
    for (int i = 0; i < 28; ++i) p.in[i] = (const float*)d_in[i];
    p.out = (float*)d_out; p.ws = (unsigned char*)d_ws;
    int n = 0;
    auto add = [&](int op, int l) { p.op[n] = (unsigned char)op; p.lay[n] = (unsigned char)l; ++n; };
    add(OP_PRO, 0);
    for (int l = 0; l < 4; ++l) {
        add(OP_NORM1, l);
        if (l % 3 == 0) { add(OP_G1, l); add(OP_GSP, l); add(OP_GOUT, l); }
        else if (l % 3 == 1) { add(OP_M1, l); add(OP_M2, l); add(OP_M3, l); add(OP_ATT, l); add(OP_MOUT, l); }
        else { add(OP_H1, l); add(OP_HA, l); add(OP_HSCAN, l); add(OP_HC, l); add(OP_HOUT, l); }
        add(OP_NORM2, l); add(OP_FUP, l); add(OP_FDN, l);
    }
    add(OP_FINAL, 0);
#if MULTI_LAUNCH
    for (int i = 0; i < n; ++i) { p.ph_lo = i; p.ph_hi = i + 1; hipLaunchKernelGGL(fwd_kernel, dim3(grid), dim3(NTHREADS), LDS_BYTES, stream, p); }
#else
    p.ph_lo = 0; p.ph_hi = n;
    void* args[] = {&p};
    hipError_t e = hipLaunchCooperativeKernel((const void*)fwd_kernel, dim3(grid), dim3(NTHREADS), args, LDS_BYTES, stream);
    if (e != hipSuccess) fprintf(stderr, "cooperative launch failed: %s (grid %d)\n", hipGetErrorString(e), grid);
#endif
}
```

```cpp
#include <hip/hip_runtime.h>
#include <hip/hip_cooperative_groups.h>
#include <cstdio>
#include <cstdint>
namespace cg = cooperative_groups;
__device__ __forceinline__ int otid_w(int w) { int l; asm volatile("v_mbcnt_lo_u32_b32 %0, -1, 0\n\tv_mbcnt_hi_u32_b32 %0, -1, %0" : "=v"(l)); return (w << 6) | l; }
#define otid() otid_w(s_wv)
__device__ __forceinline__ int obid() { int t = blockIdx.x; asm volatile("" : "+s"(t)); return t; }
namespace pg8 {
#define PG8_LAS __attribute__((address_space(3)))
typedef unsigned short bf16_t;
typedef short bf16x8 __attribute__((ext_vector_type(8)));
typedef float f32x4 __attribute__((ext_vector_type(4)));
typedef unsigned u32x4 __attribute__((ext_vector_type(4)));
constexpr int BM = 256, BK = 64, HALF = 128, HTB = HALF * BK * 2  , STAGE_BYTES = 8 * HTB, NXCD = 8, WGM = 8;

__host__ __device__ __forceinline__ int lds_byte(int r, int c) { const int st = (r >> 4) * 2 + (c >> 5), rr = r & 15, cc = c & 31, ob = rr * 64 + cc * 2; return st * 1024 + (ob ^ (((ob >> 9) & 1) << 5)); }
__host__ __device__ __forceinline__ void stage_rc(int b, int& R, int& C) { const int st = b / 1024, sb = b % 1024, swz = sb ^ (((sb >> 9) & 1) << 5); R = (st >> 1) * 16 + swz / 64; C = (st & 1) * 32 + (swz % 64) / 2; }
__host__ __device__ __forceinline__ int perm32(int rho) { const int n = rho >> 4, i = rho & 15; return 8 * (i >> 2) + 4 * n + (i & 3); }

struct Unit { int pm, pn; };
struct Gemm { const bf16_t* A; const bf16_t* Bt; int M, N, K; };

struct StaticOrder {
    int nM, nN, nwg, G, c;
    __host__ __device__ void init(int M, int N, int G_, int c_) { nM = M / BM; nN = N / BM; nwg = nM * nN; G = G_; c = c_; }
    __host__ __device__ bool next(int i, Unit& u) const {
        const long L = (long)i * G + c; if (L >= nwg) return false;
        int wgid = (int)L; { const int q = nwg / NXCD, r = nwg % NXCD, xcd = wgid % NXCD, off = wgid / NXCD; wgid = (xcd < r ? xcd * (q + 1) : r * (q + 1) + (xcd - r) * q) + off; }
        const int nig = WGM * nN, gid = wgid / nig, fm = gid * WGM, gsz = (nM - fm) < WGM ? (nM - fm) : WGM;
        u.pm = fm + ((wgid % nig) % gsz); u.pn = (wgid % nig) / gsz; return true;
    }
    __device__ __forceinline__ void a_ready(const Unit&) const {}
    __device__ __forceinline__ void done(const Unit&) const {}
};
__device__ __forceinline__ unsigned cvt_pk_bf16(float lo, float hi) { unsigned r; asm volatile("v_cvt_pk_bf16_f32 %0, %1, %2" : "=v"(r) : "v"(lo), "v"(hi)); return r; }

template <class Epi, class Sched, bool STAMP = false>
__device__ __forceinline__ void gemm_phase(const int s_wv, PG8_LAS unsigned char* lds, const Gemm g, const Sched& S, const Epi& E, unsigned long long* stamps) {
    const int tid = otid(), wid = __builtin_amdgcn_readfirstlane(tid >> 6), lane = tid & 63, wr = wid >> 2, wc = wid & 3, fr = lane & 15, fq = lane >> 4;
    const int K = g.K, nt = K / BK;
    int ts_lo = 0, ts_hi = 0, nts = 0; const unsigned long long rt_entry = STAMP ? (unsigned long long)wall_clock64() : 0ull;
#define PG8_STAMP() do { if (STAMP && wid == 0 && nts < 64) { const unsigned long long _c = (unsigned long long)clock64(); \
        ts_lo = (lane == nts) ? (int)(unsigned)_c : ts_lo; ts_hi = (lane == nts) ? (int)(unsigned)(_c >> 32) : ts_hi; ++nts; } } while (0)
    PG8_STAMP();
    unsigned voffA[2], voffB[2];
#pragma unroll
    for (int i = 0; i < 2; ++i) { int R, C; stage_rc(tid * 16 + i * 8192, R, C); const int Rb = Epi::PERM ? ((R & ~31) + perm32(R & 31)) : R;
        const int Ra = Epi::PERMA ? (62 * (R >> 6) + 4 * (R & 15) + ((R >> 4) & 3)) : R; voffA[i] = (unsigned)(Ra * K + C) * 2u; voffB[i] = (unsigned)(Rb * K + C) * 2u; }
    const size_t kstep = (size_t)(BK * 2);
    const size_t hstep = (size_t)HALF * K * 2;
    const size_t tstep = 2 * hstep;
    const size_t hstepA = Epi::PERMA ? (size_t)124 * K * 2 : hstep, tstepA = Epi::PERMA ? (size_t)248 * K * 2 : tstep;
    const unsigned ldsw = (unsigned)wid * 1024u;
    const int aoff = lds_byte(wr * 64 + fr, fq * 8), boff = lds_byte(wc * 32 + fr, fq * 8);
#define PG8_SA(b, h) (((b) * 2 + (h)) * HTB)
#define PG8_SB(b, h) ((4 + (b) * 2 + (h)) * HTB)
#define PG8_STAGE(bufoff, gbase, voff) do { _Pragma("unroll") for (int _i = 0; _i < 2; ++_i) \
        __builtin_amdgcn_global_load_lds((const unsigned*)((const char*)(gbase) + (voff)[_i]), (PG8_LAS unsigned*)(lds + (bufoff) + ldsw + _i * 8192), 16, 0, 0); } while (0)
#define PG8_LDA(dst, b, h) do { _Pragma("unroll") for (int m = 0; m < 4; ++m) _Pragma("unroll") for (int k = 0; k < 2; ++k) dst[m][k] = *(const PG8_LAS bf16x8*)(lds + PG8_SA(b, h) + aoff + m * 2048 + k * 1024); } while (0)
#define PG8_LDB(dst, b, h) do { _Pragma("unroll") for (int n = 0; n < 2; ++n) _Pragma("unroll") for (int k = 0; k < 2; ++k) dst[n][k] = *(const PG8_LAS bf16x8*)(lds + PG8_SB(b, h) + boff + n * 2048 + k * 1024); } while (0)
#define PG8_MMA(ai, bj, At, Bt) do { __builtin_amdgcn_s_setprio(1); _Pragma("unroll") for (int m = 0; m < 4; ++m) _Pragma("unroll") for (int n = 0; n < 2; ++n) _Pragma("unroll") for (int k = 0; k < 2; ++k) \
        acc[ai][bj][m][n] = __builtin_amdgcn_mfma_f32_16x16x32_bf16(Bt[n][k], At[m][k], acc[ai][bj][m][n], 0, 0, 0); __builtin_amdgcn_s_setprio(0); } while (0)
#define PG8_WAIT_V(n) asm volatile("s_waitcnt vmcnt(" #n ")" ::: "memory")
#define PG8_WAIT_L(n) asm volatile("s_waitcnt lgkmcnt(" #n ")" ::: "memory")
#define PG8_BAR __builtin_amdgcn_s_barrier()
#define PG8_SCHED __builtin_amdgcn_sched_barrier(0)
    Unit cur, nxt; int ui = 0;
    if (!S.next(0, cur)) return;
    f32x4 acc[2][2][4][2];
#pragma unroll
    for (int a = 0; a < 2; ++a)
#pragma unroll
        for (int b = 0; b < 2; ++b)
#pragma unroll
            for (int m = 0; m < 4; ++m)
#pragma unroll
                for (int n = 0; n < 2; ++n) acc[a][b][m][n] = (f32x4){0.f, 0.f, 0.f, 0.f};
    bf16x8 At[4][2], B0[2][2], B1[2][2];
    const char* cA = (const char*)g.A + (size_t)cur.pm * tstepA; const char* cB = (const char*)g.Bt + (size_t)cur.pn * tstep;
    S.a_ready(cur);
    PG8_STAGE(PG8_SB(0, 0), cB, voffB); PG8_STAGE(PG8_SA(0, 0), cA, voffA); PG8_STAGE(PG8_SB(0, 1), cB + hstep, voffB); PG8_STAGE(PG8_SA(0, 1), cA + hstepA, voffA);
    if (wr == 1) PG8_BAR;
    PG8_WAIT_V(4); PG8_BAR;
    PG8_STAGE(PG8_SB(1, 0), cB + kstep, voffB); PG8_STAGE(PG8_SA(1, 0), cA + kstep, voffA); PG8_STAGE(PG8_SB(1, 1), cB + hstep + kstep, voffB);
    PG8_WAIT_V(6); PG8_BAR;
    PG8_STAMP();
    for (;;) {
        const bool has_next = S.next(ui + 1, nxt);
        const char* nA = has_next ? (const char*)g.A + (size_t)nxt.pm * tstepA : cA; const char* nB = has_next ? (const char*)g.Bt + (size_t)nxt.pn * tstep : cB;
        for (int t = 0; t < nt; t += 2) {
            const bool last = (t == nt - 2);
            const char* a1 = cA + (size_t)(t + 1) * kstep;
            const char* a2 = last ? nA : cA + (size_t)(t + 2) * kstep; const char* b2 = last ? nB : cB + (size_t)(t + 2) * kstep;
            const char* a3 = a2 + kstep; const char* b3 = b2 + kstep;
            if (last && has_next) S.a_ready(nxt);
            PG8_LDB(B0, 0, 0); PG8_SCHED; PG8_LDA(At, 0, 0); PG8_STAGE(PG8_SA(1, 1), a1 + hstepA, voffA);
            PG8_WAIT_L(8); PG8_BAR; PG8_WAIT_L(0); PG8_MMA(0, 0, At, B0); PG8_BAR; PG8_SCHED;
            PG8_LDB(B1, 0, 1); PG8_STAGE(PG8_SB(0, 0), b2, voffB);
            PG8_BAR; PG8_WAIT_L(0); PG8_MMA(0, 1, At, B1); PG8_BAR;
            PG8_LDA(At, 0, 1); PG8_STAGE(PG8_SA(0, 0), a2, voffA);
            PG8_BAR; PG8_WAIT_L(0); PG8_MMA(1, 0, At, B0); PG8_BAR; PG8_SCHED;
            PG8_STAGE(PG8_SB(0, 1), b2 + hstep, voffB);
            PG8_WAIT_V(6); PG8_BAR; PG8_MMA(1, 1, At, B1); PG8_BAR;
            PG8_LDB(B0, 1, 0); PG8_SCHED; PG8_LDA(At, 1, 0); PG8_STAGE(PG8_SA(0, 1), a2 + hstepA, voffA);
            PG8_WAIT_L(8); PG8_BAR; PG8_WAIT_L(0); PG8_MMA(0, 0, At, B0); PG8_BAR; PG8_SCHED;
            PG8_LDB(B1, 1, 1); PG8_STAGE(PG8_SB(1, 0), b3, voffB);
            PG8_BAR; PG8_WAIT_L(0); PG8_MMA(0, 1, At, B1); PG8_BAR;
            PG8_LDA(At, 1, 1); PG8_STAGE(PG8_SA(1, 0), a3, voffA);
            PG8_BAR; PG8_WAIT_L(0); PG8_MMA(1, 0, At, B0); PG8_BAR; PG8_SCHED;
            PG8_STAGE(PG8_SB(1, 1), b3 + hstep, voffB);
            PG8_WAIT_V(6); PG8_BAR; PG8_MMA(1, 1, At, B1); PG8_BAR;
        }
        PG8_STAMP();
        if constexpr (!Epi::AFTER_DRAIN) { E(acc, cur, wr, wc, fr, fq); S.done(cur); }
        PG8_STAMP();
        if (!has_next) break;
#pragma unroll
        for (int a = 0; a < 2; ++a)
#pragma unroll
            for (int b = 0; b < 2; ++b)
#pragma unroll
                for (int m = 0; m < 4; ++m)
#pragma unroll
                    for (int n = 0; n < 2; ++n) acc[a][b][m][n] = (f32x4){0.f, 0.f, 0.f, 0.f};
        cur = nxt; cA = nA; cB = nB; ++ui;
    }
    PG8_WAIT_V(0);
    if (wr == 0) PG8_BAR;
    PG8_BAR;
    if constexpr (Epi::AFTER_DRAIN) { E.fused(acc, cur, wr, wc, fr, fq, lds, wid, lane); S.done(cur); }
    PG8_STAMP();
    if (STAMP && wid == 0) { stamps[lane] = lane < nts ? (((unsigned long long)(unsigned)ts_hi << 32) | (unsigned)ts_lo) : 0ull;
        if (lane == 62) stamps[62] = rt_entry; if (lane == 63) stamps[63] = (unsigned long long)wall_clock64(); }
#undef PG8_STAMP
#undef PG8_SA
#undef PG8_SB
#undef PG8_STAGE
#undef PG8_LDA
#undef PG8_LDB
#undef PG8_MMA
#undef PG8_WAIT_V
#undef PG8_WAIT_L
#undef PG8_BAR
#undef PG8_SCHED
}
}

using pg8::bf16_t; using pg8::bf16x8; using pg8::f32x4; using pg8::u32x4; using pg8::Unit;
typedef unsigned u32x2 __attribute__((ext_vector_type(2)));
typedef short bf16x4 __attribute__((ext_vector_type(4)));
#define LAS __attribute__((address_space(3)))
typedef LAS unsigned char* ldsp;
#define XB_TMO      128
#define XB_XCNT(j)  (256  + 64 * (j))
#define XB_XSUB(j)  (1280 + 64 * (j))
#define XB_XGEN(j)  (2304 + 64 * (j))
#define XB_TOP      3328
#define XB_TOPGEN   3392
#define XCD_BAR_WORDS 3456
#define XB_SPIN_CAP (1u << 18)

__device__ __forceinline__ unsigned xb_ld(unsigned* p)              { return __hip_atomic_load(p, __ATOMIC_RELAXED, __HIP_MEMORY_SCOPE_AGENT); }
__device__ __forceinline__ unsigned xb_add(unsigned* p, unsigned v) { return __hip_atomic_fetch_add(p, v, __ATOMIC_RELAXED, __HIP_MEMORY_SCOPE_AGENT); }
__device__ __forceinline__ unsigned xb_xcc_id() { return (unsigned)__builtin_amdgcn_s_getreg((3 << 11) | 20) & 0xFu; }
#define XB_SPIN(cond, bar) do { unsigned _sp = 0; while (cond) { __builtin_amdgcn_s_sleep(1); \
    if ((++_sp & 255u) == 0u) { if (xb_ld(&(bar)[XB_TMO])) break; if (_sp > XB_SPIN_CAP) { atomicAdd(&(bar)[XB_TMO], 1u); break; } } } } while (0)

struct XcdBarrier {
    unsigned* bar; unsigned x;
    volatile LAS unsigned* st;
};

__device__ __forceinline__ XcdBarrier xcd_barrier_post(unsigned* bar, volatile LAS unsigned* st, const int tid0) {
    XcdBarrier b; b.bar = bar; b.x = xb_xcc_id(); b.st = st;
    if (tid0 == 0) (void)xb_add(&bar[XB_XCNT(b.x)], 1u);
    return b;
}
__device__ __forceinline__ void xcd_barrier_complete(unsigned* bar, unsigned x, unsigned& nloc, unsigned& nx) {
    const unsigned G = gridDim.x * gridDim.y * gridDim.z;
    unsigned sum, cnt, mine, sp = 0u;
    for (;;) {
        sum = 0u; cnt = 0u; mine = 0u;
#pragma unroll
        for (unsigned j = 0; j < 16; ++j) { const unsigned c = xb_ld(&bar[XB_XCNT(j)]); sum += c; cnt += (c > 0u) ? 1u : 0u; mine = (j == x) ? c : mine; }
        if (sum == G) break;
        __builtin_amdgcn_s_sleep(1);
        if ((++sp & 255u) == 0u) { if (xb_ld(&bar[XB_TMO])) break; if (sp > XB_SPIN_CAP) { atomicAdd(&bar[XB_TMO], 1u); break; } }
    }
    nloc = mine > 0u ? mine : 1u; nx = cnt > 0u ? cnt : 1u;
}

__device__ __forceinline__ void xcd_barrier(const XcdBarrier& b, const int tid0) {
    asm volatile("s_waitcnt vmcnt(0)" ::: "memory");
    __syncthreads();
    if (tid0 == 0) {
        unsigned* bar = b.bar;
        __builtin_amdgcn_s_waitcnt(0);
        unsigned nloc = b.st[0], nx = b.st[1];
        if (nloc == 0u) { xcd_barrier_complete(bar, b.x, nloc, nx); b.st[0] = nloc; b.st[1] = nx; }
        const unsigned old = xb_add(&bar[XB_XSUB(b.x)], 1u);
        const unsigned gen = old / nloc;
        if (old + 1u == (gen + 1u) * nloc) {
            __builtin_amdgcn_fence(__ATOMIC_RELEASE, "agent");
            asm volatile("s_waitcnt vmcnt(0)" ::: "memory");
            const unsigned og = xb_add(&bar[XB_TOP], 1u);
            const unsigned tg = og / nx;
            if (og + 1u == (tg + 1u) * nx) xb_add(&bar[XB_TOPGEN], 1u);
            else XB_SPIN(xb_ld(&bar[XB_TOPGEN]) == tg, bar);
            __builtin_amdgcn_fence(__ATOMIC_ACQUIRE, "agent");
            xb_add(&bar[XB_XGEN(b.x)], 1u);
            asm volatile("s_waitcnt vmcnt(0)" ::: "memory");
        } else {
            XB_SPIN(xb_ld(&bar[XB_XGEN(b.x)]) == gen, bar);
            __builtin_amdgcn_fence(__ATOMIC_ACQUIRE, "agent");
            asm volatile("s_waitcnt vmcnt(0)" ::: "memory");
        }
    }
    __syncthreads();
}


constexpr int T = 16384, D = 1024, SEQ = 4096, NBATCH = 4, FF = 2816;
constexpr int NTHREADS = 512, LDS_BYTES = 131072 + 16;
constexpr float EPS = 1e-6f;
constexpr size_t MiB = 1024 * 1024;
constexpr size_t OFF_MOD = 0, OFF_LB = 512 * 1024, OFF_CWB = 576 * 1024, OFF_BAR = 768 * 1024, OFF_CSC = 1 * MiB, OFF_CSS = 3 * MiB, OFF_WT = 8 * MiB, OFF_HB = 40 * MiB, OFF_R1 = 72 * MiB, OFF_R2 = 248 * MiB, OFF_XB = 336 * MiB, WS_END = 368 * MiB;
constexpr size_t WT_MIXA = 0, WT_MIXB = 4194304, WT_FUP = 6291456, WT_FDN = 12058624, WT_MQKV = 524288;
enum { OP_PRO = 0, OP_NORM1, OP_G1, OP_GSP, OP_GOUT, OP_M1, OP_M2, OP_M3, OP_ATT, OP_MOUT, OP_H1, OP_HA, OP_HSCAN, OP_HC, OP_HOUT, OP_NORM2, OP_FUP, OP_FCONV, OP_FDN, OP_FINAL };

struct Params;
struct Params {
    const float* in[28];
    float* out;
    unsigned char* ws;
    int ph_lo, ph_hi;
    unsigned char op[48];
    unsigned char lay[48];
};

typedef const __attribute__((address_space(4))) Params* KP;
__device__ __forceinline__ unsigned pk2(float lo, float hi) { return pg8::cvt_pk_bf16(lo, hi); }
__device__ __forceinline__ float bflo(unsigned u) { return __uint_as_float(u << 16); }
__device__ __forceinline__ float bfhi(unsigned u) { return __uint_as_float(u & 0xffff0000u); }
__device__ __forceinline__ float shx(float v, int m, int lane) { return __int_as_float(__builtin_amdgcn_ds_bpermute((lane ^ m) << 2, __float_as_int(v))); }
__device__ __forceinline__ float wave_sum(float v, int lane) {
#pragma unroll
    for (int o = 32; o >= 1; o >>= 1) v += shx(v, o, lane);
    return v;
}
__device__ __forceinline__ float fast_sigmoid(float x) { return __builtin_amdgcn_rcpf(1.f + __builtin_amdgcn_exp2f(-1.4426950408889634f * x)); }
__device__ __forceinline__ float gelu_tanh(float x) { const float u = 0.7978845608028654f * (x + 0.044715f * x * x * x); return x * fast_sigmoid(2.f * u); }
__device__ __forceinline__ f32x4 sigmoid4(const f32x4 x) { const f32x4 ex = x * -1.4426950408889634f; f32x4 s;
#pragma unroll
    for (int e = 0; e < 4; ++e) s[e] = __builtin_amdgcn_rcpf(1.f + __builtin_amdgcn_exp2f(ex[e]));
    return s; }
__device__ __forceinline__ f32x4 gelu_tanh4(const f32x4 x) { const f32x4 t = x * x * 0.044715f + 1.f; const f32x4 ex = x * t * (-2.f * 0.7978845608028654f * 1.4426950408889634f); f32x4 s;
#pragma unroll
    for (int e = 0; e < 4; ++e) s[e] = __builtin_amdgcn_rcpf(1.f + __builtin_amdgcn_exp2f(ex[e]));
    return x * s; }
__device__ __forceinline__ bf16x8 mk8(unsigned a, unsigned b, unsigned c, unsigned d) { u32x4 v = {a, b, c, d}; return __builtin_bit_cast(bf16x8, v); }
__device__ __forceinline__ f32x4 zero4() { float z = 0.f; asm volatile("" : "+v"(z)); return (f32x4){z, z, z, z}; }
#define MFMA16(X, Y, C) __builtin_amdgcn_mfma_f32_16x16x32_bf16((X), (Y), (C), 0, 0, 0)

template <int ACT> struct EpiBf16 {
    static constexpr bool PERM = true, AFTER_DRAIN = false, PERMA = false;
    bf16_t* O; int ldc;
    __device__ __forceinline__ void operator()(const f32x4 (&acc)[2][2][4][2], const Unit& u, int wr, int wc, int fr, int fq) const {
        const int row0 = u.pm * 256 + wr * 64 + fr, col0 = u.pn * 256 + wc * 32 + 8 * fq;
#pragma unroll
        for (int ai = 0; ai < 2; ++ai)
#pragma unroll
            for (int m = 0; m < 4; ++m) { bf16_t* rowp = O + (size_t)(row0 + ai * 128 + m * 16) * ldc + col0;
#pragma unroll
                for (int bj = 0; bj < 2; ++bj) { f32x4 v0 = acc[ai][bj][m][0], v1 = acc[ai][bj][m][1];
                    if (ACT == 1) { v0 = gelu_tanh4(v0); v1 = gelu_tanh4(v1); }
                    u32x4 o = {pk2(v0[0], v0[1]), pk2(v0[2], v0[3]), pk2(v1[0], v1[1]), pk2(v1[2], v1[3])};
                    *(u32x4*)(rowp + bj * 128) = o; } }
    }
};
struct EpiF32 {
    static constexpr bool PERM = false, AFTER_DRAIN = false, PERMA = false;
    float* C; int ldc;
    __device__ __forceinline__ void operator()(const f32x4 (&acc)[2][2][4][2], const Unit& u, int wr, int wc, int fr, int fq) const {
        const int row0 = u.pm * 256 + wr * 64 + fr, col0 = u.pn * 256 + wc * 32 + 4 * fq;
#pragma unroll
        for (int ai = 0; ai < 2; ++ai)
#pragma unroll
            for (int m = 0; m < 4; ++m) { float* rowp = C + (size_t)(row0 + ai * 128 + m * 16) * ldc + col0;
#pragma unroll
                for (int bj = 0; bj < 2; ++bj)
#pragma unroll
                    for (int n = 0; n < 2; ++n) *(f32x4*)(rowp + bj * 128 + n * 16) = acc[ai][bj][m][n]; }
    }
};
struct EpiRes {
    static constexpr bool PERM = true, AFTER_DRAIN = false, PERMA = false;
    const bf16_t* Xs; bf16_t* Xd; const float* gate;
    __device__ __forceinline__ void operator()(const f32x4 (&acc)[2][2][4][2], const Unit& u, int wr, int wc, int fr, int fq) const {
        const int row0 = u.pm * 256 + wr * 64 + fr, col0 = u.pn * 256 + wc * 32 + 8 * fq;
        const float* gp = gate + (unsigned)((u.pm >> 4) * 6144 + col0);
        f32x4 gv[2][2];
#pragma unroll
        for (int bj = 0; bj < 2; ++bj)
#pragma unroll
            for (int n = 0; n < 2; ++n) { gv[bj][n] = *(const f32x4*)(gp + bj * 128 + n * 4); gv[bj][n] = gv[bj][n] + 1.f; }
#pragma unroll
        for (int ai = 0; ai < 2; ++ai)
#pragma unroll
            for (int m = 0; m < 4; ++m) { const unsigned ro = (unsigned)((row0 + ai * 128 + m * 16) * 1024 + col0);
#pragma unroll
                for (int bj = 0; bj < 2; ++bj) { const u32x4 xs = *(const u32x4*)(Xs + ro + bj * 128);
                    const f32x4 a0 = acc[ai][bj][m][0] * gv[bj][0], a1 = acc[ai][bj][m][1] * gv[bj][1];
                    u32x4 o = {pk2(bflo(xs[0]) + a0[0], bfhi(xs[0]) + a0[1]), pk2(bflo(xs[1]) + a0[2], bfhi(xs[1]) + a0[3]), pk2(bflo(xs[2]) + a1[0], bfhi(xs[2]) + a1[1]), pk2(bflo(xs[3]) + a1[2], bfhi(xs[3]) + a1[3])};
                    *(u32x4*)(Xd + ro + bj * 128) = o; } }
    }
};
struct EpiQ {
    static constexpr bool PERM = false, AFTER_DRAIN = false, PERMA = false;
    bf16_t* QF; const float* CSC; const float* CSS; float qs;
    __device__ __forceinline__ void operator()(const f32x4 (&acc)[2][2][4][2], const Unit& u, int wr, int wc, int fr, int fq) const {
        const int b = u.pm >> 4;
#pragma unroll
        for (int bj = 0; bj < 2; ++bj) {
            const int c0 = u.pn * 256 + bj * 128 + wc * 32;
            const int head = c0 / 192, off = c0 - head * 192;
            if (off < 128) {
#pragma unroll
                for (int ai = 0; ai < 2; ++ai)
#pragma unroll
                    for (int m = 0; m < 4; ++m) { const int r = u.pm * 256 + ai * 128 + wr * 64 + m * 16 + fr, s = r & 4095;
                        bf16_t* qp = QF + (unsigned)(((b * 8 + head) * 4096 + s) * 192 + off + 4 * fq);
#pragma unroll
                        for (int n = 0; n < 2; ++n) { const f32x4 v = acc[ai][bj][m][n] * qs; u32x2 o = {pk2(v[0], v[1]), pk2(v[2], v[3])}; *(u32x2*)(qp + 16 * n) = o; } __builtin_amdgcn_sched_barrier(0); }
            } else {
                const int jb = ((off - 128) >> 5) * 16 + 4 * fq;
#pragma unroll
                for (int ai = 0; ai < 2; ++ai)
#pragma unroll
                    for (int m = 0; m < 4; ++m) { const int r = u.pm * 256 + ai * 128 + wr * 64 + m * 16 + fr, s = r & 4095;
                        const f32x4 cs = *(const f32x4*)(CSC + (unsigned)(r * 32 + jb)), sn = *(const f32x4*)(CSS + (unsigned)(r * 32 + jb));
                        const f32x4 x1 = acc[ai][bj][m][0], x2 = acc[ai][bj][m][1];
                        const f32x4 r1 = (x1 * cs - x2 * sn) * qs, r2 = (x2 * cs + x1 * sn) * qs;
                        bf16_t* qp = QF + (unsigned)(((b * 8 + head) * 4096 + s) * 192 + 128 + jb);
                        u32x2 o1 = {pk2(r1[0], r1[1]), pk2(r1[2], r1[3])}, o2 = {pk2(r2[0], r2[1]), pk2(r2[2], r2[3])};
                        *(u32x2*)(qp) = o1; *(u32x2*)(qp + 32) = o2; __builtin_amdgcn_sched_barrier(0); }
            }
        }
    }
};
struct EpiKV {
    static constexpr bool PERM = false, AFTER_DRAIN = false, PERMA = false;
    bf16_t* KF; bf16_t* VT;
    __device__ __forceinline__ void operator()(const f32x4 (&acc)[2][2][4][2], const Unit& u, int wr, int wc, int fr, int fq) const {
        const int b = u.pm >> 4, head = u.pn;
#pragma unroll
        for (int bj = 0; bj < 2; ++bj) {
            const int off = wc * 32;
            if (bj == 0) {
#pragma unroll
                for (int ai = 0; ai < 2; ++ai)
#pragma unroll
                    for (int m = 0; m < 4; ++m) { const int r = u.pm * 256 + ai * 128 + wr * 64 + m * 16 + fr, s = r & 4095;
                        bf16_t* kp = KF + (unsigned)(((b * 8 + head) * 4096 + s) * 192 + off + 4 * fq);
#pragma unroll
                        for (int n = 0; n < 2; ++n) { const f32x4 v = acc[ai][bj][m][n]; u32x2 o = {pk2(v[0], v[1]), pk2(v[2], v[3])}; *(u32x2*)(kp + 16 * n) = o; } __builtin_amdgcn_sched_barrier(0); }
            } else {
#pragma unroll
                for (int ai = 0; ai < 2; ++ai)
#pragma unroll
                    for (int m = 0; m < 4; ++m) { const int r = u.pm * 256 + ai * 128 + wr * 64 + m * 16 + fr, s = r & 4095;
#pragma unroll
                        for (int n = 0; n < 2; ++n) { const f32x4 v = acc[ai][bj][m][n]; const int dv = off + 16 * n + 4 * fq;
                            bf16_t* vp = VT + (unsigned)(((b * 8 + head) * 128 + dv) * 4096 + s);
                            const unsigned p01 = pk2(v[0], v[1]), p23 = pk2(v[2], v[3]);
                            vp[0] = (bf16_t)(p01 & 0xffffu); vp[4096] = (bf16_t)(p01 >> 16); vp[8192] = (bf16_t)(p23 & 0xffffu); vp[12288] = (bf16_t)(p23 >> 16); } __builtin_amdgcn_sched_barrier(0); }
            }
        }
    }
};
struct EpiHg {
    static constexpr bool PERM = true, AFTER_DRAIN = false, PERMA = false;
    unsigned char* R1b; const float* LB;
    __device__ __forceinline__ void operator()(const f32x4 (&acc)[2][2][4][2], const Unit& u, int wr, int wc, int fr, int fq) const {
        const int region = u.pn >> 2, row0 = u.pm * 256 + wr * 64 + fr, cc0 = (u.pn & 3) * 256 + wc * 32 + 8 * fq;
        if (region == 1) {
#pragma unroll
            for (int bj = 0; bj < 2; ++bj) { const int cc = cc0 + bj * 128;
                const f32x4 l0 = *(const f32x4*)(LB + cc), l1 = *(const f32x4*)(LB + cc + 4);
#pragma unroll
                for (int ai = 0; ai < 2; ++ai)
#pragma unroll
                    for (int m = 0; m < 4; ++m) { float* fp = (float*)(R1b + 32 * MiB) + (unsigned)((row0 + ai * 128 + m * 16) * 1024 + cc);
                        f32x4 v0 = acc[ai][bj][m][0], v1 = acc[ai][bj][m][1];
                        v0 = l0 + (1.f - l0) * sigmoid4(v0); v1 = l1 + (1.f - l1) * sigmoid4(v1);
                        *(f32x4*)fp = v0; *(f32x4*)(fp + 4) = v1; __builtin_amdgcn_sched_barrier(0); } }
        } else {
            bf16_t* base = (bf16_t*)(R1b + (region == 0 ? (size_t)0 : (region == 2 ? 96 * MiB : 128 * MiB)));
#pragma unroll
            for (int ai = 0; ai < 2; ++ai)
#pragma unroll
                for (int m = 0; m < 4; ++m) { bf16_t* rowp = base + (unsigned)((row0 + ai * 128 + m * 16) * 1024 + cc0);
#pragma unroll
                    for (int bj = 0; bj < 2; ++bj) { f32x4 v0 = acc[ai][bj][m][0], v1 = acc[ai][bj][m][1];
                        if (region == 3) { v0 = v0 * sigmoid4(v0); v1 = v1 * sigmoid4(v1); }
                        u32x4 o = {pk2(v0[0], v0[1]), pk2(v0[2], v0[3]), pk2(v1[0], v1[1]), pk2(v1[2], v1[3])};
                        *(u32x4*)(rowp + bj * 128) = o; } }
        }
    }
};

struct EpiFFN {
    static constexpr bool PERM = true, AFTER_DRAIN = false, PERMA = true;
    bf16_t* ACT; const bf16_t* CWB;
    __device__ __forceinline__ static f32x4 shr1(const f32x4 v) { f32x4 r;
#pragma unroll
        for (int e = 0; e < 4; ++e) r[e] = __int_as_float(__builtin_amdgcn_update_dpp(0, __float_as_int(v[e]), 0x111, 0xf, 0xf, true));
        return r; }
    template <bool SPECIAL> __device__ __forceinline__ void group(const f32x4 (&acc)[2][2][4][2], int ai, int n, int tok0, int fr, int fcol,
            const f32x4 wg0, const f32x4 wg1, const f32x4 wg2, const f32x4 bg, const f32x4 wv0, const f32x4 wv1, const f32x4 wv2, const f32x4 bv) const {
        const f32x4 sg3 = shr1(acc[ai][0][3][n]), sg2 = shr1(acc[ai][0][2][n]), sv3 = shr1(acc[ai][1][3][n]), sv2 = shr1(acc[ai][1][2][n]);
#pragma unroll
        for (int m = 0; m < 4; ++m) {
            const f32x4 cg = acc[ai][0][m][n], cv = acc[ai][1][m][n];
            f32x4 p1g = m == 0 ? sg3 : acc[ai][0][m == 0 ? 0 : m - 1][n], p1v = m == 0 ? sv3 : acc[ai][1][m == 0 ? 0 : m - 1][n];
            f32x4 p2g = m == 0 ? sg2 : (m == 1 ? sg3 : acc[ai][0][m < 2 ? 0 : m - 2][n]), p2v = m == 0 ? sv2 : (m == 1 ? sv3 : acc[ai][1][m < 2 ? 0 : m - 2][n]);
            const int tok = tok0 + 4 * fr + m;
            if (SPECIAL) { const int sq = tok & 4095; const f32x4 z4 = {0.f, 0.f, 0.f, 0.f}; if (sq == 0) { p1g = z4; p1v = z4; } if (sq <= 1) { p2g = z4; p2v = z4; } }
            const f32x4 yg = bg + wg0 * p2g + wg1 * p1g + wg2 * cg, yv = bv + wv0 * p2v + wv1 * p1v + wv2 * cv;
            const f32x4 ex = yg * -1.4426950408889634f; f32x4 sg;
#pragma unroll
            for (int e = 0; e < 4; ++e) sg[e] = __builtin_amdgcn_rcpf(1.f + __builtin_amdgcn_exp2f(ex[e]));
            const f32x4 o = yg * sg * yv;
            if ((m >= 2 || fr > 0) && tok < T) { u32x2 ov = {pk2(o[0], o[1]), pk2(o[2], o[3])}; *(u32x2*)(ACT + (unsigned)(tok * 2816 + fcol)) = ov; }
        }
    }
    __device__ __forceinline__ void operator()(const f32x4 (&acc)[2][2][4][2], const Unit& u, int wr, int wc, int fr, int fq) const {
        const int fcol0 = u.pn * 128 + wc * 32 + 8 * fq;
        u32x4 tw[8];
#pragma unroll
        for (int i = 0; i < 8; ++i) tw[i] = *(const u32x4*)(CWB + (unsigned)((fcol0 + i) * 8));
#pragma unroll
        for (int n = 0; n < 2; ++n) {
            const int fcol = fcol0 + 4 * n;
            f32x4 wg0, wg1, wg2, bg, wv0, wv1, wv2, bv;
#pragma unroll
            for (int e = 0; e < 4; ++e) { const u32x4 t = tw[4 * n + e]; wg0[e] = bflo(t[0]); wg1[e] = bfhi(t[0]); wg2[e] = bflo(t[1]); bg[e] = bfhi(t[1]); wv0[e] = bflo(t[2]); wv1[e] = bfhi(t[2]); wv2[e] = bflo(t[3]); bv[e] = bfhi(t[3]); }
#pragma unroll
            for (int ai = 0; ai < 2; ++ai) {
                const int b0 = u.pm * 248 + (2 * ai + wr) * 62;
                const bool special = (((b0 + 61) >> 12) << 12) >= b0 - 1;
                if (special) group<true>(acc, ai, n, b0 - 2, fr, fcol, wg0, wg1, wg2, bg, wv0, wv1, wv2, bv);
                else group<false>(acc, ai, n, b0 - 2, fr, fcol, wg0, wg1, wg2, bg, wv0, wv1, wv2, bv);
                __builtin_amdgcn_sched_barrier(0);
            }
        }
    }
};

template <class Epi> __device__ __forceinline__ void run_gemm(const int s_wv, ldsp lds, const bf16_t* A, const bf16_t* Bt, int M, int N, int K, const Epi& E) {
    pg8::Gemm g{A, Bt, M, N, K}; pg8::StaticOrder S; S.init(M, N, (int)gridDim.x, obid());
    pg8::gemm_phase<Epi, pg8::StaticOrder, false>(s_wv, lds, g, S, E, nullptr);
}

__device__ __forceinline__ int rope_rowmap(int n) { const int head = n / 192, d = n - head * 192; if (d < 128) return n; const int r = d - 128, half = r >> 5, j = r & 31; return head * 192 + 128 + (j >> 4) * 32 + half * 16 + (j & 15); }
__device__ __forceinline__ int ffn_rowmap(int n) { const int half = n >= 2816 ? 1 : 0, f = n - half * 2816, t = f >> 7, i = f & 127; return t * 256 + half * 128 + i; }
struct TrJob { const float* src; int srcN, K, N; bf16_t* dst; int dstK, koff, rowoff, pmode; };
__device__ __forceinline__ void run_trjob(const int s_wv, const TrJob J, ldsp lds) {
    const int tid = otid(), lane = tid & 63, wave = tid >> 6;
    LAS float* sm = (LAS float*)(lds + wave * 8448);
    const int nkt = J.K / 32, nnt = J.N / 64, ntile = nkt * nnt;
    for (int t = obid() * 8 + wave; t < ntile; t += gridDim.x * 8) { const int kt = t % nkt, nt = t / nkt;
        const float* sp = J.src + (size_t)(kt * 32) * J.srcN + nt * 64 + lane;
        float v[32];
#pragma unroll
        for (int k = 0; k < 32; ++k) v[k] = sp[(size_t)k * J.srcN];
#pragma unroll
        for (int k = 0; k < 32; ++k) sm[lane * 33 + k] = v[k];
        const int kk = (lane & 15) * 2, nr = lane >> 4;
#pragma unroll
        for (int j = 0; j < 16; ++j) { const int n = nr + 4 * j, sn = nt * 64 + n, drow = J.rowoff + (J.pmode == 1 ? rope_rowmap(sn) : (J.pmode == 2 ? ffn_rowmap(sn) : sn));
            *(unsigned*)(J.dst + (size_t)drow * J.dstK + J.koff + kt * 32 + kk) = pk2(sm[n * 33 + kk], sm[n * 33 + kk + 1]); }
    }
}
__device__ __forceinline__ void zero_fill(bf16_t* dst, int rows, int cols8, int stride, int gtid, int gthreads) {
    const int n = rows * cols8; unsigned zz = 0u; asm volatile("" : "+v"(zz)); const u32x4 z = {zz, zz, zz, zz};
    for (int i = gtid; i < n; i += gthreads) { const int r = i / cols8, c = i - r * cols8; *(u32x4*)(dst + (size_t)r * stride + c * 8) = z; }
}
__device__ __forceinline__ void prep_layer(const int s_wv, KP p, int layer, ldsp lds) {
    bf16_t* WT = (bf16_t*)(p->ws + OFF_WT); const int kind = layer % 3, j = layer / 3;
    const int gtid = obid() * NTHREADS + otid(), gthreads = gridDim.x * NTHREADS;
    { const TrJob J0{p->in[23] + (size_t)layer * 1024 * 5632, 5632, 1024, 5632, WT + WT_FUP, 1024, 0, 0, 2};
      const TrJob J1{p->in[26] + (size_t)layer * 2816 * 1024, 1024, 2816, 1024, WT + WT_FDN, 2816, 0, 0, 0};
      run_trjob(s_wv, J0, lds); run_trjob(s_wv, J1, lds); }
    if (kind == 0) {
        const TrJob J0{p->in[7] + (size_t)j * 1024 * 4096, 4096, 1024, 4096, WT + WT_MIXA, 1024, 0, 0, 0};
        const TrJob J1{p->in[12] + (size_t)j * 2048 * 1024, 1024, 2048, 1024, WT + WT_MIXB, 2048, 0, 0, 0};
        run_trjob(s_wv, J0, lds); run_trjob(s_wv, J1, lds);
    } else if (kind == 1) {
        const TrJob J0{p->in[13], 448, 1024, 448, WT + WT_MIXA, 1024, 0, 0, 0};
        const TrJob J1{p->in[16], 1536, 256, 1536, WT + WT_MQKV, 256, 0, 0, 1};
        const TrJob J2{p->in[17], 2048, 128, 2048, WT + WT_MQKV + 393216, 256, 0, 0, 0};
        const TrJob J3{p->in[18], 1024, 1024, 1024, WT + WT_MIXB, 1024, 0, 0, 0};
        run_trjob(s_wv, J0, lds); run_trjob(s_wv, J1, lds); run_trjob(s_wv, J2, lds); run_trjob(s_wv, J3, lds);
        zero_fill(WT + WT_MIXA + (size_t)448 * 1024, 64, 128, 1024, gtid, gthreads);
        zero_fill(WT + WT_MQKV + 393216 + 128, 2048, 16, 256, gtid, gthreads);
    } else {
        const TrJob J0{p->in[20], 4096, 1024, 4096, WT + WT_MIXA, 1024, 0, 0, 0};
        const TrJob J1{p->in[22], 1024, 1024, 1024, WT + WT_MIXB, 1024, 0, 0, 0};
        run_trjob(s_wv, J0, lds); run_trjob(s_wv, J1, lds);
    }
}
__device__ __forceinline__ void phase_prologue(const int s_wv, KP p, ldsp lds) {
    const int tid = otid();
    float* MOD = (float*)(p->ws + OFF_MOD);
    LAS float* cact = (LAS float*)lds;
    LAS float* red = (LAS float*)(lds + 16384);
    for (int i = tid; i < 4096; i += NTHREADS) { const float c = p->in[1][i]; cact[i] = c * fast_sigmoid(c); }
    __syncthreads();
    const int l16 = tid & 15, kg = tid >> 4;
    for (int item = obid(); item < 4 * 96; item += gridDim.x) {
        const int layer = item / 96, n0 = (item % 96) * 64;
        const float* w = p->in[3] + (size_t)layer * 1024 * 6144 + n0 + 4 * l16;
        f32x4 a[4] = {{0.f, 0.f, 0.f, 0.f}, {0.f, 0.f, 0.f, 0.f}, {0.f, 0.f, 0.f, 0.f}, {0.f, 0.f, 0.f, 0.f}};
#pragma unroll 8
        for (int kk = 0; kk < 32; ++kk) { const int k = kg * 32 + kk; const f32x4 wv = *(const f32x4*)(w + (size_t)k * 6144);
#pragma unroll
            for (int b = 0; b < 4; ++b) a[b] = a[b] + wv * cact[b * 1024 + k]; }
#pragma unroll
        for (int b = 0; b < 4; ++b) *(LAS f32x4*)(red + (kg * 4 + b) * 64 + 4 * l16) = a[b];
        __syncthreads();
        if (tid < 256) { const int b = tid >> 6, col = tid & 63; float s = 0.f;
#pragma unroll 8
            for (int g = 0; g < 32; ++g) s += red[(g * 4 + b) * 64 + col];
            MOD[(size_t)(layer * 4 + b) * 6144 + n0 + col] = s + p->in[4][(size_t)layer * 6144 + n0 + col]; }
        __syncthreads();
    }
    const int gtid = obid() * NTHREADS + tid, gthreads = gridDim.x * NTHREADS;
    float* CSC = (float*)(p->ws + OFF_CSC); float* CSS = (float*)(p->ws + OFF_CSS);
    const int* pos = (const int*)p->in[2];
    for (int i = gtid; i < T * 32; i += gthreads) { const int t = i >> 5, jj = i & 31;
        const float invf = exp2f(-(float)jj * (13.287712379549449f / 32.f));
        const float ang = (float)pos[t] * invf;
        double rev = (double)ang * 0.15915494309189535; rev -= floor(rev);
        const float rf = (float)rev;
        CSC[i] = __builtin_amdgcn_cosf(rf); CSS[i] = __builtin_amdgcn_sinf(rf); }
    float* LB = (float*)(p->ws + OFF_LB);
    for (int i = gtid; i < 1024; i += gthreads) { const float l0 = p->in[19][i], l1 = p->in[19][1024 + i], l2 = p->in[19][2048 + i], l3 = p->in[19][3072 + i];
        const float mx = fmaxf(fmaxf(l0, l1), fmaxf(l2, l3)); const float e0 = __expf(l0 - mx), e1 = __expf(l1 - mx), e2 = __expf(l2 - mx), e3 = __expf(l3 - mx);
        LB[i] = (e1 + e2) / (e0 + e1 + e2 + e3); }
    prep_layer(s_wv, p, 0, lds);
}
__device__ __forceinline__ void up8(const u32x4 v, float (&o)[8]) { o[0] = bflo(v[0]); o[1] = bfhi(v[0]); o[2] = bflo(v[1]); o[3] = bfhi(v[1]); o[4] = bflo(v[2]); o[5] = bfhi(v[2]); o[6] = bflo(v[3]); o[7] = bfhi(v[3]); }
template <bool SRC32> __device__ __forceinline__ void phase_norm(const int s_wv, const float* X32, bf16_t* XB, const float* g, const float* shift, const float* scale, bf16_t* dst) {
    const int lane = otid() & 63, wave = otid() >> 6;
    for (int rb = obid() * 8 + wave; rb < T / 8; rb += gridDim.x * 8) {
        const int r0 = rb * 8, b = r0 >> 12;
        float G[16], SH[16];
#pragma unroll
        for (int j = 0; j < 2; ++j)
#pragma unroll
            for (int h = 0; h < 2; ++h) { const int c = 8 * lane + 512 * j + 4 * h; const f32x4 gg = *(const f32x4*)(g + c), sc = *(const f32x4*)(scale + (size_t)b * 6144 + c), sh = *(const f32x4*)(shift + (size_t)b * 6144 + c);
#pragma unroll
                for (int e = 0; e < 4; ++e) { G[j * 8 + h * 4 + e] = gg[e] * (sc[e] + 1.f); SH[j * 8 + h * 4 + e] = sh[e]; } }
        for (int r = r0; r < r0 + 8; ++r) {
            float x[16]; float ss = 0.f;
#pragma unroll
            for (int j = 0; j < 2; ++j) { const unsigned off = (unsigned)(r * 1024 + 8 * lane + 512 * j);
                if (SRC32) { const f32x4 a = *(const f32x4*)(X32 + off), c = *(const f32x4*)(X32 + off + 4);
#pragma unroll
                    for (int e = 0; e < 4; ++e) { x[j * 8 + e] = a[e]; x[j * 8 + 4 + e] = c[e]; }
                    u32x4 xo = {pk2(a[0], a[1]), pk2(a[2], a[3]), pk2(c[0], c[1]), pk2(c[2], c[3])}; *(u32x4*)(XB + off) = xo;
                } else { float t[8]; up8(*(const u32x4*)(XB + off), t);
#pragma unroll
                    for (int e = 0; e < 8; ++e) x[j * 8 + e] = t[e]; } }
#pragma unroll
            for (int e = 0; e < 16; ++e) ss += x[e] * x[e];
            ss = wave_sum(ss, lane); const float rstd = rsqrtf(ss * (1.f / 1024.f) + EPS);
#pragma unroll
            for (int j = 0; j < 2; ++j) { float h[8];
#pragma unroll
                for (int e = 0; e < 8; ++e) h[e] = x[j * 8 + e] * rstd * G[j * 8 + e] + SH[j * 8 + e];
                u32x4 o = {pk2(h[0], h[1]), pk2(h[2], h[3]), pk2(h[4], h[5]), pk2(h[6], h[7])}; *(u32x4*)(dst + (unsigned)(r * 1024 + 8 * lane + 512 * j)) = o; }
        }
    }
}
__device__ __forceinline__ void phase_final(const int s_wv, const bf16_t* XB, float* out, const float* g) {
    const int lane = otid() & 63, wave = otid() >> 6;
    for (int r = obid() * 8 + wave; r < T; r += gridDim.x * 8) {
        float x[16]; float ss = 0.f;
#pragma unroll
        for (int j = 0; j < 2; ++j) { float t[8]; up8(*(const u32x4*)(XB + (unsigned)(r * 1024 + 8 * lane + 512 * j)), t);
#pragma unroll
            for (int e = 0; e < 8; ++e) { x[j * 8 + e] = t[e]; ss += t[e] * t[e]; } }
        ss = wave_sum(ss, lane); const float rstd = rsqrtf(ss * (1.f / 1024.f) + EPS);
#pragma unroll
        for (int j = 0; j < 2; ++j)
#pragma unroll
            for (int h = 0; h < 2; ++h) { const int c = 8 * lane + 512 * j + 4 * h; const f32x4 gg = *(const f32x4*)(g + c);
                f32x4 o = {x[j * 8 + h * 4] * rstd * gg[0], x[j * 8 + h * 4 + 1] * rstd * gg[1], x[j * 8 + h * 4 + 2] * rstd * gg[2], x[j * 8 + h * 4 + 3] * rstd * gg[3]};
                *(f32x4*)(out + (size_t)r * 1024 + c) = o; }
    }
}
__device__ __forceinline__ void phase_ffix(const int s_wv, const bf16_t* SIDE, bf16_t* ACT, const float* cw, const float* cb) {
    const int gtid = obid() * NTHREADS + otid(), gthreads = gridDim.x * NTHREADS;
    for (int q = gtid; q < 256 * 2 * 352; q += gthreads) {
        const int cgp = q % 352, gi = q / 352, i = gi & 1, g = gi >> 1, f0 = cgp * 8;
        const bool first = (g & 63) == 0;
        const bf16_t* own = SIDE + (size_t)((g * 4 + 2 + i) * 2) * 2816 + f0;
        const bf16_t* p1 = i == 0 ? SIDE + (size_t)(((g - 1) * 4 + 1) * 2) * 2816 + f0 : SIDE + (size_t)((g * 4 + 2) * 2) * 2816 + f0;
        const bf16_t* p2 = i == 0 ? SIDE + (size_t)(((g - 1) * 4 + 0) * 2) * 2816 + f0 : SIDE + (size_t)(((g - 1) * 4 + 1) * 2) * 2816 + f0;
        float gc[8], vc[8], g1[8], v1[8], g2[8], v2[8];
        up8(*(const u32x4*)own, gc); up8(*(const u32x4*)(own + 2816), vc);
        if (i == 1 || !first) { up8(*(const u32x4*)p1, g1); up8(*(const u32x4*)(p1 + 2816), v1); } else {
#pragma unroll
            for (int e = 0; e < 8; ++e) { g1[e] = 0.f; v1[e] = 0.f; } }
        if (!first) { up8(*(const u32x4*)p2, g2); up8(*(const u32x4*)(p2 + 2816), v2); } else {
#pragma unroll
            for (int e = 0; e < 8; ++e) { g2[e] = 0.f; v2[e] = 0.f; } }
        float o[8];
#pragma unroll
        for (int e = 0; e < 8; ++e) { const int f = f0 + e;
            const float yg = cb[f] + cw[f] * g2[e] + cw[5632 + f] * g1[e] + cw[11264 + f] * gc[e], yv = cb[2816 + f] + cw[2816 + f] * v2[e] + cw[5632 + 2816 + f] * v1[e] + cw[11264 + 2816 + f] * vc[e];
            o[e] = yg * fast_sigmoid(yg) * yv; }
        u32x4 ov = {pk2(o[0], o[1]), pk2(o[2], o[3]), pk2(o[4], o[5]), pk2(o[6], o[7])};
        *(u32x4*)(ACT + (size_t)(g * 64 + i) * 2816 + f0) = ov;
    }
}

__device__ __forceinline__ void phase_gsp(const int s_wv, KP p, int j, ldsp lds) {
    const bf16_t* Z = (const bf16_t*)(p->ws + OFF_R1); bf16_t* Y = (bf16_t*)(p->ws + OFF_R2);
    const float* ws_w = p->in[10] + (size_t)j * 8 * 128 * 128; const float* bs = p->in[11] + (size_t)j * 8 * 128;
    const float* lng = p->in[8] + (size_t)j * 2048; const float* lnb = p->in[9] + (size_t)j * 2048;
    const int tid = otid(), lane = tid & 63, wave = tid >> 6, l15 = lane & 15, g4 = lane >> 4;
    ldsp As = lds, Bs = lds + 34816; LAS float* mu = (LAS float*)(lds + 104448); LAS float* rs = mu + 128;
    for (int unit = obid(); unit < 256; unit += gridDim.x) {
        const int gh = unit & 1, chunk = unit >> 1, t0 = chunk * 128;
        for (int rr = 0; rr < 16; ++rr) { const int r = wave * 16 + rr; const bf16_t* zp = Z + (size_t)(t0 + r) * 4096 + 2048 + lane * 32; float s = 0.f, s2 = 0.f;
#pragma unroll
            for (int i = 0; i < 4; ++i) { float v[8]; up8(*(const u32x4*)(zp + 8 * i), v);
#pragma unroll
                for (int e = 0; e < 8; ++e) { s += v[e]; s2 += v[e] * v[e]; } }
            s = wave_sum(s, lane); s2 = wave_sum(s2, lane);
            if (lane == 0) { const float m = s * (1.f / 2048.f); float var = s2 * (1.f / 2048.f) - m * m; var = fmaxf(var, 0.f); mu[r] = m; rs[r] = rsqrtf(var + EPS); } }
        __syncthreads();
        for (int gi = 0; gi < 4; ++gi) {
            const int g = gh * 4 + gi;
#pragma unroll 2
            for (int i = 0; i < 8; ++i) { const int idx = tid + 512 * i, t = idx >> 5, s4 = (idx & 31) * 4; f32x4 w = *(const f32x4*)(ws_w + (size_t)g * 16384 + t * 128 + s4);
#pragma unroll
                for (int e = 0; e < 4; ++e) w[e] = (s4 + e <= t) ? w[e] : 0.f;
                u32x2 o = {pk2(w[0], w[1]), pk2(w[2], w[3])}; *(LAS u32x2*)(As + t * 272 + s4 * 2) = o; }
#pragma unroll 2
            for (int i = 0; i < 8; ++i) { const int idx = tid + 512 * i, s = idx >> 5, c8 = idx & 31; float v[8]; up8(*(const u32x4*)(Z + (size_t)(t0 + s) * 4096 + 2048 + g * 256 + c8 * 8), v);
                const float m = mu[s], r = rs[s]; const f32x4 ga = *(const f32x4*)(lng + g * 256 + c8 * 8), gb = *(const f32x4*)(lng + g * 256 + c8 * 8 + 4), ba = *(const f32x4*)(lnb + g * 256 + c8 * 8), bb = *(const f32x4*)(lnb + g * 256 + c8 * 8 + 4);
                const int boff = (((s >> 3) ^ (c8 & 15)) << 4) + (s & 7) * 2;
#pragma unroll
                for (int e = 0; e < 8; ++e) { const float gg = e < 4 ? ga[e] : gb[e - 4], bbv = e < 4 ? ba[e] : bb[e - 4]; const float val = (v[e] - m) * r * gg + bbv;
                    *(LAS bf16_t*)(Bs + (c8 * 8 + e) * 272 + boff) = (bf16_t)(pk2(val, 0.f) & 0xffffu); } }
            __syncthreads();
            f32x4 acc[8][2];
#pragma unroll
            for (int tt = 0; tt < 8; ++tt) { acc[tt][0] = zero4(); acc[tt][1] = zero4(); }
#pragma unroll
            for (int tt = 0; tt < 8; ++tt)
#pragma unroll
                for (int ks = 0; ks <= tt / 2; ++ks) { const bf16x8 yf = *(const LAS bf16x8*)(As + (16 * tt + l15) * 272 + (32 * ks + 8 * g4) * 2);
#pragma unroll
                    for (int ct = 0; ct < 2; ++ct) { const int c = 32 * wave + 16 * ct + l15; const bf16x8 xf = *(const LAS bf16x8*)(Bs + c * 272 + (((4 * ks + g4) ^ ((c >> 3) & 15)) << 4));
                        acc[tt][ct] = MFMA16(xf, yf, acc[tt][ct]); } }
#pragma unroll
            for (int tt = 0; tt < 8; ++tt) { const int t = 16 * tt + l15; const float bias = bs[g * 128 + t];
#pragma unroll
                for (int ct = 0; ct < 2; ++ct) { const int c = g * 256 + 32 * wave + 16 * ct + 4 * g4; const u32x2 uu = *(const u32x2*)(Z + (size_t)(t0 + t) * 4096 + c);
                    const f32x4 a = acc[tt][ct]; u32x2 o = {pk2(bflo(uu[0]) * (a[0] + bias), bfhi(uu[0]) * (a[1] + bias)), pk2(bflo(uu[1]) * (a[2] + bias), bfhi(uu[1]) * (a[3] + bias))};
                    *(u32x2*)(Y + (size_t)(t0 + t) * 2048 + c) = o; } }
            __syncthreads();
        }
    }
}

__device__ __forceinline__ void phase_m2(const int s_wv, KP p) {
    const float* A1 = (const float*)(p->ws + OFF_R1); bf16_t* CQN = (bf16_t*)(p->ws + OFF_R1 + 32 * MiB); bf16_t* CKVN = (bf16_t*)(p->ws + OFF_R1 + 40 * MiB); bf16_t* KF = (bf16_t*)(p->ws + OFF_R1 + 96 * MiB);
    const float* CSC = (const float*)(p->ws + OFF_CSC); const float* CSS = (const float*)(p->ws + OFF_CSS);
    const int lane = otid() & 63, wave = otid() >> 6;
    const f32x4 qg = *(const f32x4*)(p->in[14] + 4 * lane); const f32x4 kg = *(const f32x4*)(p->in[15] + 4 * (lane & 31));
    for (int r = obid() * 8 + wave; r < T; r += gridDim.x * 8) {
        const float* a = A1 + (size_t)r * 512;
        const f32x4 cq = *(const f32x4*)(a + 4 * lane); float ss = wave_sum(cq[0] * cq[0] + cq[1] * cq[1] + cq[2] * cq[2] + cq[3] * cq[3], lane);
        const float rq = rsqrtf(ss * (1.f / 256.f) + EPS);
        { const f32x4 h = cq * rq * qg; u32x2 o = {pk2(h[0], h[1]), pk2(h[2], h[3])}; *(u32x2*)(CQN + (size_t)r * 256 + 4 * lane) = o; }
        const f32x4 ck = *(const f32x4*)(a + 256 + 4 * (lane & 31)); float s2 = lane < 32 ? (ck[0] * ck[0] + ck[1] * ck[1] + ck[2] * ck[2] + ck[3] * ck[3]) : 0.f; s2 = wave_sum(s2, lane);
        const float rk = rsqrtf(s2 * (1.f / 128.f) + EPS);
        { const f32x4 h = ck * rk * kg; u32x2 o = {pk2(h[0], h[1]), pk2(h[2], h[3])}; if (lane >= 32) { o[0] = 0u; o[1] = 0u; } *(u32x2*)(CKVN + (size_t)r * 256 + 4 * lane) = o; }
        if (lane < 32) {
            const float x1 = a[384 + lane], x2 = a[416 + lane], c = CSC[(size_t)r * 32 + lane], s = CSS[(size_t)r * 32 + lane];
            const unsigned pr = pk2(x1 * c - x2 * s, x2 * c + x1 * s); const int b = r >> 12, sq = r & 4095;
#pragma unroll
            for (int h8 = 0; h8 < 8; ++h8) { bf16_t* kp = KF + ((size_t)((b * 8 + h8) * 4096 + sq)) * 192 + 128 + lane; kp[0] = (bf16_t)(pr & 0xffffu); kp[32] = (bf16_t)(pr >> 16); } }
    }
}

__device__ __forceinline__ void phase_attn(const int s_wv, KP p, ldsp lds) {
    const bf16_t* QF = (const bf16_t*)(p->ws + OFF_R1 + 48 * MiB); const bf16_t* KF = (const bf16_t*)(p->ws + OFF_R1 + 96 * MiB); const bf16_t* VT = (const bf16_t*)(p->ws + OFF_R1 + 144 * MiB);
    bf16_t* O = (bf16_t*)(p->ws + OFF_R2);
    const int tid = otid(), lane = tid & 63, wave = __builtin_amdgcn_readfirstlane(tid >> 6), l15 = lane & 15, g4 = lane >> 4;
    const int G = gridDim.x, bx = obid(), vcu = (G % 8 == 0) ? (bx % 8) * (G / 8) + bx / 8 : bx;
    constexpr int KB = 25600, VB = 18432, BUF = KB + VB;
    for (int unit = vcu; unit < 256; unit += G) {
        const int bh = unit >> 3, pr = unit & 7, b = bh >> 3, h = bh & 7;
        const unsigned char* kbase = (const unsigned char*)(KF + (size_t)bh * 4096 * 192);
        const unsigned char* vbase = (const unsigned char*)(VT + (size_t)bh * 128 * 4096);
        for (int half = 0; half < 2; ++half) {
            const int qb = half == 0 ? 15 - pr : pr, ntile = 4 * qb + 4;
            const int qrow0 = qb * 256 + 32 * wave;
            bf16x8 Qf[2][6];
#pragma unroll
            for (int qt = 0; qt < 2; ++qt)
#pragma unroll
                for (int ks = 0; ks < 6; ++ks) Qf[qt][ks] = *(const bf16x8*)((const unsigned char*)(QF + (size_t)(bh * 4096 + qrow0) * 192) + (unsigned)(((16 * qt + l15) * 192 + 32 * ks + 8 * g4) * 2));
            f32x4 Oa[2][8]; float mrun[2] = {-1e30f, -1e30f}, lsum[2] = {0.f, 0.f};
#pragma unroll
            for (int qt = 0; qt < 2; ++qt)
#pragma unroll
                for (int d = 0; d < 8; ++d) Oa[qt][d] = zero4();
#define ATT_DMA(j, bufi) do { ldsp kb_ = lds + (bufi) * BUF; \
                for (int c = wave; c < 25; c += 8) { const int q_ = c * 64 + lane, row = q_ / 25, c16 = min(q_ - row * 25, 23); \
                    __builtin_amdgcn_global_load_lds((const unsigned*)(kbase + (size_t)(j) * 24576 + (unsigned)(row * 384 + c16 * 16)), (LAS unsigned*)(kb_ + c * 1024), 16, 0, 0); } \
                for (int c = wave; c < 18; c += 8) { const int q_ = c * 64 + lane, dv = q_ / 9, k8 = min(q_ - dv * 9, 7); \
                    __builtin_amdgcn_global_load_lds((const unsigned*)(vbase + (size_t)(j) * 128 + (unsigned)(dv * 8192 + k8 * 16)), (LAS unsigned*)(kb_ + KB + c * 1024), 16, 0, 0); } } while (0)
            ATT_DMA(0, 0); asm volatile("s_waitcnt vmcnt(0)" ::: "memory"); __syncthreads();
#pragma unroll 1
            for (int j = 0; j < ntile; ++j) {
                if (j + 1 < ntile) ATT_DMA(j + 1, (j + 1) & 1);
                if (wave >= 4) __builtin_amdgcn_s_sleep(8);
                const int jj = j - 4 * qb; const bool diag = jj >= 0; const bool active = !(diag && 64 * jj > 32 * wave + 31);
                ldsp Kb = lds + (j & 1) * BUF; ldsp Vb = Kb + KB;
#pragma unroll
                for (int hs = 0; hs < 2; ++hs) {
                    if (active) {
                        f32x4 S[2][2];
#pragma unroll
                        for (int qt = 0; qt < 2; ++qt) { S[qt][0] = zero4(); S[qt][1] = zero4(); }
                        {
#define ATT_KLD(i) (*(const LAS bf16x8*)(Kb + (16 * (2 * hs + ((i) & 1)) + l15) * 400 + (32 * ((i) >> 1) + 8 * g4) * 2))
                            bf16x8 kq[3]; kq[0] = ATT_KLD(0); kq[1] = ATT_KLD(1);
#pragma unroll
                            for (int i = 0; i < 12; ++i) { if (i + 2 < 12) kq[(i + 2) % 3] = ATT_KLD(i + 2);
                                __builtin_amdgcn_sched_barrier(0);
                                S[0][i & 1] = MFMA16(kq[i % 3], Qf[0][i >> 1], S[0][i & 1]); S[1][i & 1] = MFMA16(kq[i % 3], Qf[1][i >> 1], S[1][i & 1]);
                                __builtin_amdgcn_sched_barrier(0); }
#undef ATT_KLD
                        }
                        bf16x8 Pf[2];
#pragma unroll
                        for (int qt = 0; qt < 2; ++qt) {
                            if (diag) { int dq = 32 * wave + 16 * qt + l15 - 4 * g4 - 64 * jj; asm volatile("" : "+v"(dq));
#pragma unroll
                                for (int sb = 0; sb < 2; ++sb)
#pragma unroll
                                    for (int e = 0; e < 4; ++e) { if (32 * hs + 16 * sb + e > dq) S[qt][sb][e] = -1e30f; } }
                            float tm = -1e30f;
#pragma unroll
                            for (int sb = 0; sb < 2; ++sb)
#pragma unroll
                                for (int e = 0; e < 4; ++e) tm = fmaxf(tm, S[qt][sb][e]);
                            tm = fmaxf(tm, shx(tm, 16, lane)); tm = fmaxf(tm, shx(tm, 32, lane));
                            if (__builtin_amdgcn_ballot_w64(tm > mrun[qt]) != 0ull) {
                                const float mn = fmaxf(mrun[qt], tm), sc = __builtin_amdgcn_exp2f(mrun[qt] - mn); mrun[qt] = mn; lsum[qt] *= sc;
#pragma unroll
                                for (int d = 0; d < 8; ++d) Oa[qt][d] = Oa[qt][d] * sc; }
                            const float mn = mrun[qt];
                            float ps = 0.f;
#pragma unroll
                            for (int sb = 0; sb < 2; ++sb)
#pragma unroll
                                for (int e = 0; e < 4; ++e) { const float pe = __builtin_amdgcn_exp2f(S[qt][sb][e] - mn); S[qt][sb][e] = pe; ps += pe; }
                            lsum[qt] += ps;
                            Pf[qt] = mk8(pk2(S[qt][0][0], S[qt][0][1]), pk2(S[qt][0][2], S[qt][0][3]), pk2(S[qt][1][0], S[qt][1][1]), pk2(S[qt][1][2], S[qt][1][3]));
                        }
                        {
#define ATT_VLD(d) __builtin_shufflevector(*(const LAS bf16x4*)(Vb + (16 * (d) + l15) * 144 + (32 * hs + 4 * g4) * 2), *(const LAS bf16x4*)(Vb + (16 * (d) + l15) * 144 + (32 * hs + 16 + 4 * g4) * 2), 0, 1, 2, 3, 4, 5, 6, 7)
                            bf16x8 vq[3]; vq[0] = ATT_VLD(0); vq[1] = ATT_VLD(1);
#pragma unroll
                            for (int d = 0; d < 8; ++d) { if (d + 2 < 8) vq[(d + 2) % 3] = ATT_VLD(d + 2);
                                __builtin_amdgcn_sched_barrier(0);
                                Oa[0][d] = MFMA16(vq[d % 3], Pf[0], Oa[0][d]); Oa[1][d] = MFMA16(vq[d % 3], Pf[1], Oa[1][d]);
                                __builtin_amdgcn_sched_barrier(0); }
#undef ATT_VLD
                        }
                    }
                }
                asm volatile("s_waitcnt vmcnt(0)" ::: "memory"); __syncthreads();
            }
#pragma unroll
            for (int qt = 0; qt < 2; ++qt) { float ls = lsum[qt]; ls += shx(ls, 16, lane); ls += shx(ls, 32, lane); const float inv = 1.f / ls;
                bf16_t* op = (bf16_t*)((unsigned char*)(O + (size_t)(b * 4096 + qrow0) * 1024 + h * 128) + (unsigned)(((16 * qt + l15) * 1024 + 4 * g4) * 2));
#pragma unroll
                for (int d = 0; d < 8; ++d) { const f32x4 v = Oa[qt][d] * inv; u32x2 o = {pk2(v[0], v[1]), pk2(v[2], v[3])}; *(u32x2*)(op + 16 * d) = o; } }
        }
    }
#undef ATT_DMA
}

template <bool TOF32> __device__ __forceinline__ void hg_load_f_v(const float* HF, const bf16_t* HV, int t0, int col0, LAS float* BC, LAS float* K1f, ldsp K1b, ldsp VTl, int tid) {
#pragma unroll
    for (int i = 0; i < 4; ++i) { const int idx = tid + 512 * i, s = idx >> 5, k4 = (idx & 31) * 4; const f32x4 f = *(const f32x4*)(HF + (size_t)(t0 + s) * 1024 + col0 + k4);
#pragma unroll
        for (int e = 0; e < 4; ++e) BC[s * 129 + k4 + e] = __logf(f[e]);
        if (TOF32) {
#pragma unroll
            for (int e = 0; e < 4; ++e) K1f[s * 129 + k4 + e] = 1.f - f[e];
        } else { u32x2 o = {pk2(1.f - f[0], 1.f - f[1]), pk2(1.f - f[2], 1.f - f[3])}; *(LAS u32x2*)(K1b + s * 272 + k4 * 2) = o; } }
#pragma unroll
    for (int i = 0; i < 2; ++i) { const int idx = tid + 512 * i, s = idx >> 4, v8 = idx & 15; const u32x4 vv = *(const u32x4*)(HV + (size_t)(t0 + s) * 1024 + col0 + v8 * 8);
#pragma unroll
        for (int e = 0; e < 4; ++e) { *(LAS bf16_t*)(VTl + (v8 * 8 + 2 * e) * 144 + s * 2) = (bf16_t)(vv[e] & 0xffffu); *(LAS bf16_t*)(VTl + (v8 * 8 + 2 * e + 1) * 144 + s * 2) = (bf16_t)(vv[e] >> 16); } }
}
__device__ __forceinline__ void phase_ha(const int s_wv, KP p, ldsp lds) {
    const float* HF = (const float*)(p->ws + OFF_R1 + 32 * MiB); const bf16_t* HV = (const bf16_t*)(p->ws + OFF_R1 + 96 * MiB);
    bf16_t* LCT = (bf16_t*)(p->ws + OFF_R2); float* DEC = (float*)(p->ws + OFF_R2 + 64 * MiB);
    const int tid = otid(), lane = tid & 63, wave = tid >> 6, l15 = lane & 15, g4 = lane >> 4;
    LAS float* BC = (LAS float*)lds; LAS float* K1 = (LAS float*)(lds + 33024); ldsp KT = lds + 66048; ldsp VTl = lds + 84480;
    for (int u = obid(); u < 2048; u += gridDim.x) {
        const int bh = u >> 6, n = u & 63, b = bh >> 3, h = bh & 7, t0 = b * 4096 + n * 64, col0 = h * 128;
        hg_load_f_v<true>(HF, HV, t0, col0, BC, K1, VTl, VTl, tid);
        __syncthreads();
        if (tid < 128) { float run = 0.f;
#pragma unroll 8
            for (int s = 0; s < 64; ++s) { run += BC[s * 129 + tid]; BC[s * 129 + tid] = run; }
            DEC[(size_t)u * 128 + tid] = __expf(run); }
        __syncthreads();
        { const int sp = tid & 31, kk0 = tid >> 5;
#pragma unroll
          for (int it = 0; it < 8; ++it) { const int k = kk0 + 16 * it; const float bl = BC[63 * 129 + k];
              const float a0 = K1[(2 * sp) * 129 + k] * __expf(bl - BC[(2 * sp) * 129 + k]), a1 = K1[(2 * sp + 1) * 129 + k] * __expf(bl - BC[(2 * sp + 1) * 129 + k]);
              *(LAS unsigned*)(KT + k * 144 + sp * 4) = pk2(a0, a1); } }
        __syncthreads();
        f32x4 acc[8];
#pragma unroll
        for (int vt = 0; vt < 8; ++vt) acc[vt] = zero4();
#pragma unroll
        for (int ks = 0; ks < 2; ++ks) { const bf16x8 xf = *(const LAS bf16x8*)(KT + (16 * wave + l15) * 144 + (32 * ks + 8 * g4) * 2);
#pragma unroll
            for (int vt = 0; vt < 8; ++vt) { const bf16x8 yf = *(const LAS bf16x8*)(VTl + (16 * vt + l15) * 144 + (32 * ks + 8 * g4) * 2); acc[vt] = MFMA16(xf, yf, acc[vt]); } }
#pragma unroll
        for (int vt = 0; vt < 8; ++vt) { u32x2 o = {pk2(acc[vt][0], acc[vt][1]), pk2(acc[vt][2], acc[vt][3])}; *(u32x2*)(LCT + ((size_t)u * 128 + 16 * vt + l15) * 128 + 16 * wave + 4 * g4) = o; }
        __syncthreads();
    }
}
__device__ __forceinline__ void phase_hscan(const int s_wv, KP p) {
    bf16_t* LCT = (bf16_t*)(p->ws + OFF_R2); const float* DEC = (const float*)(p->ws + OFF_R2 + 64 * MiB);
    const int gtid = obid() * NTHREADS + otid(), gthreads = gridDim.x * NTHREADS;
    for (int id = gtid; id < 32 * 128 * 32; id += gthreads) {
        const int k4 = id & 31, v = (id >> 5) & 127, bh = id >> 12;
        f32x4 st = zero4();
#pragma unroll 4
        for (int n = 0; n < 64; ++n) { const int u = bh * 64 + n; bf16_t* ptr = LCT + ((size_t)u * 128 + v) * 128 + 4 * k4;
            const u32x2 t = *(const u32x2*)ptr; const f32x4 dec = *(const f32x4*)(DEC + (size_t)u * 128 + 4 * k4);
            u32x2 o = {pk2(st[0], st[1]), pk2(st[2], st[3])}; *(u32x2*)ptr = o;
            st[0] = dec[0] * st[0] + bflo(t[0]); st[1] = dec[1] * st[1] + bfhi(t[0]); st[2] = dec[2] * st[2] + bflo(t[1]); st[3] = dec[3] * st[3] + bfhi(t[1]); }
    }
}
__device__ __forceinline__ void phase_hc(const int s_wv, KP p, ldsp lds) {
    const bf16_t* HQ = (const bf16_t*)(p->ws + OFF_R1); const float* HF = (const float*)(p->ws + OFF_R1 + 32 * MiB); const bf16_t* HV = (const bf16_t*)(p->ws + OFF_R1 + 96 * MiB); const bf16_t* HG = (const bf16_t*)(p->ws + OFF_R1 + 128 * MiB);
    const bf16_t* SST = (const bf16_t*)(p->ws + OFF_R2); bf16_t* O = (bf16_t*)(p->ws + OFF_HB); const float* ng = p->in[21];
    const int tid = otid(), lane = tid & 63, wave = tid >> 6, l15 = lane & 15, g4 = lane >> 4;
    LAS float* BC = (LAS float*)lds; ldsp QT = lds + 33024; ldsp KTl = lds + 50432; ldsp QH = lds + 67840; ldsp VTl = lds + 85248; ldsp AT = lds + 103680; LAS float* SSQ = (LAS float*)(lds + 112896);
    for (int u = obid(); u < 2048; u += gridDim.x) {
        const int bh = u >> 6, n = u & 63, b = bh >> 3, h = bh & 7, t0 = b * 4096 + n * 64, col0 = h * 128;
        hg_load_f_v<false>(HF, HV, t0, col0, BC, BC, KTl, VTl, tid);
        u32x4 qraw[2];
#pragma unroll
        for (int i = 0; i < 2; ++i) { const int idx = tid + 512 * i, s = idx >> 4, k8 = idx & 15; qraw[i] = *(const u32x4*)(HQ + (size_t)(t0 + s) * 1024 + col0 + k8 * 8); }
        __syncthreads();
        if (tid < 128) { float run = 0.f;
#pragma unroll 8
            for (int s = 0; s < 64; ++s) { run += BC[s * 129 + tid]; BC[s * 129 + tid] = run; } }
        __syncthreads();
#pragma unroll
        for (int i = 0; i < 2; ++i) { const int idx = tid + 512 * i, s = idx >> 4, k8 = idx & 15; float q[8], kk[8], qt[8], qh[8]; up8(qraw[i], q); up8(*(const LAS u32x4*)(KTl + s * 272 + k8 * 16), kk);
#pragma unroll
            for (int e = 0; e < 8; ++e) { const int k = k8 * 8 + e; const float bc = BC[s * 129 + k], bm = BC[31 * 129 + k]; qt[e] = q[e] * __expf(bc - bm); qh[e] = q[e] * __expf(bc); kk[e] = kk[e] * __expf(bm - bc); }
            u32x4 o1 = {pk2(qt[0], qt[1]), pk2(qt[2], qt[3]), pk2(qt[4], qt[5]), pk2(qt[6], qt[7])}, o2 = {pk2(qh[0], qh[1]), pk2(qh[2], qh[3]), pk2(qh[4], qh[5]), pk2(qh[6], qh[7])}, o3 = {pk2(kk[0], kk[1]), pk2(kk[2], kk[3]), pk2(kk[4], kk[5]), pk2(kk[6], kk[7])};
            *(LAS u32x4*)(QT + s * 272 + k8 * 16) = o1; *(LAS u32x4*)(QH + s * 272 + k8 * 16) = o2; *(LAS u32x4*)(KTl + s * 272 + k8 * 16) = o3; }
        __syncthreads();
        { const int st = wave & 3;
#pragma unroll
          for (int ti = 0; ti < 2; ++ti) { const int tt = 2 * (wave >> 2) + ti; f32x4 a = zero4();
              if (st <= tt) {
#pragma unroll
                  for (int ks = 0; ks < 4; ++ks) { const bf16x8 xf = *(const LAS bf16x8*)(KTl + (16 * st + l15) * 272 + (32 * ks + 8 * g4) * 2), yf = *(const LAS bf16x8*)(QT + (16 * tt + l15) * 272 + (32 * ks + 8 * g4) * 2); a = MFMA16(xf, yf, a); }
                  const int t = 16 * tt + l15;
#pragma unroll
                  for (int e = 0; e < 4; ++e) { const int s = 16 * st + 4 * g4 + e; if (s > t) a[e] = 0.f; } }
              u32x2 o = {pk2(a[0], a[1]), pk2(a[2], a[3])}; *(LAS u32x2*)(AT + (16 * tt + l15) * 144 + (16 * st + 4 * g4) * 2) = o; } }
        __syncthreads();
        { const int tt = wave >> 1, vh = wave & 1; f32x4 acc[4];
#pragma unroll
          for (int vi = 0; vi < 4; ++vi) acc[vi] = zero4();
#pragma unroll
          for (int ks = 0; ks < 2; ++ks) if (32 * ks <= 16 * tt + 15) { const bf16x8 yf = *(const LAS bf16x8*)(AT + (16 * tt + l15) * 144 + (32 * ks + 8 * g4) * 2);
#pragma unroll
              for (int vi = 0; vi < 4; ++vi) { const bf16x8 xf = *(const LAS bf16x8*)(VTl + (16 * (4 * vh + vi) + l15) * 144 + (32 * ks + 8 * g4) * 2); acc[vi] = MFMA16(xf, yf, acc[vi]); } }
#pragma unroll
          for (int ks = 0; ks < 4; ++ks) { const bf16x8 yf = *(const LAS bf16x8*)(QH + (16 * tt + l15) * 272 + (32 * ks + 8 * g4) * 2);
#pragma unroll
              for (int vi = 0; vi < 4; ++vi) { const bf16x8 xf = *(const bf16x8*)(SST + ((size_t)u * 128 + 16 * (4 * vh + vi) + l15) * 128 + 32 * ks + 8 * g4); acc[vi] = MFMA16(xf, yf, acc[vi]); } }
          float sq = 0.f;
#pragma unroll
          for (int vi = 0; vi < 4; ++vi)
#pragma unroll
              for (int e = 0; e < 4; ++e) sq += acc[vi][e] * acc[vi][e];
          sq += shx(sq, 16, lane); sq += shx(sq, 32, lane);
          if (g4 == 0) SSQ[(16 * tt + l15) * 2 + vh] = sq;
          __syncthreads();
          const int t = 16 * tt + l15; const float rstd = rsqrtf((SSQ[t * 2] + SSQ[t * 2 + 1]) * (1.f / 128.f) + EPS);
#pragma unroll
          for (int vi = 0; vi < 4; ++vi) { const int v = 16 * (4 * vh + vi) + 4 * g4; const f32x4 gn = *(const f32x4*)(ng + v); const u32x2 gg = *(const u32x2*)(HG + (size_t)(t0 + t) * 1024 + col0 + v);
              const f32x4 a = acc[vi] * rstd * gn; u32x2 o = {pk2(a[0] * bflo(gg[0]), a[1] * bfhi(gg[0])), pk2(a[2] * bflo(gg[1]), a[3] * bfhi(gg[1]))};
              *(u32x2*)(O + (size_t)(t0 + t) * 1024 + col0 + v) = o; } }
        __syncthreads();
    }
}

__global__ void __launch_bounds__(NTHREADS, 2) fwd_kernel(Params pk) {
    extern __shared__ __attribute__((aligned(16))) unsigned char smem[];
    ldsp lds = (ldsp)smem;
    const int ph_lo = pk.ph_lo, ph_hi = pk.ph_hi;
    const int s_wv = __builtin_amdgcn_readfirstlane((int)threadIdx.x >> 6);
    if (threadIdx.x < 4) ((LAS unsigned*)(lds + 131072))[threadIdx.x] = 0u;
    __syncthreads();
    XcdBarrier xbar = xcd_barrier_post((unsigned*)(pk.ws + OFF_BAR), (volatile LAS unsigned*)(lds + 131072), (int)threadIdx.x);
    for (int ph = ph_lo; ph < ph_hi; ++ph) {
        KP p = (KP)__builtin_amdgcn_kernarg_segment_ptr();
        asm volatile("" : "+s"(p));
        const int op = p->op[ph], layraw = p->lay[ph], layer = layraw & 3; const bool dummy = (layraw & 4) != 0;
        unsigned char* ws = p->ws; bf16_t* xdst = dummy ? (bf16_t*)(ws + OFF_R1) : (bf16_t*)(ws + OFF_XB);
        float* MOD = (float*)(ws + OFF_MOD); bf16_t* WT = (bf16_t*)(ws + OFF_WT); bf16_t* HB = (bf16_t*)(ws + OFF_HB); bf16_t* XB = (bf16_t*)(ws + OFF_XB);
        bf16_t* R1 = (bf16_t*)(ws + OFF_R1); bf16_t* R2 = (bf16_t*)(ws + OFF_R2);
        const float* modl = MOD + (size_t)layer * 4 * 6144;
        switch (op) {
        case OP_PRO: phase_prologue(s_wv, p, lds); break;
        case OP_NORM1: if (layer == 0) phase_norm<true>(s_wv, p->in[0], XB, p->in[5], modl + 0, modl + 1024, HB); else { phase_norm<false>(s_wv, p->in[0], XB, p->in[5] + layer * 1024, modl + 0, modl + 1024, HB); prep_layer(s_wv, p, layer, lds); } break;
        case OP_NORM2: { const float* cw = p->in[24] + (size_t)layer * 3 * 5632; const float* cb = p->in[25] + (size_t)layer * 5632; bf16_t* CWB = (bf16_t*)(ws + OFF_CWB);
                         for (int f = obid() * NTHREADS + otid(); f < 2816; f += gridDim.x * NTHREADS) { u32x4 o = {pk2(cw[f], cw[5632 + f]), pk2(cw[11264 + f], cb[f]), pk2(cw[2816 + f], cw[5632 + 2816 + f]), pk2(cw[11264 + 2816 + f], cb[2816 + f])}; *(u32x4*)(CWB + f * 8) = o; }
                         phase_norm<false>(s_wv, p->in[0], XB, p->in[6] + layer * 1024, modl + 3072, modl + 4096, HB); } break;
        case OP_G1: { EpiBf16<1> E{R1, 4096}; run_gemm(s_wv, lds, HB, WT + WT_MIXA, T, 4096, 1024, E); } break;
        case OP_GSP: phase_gsp(s_wv, p, layer / 3, lds); break;
        case OP_GOUT: { EpiRes E{XB, xdst, modl + 2048}; run_gemm(s_wv, lds, R2, WT + WT_MIXB, T, 1024, 2048, E); } break;
        case OP_M1: { EpiF32 E{(float*)R1, 512}; run_gemm(s_wv, lds, HB, WT + WT_MIXA, T, 512, 1024, E); } break;
        case OP_M2: phase_m2(s_wv, p); break;
        case OP_M3: { EpiQ EQ{(bf16_t*)(ws + OFF_R1 + 48 * MiB), (const float*)(ws + OFF_CSC), (const float*)(ws + OFF_CSS), 0.07216878364870322f * 1.4426950408889634f}; run_gemm(s_wv, lds, (const bf16_t*)(ws + OFF_R1 + 32 * MiB), WT + WT_MQKV, T, 1536, 256, EQ); EpiKV EK{(bf16_t*)(ws + OFF_R1 + 96 * MiB), (bf16_t*)(ws + OFF_R1 + 144 * MiB)}; run_gemm(s_wv, lds, (const bf16_t*)(ws + OFF_R1 + 40 * MiB), WT + WT_MQKV + 393216, T, 2048, 256, EK); } break;
        case OP_ATT: phase_attn(s_wv, p, lds); break;
        case OP_MOUT: { EpiRes E{XB, XB, modl + 2048}; run_gemm(s_wv, lds, R2, WT + WT_MIXB, T, 1024, 1024, E); } break;
        case OP_H1: { EpiHg E{ws + OFF_R1, (const float*)(ws + OFF_LB)}; run_gemm(s_wv, lds, HB, WT + WT_MIXA, T, 4096, 1024, E); } break;
        case OP_HA: phase_ha(s_wv, p, lds); break;
        case OP_HSCAN: phase_hscan(s_wv, p); break;
        case OP_HC: phase_hc(s_wv, p, lds); break;
        case OP_HOUT: { EpiRes E{XB, XB, modl + 2048}; run_gemm(s_wv, lds, HB, WT + WT_MIXB, T, 1024, 1024, E); } break;
        case OP_FUP: { EpiFFN E{R2, (const bf16_t*)(ws + OFF_CWB)}; run_gemm(s_wv, lds, HB - 2 * 1024, WT + WT_FUP, 67 * 256, 5632, 1024, E); } break;
        case OP_FDN: { EpiRes E{XB, xdst, modl + 5120}; run_gemm(s_wv, lds, R2, WT + WT_FDN, T, 1024, 2816, E); } break;
        case OP_FINAL: phase_final(s_wv, XB, p->out, p->in[27]); break;
        default: break;
        }
        if (ph + 1 < ph_hi) { if (ph == ph_lo) { __syncthreads(); cg::this_grid().sync(); } else xcd_barrier(xbar, otid()); }
    }
}

#ifndef MULTI_LAUNCH
#define MULTI_LAUNCH 0
#endif
extern "C" void kernel_launch(void* const* d_in, const int* in_sizes, int n_in, void* d_out, int out_size, void* d_ws, size_t ws_size, hipStream_t stream) {
    static int grid = 0;
    if (grid == 0) {
        int dev = 0, cus = 0, per_cu = 0;
        hipGetDevice(&dev); hipDeviceGetAttribute(&cus, hipDeviceAttributeMultiprocessorCount, dev);
        hipFuncSetAttribute((const void*)fwd_kernel, hipFuncAttributeMaxDynamicSharedMemorySize, LDS_BYTES);
        hipOccupancyMaxActiveBlocksPerMultiprocessor(&per_cu, (const void*)fwd_kernel, NTHREADS, LDS_BYTES);
        if (per_cu < 1) per_cu = 1;
        grid = cus * 1; (void)per_cu;
        if (ws_size < WS_END) fprintf(stderr, "kernel_launch: workspace too small: %zu < %zu\n", ws_size, (size_t)WS_END);
        (void)hipGetLastError();
    }
    (void)hipMemsetAsync((char*)d_ws + OFF_BAR, 0, XCD_BAR_WORDS * sizeof(unsigned), stream);
    Params p{};
    for (int i = 0; i < 28; ++i) p.in[i] = (const float*)d_in[i];
    p.out = (float*)d_out; p.ws = (unsigned char*)d_ws;
    int n = 0;
    auto add = [&](int op, int l) { p.op[n] = (unsigned char)op; p.lay[n] = (unsigned char)l; ++n; };
    add(OP_PRO, 0);
    for (int l = 0; l < 4; ++l) {
        add(OP_NORM1, l);
        if (l % 3 == 0) { add(OP_G1, l); add(OP_GSP, l); add(OP_GOUT, l); }
        else if (l % 3 == 1) { add(OP_M1, l); add(OP_M2, l); add(OP_M3, l); add(OP_ATT, l); add(OP_MOUT, l); }
        else { add(OP_H1, l); add(OP_HA, l); add(OP_HSCAN, l); add(OP_HC, l); add(OP_HOUT, l); }
        add(OP_NORM2, l); add(OP_FUP, l); add(OP_FDN, l);
    }
    add(OP_FINAL, 0);
#if MULTI_LAUNCH
    for (int i = 0; i < n; ++i) { p.ph_lo = i; p.ph_hi = i + 1; hipLaunchKernelGGL(fwd_kernel, dim3(grid), dim3(NTHREADS), LDS_BYTES, stream, p); }
#else
    p.ph_lo = 0; p.ph_hi = n;
    void* args[] = {&p};
    hipError_t e = hipLaunchCooperativeKernel((const void*)fwd_kernel, dim3(grid), dim3(NTHREADS), args, LDS_BYTES, stream);
    if (e != hipSuccess) fprintf(stderr, "cooperative launch failed: %s (grid %d)\n", hipGetErrorString(e), grid);
#endif
}
```

```cpp
#include <hip/hip_runtime.h>
#include <hip/hip_cooperative_groups.h>
#include <cstdio>
#include <cstdint>
namespace cg = cooperative_groups;
__device__ __forceinline__ int otid_w(int w) { int l; asm volatile("v_mbcnt_lo_u32_b32 %0, -1, 0\n\tv_mbcnt_hi_u32_b32 %0, -1, %0" : "=v"(l)); return (w << 6) | l; }
#define otid() otid_w(s_wv)
__device__ __forceinline__ int obid() { int t = blockIdx.x; asm volatile("" : "+s"(t)); return t; }
namespace pg8 {
#define PG8_LAS __attribute__((address_space(3)))
typedef unsigned short bf16_t;
typedef short bf16x8 __attribute__((ext_vector_type(8)));
typedef float f32x4 __attribute__((ext_vector_type(4)));
typedef unsigned u32x4 __attribute__((ext_vector_type(4)));
constexpr int BM = 256, BK = 64, HALF = 128, HTB = HALF * BK * 2  , STAGE_BYTES = 8 * HTB, NXCD = 8, WGM = 8;

__host__ __device__ __forceinline__ int lds_byte(int r, int c) { const int st = (r >> 4) * 2 + (c >> 5), rr = r & 15, cc = c & 31, ob = rr * 64 + cc * 2; return st * 1024 + (ob ^ (((ob >> 9) & 1) << 5)); }
__host__ __device__ __forceinline__ void stage_rc(int b, int& R, int& C) { const int st = b / 1024, sb = b % 1024, swz = sb ^ (((sb >> 9) & 1) << 5); R = (st >> 1) * 16 + swz / 64; C = (st & 1) * 32 + (swz % 64) / 2; }
__host__ __device__ __forceinline__ int perm32(int rho) { const int n = rho >> 4, i = rho & 15; return 8 * (i >> 2) + 4 * n + (i & 3); }

struct Unit { int pm, pn; };
struct Gemm { const bf16_t* A; const bf16_t* Bt; int M, N, K; };

struct StaticOrder {
    int nM, nN, nwg, G, c;
    __host__ __device__ void init(int M, int N, int G_, int c_) { nM = M / BM; nN = N / BM; nwg = nM * nN; G = G_; c = c_; }
    __host__ __device__ bool next(int i, Unit& u) const {
        const long L = (long)i * G + c; if (L >= nwg) return false;
        int wgid = (int)L; { const int q = nwg / NXCD, r = nwg % NXCD, xcd = wgid % NXCD, off = wgid / NXCD; wgid = (xcd < r ? xcd * (q + 1) : r * (q + 1) + (xcd - r) * q) + off; }
        const int nig = WGM * nN, gid = wgid / nig, fm = gid * WGM, gsz = (nM - fm) < WGM ? (nM - fm) : WGM;
        u.pm = fm + ((wgid % nig) % gsz); u.pn = (wgid % nig) / gsz; return true;
    }
    __device__ __forceinline__ void a_ready(const Unit&) const {}
    __device__ __forceinline__ void done(const Unit&) const {}
};
__device__ __forceinline__ unsigned cvt_pk_bf16(float lo, float hi) { unsigned r; asm volatile("v_cvt_pk_bf16_f32 %0, %1, %2" : "=v"(r) : "v"(lo), "v"(hi)); return r; }

template <class Epi, class Sched, bool STAMP = false>
__device__ __forceinline__ void gemm_phase(const int s_wv, PG8_LAS unsigned char* lds, const Gemm g, const Sched& S, const Epi& E, unsigned long long* stamps) {
    const int tid = otid(), wid = __builtin_amdgcn_readfirstlane(tid >> 6), lane = tid & 63, wr = wid >> 2, wc = wid & 3, fr = lane & 15, fq = lane >> 4;
    const int K = g.K, nt = K / BK;
    int ts_lo = 0, ts_hi = 0, nts = 0; const unsigned long long rt_entry = STAMP ? (unsigned long long)wall_clock64() : 0ull;
#define PG8_STAMP() do { if (STAMP && wid == 0 && nts < 64) { const unsigned long long _c = (unsigned long long)clock64(); \
        ts_lo = (lane == nts) ? (int)(unsigned)_c : ts_lo; ts_hi = (lane == nts) ? (int)(unsigned)(_c >> 32) : ts_hi; ++nts; } } while (0)
    PG8_STAMP();
    unsigned voffA[2], voffB[2];
#pragma unroll
    for (int i = 0; i < 2; ++i) { int R, C; stage_rc(tid * 16 + i * 8192, R, C); const int Rb = Epi::PERM ? ((R & ~31) + perm32(R & 31)) : R;
        const int Ra = Epi::PERMA ? (62 * (R >> 6) + 4 * (R & 15) + ((R >> 4) & 3)) : R; voffA[i] = (unsigned)(Ra * K + C) * 2u; voffB[i] = (unsigned)(Rb * K + C) * 2u; }
    const size_t kstep = (size_t)(BK * 2);
    const size_t hstep = (size_t)HALF * K * 2;
    const size_t tstep = 2 * hstep;
    const size_t hstepA = Epi::PERMA ? (size_t)124 * K * 2 : hstep, tstepA = Epi::PERMA ? (size_t)248 * K * 2 : tstep;
    const unsigned ldsw = (unsigned)wid * 1024u;
    const int aoff = lds_byte(wr * 64 + fr, fq * 8), boff = lds_byte(wc * 32 + fr, fq * 8);
#define PG8_SA(b, h) (((b) * 2 + (h)) * HTB)
#define PG8_SB(b, h) ((4 + (b) * 2 + (h)) * HTB)
#define PG8_STAGE(bufoff, gbase, voff) do { _Pragma("unroll") for (int _i = 0; _i < 2; ++_i) \
        __builtin_amdgcn_global_load_lds((const unsigned*)((const char*)(gbase) + (voff)[_i]), (PG8_LAS unsigned*)(lds + (bufoff) + ldsw + _i * 8192), 16, 0, 0); } while (0)
#define PG8_LDA(dst, b, h) do { _Pragma("unroll") for (int m = 0; m < 4; ++m) _Pragma("unroll") for (int k = 0; k < 2; ++k) dst[m][k] = *(const PG8_LAS bf16x8*)(lds + PG8_SA(b, h) + aoff + m * 2048 + k * 1024); } while (0)
#define PG8_LDB(dst, b, h) do { _Pragma("unroll") for (int n = 0; n < 2; ++n) _Pragma("unroll") for (int k = 0; k < 2; ++k) dst[n][k] = *(const PG8_LAS bf16x8*)(lds + PG8_SB(b, h) + boff + n * 2048 + k * 1024); } while (0)
#define PG8_MMA(ai, bj, At, Bt) do { __builtin_amdgcn_s_setprio(1); _Pragma("unroll") for (int m = 0; m < 4; ++m) _Pragma("unroll") for (int n = 0; n < 2; ++n) _Pragma("unroll") for (int k = 0; k < 2; ++k) \
        acc[ai][bj][m][n] = __builtin_amdgcn_mfma_f32_16x16x32_bf16(Bt[n][k], At[m][k], acc[ai][bj][m][n], 0, 0, 0); __builtin_amdgcn_s_setprio(0); } while (0)
#define PG8_WAIT_V(n) asm volatile("s_waitcnt vmcnt(" #n ")" ::: "memory")
#define PG8_WAIT_L(n) asm volatile("s_waitcnt lgkmcnt(" #n ")" ::: "memory")
#define PG8_BAR __builtin_amdgcn_s_barrier()
#define PG8_SCHED __builtin_amdgcn_sched_barrier(0)
    Unit cur, nxt; int ui = 0;
    if (!S.next(0, cur)) return;
    f32x4 acc[2][2][4][2];
#pragma unroll
    for (int a = 0; a < 2; ++a)
#pragma unroll
        for (int b = 0; b < 2; ++b)
#pragma unroll
            for (int m = 0; m < 4; ++m)
#pragma unroll
                for (int n = 0; n < 2; ++n) acc[a][b][m][n] = (f32x4){0.f, 0.f, 0.f, 0.f};
    bf16x8 At[4][2], B0[2][2], B1[2][2];
    const char* cA = (const char*)g.A + (size_t)cur.pm * tstepA; const char* cB = (const char*)g.Bt + (size_t)cur.pn * tstep;
    S.a_ready(cur);
    PG8_STAGE(PG8_SB(0, 0), cB, voffB); PG8_STAGE(PG8_SA(0, 0), cA, voffA); PG8_STAGE(PG8_SB(0, 1), cB + hstep, voffB); PG8_STAGE(PG8_SA(0, 1), cA + hstepA, voffA);
    if (wr == 1) PG8_BAR;
    PG8_WAIT_V(4); PG8_BAR;
    PG8_STAGE(PG8_SB(1, 0), cB + kstep, voffB); PG8_STAGE(PG8_SA(1, 0), cA + kstep, voffA); PG8_STAGE(PG8_SB(1, 1), cB + hstep + kstep, voffB);
    PG8_WAIT_V(6); PG8_BAR;
    PG8_STAMP();
    for (;;) {
        const bool has_next = S.next(ui + 1, nxt);
        const char* nA = has_next ? (const char*)g.A + (size_t)nxt.pm * tstepA : cA; const char* nB = has_next ? (const char*)g.Bt + (size_t)nxt.pn * tstep : cB;
        for (int t = 0; t < nt; t += 2) {
            const bool last = (t == nt - 2);
            const char* a1 = cA + (size_t)(t + 1) * kstep;
            const char* a2 = last ? nA : cA + (size_t)(t + 2) * kstep; const char* b2 = last ? nB : cB + (size_t)(t + 2) * kstep;
            const char* a3 = a2 + kstep; const char* b3 = b2 + kstep;
            if (last && has_next) S.a_ready(nxt);
            PG8_LDB(B0, 0, 0); PG8_SCHED; PG8_LDA(At, 0, 0); PG8_STAGE(PG8_SA(1, 1), a1 + hstepA, voffA);
            PG8_WAIT_L(8); PG8_BAR; PG8_WAIT_L(0); PG8_MMA(0, 0, At, B0); PG8_BAR; PG8_SCHED;
            PG8_LDB(B1, 0, 1); PG8_STAGE(PG8_SB(0, 0), b2, voffB);
            PG8_BAR; PG8_WAIT_L(0); PG8_MMA(0, 1, At, B1); PG8_BAR;
            PG8_LDA(At, 0, 1); PG8_STAGE(PG8_SA(0, 0), a2, voffA);
            PG8_BAR; PG8_WAIT_L(0); PG8_MMA(1, 0, At, B0); PG8_BAR; PG8_SCHED;
            PG8_STAGE(PG8_SB(0, 1), b2 + hstep, voffB);
            PG8_WAIT_V(6); PG8_BAR; PG8_MMA(1, 1, At, B1); PG8_BAR;
            PG8_LDB(B0, 1, 0); PG8_SCHED; PG8_LDA(At, 1, 0); PG8_STAGE(PG8_SA(0, 1), a2 + hstepA, voffA);
            PG8_WAIT_L(8); PG8_BAR; PG8_WAIT_L(0); PG8_MMA(0, 0, At, B0); PG8_BAR; PG8_SCHED;
            PG8_LDB(B1, 1, 1); PG8_STAGE(PG8_SB(1, 0), b3, voffB);
            PG8_BAR; PG8_WAIT_L(0); PG8_MMA(0, 1, At, B1); PG8_BAR;
            PG8_LDA(At, 1, 1); PG8_STAGE(PG8_SA(1, 0), a3, voffA);
            PG8_BAR; PG8_WAIT_L(0); PG8_MMA(1, 0, At, B0); PG8_BAR; PG8_SCHED;
            PG8_STAGE(PG8_SB(1, 1), b3 + hstep, voffB);
            PG8_WAIT_V(6); PG8_BAR; PG8_MMA(1, 1, At, B1); PG8_BAR;
        }
        PG8_STAMP();
        if constexpr (!Epi::AFTER_DRAIN) { E(acc, cur, wr, wc, fr, fq); S.done(cur); }
        PG8_STAMP();
        if (!has_next) break;
#pragma unroll
        for (int a = 0; a < 2; ++a)
#pragma unroll
            for (int b = 0; b < 2; ++b)
#pragma unroll
                for (int m = 0; m < 4; ++m)
#pragma unroll
                    for (int n = 0; n < 2; ++n) acc[a][b][m][n] = (f32x4){0.f, 0.f, 0.f, 0.f};
        cur = nxt; cA = nA; cB = nB; ++ui;
    }
    PG8_WAIT_V(0);
    if (wr == 0) PG8_BAR;
    PG8_BAR;
    if constexpr (Epi::AFTER_DRAIN) { E.fused(acc, cur, wr, wc, fr, fq, lds, wid, lane); S.done(cur); }
    PG8_STAMP();
    if (STAMP && wid == 0) { stamps[lane] = lane < nts ? (((unsigned long long)(unsigned)ts_hi << 32) | (unsigned)ts_lo) : 0ull;
        if (lane == 62) stamps[62] = rt_entry; if (lane == 63) stamps[63] = (unsigned long long)wall_clock64(); }
#undef PG8_STAMP
#undef PG8_SA
#undef PG8_SB
#undef PG8_STAGE
#undef PG8_LDA
#undef PG8_LDB
#undef PG8_MMA
#undef PG8_WAIT_V
#undef PG8_WAIT_L
#undef PG8_BAR
#undef PG8_SCHED
}
}

using pg8::bf16_t; using pg8::bf16x8; using pg8::f32x4; using pg8::u32x4; using pg8::Unit;
typedef unsigned u32x2 __attribute__((ext_vector_type(2)));
typedef short bf16x4 __attribute__((ext_vector_type(4)));
#define LAS __attribute__((address_space(3)))
typedef LAS unsigned char* ldsp;
#define XB_TMO      128
#define XB_XCNT(j)  (256  + 64 * (j))
#define XB_XSUB(j)  (1280 + 64 * (j))
#define XB_XGEN(j)  (2304 + 64 * (j))
#define XB_TOP      3328
#define XB_TOPGEN   3392
#define XCD_BAR_WORDS 3456
#define XB_SPIN_CAP (1u << 18)

__device__ __forceinline__ unsigned xb_ld(unsigned* p)              { return __hip_atomic_load(p, __ATOMIC_RELAXED, __HIP_MEMORY_SCOPE_AGENT); }
__device__ __forceinline__ unsigned xb_add(unsigned* p, unsigned v) { return __hip_atomic_fetch_add(p, v, __ATOMIC_RELAXED, __HIP_MEMORY_SCOPE_AGENT); }
__device__ __forceinline__ unsigned xb_xcc_id() { return (unsigned)__builtin_amdgcn_s_getreg((3 << 11) | 20) & 0xFu; }
#define XB_SPIN(cond, bar) do { unsigned _sp = 0; while (cond) { __builtin_amdgcn_s_sleep(1); \
    if ((++_sp & 255u) == 0u) { if (xb_ld(&(bar)[XB_TMO])) break; if (_sp > XB_SPIN_CAP) { atomicAdd(&(bar)[XB_TMO], 1u); break; } } } } while (0)

struct XcdBarrier {
    unsigned* bar; unsigned x;
    volatile LAS unsigned* st;
};

__device__ __forceinline__ XcdBarrier xcd_barrier_post(unsigned* bar, volatile LAS unsigned* st, const int tid0) {
    XcdBarrier b; b.bar = bar; b.x = xb_xcc_id(); b.st = st;
    if (tid0 == 0) (void)xb_add(&bar[XB_XCNT(b.x)], 1u);
    return b;
}
__device__ __forceinline__ void xcd_barrier_complete(unsigned* bar, unsigned x, unsigned& nloc, unsigned& nx) {
    const unsigned G = gridDim.x * gridDim.y * gridDim.z;
    unsigned sum, cnt, mine, sp = 0u;
    for (;;) {
        sum = 0u; cnt = 0u; mine = 0u;
#pragma unroll
        for (unsigned j = 0; j < 16; ++j) { const unsigned c = xb_ld(&bar[XB_XCNT(j)]); sum += c; cnt += (c > 0u) ? 1u : 0u; mine = (j == x) ? c : mine; }
        if (sum == G) break;
        __builtin_amdgcn_s_sleep(1);
        if ((++sp & 255u) == 0u) { if (xb_ld(&bar[XB_TMO])) break; if (sp > XB_SPIN_CAP) { atomicAdd(&bar[XB_TMO], 1u); break; } }
    }
    nloc = mine > 0u ? mine : 1u; nx = cnt > 0u ? cnt : 1u;
}

__device__ __forceinline__ void xcd_barrier(const XcdBarrier& b, const int tid0) {
    asm volatile("s_waitcnt vmcnt(0)" ::: "memory");
    __syncthreads();
    if (tid0 == 0) {
        unsigned* bar = b.bar;
        __builtin_amdgcn_s_waitcnt(0);
        unsigned nloc = b.st[0], nx = b.st[1];
        if (nloc == 0u) { xcd_barrier_complete(bar, b.x, nloc, nx); b.st[0] = nloc; b.st[1] = nx; }
        const unsigned old = xb_add(&bar[XB_XSUB(b.x)], 1u);
        const unsigned gen = old / nloc;
        if (old + 1u == (gen + 1u) * nloc) {
            __builtin_amdgcn_fence(__ATOMIC_RELEASE, "agent");
            asm volatile("s_waitcnt vmcnt(0)" ::: "memory");
            const unsigned og = xb_add(&bar[XB_TOP], 1u);
            const unsigned tg = og / nx;
            if (og + 1u == (tg + 1u) * nx) xb_add(&bar[XB_TOPGEN], 1u);
            else XB_SPIN(xb_ld(&bar[XB_TOPGEN]) == tg, bar);
            __builtin_amdgcn_fence(__ATOMIC_ACQUIRE, "agent");
            xb_add(&bar[XB_XGEN(b.x)], 1u);
            asm volatile("s_waitcnt vmcnt(0)" ::: "memory");
        } else {
            XB_SPIN(xb_ld(&bar[XB_XGEN(b.x)]) == gen, bar);
            __builtin_amdgcn_fence(__ATOMIC_ACQUIRE, "agent");
            asm volatile("s_waitcnt vmcnt(0)" ::: "memory");
        }
    }
    __syncthreads();
}


constexpr int T = 16384, D = 1024, SEQ = 4096, NBATCH = 4, FF = 2816;
constexpr int NTHREADS = 512, LDS_BYTES = 131072 + 16;
constexpr float EPS = 1e-6f;
constexpr size_t MiB = 1024 * 1024;
constexpr size_t OFF_MOD = 0, OFF_LB = 512 * 1024, OFF_CWB = 576 * 1024, OFF_BAR = 768 * 1024, OFF_CSC = 1 * MiB, OFF_CSS = 3 * MiB, OFF_WT = 8 * MiB, OFF_HB = 40 * MiB, OFF_R1 = 72 * MiB, OFF_R2 = 248 * MiB, OFF_XB = 336 * MiB, WS_END = 368 * MiB;
constexpr size_t WT_MIXA = 0, WT_MIXB = 4194304, WT_FUP = 6291456, WT_FDN = 12058624, WT_MQKV = 524288;
enum { OP_PRO = 0, OP_NORM1, OP_G1, OP_GSP, OP_GOUT, OP_M1, OP_M2, OP_M3, OP_ATT, OP_MOUT, OP_H1, OP_HA, OP_HSCAN, OP_HC, OP_HOUT, OP_NORM2, OP_FUP, OP_FCONV, OP_FDN, OP_FINAL };

struct Params;
struct Params {
    const float* in[28];
    float* out;
    unsigned char* ws;
    int ph_lo, ph_hi;
    unsigned char op[48];
    unsigned char lay[48];
};

typedef const __attribute__((address_space(4))) Params* KP;
__device__ __forceinline__ unsigned pk2(float lo, float hi) { return pg8::cvt_pk_bf16(lo, hi); }
__device__ __forceinline__ float bflo(unsigned u) { return __uint_as_float(u << 16); }
__device__ __forceinline__ float bfhi(unsigned u) { return __uint_as_float(u & 0xffff0000u); }
__device__ __forceinline__ float shx(float v, int m, int lane) { return __int_as_float(__builtin_amdgcn_ds_bpermute((lane ^ m) << 2, __float_as_int(v))); }
__device__ __forceinline__ float wave_sum(float v, int lane) {
#pragma unroll
    for (int o = 32; o >= 1; o >>= 1) v += shx(v, o, lane);
    return v;
}
__device__ __forceinline__ float fast_sigmoid(float x) { return __builtin_amdgcn_rcpf(1.f + __builtin_amdgcn_exp2f(-1.4426950408889634f * x)); }
__device__ __forceinline__ float gelu_tanh(float x) { const float u = 0.7978845608028654f * (x + 0.044715f * x * x * x); return x * fast_sigmoid(2.f * u); }
__device__ __forceinline__ f32x4 sigmoid4(const f32x4 x) { const f32x4 ex = x * -1.4426950408889634f; f32x4 s;
#pragma unroll
    for (int e = 0; e < 4; ++e) s[e] = __builtin_amdgcn_rcpf(1.f + __builtin_amdgcn_exp2f(ex[e]));
    return s; }
__device__ __forceinline__ f32x4 gelu_tanh4(const f32x4 x) { const f32x4 t = x * x * 0.044715f + 1.f; const f32x4 ex = x * t * (-2.f * 0.7978845608028654f * 1.4426950408889634f); f32x4 s;
#pragma unroll
    for (int e = 0; e < 4; ++e) s[e] = __builtin_amdgcn_rcpf(1.f + __builtin_amdgcn_exp2f(ex[e]));
    return x * s; }
__device__ __forceinline__ bf16x8 mk8(unsigned a, unsigned b, unsigned c, unsigned d) { u32x4 v = {a, b, c, d}; return __builtin_bit_cast(bf16x8, v); }
__device__ __forceinline__ f32x4 zero4() { float z = 0.f; asm volatile("" : "+v"(z)); return (f32x4){z, z, z, z}; }
#define MFMA16(X, Y, C) __builtin_amdgcn_mfma_f32_16x16x32_bf16((X), (Y), (C), 0, 0, 0)

template <int ACT> struct EpiBf16 {
    static constexpr bool PERM = true, AFTER_DRAIN = false, PERMA = false;
    bf16_t* O; int ldc;
    __device__ __forceinline__ void operator()(const f32x4 (&acc)[2][2][4][2], const Unit& u, int wr, int wc, int fr, int fq) const {
        const int row0 = u.pm * 256 + wr * 64 + fr, col0 = u.pn * 256 + wc * 32 + 8 * fq;
#pragma unroll
        for (int ai = 0; ai < 2; ++ai)
#pragma unroll
            for (int m = 0; m < 4; ++m) { bf16_t* rowp = O + (size_t)(row0 + ai * 128 + m * 16) * ldc + col0;
#pragma unroll
                for (int bj = 0; bj < 2; ++bj) { f32x4 v0 = acc[ai][bj][m][0], v1 = acc[ai][bj][m][1];
                    if (ACT == 1) { v0 = gelu_tanh4(v0); v1 = gelu_tanh4(v1); }
                    u32x4 o = {pk2(v0[0], v0[1]), pk2(v0[2], v0[3]), pk2(v1[0], v1[1]), pk2(v1[2], v1[3])};
                    *(u32x4*)(rowp + bj * 128) = o; } }
    }
};
struct EpiF32 {
    static constexpr bool PERM = false, AFTER_DRAIN = false, PERMA = false;
    float* C; int ldc;
    __device__ __forceinline__ void operator()(const f32x4 (&acc)[2][2][4][2], const Unit& u, int wr, int wc, int fr, int fq) const {
        const int row0 = u.pm * 256 + wr * 64 + fr, col0 = u.pn * 256 + wc * 32 + 4 * fq;
#pragma unroll
        for (int ai = 0; ai < 2; ++ai)
#pragma unroll
            for (int m = 0; m < 4; ++m) { float* rowp = C + (size_t)(row0 + ai * 128 + m * 16) * ldc + col0;
#pragma unroll
                for (int bj = 0; bj < 2; ++bj)
#pragma unroll
                    for (int n = 0; n < 2; ++n) *(f32x4*)(rowp + bj * 128 + n * 16) = acc[ai][bj][m][n]; }
    }
};
struct EpiRes {
    static constexpr bool PERM = true, AFTER_DRAIN = false, PERMA = false;
    const bf16_t* Xs; bf16_t* Xd; const float* gate;
    __device__ __forceinline__ void operator()(const f32x4 (&acc)[2][2][4][2], const Unit& u, int wr, int wc, int fr, int fq) const {
        const int row0 = u.pm * 256 + wr * 64 + fr, col0 = u.pn * 256 + wc * 32 + 8 * fq;
        const float* gp = gate + (unsigned)((u.pm >> 4) * 6144 + col0);
        f32x4 gv[2][2];
#pragma unroll
        for (int bj = 0; bj < 2; ++bj)
#pragma unroll
            for (int n = 0; n < 2; ++n) { gv[bj][n] = *(const f32x4*)(gp + bj * 128 + n * 4); gv[bj][n] = gv[bj][n] + 1.f; }
#pragma unroll
        for (int ai = 0; ai < 2; ++ai)
#pragma unroll
            for (int m = 0; m < 4; ++m) { const unsigned ro = (unsigned)((row0 + ai * 128 + m * 16) * 1024 + col0);
#pragma unroll
                for (int bj = 0; bj < 2; ++bj) { const u32x4 xs = *(const u32x4*)(Xs + ro + bj * 128);
                    const f32x4 a0 = acc[ai][bj][m][0] * gv[bj][0], a1 = acc[ai][bj][m][1] * gv[bj][1];
                    u32x4 o = {pk2(bflo(xs[0]) + a0[0], bfhi(xs[0]) + a0[1]), pk2(bflo(xs[1]) + a0[2], bfhi(xs[1]) + a0[3]), pk2(bflo(xs[2]) + a1[0], bfhi(xs[2]) + a1[1]), pk2(bflo(xs[3]) + a1[2], bfhi(xs[3]) + a1[3])};
                    *(u32x4*)(Xd + ro + bj * 128) = o; } }
    }
};
struct EpiQ {
    static constexpr bool PERM = false, AFTER_DRAIN = false, PERMA = false;
    bf16_t* QF; const float* CSC; const float* CSS; float qs;
    __device__ __forceinline__ void operator()(const f32x4 (&acc)[2][2][4][2], const Unit& u, int wr, int wc, int fr, int fq) const {
        const int b = u.pm >> 4;
#pragma unroll
        for (int bj = 0; bj < 2; ++bj) {
            const int c0 = u.pn * 256 + bj * 128 + wc * 32;
            const int head = c0 / 192, off = c0 - head * 192;
            if (off < 128) {
#pragma unroll
                for (int ai = 0; ai < 2; ++ai)
#pragma unroll
                    for (int m = 0; m < 4; ++m) { const int r = u.pm * 256 + ai * 128 + wr * 64 + m * 16 + fr, s = r & 4095;
                        bf16_t* qp = QF + (unsigned)(((b * 8 + head) * 4096 + s) * 192 + off + 4 * fq);
#pragma unroll
                        for (int n = 0; n < 2; ++n) { const f32x4 v = acc[ai][bj][m][n] * qs; u32x2 o = {pk2(v[0], v[1]), pk2(v[2], v[3])}; *(u32x2*)(qp + 16 * n) = o; } __builtin_amdgcn_sched_barrier(0); }
            } else {
                const int jb = ((off - 128) >> 5) * 16 + 4 * fq;
#pragma unroll
                for (int ai = 0; ai < 2; ++ai)
#pragma unroll
                    for (int m = 0; m < 4; ++m) { const int r = u.pm * 256 + ai * 128 + wr * 64 + m * 16 + fr, s = r & 4095;
                        const f32x4 cs = *(const f32x4*)(CSC + (unsigned)(r * 32 + jb)), sn = *(const f32x4*)(CSS + (unsigned)(r * 32 + jb));
                        const f32x4 x1 = acc[ai][bj][m][0], x2 = acc[ai][bj][m][1];
                        const f32x4 r1 = (x1 * cs - x2 * sn) * qs, r2 = (x2 * cs + x1 * sn) * qs;
                        bf16_t* qp = QF + (unsigned)(((b * 8 + head) * 4096 + s) * 192 + 128 + jb);
                        u32x2 o1 = {pk2(r1[0], r1[1]), pk2(r1[2], r1[3])}, o2 = {pk2(r2[0], r2[1]), pk2(r2[2], r2[3])};
                        *(u32x2*)(qp) = o1; *(u32x2*)(qp + 32) = o2; __builtin_amdgcn_sched_barrier(0); }
            }
        }
    }
};
struct EpiKV {
    static constexpr bool PERM = false, AFTER_DRAIN = false, PERMA = false;
    bf16_t* KF; bf16_t* VT;
    __device__ __forceinline__ void operator()(const f32x4 (&acc)[2][2][4][2], const Unit& u, int wr, int wc, int fr, int fq) const {
        const int b = u.pm >> 4, head = u.pn;
#pragma unroll
        for (int bj = 0; bj < 2; ++bj) {
            const int off = wc * 32;
            if (bj == 0) {
#pragma unroll
                for (int ai = 0; ai < 2; ++ai)
#pragma unroll
                    for (int m = 0; m < 4; ++m) { const int r = u.pm * 256 + ai * 128 + wr * 64 + m * 16 + fr, s = r & 4095;
                        bf16_t* kp = KF + (unsigned)(((b * 8 + head) * 4096 + s) * 192 + off + 4 * fq);
#pragma unroll
                        for (int n = 0; n < 2; ++n) { const f32x4 v = acc[ai][bj][m][n]; u32x2 o = {pk2(v[0], v[1]), pk2(v[2], v[3])}; *(u32x2*)(kp + 16 * n) = o; } __builtin_amdgcn_sched_barrier(0); }
            } else {
#pragma unroll
                for (int ai = 0; ai < 2; ++ai)
#pragma unroll
                    for (int m = 0; m < 4; ++m) { const int r = u.pm * 256 + ai * 128 + wr * 64 + m * 16 + fr, s = r & 4095;
#pragma unroll
                        for (int n = 0; n < 2; ++n) { const f32x4 v = acc[ai][bj][m][n]; const int dv = off + 16 * n + 4 * fq;
                            bf16_t* vp = VT + (unsigned)(((b * 8 + head) * 128 + dv) * 4096 + s);
                            const unsigned p01 = pk2(v[0], v[1]), p23 = pk2(v[2], v[3]);
                            vp[0] = (bf16_t)(p01 & 0xffffu); vp[4096] = (bf16_t)(p01 >> 16); vp[8192] = (bf16_t)(p23 & 0xffffu); vp[12288] = (bf16_t)(p23 >> 16); } __builtin_amdgcn_sched_barrier(0); }
            }
        }
    }
};
struct EpiHg {
    static constexpr bool PERM = true, AFTER_DRAIN = false, PERMA = false;
    unsigned char* R1b; const float* LB;
    __device__ __forceinline__ void operator()(const f32x4 (&acc)[2][2][4][2], const Unit& u, int wr, int wc, int fr, int fq) const {
        const int region = u.pn >> 2, row0 = u.pm * 256 + wr * 64 + fr, cc0 = (u.pn & 3) * 256 + wc * 32 + 8 * fq;
        if (region == 1) {
#pragma unroll
            for (int bj = 0; bj < 2; ++bj) { const int cc = cc0 + bj * 128;
                const f32x4 l0 = *(const f32x4*)(LB + cc), l1 = *(const f32x4*)(LB + cc + 4);
#pragma unroll
                for (int ai = 0; ai < 2; ++ai)
#pragma unroll
                    for (int m = 0; m < 4; ++m) { float* fp = (float*)(R1b + 32 * MiB) + (unsigned)((row0 + ai * 128 + m * 16) * 1024 + cc);
                        f32x4 v0 = acc[ai][bj][m][0], v1 = acc[ai][bj][m][1];
                        v0 = l0 + (1.f - l0) * sigmoid4(v0); v1 = l1 + (1.f - l1) * sigmoid4(v1);
                        *(f32x4*)fp = v0; *(f32x4*)(fp + 4) = v1; __builtin_amdgcn_sched_barrier(0); } }
        } else {
            bf16_t* base = (bf16_t*)(R1b + (region == 0 ? (size_t)0 : (region == 2 ? 96 * MiB : 128 * MiB)));
#pragma unroll
            for (int ai = 0; ai < 2; ++ai)
#pragma unroll
                for (int m = 0; m < 4; ++m) { bf16_t* rowp = base + (unsigned)((row0 + ai * 128 + m * 16) * 1024 + cc0);
#pragma unroll
                    for (int bj = 0; bj < 2; ++bj) { f32x4 v0 = acc[ai][bj][m][0], v1 = acc[ai][bj][m][1];
                        if (region == 3) { v0 = v0 * sigmoid4(v0); v1 = v1 * sigmoid4(v1); }
                        u32x4 o = {pk2(v0[0], v0[1]), pk2(v0[2], v0[3]), pk2(v1[0], v1[1]), pk2(v1[2], v1[3])};
                        *(u32x4*)(rowp + bj * 128) = o; } }
        }
    }
};

struct EpiFFN {
    static constexpr bool PERM = true, AFTER_DRAIN = false, PERMA = true;
    bf16_t* ACT; const bf16_t* CWB;
    __device__ __forceinline__ static f32x4 shr1(const f32x4 v) { f32x4 r;
#pragma unroll
        for (int e = 0; e < 4; ++e) r[e] = __int_as_float(__builtin_amdgcn_update_dpp(0, __float_as_int(v[e]), 0x111, 0xf, 0xf, true));
        return r; }
    template <bool SPECIAL> __device__ __forceinline__ void group(const f32x4 (&acc)[2][2][4][2], int ai, int n, int tok0, int fr, int fcol,
            const f32x4 wg0, const f32x4 wg1, const f32x4 wg2, const f32x4 bg, const f32x4 wv0, const f32x4 wv1, const f32x4 wv2, const f32x4 bv) const {
        const f32x4 sg3 = shr1(acc[ai][0][3][n]), sg2 = shr1(acc[ai][0][2][n]), sv3 = shr1(acc[ai][1][3][n]), sv2 = shr1(acc[ai][1][2][n]);
#pragma unroll
        for (int m = 0; m < 4; ++m) {
            const f32x4 cg = acc[ai][0][m][n], cv = acc[ai][1][m][n];
            f32x4 p1g = m == 0 ? sg3 : acc[ai][0][m == 0 ? 0 : m - 1][n], p1v = m == 0 ? sv3 : acc[ai][1][m == 0 ? 0 : m - 1][n];
            f32x4 p2g = m == 0 ? sg2 : (m == 1 ? sg3 : acc[ai][0][m < 2 ? 0 : m - 2][n]), p2v = m == 0 ? sv2 : (m == 1 ? sv3 : acc[ai][1][m < 2 ? 0 : m - 2][n]);
            const int tok = tok0 + 4 * fr + m;
            if (SPECIAL) { const int sq = tok & 4095; const f32x4 z4 = {0.f, 0.f, 0.f, 0.f}; if (sq == 0) { p1g = z4; p1v = z4; } if (sq <= 1) { p2g = z4; p2v = z4; } }
            const f32x4 yg = bg + wg0 * p2g + wg1 * p1g + wg2 * cg, yv = bv + wv0 * p2v + wv1 * p1v + wv2 * cv;
            const f32x4 ex = yg * -1.4426950408889634f; f32x4 sg;
#pragma unroll
            for (int e = 0; e < 4; ++e) sg[e] = __builtin_amdgcn_rcpf(1.f + __builtin_amdgcn_exp2f(ex[e]));
            const f32x4 o = yg * sg * yv;
            if ((m >= 2 || fr > 0) && tok < T) { u32x2 ov = {pk2(o[0], o[1]), pk2(o[2], o[3])}; *(u32x2*)(ACT + (unsigned)(tok * 2816 + fcol)) = ov; }
        }
    }
    __device__ __forceinline__ void operator()(const f32x4 (&acc)[2][2][4][2], const Unit& u, int wr, int wc, int fr, int fq) const {
        const int fcol0 = u.pn * 128 + wc * 32 + 8 * fq;
        u32x4 tw[8];
#pragma unroll
        for (int i = 0; i < 8; ++i) tw[i] = *(const u32x4*)(CWB + (unsigned)((fcol0 + i) * 8));
#pragma unroll
        for (int n = 0; n < 2; ++n) {
            const int fcol = fcol0 + 4 * n;
            f32x4 wg0, wg1, wg2, bg, wv0, wv1, wv2, bv;
#pragma unroll
            for (int e = 0; e < 4; ++e) { const u32x4 t = tw[4 * n + e]; wg0[e] = bflo(t[0]); wg1[e] = bfhi(t[0]); wg2[e] = bflo(t[1]); bg[e] = bfhi(t[1]); wv0[e] = bflo(t[2]); wv1[e] = bfhi(t[2]); wv2[e] = bflo(t[3]); bv[e] = bfhi(t[3]); }
#pragma unroll
            for (int ai = 0; ai < 2; ++ai) {
                const int b0 = u.pm * 248 + (2 * ai + wr) * 62;
                const bool special = (((b0 + 61) >> 12) << 12) >= b0 - 1;
                if (special) group<true>(acc, ai, n, b0 - 2, fr, fcol, wg0, wg1, wg2, bg, wv0, wv1, wv2, bv);
                else group<false>(acc, ai, n, b0 - 2, fr, fcol, wg0, wg1, wg2, bg, wv0, wv1, wv2, bv);
                __builtin_amdgcn_sched_barrier(0);
            }
        }
    }
};

template <class Epi> __device__ __forceinline__ void run_gemm(const int s_wv, ldsp lds, const bf16_t* A, const bf16_t* Bt, int M, int N, int K, const Epi& E) {
    pg8::Gemm g{A, Bt, M, N, K}; pg8::StaticOrder S; S.init(M, N, (int)gridDim.x, obid());
    pg8::gemm_phase<Epi, pg8::StaticOrder, false>(s_wv, lds, g, S, E, nullptr);
}

__device__ __forceinline__ int rope_rowmap(int n) { const int head = n / 192, d = n - head * 192; if (d < 128) return n; const int r = d - 128, half = r >> 5, j = r & 31; return head * 192 + 128 + (j >> 4) * 32 + half * 16 + (j & 15); }
__device__ __forceinline__ int ffn_rowmap(int n) { const int half = n >= 2816 ? 1 : 0, f = n - half * 2816, t = f >> 7, i = f & 127; return t * 256 + half * 128 + i; }
struct TrJob { const float* src; int srcN, K, N; bf16_t* dst; int dstK, koff, rowoff, pmode; };
__device__ __forceinline__ void run_trjob(const int s_wv, const TrJob J, ldsp lds, const int wg0 = 0, const int nwg = 0) {
    const int tid = otid(), lane = tid & 63, wave = tid >> 6;
    LAS float* sm = (LAS float*)(lds + wave * 8448);
    const int nkt = J.K / 32, nnt = J.N / 64, ntile = nkt * nnt;
    const int nw_ = nwg ? nwg : (int)gridDim.x;
    for (int t = (obid() - wg0) * 8 + wave; t < ntile; t += nw_ * 8) { const int kt = t % nkt, nt = t / nkt;
        const float* sp = J.src + (size_t)(kt * 32) * J.srcN + nt * 64 + lane;
        float v[32];
#pragma unroll
        for (int k = 0; k < 32; ++k) v[k] = sp[(size_t)k * J.srcN];
#pragma unroll
        for (int k = 0; k < 32; ++k) sm[lane * 33 + k] = v[k];
        const int kk = (lane & 15) * 2, nr = lane >> 4;
#pragma unroll
        for (int j = 0; j < 16; ++j) { const int n = nr + 4 * j, sn = nt * 64 + n, drow = J.rowoff + (J.pmode == 1 ? rope_rowmap(sn) : (J.pmode == 2 ? ffn_rowmap(sn) : sn));
            *(unsigned*)(J.dst + (size_t)drow * J.dstK + J.koff + kt * 32 + kk) = pk2(sm[n * 33 + kk], sm[n * 33 + kk + 1]); }
    }
}
__device__ __forceinline__ void zero_fill(bf16_t* dst, int rows, int cols8, int stride, int gtid, int gthreads) {
    const int n = rows * cols8; unsigned zz = 0u; asm volatile("" : "+v"(zz)); const u32x4 z = {zz, zz, zz, zz};
    for (int i = gtid; i < n; i += gthreads) { const int r = i / cols8, c = i - r * cols8; *(u32x4*)(dst + (size_t)r * stride + c * 8) = z; }
}
__device__ __forceinline__ void prep_ffn(const int s_wv, KP p, int layer, ldsp lds, const int wg0, const int nwg) {
    bf16_t* WT = (bf16_t*)(p->ws + OFF_WT);
    const TrJob J0{p->in[23] + (size_t)layer * 1024 * 5632, 5632, 1024, 5632, WT + WT_FUP, 1024, 0, 0, 2};
    const TrJob J1{p->in[26] + (size_t)layer * 2816 * 1024, 1024, 2816, 1024, WT + WT_FDN, 2816, 0, 0, 0};
    run_trjob(s_wv, J0, lds, wg0, nwg); run_trjob(s_wv, J1, lds, wg0, nwg);
}
__device__ __forceinline__ void prep_layer(const int s_wv, KP p, int layer, ldsp lds, const bool with_ffn = true) {
    bf16_t* WT = (bf16_t*)(p->ws + OFF_WT); const int kind = layer % 3, j = layer / 3;
    const int gtid = obid() * NTHREADS + otid(), gthreads = gridDim.x * NTHREADS;
    if (with_ffn) { const TrJob J0{p->in[23] + (size_t)layer * 1024 * 5632, 5632, 1024, 5632, WT + WT_FUP, 1024, 0, 0, 2};
      const TrJob J1{p->in[26] + (size_t)layer * 2816 * 1024, 1024, 2816, 1024, WT + WT_FDN, 2816, 0, 0, 0};
      run_trjob(s_wv, J0, lds); run_trjob(s_wv, J1, lds); }
    if (kind == 0) {
        const TrJob J0{p->in[7] + (size_t)j * 1024 * 4096, 4096, 1024, 4096, WT + WT_MIXA, 1024, 0, 0, 0};
        const TrJob J1{p->in[12] + (size_t)j * 2048 * 1024, 1024, 2048, 1024, WT + WT_MIXB, 2048, 0, 0, 0};
        run_trjob(s_wv, J0, lds); run_trjob(s_wv, J1, lds);
    } else if (kind == 1) {
        const TrJob J0{p->in[13], 448, 1024, 448, WT + WT_MIXA, 1024, 0, 0, 0};
        const TrJob J1{p->in[16], 1536, 256, 1536, WT + WT_MQKV, 256, 0, 0, 1};
        const TrJob J2{p->in[17], 2048, 128, 2048, WT + WT_MQKV + 393216, 256, 0, 0, 0};
        const TrJob J3{p->in[18], 1024, 1024, 1024, WT + WT_MIXB, 1024, 0, 0, 0};
        run_trjob(s_wv, J0, lds); run_trjob(s_wv, J1, lds); run_trjob(s_wv, J2, lds); run_trjob(s_wv, J3, lds);
        zero_fill(WT + WT_MIXA + (size_t)448 * 1024, 64, 128, 1024, gtid, gthreads);
        zero_fill(WT + WT_MQKV + 393216 + 128, 2048, 16, 256, gtid, gthreads);
    } else {
        const TrJob J0{p->in[20], 4096, 1024, 4096, WT + WT_MIXA, 1024, 0, 0, 0};
        const TrJob J1{p->in[22], 1024, 1024, 1024, WT + WT_MIXB, 1024, 0, 0, 0};
        run_trjob(s_wv, J0, lds); run_trjob(s_wv, J1, lds);
    }
}
__device__ __forceinline__ void phase_prologue(const int s_wv, KP p, ldsp lds) {
    const int tid = otid();
    float* MOD = (float*)(p->ws + OFF_MOD);
    LAS float* cact = (LAS float*)lds;
    LAS float* red = (LAS float*)(lds + 16384);
    for (int i = tid; i < 4096; i += NTHREADS) { const float c = p->in[1][i]; cact[i] = c * fast_sigmoid(c); }
    __syncthreads();
    const int l16 = tid & 15, kg = tid >> 4;
    for (int item = obid(); item < 4 * 96; item += gridDim.x) {
        const int layer = item / 96, n0 = (item % 96) * 64;
        const float* w = p->in[3] + (size_t)layer * 1024 * 6144 + n0 + 4 * l16;
        f32x4 a[4] = {{0.f, 0.f, 0.f, 0.f}, {0.f, 0.f, 0.f, 0.f}, {0.f, 0.f, 0.f, 0.f}, {0.f, 0.f, 0.f, 0.f}};
#pragma unroll 8
        for (int kk = 0; kk < 32; ++kk) { const int k = kg * 32 + kk; const f32x4 wv = *(const f32x4*)(w + (size_t)k * 6144);
#pragma unroll
            for (int b = 0; b < 4; ++b) a[b] = a[b] + wv * cact[b * 1024 + k]; }
#pragma unroll
        for (int b = 0; b < 4; ++b) *(LAS f32x4*)(red + (kg * 4 + b) * 64 + 4 * l16) = a[b];
        __syncthreads();
        if (tid < 256) { const int b = tid >> 6, col = tid & 63; float s = 0.f;
#pragma unroll 8
            for (int g = 0; g < 32; ++g) s += red[(g * 4 + b) * 64 + col];
            MOD[(size_t)(layer * 4 + b) * 6144 + n0 + col] = s + p->in[4][(size_t)layer * 6144 + n0 + col]; }
        __syncthreads();
    }
    const int gtid = obid() * NTHREADS + tid, gthreads = gridDim.x * NTHREADS;
    float* CSC = (float*)(p->ws + OFF_CSC); float* CSS = (float*)(p->ws + OFF_CSS);
    const int* pos = (const int*)p->in[2];
    for (int i = gtid; i < T * 32; i += gthreads) { const int t = i >> 5, jj = i & 31;
        const float invf = exp2f(-(float)jj * (13.287712379549449f / 32.f));
        const float ang = (float)pos[t] * invf;
        double rev = (double)ang * 0.15915494309189535; rev -= floor(rev);
        const float rf = (float)rev;
        CSC[i] = __builtin_amdgcn_cosf(rf); CSS[i] = __builtin_amdgcn_sinf(rf); }
    float* LB = (float*)(p->ws + OFF_LB);
    for (int i = gtid; i < 1024; i += gthreads) { const float l0 = p->in[19][i], l1 = p->in[19][1024 + i], l2 = p->in[19][2048 + i], l3 = p->in[19][3072 + i];
        const float mx = fmaxf(fmaxf(l0, l1), fmaxf(l2, l3)); const float e0 = __expf(l0 - mx), e1 = __expf(l1 - mx), e2 = __expf(l2 - mx), e3 = __expf(l3 - mx);
        LB[i] = (e1 + e2) / (e0 + e1 + e2 + e3); }
    prep_layer(s_wv, p, 0, lds);
}
__device__ __forceinline__ void up8(const u32x4 v, float (&o)[8]) { o[0] = bflo(v[0]); o[1] = bfhi(v[0]); o[2] = bflo(v[1]); o[3] = bfhi(v[1]); o[4] = bflo(v[2]); o[5] = bfhi(v[2]); o[6] = bflo(v[3]); o[7] = bfhi(v[3]); }
template <bool SRC32> __device__ __forceinline__ void phase_norm(const int s_wv, const float* X32, bf16_t* XB, const float* g, const float* shift, const float* scale, bf16_t* dst) {
    const int lane = otid() & 63, wave = otid() >> 6;
    for (int rb = obid() * 8 + wave; rb < T / 8; rb += gridDim.x * 8) {
        const int r0 = rb * 8, b = r0 >> 12;
        float G[16], SH[16];
#pragma unroll
        for (int j = 0; j < 2; ++j)
#pragma unroll
            for (int h = 0; h < 2; ++h) { const int c = 8 * lane + 512 * j + 4 * h; const f32x4 gg = *(const f32x4*)(g + c), sc = *(const f32x4*)(scale + (size_t)b * 6144 + c), sh = *(const f32x4*)(shift + (size_t)b * 6144 + c);
#pragma unroll
                for (int e = 0; e < 4; ++e) { G[j * 8 + h * 4 + e] = gg[e] * (sc[e] + 1.f); SH[j * 8 + h * 4 + e] = sh[e]; } }
        for (int r = r0; r < r0 + 8; ++r) {
            float x[16]; float ss = 0.f;
#pragma unroll
            for (int j = 0; j < 2; ++j) { const unsigned off = (unsigned)(r * 1024 + 8 * lane + 512 * j);
                if (SRC32) { const f32x4 a = *(const f32x4*)(X32 + off), c = *(const f32x4*)(X32 + off + 4);
#pragma unroll
                    for (int e = 0; e < 4; ++e) { x[j * 8 + e] = a[e]; x[j * 8 + 4 + e] = c[e]; }
                    u32x4 xo = {pk2(a[0], a[1]), pk2(a[2], a[3]), pk2(c[0], c[1]), pk2(c[2], c[3])}; *(u32x4*)(XB + off) = xo;
                } else { float t[8]; up8(*(const u32x4*)(XB + off), t);
#pragma unroll
                    for (int e = 0; e < 8; ++e) x[j * 8 + e] = t[e]; } }
#pragma unroll
            for (int e = 0; e < 16; ++e) ss += x[e] * x[e];
            ss = wave_sum(ss, lane); const float rstd = rsqrtf(ss * (1.f / 1024.f) + EPS);
#pragma unroll
            for (int j = 0; j < 2; ++j) { float h[8];
#pragma unroll
                for (int e = 0; e < 8; ++e) h[e] = x[j * 8 + e] * rstd * G[j * 8 + e] + SH[j * 8 + e];
                u32x4 o = {pk2(h[0], h[1]), pk2(h[2], h[3]), pk2(h[4], h[5]), pk2(h[6], h[7])}; *(u32x4*)(dst + (unsigned)(r * 1024 + 8 * lane + 512 * j)) = o; }
        }
    }
}
__device__ __forceinline__ void phase_final(const int s_wv, const bf16_t* XB, float* out, const float* g) {
    const int lane = otid() & 63, wave = otid() >> 6;
    for (int r = obid() * 8 + wave; r < T; r += gridDim.x * 8) {
        float x[16]; float ss = 0.f;
#pragma unroll
        for (int j = 0; j < 2; ++j) { float t[8]; up8(*(const u32x4*)(XB + (unsigned)(r * 1024 + 8 * lane + 512 * j)), t);
#pragma unroll
            for (int e = 0; e < 8; ++e) { x[j * 8 + e] = t[e]; ss += t[e] * t[e]; } }
        ss = wave_sum(ss, lane); const float rstd = rsqrtf(ss * (1.f / 1024.f) + EPS);
#pragma unroll
        for (int j = 0; j < 2; ++j)
#pragma unroll
            for (int h = 0; h < 2; ++h) { const int c = 8 * lane + 512 * j + 4 * h; const f32x4 gg = *(const f32x4*)(g + c);
                f32x4 o = {x[j * 8 + h * 4] * rstd * gg[0], x[j * 8 + h * 4 + 1] * rstd * gg[1], x[j * 8 + h * 4 + 2] * rstd * gg[2], x[j * 8 + h * 4 + 3] * rstd * gg[3]};
                *(f32x4*)(out + (size_t)r * 1024 + c) = o; }
    }
}
__device__ __forceinline__ void phase_ffix(const int s_wv, const bf16_t* SIDE, bf16_t* ACT, const float* cw, const float* cb) {
    const int gtid = obid() * NTHREADS + otid(), gthreads = gridDim.x * NTHREADS;
    for (int q = gtid; q < 256 * 2 * 352; q += gthreads) {
        const int cgp = q % 352, gi = q / 352, i = gi & 1, g = gi >> 1, f0 = cgp * 8;
        const bool first = (g & 63) == 0;
        const bf16_t* own = SIDE + (size_t)((g * 4 + 2 + i) * 2) * 2816 + f0;
        const bf16_t* p1 = i == 0 ? SIDE + (size_t)(((g - 1) * 4 + 1) * 2) * 2816 + f0 : SIDE + (size_t)((g * 4 + 2) * 2) * 2816 + f0;
        const bf16_t* p2 = i == 0 ? SIDE + (size_t)(((g - 1) * 4 + 0) * 2) * 2816 + f0 : SIDE + (size_t)(((g - 1) * 4 + 1) * 2) * 2816 + f0;
        float gc[8], vc[8], g1[8], v1[8], g2[8], v2[8];
        up8(*(const u32x4*)own, gc); up8(*(const u32x4*)(own + 2816), vc);
        if (i == 1 || !first) { up8(*(const u32x4*)p1, g1); up8(*(const u32x4*)(p1 + 2816), v1); } else {
#pragma unroll
            for (int e = 0; e < 8; ++e) { g1[e] = 0.f; v1[e] = 0.f; } }
        if (!first) { up8(*(const u32x4*)p2, g2); up8(*(const u32x4*)(p2 + 2816), v2); } else {
#pragma unroll
            for (int e = 0; e < 8; ++e) { g2[e] = 0.f; v2[e] = 0.f; } }
        float o[8];
#pragma unroll
        for (int e = 0; e < 8; ++e) { const int f = f0 + e;
            const float yg = cb[f] + cw[f] * g2[e] + cw[5632 + f] * g1[e] + cw[11264 + f] * gc[e], yv = cb[2816 + f] + cw[2816 + f] * v2[e] + cw[5632 + 2816 + f] * v1[e] + cw[11264 + 2816 + f] * vc[e];
            o[e] = yg * fast_sigmoid(yg) * yv; }
        u32x4 ov = {pk2(o[0], o[1]), pk2(o[2], o[3]), pk2(o[4], o[5]), pk2(o[6], o[7])};
        *(u32x4*)(ACT + (size_t)(g * 64 + i) * 2816 + f0) = ov;
    }
}

__device__ __forceinline__ void phase_gsp(const int s_wv, KP p, int j, ldsp lds) {
    const bf16_t* Z = (const bf16_t*)(p->ws + OFF_R1); bf16_t* Y = (bf16_t*)(p->ws + OFF_R2);
    const float* ws_w = p->in[10] + (size_t)j * 8 * 128 * 128; const float* bs = p->in[11] + (size_t)j * 8 * 128;
    const float* lng = p->in[8] + (size_t)j * 2048; const float* lnb = p->in[9] + (size_t)j * 2048;
    const int tid = otid(), lane = tid & 63, wave = tid >> 6, l15 = lane & 15, g4 = lane >> 4;
    ldsp As = lds, Bs = lds + 34816; LAS float* mu = (LAS float*)(lds + 104448); LAS float* rs = mu + 128;
    for (int unit = obid(); unit < 256; unit += gridDim.x) {
        const int gh = unit & 1, chunk = unit >> 1, t0 = chunk * 128;
        for (int rr = 0; rr < 16; ++rr) { const int r = wave * 16 + rr; const bf16_t* zp = Z + (size_t)(t0 + r) * 4096 + 2048 + lane * 32; float s = 0.f, s2 = 0.f;
#pragma unroll
            for (int i = 0; i < 4; ++i) { float v[8]; up8(*(const u32x4*)(zp + 8 * i), v);
#pragma unroll
                for (int e = 0; e < 8; ++e) { s += v[e]; s2 += v[e] * v[e]; } }
            s = wave_sum(s, lane); s2 = wave_sum(s2, lane);
            if (lane == 0) { const float m = s * (1.f / 2048.f); float var = s2 * (1.f / 2048.f) - m * m; var = fmaxf(var, 0.f); mu[r] = m; rs[r] = rsqrtf(var + EPS); } }
        __syncthreads();
        for (int gi = 0; gi < 4; ++gi) {
            const int g = gh * 4 + gi;
#pragma unroll 2
            for (int i = 0; i < 8; ++i) { const int idx = tid + 512 * i, t = idx >> 5, s4 = (idx & 31) * 4; f32x4 w = *(const f32x4*)(ws_w + (size_t)g * 16384 + t * 128 + s4);
#pragma unroll
                for (int e = 0; e < 4; ++e) w[e] = (s4 + e <= t) ? w[e] : 0.f;
                u32x2 o = {pk2(w[0], w[1]), pk2(w[2], w[3])}; *(LAS u32x2*)(As + t * 272 + s4 * 2) = o; }
#pragma unroll 2
            for (int i = 0; i < 8; ++i) { const int idx = tid + 512 * i, s = idx >> 5, c8 = idx & 31; float v[8]; up8(*(const u32x4*)(Z + (size_t)(t0 + s) * 4096 + 2048 + g * 256 + c8 * 8), v);
                const float m = mu[s], r = rs[s]; const f32x4 ga = *(const f32x4*)(lng + g * 256 + c8 * 8), gb = *(const f32x4*)(lng + g * 256 + c8 * 8 + 4), ba = *(const f32x4*)(lnb + g * 256 + c8 * 8), bb = *(const f32x4*)(lnb + g * 256 + c8 * 8 + 4);
                const int boff = (((s >> 3) ^ (c8 & 15)) << 4) + (s & 7) * 2;
#pragma unroll
                for (int e = 0; e < 8; ++e) { const float gg = e < 4 ? ga[e] : gb[e - 4], bbv = e < 4 ? ba[e] : bb[e - 4]; const float val = (v[e] - m) * r * gg + bbv;
                    *(LAS bf16_t*)(Bs + (c8 * 8 + e) * 272 + boff) = (bf16_t)(pk2(val, 0.f) & 0xffffu); } }
            __syncthreads();
            f32x4 acc[8][2];
#pragma unroll
            for (int tt = 0; tt < 8; ++tt) { acc[tt][0] = zero4(); acc[tt][1] = zero4(); }
#pragma unroll
            for (int tt = 0; tt < 8; ++tt)
#pragma unroll
                for (int ks = 0; ks <= tt / 2; ++ks) { const bf16x8 yf = *(const LAS bf16x8*)(As + (16 * tt + l15) * 272 + (32 * ks + 8 * g4) * 2);
#pragma unroll
                    for (int ct = 0; ct < 2; ++ct) { const int c = 32 * wave + 16 * ct + l15; const bf16x8 xf = *(const LAS bf16x8*)(Bs + c * 272 + (((4 * ks + g4) ^ ((c >> 3) & 15)) << 4));
                        acc[tt][ct] = MFMA16(xf, yf, acc[tt][ct]); } }
#pragma unroll
            for (int tt = 0; tt < 8; ++tt) { const int t = 16 * tt + l15; const float bias = bs[g * 128 + t];
#pragma unroll
                for (int ct = 0; ct < 2; ++ct) { const int c = g * 256 + 32 * wave + 16 * ct + 4 * g4; const u32x2 uu = *(const u32x2*)(Z + (size_t)(t0 + t) * 4096 + c);
                    const f32x4 a = acc[tt][ct]; u32x2 o = {pk2(bflo(uu[0]) * (a[0] + bias), bfhi(uu[0]) * (a[1] + bias)), pk2(bflo(uu[1]) * (a[2] + bias), bfhi(uu[1]) * (a[3] + bias))};
                    *(u32x2*)(Y + (size_t)(t0 + t) * 2048 + c) = o; } }
            __syncthreads();
        }
    }
}

__device__ __forceinline__ void phase_m2(const int s_wv, KP p) {
    const float* A1 = (const float*)(p->ws + OFF_R1); bf16_t* CQN = (bf16_t*)(p->ws + OFF_R1 + 32 * MiB); bf16_t* CKVN = (bf16_t*)(p->ws + OFF_R1 + 40 * MiB); bf16_t* KF = (bf16_t*)(p->ws + OFF_R1 + 96 * MiB);
    const float* CSC = (const float*)(p->ws + OFF_CSC); const float* CSS = (const float*)(p->ws + OFF_CSS);
    const int lane = otid() & 63, wave = otid() >> 6;
    const f32x4 qg = *(const f32x4*)(p->in[14] + 4 * lane); const f32x4 kg = *(const f32x4*)(p->in[15] + 4 * (lane & 31));
    for (int r = obid() * 8 + wave; r < T; r += gridDim.x * 8) {
        const float* a = A1 + (size_t)r * 512;
        const f32x4 cq = *(const f32x4*)(a + 4 * lane); float ss = wave_sum(cq[0] * cq[0] + cq[1] * cq[1] + cq[2] * cq[2] + cq[3] * cq[3], lane);
        const float rq = rsqrtf(ss * (1.f / 256.f) + EPS);
        { const f32x4 h = cq * rq * qg; u32x2 o = {pk2(h[0], h[1]), pk2(h[2], h[3])}; *(u32x2*)(CQN + (size_t)r * 256 + 4 * lane) = o; }
        const f32x4 ck = *(const f32x4*)(a + 256 + 4 * (lane & 31)); float s2 = lane < 32 ? (ck[0] * ck[0] + ck[1] * ck[1] + ck[2] * ck[2] + ck[3] * ck[3]) : 0.f; s2 = wave_sum(s2, lane);
        const float rk = rsqrtf(s2 * (1.f / 128.f) + EPS);
        { const f32x4 h = ck * rk * kg; u32x2 o = {pk2(h[0], h[1]), pk2(h[2], h[3])}; if (lane >= 32) { o[0] = 0u; o[1] = 0u; } *(u32x2*)(CKVN + (size_t)r * 256 + 4 * lane) = o; }
        if (lane < 32) {
            const float x1 = a[384 + lane], x2 = a[416 + lane], c = CSC[(size_t)r * 32 + lane], s = CSS[(size_t)r * 32 + lane];
            const unsigned pr = pk2(x1 * c - x2 * s, x2 * c + x1 * s); const int b = r >> 12, sq = r & 4095;
#pragma unroll
            for (int h8 = 0; h8 < 8; ++h8) { bf16_t* kp = KF + ((size_t)((b * 8 + h8) * 4096 + sq)) * 192 + 128 + lane; kp[0] = (bf16_t)(pr & 0xffffu); kp[32] = (bf16_t)(pr >> 16); } }
    }
}

__device__ __forceinline__ void phase_attn(const int s_wv, KP p, ldsp lds) {
    const bf16_t* QF = (const bf16_t*)(p->ws + OFF_R1 + 48 * MiB); const bf16_t* KF = (const bf16_t*)(p->ws + OFF_R1 + 96 * MiB); const bf16_t* VT = (const bf16_t*)(p->ws + OFF_R1 + 144 * MiB);
    bf16_t* O = (bf16_t*)(p->ws + OFF_R2);
    const int tid = otid(), lane = tid & 63, wave = __builtin_amdgcn_readfirstlane(tid >> 6), l15 = lane & 15, g4 = lane >> 4;
    const int G = gridDim.x, bx = obid(), vcu = (G % 8 == 0) ? (bx % 8) * (G / 8) + bx / 8 : bx;
    constexpr int KB = 25600, VB = 18432, BUF = KB + VB;
    for (int unit = vcu; unit < 256; unit += G) {
        const int bh = unit >> 3, pr = unit & 7, b = bh >> 3, h = bh & 7;
        const unsigned char* kbase = (const unsigned char*)(KF + (size_t)bh * 4096 * 192);
        const unsigned char* vbase = (const unsigned char*)(VT + (size_t)bh * 128 * 4096);
        for (int half = 0; half < 2; ++half) {
            const int qb = half == 0 ? 15 - pr : pr, ntile = 4 * qb + 4;
            const int qrow0 = qb * 256 + 32 * wave;
            bf16x8 Qf[2][6];
#pragma unroll
            for (int qt = 0; qt < 2; ++qt)
#pragma unroll
                for (int ks = 0; ks < 6; ++ks) Qf[qt][ks] = *(const bf16x8*)((const unsigned char*)(QF + (size_t)(bh * 4096 + qrow0) * 192) + (unsigned)(((16 * qt + l15) * 192 + 32 * ks + 8 * g4) * 2));
            f32x4 Oa[2][8]; float mrun[2] = {-1e30f, -1e30f}, lsum[2] = {0.f, 0.f};
#pragma unroll
            for (int qt = 0; qt < 2; ++qt)
#pragma unroll
                for (int d = 0; d < 8; ++d) Oa[qt][d] = zero4();
#define ATT_DMA(j, bufi) do { ldsp kb_ = lds + (bufi) * BUF; \
                for (int c = wave; c < 25; c += 8) { const int q_ = c * 64 + lane, row = q_ / 25, c16 = min(q_ - row * 25, 23); \
                    __builtin_amdgcn_global_load_lds((const unsigned*)(kbase + (size_t)(j) * 24576 + (unsigned)(row * 384 + c16 * 16)), (LAS unsigned*)(kb_ + c * 1024), 16, 0, 0); } \
                for (int c = wave; c < 18; c += 8) { const int q_ = c * 64 + lane, dv = q_ / 9, k8 = min(q_ - dv * 9, 7); \
                    __builtin_amdgcn_global_load_lds((const unsigned*)(vbase + (size_t)(j) * 128 + (unsigned)(dv * 8192 + k8 * 16)), (LAS unsigned*)(kb_ + KB + c * 1024), 16, 0, 0); } } while (0)
            ATT_DMA(0, 0); asm volatile("s_waitcnt vmcnt(0)" ::: "memory"); __syncthreads();
#pragma unroll 1
            for (int j = 0; j < ntile; ++j) {
                if (j + 1 < ntile) ATT_DMA(j + 1, (j + 1) & 1);
                if (wave >= 4) __builtin_amdgcn_s_sleep(8);
                const int jj = j - 4 * qb; const bool diag = jj >= 0; const bool active = !(diag && 64 * jj > 32 * wave + 31);
                ldsp Kb = lds + (j & 1) * BUF; ldsp Vb = Kb + KB;
#pragma unroll
                for (int hs = 0; hs < 2; ++hs) {
                    if (active) {
                        f32x4 S[2][2];
#pragma unroll
                        for (int qt = 0; qt < 2; ++qt) { S[qt][0] = zero4(); S[qt][1] = zero4(); }
                        {
#define ATT_KLD(i) (*(const LAS bf16x8*)(Kb + (16 * (2 * hs + ((i) & 1)) + l15) * 400 + (32 * ((i) >> 1) + 8 * g4) * 2))
                            bf16x8 kq[3]; kq[0] = ATT_KLD(0); kq[1] = ATT_KLD(1);
#pragma unroll
                            for (int i = 0; i < 12; ++i) { if (i + 2 < 12) kq[(i + 2) % 3] = ATT_KLD(i + 2);
                                __builtin_amdgcn_sched_barrier(0);
                                S[0][i & 1] = MFMA16(kq[i % 3], Qf[0][i >> 1], S[0][i & 1]); S[1][i & 1] = MFMA16(kq[i % 3], Qf[1][i >> 1], S[1][i & 1]);
                                __builtin_amdgcn_sched_barrier(0); }
#undef ATT_KLD
                        }
                        bf16x8 Pf[2];
#pragma unroll
                        for (int qt = 0; qt < 2; ++qt) {
                            if (diag) { int dq = 32 * wave + 16 * qt + l15 - 4 * g4 - 64 * jj; asm volatile("" : "+v"(dq));
#pragma unroll
                                for (int sb = 0; sb < 2; ++sb)
#pragma unroll
                                    for (int e = 0; e < 4; ++e) { if (32 * hs + 16 * sb + e > dq) S[qt][sb][e] = -1e30f; } }
                            float tm = -1e30f;
#pragma unroll
                            for (int sb = 0; sb < 2; ++sb)
#pragma unroll
                                for (int e = 0; e < 4; ++e) tm = fmaxf(tm, S[qt][sb][e]);
                            tm = fmaxf(tm, shx(tm, 16, lane)); tm = fmaxf(tm, shx(tm, 32, lane));
                            if (__builtin_amdgcn_ballot_w64(tm > mrun[qt]) != 0ull) {
                                const float mn = fmaxf(mrun[qt], tm), sc = __builtin_amdgcn_exp2f(mrun[qt] - mn); mrun[qt] = mn; lsum[qt] *= sc;
#pragma unroll
                                for (int d = 0; d < 8; ++d) Oa[qt][d] = Oa[qt][d] * sc; }
                            const float mn = mrun[qt];
                            float ps = 0.f;
#pragma unroll
                            for (int sb = 0; sb < 2; ++sb)
#pragma unroll
                                for (int e = 0; e < 4; ++e) { const float pe = __builtin_amdgcn_exp2f(S[qt][sb][e] - mn); S[qt][sb][e] = pe; ps += pe; }
                            lsum[qt] += ps;
                            Pf[qt] = mk8(pk2(S[qt][0][0], S[qt][0][1]), pk2(S[qt][0][2], S[qt][0][3]), pk2(S[qt][1][0], S[qt][1][1]), pk2(S[qt][1][2], S[qt][1][3]));
                        }
                        {
#define ATT_VLD(d) __builtin_shufflevector(*(const LAS bf16x4*)(Vb + (16 * (d) + l15) * 144 + (32 * hs + 4 * g4) * 2), *(const LAS bf16x4*)(Vb + (16 * (d) + l15) * 144 + (32 * hs + 16 + 4 * g4) * 2), 0, 1, 2, 3, 4, 5, 6, 7)
                            bf16x8 vq[3]; vq[0] = ATT_VLD(0); vq[1] = ATT_VLD(1);
#pragma unroll
                            for (int d = 0; d < 8; ++d) { if (d + 2 < 8) vq[(d + 2) % 3] = ATT_VLD(d + 2);
                                __builtin_amdgcn_sched_barrier(0);
                                Oa[0][d] = MFMA16(vq[d % 3], Pf[0], Oa[0][d]); Oa[1][d] = MFMA16(vq[d % 3], Pf[1], Oa[1][d]);
                                __builtin_amdgcn_sched_barrier(0); }
#undef ATT_VLD
                        }
                    }
                }
                asm volatile("s_waitcnt vmcnt(0)" ::: "memory"); __syncthreads();
            }
#pragma unroll
            for (int qt = 0; qt < 2; ++qt) { float ls = lsum[qt]; ls += shx(ls, 16, lane); ls += shx(ls, 32, lane); const float inv = 1.f / ls;
                bf16_t* op = (bf16_t*)((unsigned char*)(O + (size_t)(b * 4096 + qrow0) * 1024 + h * 128) + (unsigned)(((16 * qt + l15) * 1024 + 4 * g4) * 2));
#pragma unroll
                for (int d = 0; d < 8; ++d) { const f32x4 v = Oa[qt][d] * inv; u32x2 o = {pk2(v[0], v[1]), pk2(v[2], v[3])}; *(u32x2*)(op + 16 * d) = o; } }
        }
    }
#undef ATT_DMA
}

template <bool TOF32> __device__ __forceinline__ void hg_load_f_v(const float* HF, const bf16_t* HV, int t0, int col0, LAS float* BC, LAS float* K1f, ldsp K1b, ldsp VTl, int tid) {
#pragma unroll
    for (int i = 0; i < 4; ++i) { const int idx = tid + 512 * i, s = idx >> 5, k4 = (idx & 31) * 4; const f32x4 f = *(const f32x4*)(HF + (size_t)(t0 + s) * 1024 + col0 + k4);
#pragma unroll
        for (int e = 0; e < 4; ++e) BC[s * 129 + k4 + e] = __logf(f[e]);
        if (TOF32) {
#pragma unroll
            for (int e = 0; e < 4; ++e) K1f[s * 129 + k4 + e] = 1.f - f[e];
        } else { u32x2 o = {pk2(1.f - f[0], 1.f - f[1]), pk2(1.f - f[2], 1.f - f[3])}; *(LAS u32x2*)(K1b + s * 272 + k4 * 2) = o; } }
#pragma unroll
    for (int i = 0; i < 2; ++i) { const int idx = tid + 512 * i, s = idx >> 4, v8 = idx & 15; const u32x4 vv = *(const u32x4*)(HV + (size_t)(t0 + s) * 1024 + col0 + v8 * 8);
#pragma unroll
        for (int e = 0; e < 4; ++e) { *(LAS bf16_t*)(VTl + (v8 * 8 + 2 * e) * 144 + s * 2) = (bf16_t)(vv[e] & 0xffffu); *(LAS bf16_t*)(VTl + (v8 * 8 + 2 * e + 1) * 144 + s * 2) = (bf16_t)(vv[e] >> 16); } }
}
__device__ __forceinline__ void phase_ha(const int s_wv, KP p, ldsp lds) {
    const float* HF = (const float*)(p->ws + OFF_R1 + 32 * MiB); const bf16_t* HV = (const bf16_t*)(p->ws + OFF_R1 + 96 * MiB);
    bf16_t* LCT = (bf16_t*)(p->ws + OFF_R2); float* DEC = (float*)(p->ws + OFF_R2 + 64 * MiB);
    const int tid = otid(), lane = tid & 63, wave = tid >> 6, l15 = lane & 15, g4 = lane >> 4;
    LAS float* BC = (LAS float*)lds; LAS float* K1 = (LAS float*)(lds + 33024); ldsp KT = lds + 66048; ldsp VTl = lds + 84480;
    for (int u = obid(); u < 2048; u += gridDim.x) {
        const int bh = u >> 6, n = u & 63, b = bh >> 3, h = bh & 7, t0 = b * 4096 + n * 64, col0 = h * 128;
        hg_load_f_v<true>(HF, HV, t0, col0, BC, K1, VTl, VTl, tid);
        __syncthreads();
        if (tid < 128) { float run = 0.f;
#pragma unroll 8
            for (int s = 0; s < 64; ++s) { run += BC[s * 129 + tid]; BC[s * 129 + tid] = run; }
            DEC[(size_t)u * 128 + tid] = __expf(run); }
        __syncthreads();
        { const int sp = tid & 31, kk0 = tid >> 5;
#pragma unroll
          for (int it = 0; it < 8; ++it) { const int k = kk0 + 16 * it; const float bl = BC[63 * 129 + k];
              const float a0 = K1[(2 * sp) * 129 + k] * __expf(bl - BC[(2 * sp) * 129 + k]), a1 = K1[(2 * sp + 1) * 129 + k] * __expf(bl - BC[(2 * sp + 1) * 129 + k]);
              *(LAS unsigned*)(KT + k * 144 + sp * 4) = pk2(a0, a1); } }
        __syncthreads();
        f32x4 acc[8];
#pragma unroll
        for (int vt = 0; vt < 8; ++vt) acc[vt] = zero4();
#pragma unroll
        for (int ks = 0; ks < 2; ++ks) { const bf16x8 xf = *(const LAS bf16x8*)(KT + (16 * wave + l15) * 144 + (32 * ks + 8 * g4) * 2);
#pragma unroll
            for (int vt = 0; vt < 8; ++vt) { const bf16x8 yf = *(const LAS bf16x8*)(VTl + (16 * vt + l15) * 144 + (32 * ks + 8 * g4) * 2); acc[vt] = MFMA16(xf, yf, acc[vt]); } }
#pragma unroll
        for (int vt = 0; vt < 8; ++vt) { u32x2 o = {pk2(acc[vt][0], acc[vt][1]), pk2(acc[vt][2], acc[vt][3])}; *(u32x2*)(LCT + ((size_t)u * 128 + 16 * vt + l15) * 128 + 16 * wave + 4 * g4) = o; }
        __syncthreads();
    }
}
__device__ __forceinline__ void phase_hscan(const int s_wv, KP p) {
    bf16_t* LCT = (bf16_t*)(p->ws + OFF_R2); const float* DEC = (const float*)(p->ws + OFF_R2 + 64 * MiB);
    const int gtid = obid() * NTHREADS + otid(), gthreads = gridDim.x * NTHREADS;
    for (int id = gtid; id < 32 * 128 * 32; id += gthreads) {
        const int k4 = id & 31, v = (id >> 5) & 127, bh = id >> 12;
        f32x4 st = zero4();
#pragma unroll 4
        for (int n = 0; n < 64; ++n) { const int u = bh * 64 + n; bf16_t* ptr = LCT + ((size_t)u * 128 + v) * 128 + 4 * k4;
            const u32x2 t = *(const u32x2*)ptr; const f32x4 dec = *(const f32x4*)(DEC + (size_t)u * 128 + 4 * k4);
            u32x2 o = {pk2(st[0], st[1]), pk2(st[2], st[3])}; *(u32x2*)ptr = o;
            st[0] = dec[0] * st[0] + bflo(t[0]); st[1] = dec[1] * st[1] + bfhi(t[0]); st[2] = dec[2] * st[2] + bflo(t[1]); st[3] = dec[3] * st[3] + bfhi(t[1]); }
    }
}
__device__ __forceinline__ void phase_hc(const int s_wv, KP p, ldsp lds) {
    const bf16_t* HQ = (const bf16_t*)(p->ws + OFF_R1); const float* HF = (const float*)(p->ws + OFF_R1 + 32 * MiB); const bf16_t* HV = (const bf16_t*)(p->ws + OFF_R1 + 96 * MiB); const bf16_t* HG = (const bf16_t*)(p->ws + OFF_R1 + 128 * MiB);
    const bf16_t* SST = (const bf16_t*)(p->ws + OFF_R2); bf16_t* O = (bf16_t*)(p->ws + OFF_HB); const float* ng = p->in[21];
    const int tid = otid(), lane = tid & 63, wave = tid >> 6, l15 = lane & 15, g4 = lane >> 4;
    LAS float* BC = (LAS float*)lds; ldsp QT = lds + 33024; ldsp KTl = lds + 50432; ldsp QH = lds + 67840; ldsp VTl = lds + 85248; ldsp AT = lds + 103680; LAS float* SSQ = (LAS float*)(lds + 112896);
    for (int u = obid(); u < 2048; u += gridDim.x) {
        const int bh = u >> 6, n = u & 63, b = bh >> 3, h = bh & 7, t0 = b * 4096 + n * 64, col0 = h * 128;
        hg_load_f_v<false>(HF, HV, t0, col0, BC, BC, KTl, VTl, tid);
        u32x4 qraw[2];
#pragma unroll
        for (int i = 0; i < 2; ++i) { const int idx = tid + 512 * i, s = idx >> 4, k8 = idx & 15; qraw[i] = *(const u32x4*)(HQ + (size_t)(t0 + s) * 1024 + col0 + k8 * 8); }
        __syncthreads();
        if (tid < 128) { float run = 0.f;
#pragma unroll 8
            for (int s = 0; s < 64; ++s) { run += BC[s * 129 + tid]; BC[s * 129 + tid] = run; } }
        __syncthreads();
#pragma unroll
        for (int i = 0; i < 2; ++i) { const int idx = tid + 512 * i, s = idx >> 4, k8 = idx & 15; float q[8], kk[8], qt[8], qh[8]; up8(qraw[i], q); up8(*(const LAS u32x4*)(KTl + s * 272 + k8 * 16), kk);
#pragma unroll
            for (int e = 0; e < 8; ++e) { const int k = k8 * 8 + e; const float bc = BC[s * 129 + k], bm = BC[31 * 129 + k]; qt[e] = q[e] * __expf(bc - bm); qh[e] = q[e] * __expf(bc); kk[e] = kk[e] * __expf(bm - bc); }
            u32x4 o1 = {pk2(qt[0], qt[1]), pk2(qt[2], qt[3]), pk2(qt[4], qt[5]), pk2(qt[6], qt[7])}, o2 = {pk2(qh[0], qh[1]), pk2(qh[2], qh[3]), pk2(qh[4], qh[5]), pk2(qh[6], qh[7])}, o3 = {pk2(kk[0], kk[1]), pk2(kk[2], kk[3]), pk2(kk[4], kk[5]), pk2(kk[6], kk[7])};
            *(LAS u32x4*)(QT + s * 272 + k8 * 16) = o1; *(LAS u32x4*)(QH + s * 272 + k8 * 16) = o2; *(LAS u32x4*)(KTl + s * 272 + k8 * 16) = o3; }
        __syncthreads();
        { const int st = wave & 3;
#pragma unroll
          for (int ti = 0; ti < 2; ++ti) { const int tt = 2 * (wave >> 2) + ti; f32x4 a = zero4();
              if (st <= tt) {
#pragma unroll
                  for (int ks = 0; ks < 4; ++ks) { const bf16x8 xf = *(const LAS bf16x8*)(KTl + (16 * st + l15) * 272 + (32 * ks + 8 * g4) * 2), yf = *(const LAS bf16x8*)(QT + (16 * tt + l15) * 272 + (32 * ks + 8 * g4) * 2); a = MFMA16(xf, yf, a); }
                  const int t = 16 * tt + l15;
#pragma unroll
                  for (int e = 0; e < 4; ++e) { const int s = 16 * st + 4 * g4 + e; if (s > t) a[e] = 0.f; } }
              u32x2 o = {pk2(a[0], a[1]), pk2(a[2], a[3])}; *(LAS u32x2*)(AT + (16 * tt + l15) * 144 + (16 * st + 4 * g4) * 2) = o; } }
        __syncthreads();
        { const int tt = wave >> 1, vh = wave & 1; f32x4 acc[4];
#pragma unroll
          for (int vi = 0; vi < 4; ++vi) acc[vi] = zero4();
#pragma unroll
          for (int ks = 0; ks < 2; ++ks) if (32 * ks <= 16 * tt + 15) { const bf16x8 yf = *(const LAS bf16x8*)(AT + (16 * tt + l15) * 144 + (32 * ks + 8 * g4) * 2);
#pragma unroll
              for (int vi = 0; vi < 4; ++vi) { const bf16x8 xf = *(const LAS bf16x8*)(VTl + (16 * (4 * vh + vi) + l15) * 144 + (32 * ks + 8 * g4) * 2); acc[vi] = MFMA16(xf, yf, acc[vi]); } }
#pragma unroll
          for (int ks = 0; ks < 4; ++ks) { const bf16x8 yf = *(const LAS bf16x8*)(QH + (16 * tt + l15) * 272 + (32 * ks + 8 * g4) * 2);
#pragma unroll
              for (int vi = 0; vi < 4; ++vi) { const bf16x8 xf = *(const bf16x8*)(SST + ((size_t)u * 128 + 16 * (4 * vh + vi) + l15) * 128 + 32 * ks + 8 * g4); acc[vi] = MFMA16(xf, yf, acc[vi]); } }
          float sq = 0.f;
#pragma unroll
          for (int vi = 0; vi < 4; ++vi)
#pragma unroll
              for (int e = 0; e < 4; ++e) sq += acc[vi][e] * acc[vi][e];
          sq += shx(sq, 16, lane); sq += shx(sq, 32, lane);
          if (g4 == 0) SSQ[(16 * tt + l15) * 2 + vh] = sq;
          __syncthreads();
          const int t = 16 * tt + l15; const float rstd = rsqrtf((SSQ[t * 2] + SSQ[t * 2 + 1]) * (1.f / 128.f) + EPS);
#pragma unroll
          for (int vi = 0; vi < 4; ++vi) { const int v = 16 * (4 * vh + vi) + 4 * g4; const f32x4 gn = *(const f32x4*)(ng + v); const u32x2 gg = *(const u32x2*)(HG + (size_t)(t0 + t) * 1024 + col0 + v);
              const f32x4 a = acc[vi] * rstd * gn; u32x2 o = {pk2(a[0] * bflo(gg[0]), a[1] * bfhi(gg[0])), pk2(a[2] * bflo(gg[1]), a[3] * bfhi(gg[1]))};
              *(u32x2*)(O + (size_t)(t0 + t) * 1024 + col0 + v) = o; } }
        __syncthreads();
    }
}

__global__ void __launch_bounds__(NTHREADS, 2) fwd_kernel(Params pk) {
    extern __shared__ __attribute__((aligned(16))) unsigned char smem[];
    ldsp lds = (ldsp)smem;
    const int ph_lo = pk.ph_lo, ph_hi = pk.ph_hi;
    const int s_wv = __builtin_amdgcn_readfirstlane((int)threadIdx.x >> 6);
    if (threadIdx.x < 4) ((LAS unsigned*)(lds + 131072))[threadIdx.x] = 0u;
    __syncthreads();
    XcdBarrier xbar = xcd_barrier_post((unsigned*)(pk.ws + OFF_BAR), (volatile LAS unsigned*)(lds + 131072), (int)threadIdx.x);
    for (int ph = ph_lo; ph < ph_hi; ++ph) {
        KP p = (KP)__builtin_amdgcn_kernarg_segment_ptr();
        asm volatile("" : "+s"(p));
        const int op = p->op[ph], layraw = p->lay[ph], layer = layraw & 3; const bool dummy = (layraw & 4) != 0;
        unsigned char* ws = p->ws; bf16_t* xdst = dummy ? (bf16_t*)(ws + OFF_R1) : (bf16_t*)(ws + OFF_XB);
        float* MOD = (float*)(ws + OFF_MOD); bf16_t* WT = (bf16_t*)(ws + OFF_WT); bf16_t* HB = (bf16_t*)(ws + OFF_HB); bf16_t* XB = (bf16_t*)(ws + OFF_XB);
        bf16_t* R1 = (bf16_t*)(ws + OFF_R1); bf16_t* R2 = (bf16_t*)(ws + OFF_R2);
        const float* modl = MOD + (size_t)layer * 4 * 6144;
        switch (op) {
        case OP_PRO: phase_prologue(s_wv, p, lds); break;
        case OP_NORM1: if (layer == 0) phase_norm<true>(s_wv, p->in[0], XB, p->in[5], modl + 0, modl + 1024, HB); else { phase_norm<false>(s_wv, p->in[0], XB, p->in[5] + layer * 1024, modl + 0, modl + 1024, HB); prep_layer(s_wv, p, layer, lds, layer != 1); } break;
        case OP_NORM2: { const float* cw = p->in[24] + (size_t)layer * 3 * 5632; const float* cb = p->in[25] + (size_t)layer * 5632; bf16_t* CWB = (bf16_t*)(ws + OFF_CWB);
                         for (int f = obid() * NTHREADS + otid(); f < 2816; f += gridDim.x * NTHREADS) { u32x4 o = {pk2(cw[f], cw[5632 + f]), pk2(cw[11264 + f], cb[f]), pk2(cw[2816 + f], cw[5632 + 2816 + f]), pk2(cw[11264 + 2816 + f], cb[2816 + f])}; *(u32x4*)(CWB + f * 8) = o; }
                         phase_norm<false>(s_wv, p->in[0], XB, p->in[6] + layer * 1024, modl + 3072, modl + 4096, HB); } break;
        case OP_G1: { EpiBf16<1> E{R1, 4096}; run_gemm(s_wv, lds, HB, WT + WT_MIXA, T, 4096, 1024, E); } break;
        case OP_GSP: phase_gsp(s_wv, p, layer / 3, lds); break;
        case OP_GOUT: { EpiRes E{XB, xdst, modl + 2048}; run_gemm(s_wv, lds, R2, WT + WT_MIXB, T, 1024, 2048, E); } break;
        case OP_M1: { EpiF32 E{(float*)R1, 512}; run_gemm(s_wv, lds, HB, WT + WT_MIXA, T, 512, 1024, E);
                      if ((int)gridDim.x >= 256) { if (obid() >= 128) prep_ffn(s_wv, p, layer, lds, 128, (int)gridDim.x - 128); } else prep_ffn(s_wv, p, layer, lds, 0, 0); } break;
        case OP_M2: phase_m2(s_wv, p); break;
        case OP_M3: { EpiQ EQ{(bf16_t*)(ws + OFF_R1 + 48 * MiB), (const float*)(ws + OFF_CSC), (const float*)(ws + OFF_CSS), 0.07216878364870322f * 1.4426950408889634f}; run_gemm(s_wv, lds, (const bf16_t*)(ws + OFF_R1 + 32 * MiB), WT + WT_MQKV, T, 1536, 256, EQ); EpiKV EK{(bf16_t*)(ws + OFF_R1 + 96 * MiB), (bf16_t*)(ws + OFF_R1 + 144 * MiB)}; run_gemm(s_wv, lds, (const bf16_t*)(ws + OFF_R1 + 40 * MiB), WT + WT_MQKV + 393216, T, 2048, 256, EK); } break;
        case OP_ATT: phase_attn(s_wv, p, lds); break;
        case OP_MOUT: { EpiRes E{XB, XB, modl + 2048}; run_gemm(s_wv, lds, R2, WT + WT_MIXB, T, 1024, 1024, E); } break;
        case OP_H1: { EpiHg E{ws + OFF_R1, (const float*)(ws + OFF_LB)}; run_gemm(s_wv, lds, HB, WT + WT_MIXA, T, 4096, 1024, E); } break;
        case OP_HA: phase_ha(s_wv, p, lds); break;
        case OP_HSCAN: phase_hscan(s_wv, p); break;
        case OP_HC: phase_hc(s_wv, p, lds); break;
        case OP_HOUT: { EpiRes E{XB, XB, modl + 2048}; run_gemm(s_wv, lds, HB, WT + WT_MIXB, T, 1024, 1024, E); } break;
        case OP_FUP: { EpiFFN E{R2, (const bf16_t*)(ws + OFF_CWB)}; run_gemm(s_wv, lds, HB - 2 * 1024, WT + WT_FUP, 67 * 256, 5632, 1024, E); } break;
        case OP_FDN: { EpiRes E{XB, xdst, modl + 5120}; run_gemm(s_wv, lds, R2, WT + WT_FDN, T, 1024, 2816, E); } break;
        case OP_FINAL: phase_final(s_wv, XB, p->out, p->in[27]); break;
        default: break;
        }
        if (ph + 1 < ph_hi) { if (ph == ph_lo) { __syncthreads(); cg::this_grid().sync(); } else xcd_barrier(xbar, otid()); }
    }
}

#ifndef MULTI_LAUNCH
#define MULTI_LAUNCH 0
#endif
extern "C" void kernel_launch(void* const* d_in, const int* in_sizes, int n_in, void* d_out, int out_size, void* d_ws, size_t ws_size, hipStream_t stream) {
    static int grid = 0;
    if (grid == 0) {
        int dev = 0, cus = 0, per_cu = 0;
        hipGetDevice(&dev); hipDeviceGetAttribute(&cus, hipDeviceAttributeMultiprocessorCount, dev);
        hipFuncSetAttribute((const void*)fwd_kernel, hipFuncAttributeMaxDynamicSharedMemorySize, LDS_BYTES);
        hipOccupancyMaxActiveBlocksPerMultiprocessor(&per_cu, (const void*)fwd_kernel, NTHREADS, LDS_BYTES);
        if (per_cu < 1) per_cu = 1;
        grid = cus * 1; (void)per_cu;
        if (ws_size < WS_END) fprintf(stderr, "kernel_launch: workspace too small: %zu < %zu\n", ws_size, (size_t)WS_END);
        (void)hipGetLastError();
    }
    (void)hipMemsetAsync((char*)d_ws + OFF_BAR, 0, XCD_BAR_WORDS * sizeof(unsigned), stream);
    Params p{};
    for (int i = 0; i < 28; ++i) p.in[i] = (const float*)d_in[i];
    p.out = (float*)d_out; p.ws = (unsigned char*)d_ws;
    int n = 0;
    auto add = [&](int op, int l) { p.op[n] = (unsigned char)op; p.lay[n] = (unsigned char)l; ++n; };
    add(OP_PRO, 0);
    for (int l = 0; l < 4; ++l) {
        add(OP_NORM1, l);
        if (l % 3 == 0) { add(OP_G1, l); add(OP_GSP, l); add(OP_GOUT, l); }
        else if (l % 3 == 1) { add(OP_M1, l); add(OP_M2, l); add(OP_M3, l); add(OP_ATT, l); add(OP_MOUT, l); }
        else { add(OP_H1, l); add(OP_HA, l); add(OP_HSCAN, l); add(OP_HC, l); add(OP_HOUT, l); }
        add(OP_NORM2, l); add(OP_FUP, l); add(OP_FDN, l);
    }
    add(OP_FINAL, 0);
#if MULTI_LAUNCH
    for (int i = 0; i < n; ++i) { p.ph_lo = i; p.ph_hi = i + 1; hipLaunchKernelGGL(fwd_kernel, dim3(grid), dim3(NTHREADS), LDS_BYTES, stream, p); }
#else
    p.ph_lo = 0; p.ph_hi = n;
    void* args[] = {&p};
    hipError_t e = hipLaunchCooperativeKernel((const void*)fwd_kernel, dim3(grid), dim3(NTHREADS), args, LDS_BYTES, stream);
    if (e != hipSuccess) fprintf(stderr, "cooperative launch failed: %s (grid %d)\n", hipGetErrorString(e), grid);
#endif
}
```

```cpp
#include <hip/hip_runtime.h>
#include <hip/hip_cooperative_groups.h>
#include <cstdio>
#include <cstdint>
namespace cg = cooperative_groups;
__device__ __forceinline__ int otid_w(int w) { int l; asm volatile("v_mbcnt_lo_u32_b32 %0, -1, 0\n\tv_mbcnt_hi_u32_b32 %0, -1, %0" : "=v"(l)); return (w << 6) | l; }
#define otid() otid_w(s_wv)
__device__ __forceinline__ int obid() { int t = blockIdx.x; asm volatile("" : "+s"(t)); return t; }
namespace pg8 {
#define PG8_LAS __attribute__((address_space(3)))
typedef unsigned short bf16_t;
typedef short bf16x8 __attribute__((ext_vector_type(8)));
typedef float f32x4 __attribute__((ext_vector_type(4)));
typedef unsigned u32x4 __attribute__((ext_vector_type(4)));
constexpr int BM = 256, BK = 64, HALF = 128, HTB = HALF * BK * 2  , STAGE_BYTES = 8 * HTB, NXCD = 8, WGM = 8;

__host__ __device__ __forceinline__ int lds_byte(int r, int c) { const int st = (r >> 4) * 2 + (c >> 5), rr = r & 15, cc = c & 31, ob = rr * 64 + cc * 2; return st * 1024 + (ob ^ (((ob >> 9) & 1) << 5)); }
__host__ __device__ __forceinline__ void stage_rc(int b, int& R, int& C) { const int st = b / 1024, sb = b % 1024, swz = sb ^ (((sb >> 9) & 1) << 5); R = (st >> 1) * 16 + swz / 64; C = (st & 1) * 32 + (swz % 64) / 2; }
__host__ __device__ __forceinline__ int perm32(int rho) { const int n = rho >> 4, i = rho & 15; return 8 * (i >> 2) + 4 * n + (i & 3); }

struct Unit { int pm, pn; };
struct Gemm { const bf16_t* A; const bf16_t* Bt; int M, N, K; };

struct StaticOrder {
    int nM, nN, nwg, G, c;
    __host__ __device__ void init(int M, int N, int G_, int c_) { nM = M / BM; nN = N / BM; nwg = nM * nN; G = G_; c = c_; }
    __host__ __device__ bool next(int i, Unit& u) const {
        const long L = (long)i * G + c; if (L >= nwg) return false;
        int wgid = (int)L; { const int q = nwg / NXCD, r = nwg % NXCD, xcd = wgid % NXCD, off = wgid / NXCD; wgid = (xcd < r ? xcd * (q + 1) : r * (q + 1) + (xcd - r) * q) + off; }
        const int nig = WGM * nN, gid = wgid / nig, fm = gid * WGM, gsz = (nM - fm) < WGM ? (nM - fm) : WGM;
        u.pm = fm + ((wgid % nig) % gsz); u.pn = (wgid % nig) / gsz; return true;
    }
    __device__ __forceinline__ void a_ready(const Unit&) const {}
    __device__ __forceinline__ void done(const Unit&) const {}
};
__device__ __forceinline__ unsigned cvt_pk_bf16(float lo, float hi) { unsigned r; asm volatile("v_cvt_pk_bf16_f32 %0, %1, %2" : "=v"(r) : "v"(lo), "v"(hi)); return r; }

template <class Epi, class Sched, bool STAMP = false>
__device__ __forceinline__ void gemm_phase(const int s_wv, PG8_LAS unsigned char* lds, const Gemm g, const Sched& S, const Epi& E, unsigned long long* stamps) {
    const int tid = otid(), wid = __builtin_amdgcn_readfirstlane(tid >> 6), lane = tid & 63, wr = wid >> 2, wc = wid & 3, fr = lane & 15, fq = lane >> 4;
    const int K = g.K, nt = K / BK;
    int ts_lo = 0, ts_hi = 0, nts = 0; const unsigned long long rt_entry = STAMP ? (unsigned long long)wall_clock64() : 0ull;
#define PG8_STAMP() do { if (STAMP && wid == 0 && nts < 64) { const unsigned long long _c = (unsigned long long)clock64(); \
        ts_lo = (lane == nts) ? (int)(unsigned)_c : ts_lo; ts_hi = (lane == nts) ? (int)(unsigned)(_c >> 32) : ts_hi; ++nts; } } while (0)
    PG8_STAMP();
    unsigned voffA[2], voffB[2];
#pragma unroll
    for (int i = 0; i < 2; ++i) { int R, C; stage_rc(tid * 16 + i * 8192, R, C); const int Rb = Epi::PERM ? ((R & ~31) + perm32(R & 31)) : R;
        const int Ra = Epi::PERMA ? (62 * (R >> 6) + 4 * (R & 15) + ((R >> 4) & 3)) : R; voffA[i] = (unsigned)(Ra * K + C) * 2u; voffB[i] = (unsigned)(Rb * K + C) * 2u; }
    const size_t kstep = (size_t)(BK * 2);
    const size_t hstep = (size_t)HALF * K * 2;
    const size_t tstep = 2 * hstep;
    const size_t hstepA = Epi::PERMA ? (size_t)124 * K * 2 : hstep, tstepA = Epi::PERMA ? (size_t)248 * K * 2 : tstep;
    const unsigned ldsw = (unsigned)wid * 1024u;
    const int aoff = lds_byte(wr * 64 + fr, fq * 8), boff = lds_byte(wc * 32 + fr, fq * 8);
#define PG8_SA(b, h) (((b) * 2 + (h)) * HTB)
#define PG8_SB(b, h) ((4 + (b) * 2 + (h)) * HTB)
#define PG8_STAGE(bufoff, gbase, voff) do { _Pragma("unroll") for (int _i = 0; _i < 2; ++_i) \
        __builtin_amdgcn_global_load_lds((const unsigned*)((const char*)(gbase) + (voff)[_i]), (PG8_LAS unsigned*)(lds + (bufoff) + ldsw + _i * 8192), 16, 0, 0); } while (0)
#define PG8_LDA(dst, b, h) do { _Pragma("unroll") for (int m = 0; m < 4; ++m) _Pragma("unroll") for (int k = 0; k < 2; ++k) dst[m][k] = *(const PG8_LAS bf16x8*)(lds + PG8_SA(b, h) + aoff + m * 2048 + k * 1024); } while (0)
#define PG8_LDB(dst, b, h) do { _Pragma("unroll") for (int n = 0; n < 2; ++n) _Pragma("unroll") for (int k = 0; k < 2; ++k) dst[n][k] = *(const PG8_LAS bf16x8*)(lds + PG8_SB(b, h) + boff + n * 2048 + k * 1024); } while (0)
#define PG8_MMA(ai, bj, At, Bt) do { __builtin_amdgcn_s_setprio(1); _Pragma("unroll") for (int m = 0; m < 4; ++m) _Pragma("unroll") for (int n = 0; n < 2; ++n) _Pragma("unroll") for (int k = 0; k < 2; ++k) \
        acc[ai][bj][m][n] = __builtin_amdgcn_mfma_f32_16x16x32_bf16(Bt[n][k], At[m][k], acc[ai][bj][m][n], 0, 0, 0); __builtin_amdgcn_s_setprio(0); } while (0)
#define PG8_WAIT_V(n) asm volatile("s_waitcnt vmcnt(" #n ")" ::: "memory")
#define PG8_WAIT_L(n) asm volatile("s_waitcnt lgkmcnt(" #n ")" ::: "memory")
#define PG8_BAR __builtin_amdgcn_s_barrier()
#define PG8_SCHED __builtin_amdgcn_sched_barrier(0)
    Unit cur, nxt; int ui = 0;
    if (!S.next(0, cur)) return;
    f32x4 acc[2][2][4][2];
#pragma unroll
    for (int a = 0; a < 2; ++a)
#pragma unroll
        for (int b = 0; b < 2; ++b)
#pragma unroll
            for (int m = 0; m < 4; ++m)
#pragma unroll
                for (int n = 0; n < 2; ++n) acc[a][b][m][n] = (f32x4){0.f, 0.f, 0.f, 0.f};
    bf16x8 At[4][2], B0[2][2], B1[2][2];
    const char* cA = (const char*)g.A + (size_t)cur.pm * tstepA; const char* cB = (const char*)g.Bt + (size_t)cur.pn * tstep;
    S.a_ready(cur);
    PG8_STAGE(PG8_SB(0, 0), cB, voffB); PG8_STAGE(PG8_SA(0, 0), cA, voffA); PG8_STAGE(PG8_SB(0, 1), cB + hstep, voffB); PG8_STAGE(PG8_SA(0, 1), cA + hstepA, voffA);
    if (wr == 1) PG8_BAR;
    PG8_WAIT_V(4); PG8_BAR;
    PG8_STAGE(PG8_SB(1, 0), cB + kstep, voffB); PG8_STAGE(PG8_SA(1, 0), cA + kstep, voffA); PG8_STAGE(PG8_SB(1, 1), cB + hstep + kstep, voffB);
    PG8_WAIT_V(6); PG8_BAR;
    PG8_STAMP();
    for (;;) {
        const bool has_next = S.next(ui + 1, nxt);
        const char* nA = has_next ? (const char*)g.A + (size_t)nxt.pm * tstepA : cA; const char* nB = has_next ? (const char*)g.Bt + (size_t)nxt.pn * tstep : cB;
        for (int t = 0; t < nt; t += 2) {
            const bool last = (t == nt - 2);
            const char* a1 = cA + (size_t)(t + 1) * kstep;
            const char* a2 = last ? nA : cA + (size_t)(t + 2) * kstep; const char* b2 = last ? nB : cB + (size_t)(t + 2) * kstep;
            const char* a3 = a2 + kstep; const char* b3 = b2 + kstep;
            if (last && has_next) S.a_ready(nxt);
            PG8_LDB(B0, 0, 0); PG8_SCHED; PG8_LDA(At, 0, 0); PG8_STAGE(PG8_SA(1, 1), a1 + hstepA, voffA);
            PG8_WAIT_L(8); PG8_BAR; PG8_WAIT_L(0); PG8_MMA(0, 0, At, B0); PG8_BAR; PG8_SCHED;
            PG8_LDB(B1, 0, 1); PG8_STAGE(PG8_SB(0, 0), b2, voffB);
            PG8_BAR; PG8_WAIT_L(0); PG8_MMA(0, 1, At, B1); PG8_BAR;
            PG8_LDA(At, 0, 1); PG8_STAGE(PG8_SA(0, 0), a2, voffA);
            PG8_BAR; PG8_WAIT_L(0); PG8_MMA(1, 0, At, B0); PG8_BAR; PG8_SCHED;
            PG8_STAGE(PG8_SB(0, 1), b2 + hstep, voffB);
            PG8_WAIT_V(6); PG8_BAR; PG8_MMA(1, 1, At, B1); PG8_BAR;
            PG8_LDB(B0, 1, 0); PG8_SCHED; PG8_LDA(At, 1, 0); PG8_STAGE(PG8_SA(0, 1), a2 + hstepA, voffA);
            PG8_WAIT_L(8); PG8_BAR; PG8_WAIT_L(0); PG8_MMA(0, 0, At, B0); PG8_BAR; PG8_SCHED;
            PG8_LDB(B1, 1, 1); PG8_STAGE(PG8_SB(1, 0), b3, voffB);
            PG8_BAR; PG8_WAIT_L(0); PG8_MMA(0, 1, At, B1); PG8_BAR;
            PG8_LDA(At, 1, 1); PG8_STAGE(PG8_SA(1, 0), a3, voffA);
            PG8_BAR; PG8_WAIT_L(0); PG8_MMA(1, 0, At, B0); PG8_BAR; PG8_SCHED;
            PG8_STAGE(PG8_SB(1, 1), b3 + hstep, voffB);
            PG8_WAIT_V(6); PG8_BAR; PG8_MMA(1, 1, At, B1); PG8_BAR;
        }
        PG8_STAMP();
        if constexpr (!Epi::AFTER_DRAIN) { E(acc, cur, wr, wc, fr, fq); S.done(cur); }
        PG8_STAMP();
        if (!has_next) break;
#pragma unroll
        for (int a = 0; a < 2; ++a)
#pragma unroll
            for (int b = 0; b < 2; ++b)
#pragma unroll
                for (int m = 0; m < 4; ++m)
#pragma unroll
                    for (int n = 0; n < 2; ++n) acc[a][b][m][n] = (f32x4){0.f, 0.f, 0.f, 0.f};
        cur = nxt; cA = nA; cB = nB; ++ui;
    }
    PG8_WAIT_V(0);
    if (wr == 0) PG8_BAR;
    PG8_BAR;
    if constexpr (Epi::AFTER_DRAIN) { E.fused(acc, cur, wr, wc, fr, fq, lds, wid, lane); S.done(cur); }
    PG8_STAMP();
    if (STAMP && wid == 0) { stamps[lane] = lane < nts ? (((unsigned long long)(unsigned)ts_hi << 32) | (unsigned)ts_lo) : 0ull;
        if (lane == 62) stamps[62] = rt_entry; if (lane == 63) stamps[63] = (unsigned long long)wall_clock64(); }
#undef PG8_STAMP
#undef PG8_SA
#undef PG8_SB
#undef PG8_STAGE
#undef PG8_LDA
#undef PG8_LDB
#undef PG8_MMA
#undef PG8_WAIT_V
#undef PG8_WAIT_L
#undef PG8_BAR
#undef PG8_SCHED
}
}

using pg8::bf16_t; using pg8::bf16x8; using pg8::f32x4; using pg8::u32x4; using pg8::Unit;
typedef unsigned u32x2 __attribute__((ext_vector_type(2)));
typedef short bf16x4 __attribute__((ext_vector_type(4)));
#define LAS __attribute__((address_space(3)))
typedef LAS unsigned char* ldsp;
#define XB_TMO      128
#define XB_XCNT(j)  (256  + 64 * (j))
#define XB_XSUB(j)  (1280 + 64 * (j))
#define XB_XGEN(j)  (2304 + 64 * (j))
#define XB_TOP      3328
#define XB_TOPGEN   3392
#define XCD_BAR_WORDS 3456
#define XB_SPIN_CAP (1u << 18)

__device__ __forceinline__ unsigned xb_ld(unsigned* p)              { return __hip_atomic_load(p, __ATOMIC_RELAXED, __HIP_MEMORY_SCOPE_AGENT); }
__device__ __forceinline__ unsigned xb_add(unsigned* p, unsigned v) { return __hip_atomic_fetch_add(p, v, __ATOMIC_RELAXED, __HIP_MEMORY_SCOPE_AGENT); }
__device__ __forceinline__ unsigned xb_xcc_id() { return (unsigned)__builtin_amdgcn_s_getreg((3 << 11) | 20) & 0xFu; }
#define XB_SPIN(cond, bar) do { unsigned _sp = 0; while (cond) { __builtin_amdgcn_s_sleep(1); \
    if ((++_sp & 255u) == 0u) { if (xb_ld(&(bar)[XB_TMO])) break; if (_sp > XB_SPIN_CAP) { atomicAdd(&(bar)[XB_TMO], 1u); break; } } } } while (0)

struct XcdBarrier {
    unsigned* bar; unsigned x;
    volatile LAS unsigned* st;
};

__device__ __forceinline__ XcdBarrier xcd_barrier_post(unsigned* bar, volatile LAS unsigned* st, const int tid0) {
    XcdBarrier b; b.bar = bar; b.x = xb_xcc_id(); b.st = st;
    if (tid0 == 0) (void)xb_add(&bar[XB_XCNT(b.x)], 1u);
    return b;
}
__device__ __forceinline__ void xcd_barrier_complete(unsigned* bar, unsigned x, unsigned& nloc, unsigned& nx) {
    const unsigned G = gridDim.x * gridDim.y * gridDim.z;
    unsigned sum, cnt, mine, sp = 0u;
    for (;;) {
        sum = 0u; cnt = 0u; mine = 0u;
#pragma unroll
        for (unsigned j = 0; j < 16; ++j) { const unsigned c = xb_ld(&bar[XB_XCNT(j)]); sum += c; cnt += (c > 0u) ? 1u : 0u; mine = (j == x) ? c : mine; }
        if (sum == G) break;
        __builtin_amdgcn_s_sleep(1);
        if ((++sp & 255u) == 0u) { if (xb_ld(&bar[XB_TMO])) break; if (sp > XB_SPIN_CAP) { atomicAdd(&bar[XB_TMO], 1u); break; } }
    }
    nloc = mine > 0u ? mine : 1u; nx = cnt > 0u ? cnt : 1u;
}

__device__ __forceinline__ void xcd_barrier(const XcdBarrier& b, const int tid0) {
    asm volatile("s_waitcnt vmcnt(0)" ::: "memory");
    __syncthreads();
    if (tid0 == 0) {
        unsigned* bar = b.bar;
        __builtin_amdgcn_s_waitcnt(0);
        unsigned nloc = b.st[0], nx = b.st[1];
        if (nloc == 0u) { xcd_barrier_complete(bar, b.x, nloc, nx); b.st[0] = nloc; b.st[1] = nx; }
        const unsigned old = xb_add(&bar[XB_XSUB(b.x)], 1u);
        const unsigned gen = old / nloc;
        if (old + 1u == (gen + 1u) * nloc) {
            __builtin_amdgcn_fence(__ATOMIC_RELEASE, "agent");
            asm volatile("s_waitcnt vmcnt(0)" ::: "memory");
            const unsigned og = xb_add(&bar[XB_TOP], 1u);
            const unsigned tg = og / nx;
            if (og + 1u == (tg + 1u) * nx) xb_add(&bar[XB_TOPGEN], 1u);
            else XB_SPIN(xb_ld(&bar[XB_TOPGEN]) == tg, bar);
            __builtin_amdgcn_fence(__ATOMIC_ACQUIRE, "agent");
            xb_add(&bar[XB_XGEN(b.x)], 1u);
            asm volatile("s_waitcnt vmcnt(0)" ::: "memory");
        } else {
            XB_SPIN(xb_ld(&bar[XB_XGEN(b.x)]) == gen, bar);
            __builtin_amdgcn_fence(__ATOMIC_ACQUIRE, "agent");
            asm volatile("s_waitcnt vmcnt(0)" ::: "memory");
        }
    }
    __syncthreads();
}


constexpr int T = 16384, D = 1024, SEQ = 4096, NBATCH = 4, FF = 2816;
constexpr int NTHREADS = 512, LDS_BYTES = 131072 + 16;
constexpr float EPS = 1e-6f;
constexpr size_t MiB = 1024 * 1024;
constexpr size_t OFF_MOD = 0, OFF_LB = 512 * 1024, OFF_CWB = 576 * 1024, OFF_BAR = 768 * 1024, OFF_CSC = 1 * MiB, OFF_CSS = 3 * MiB, OFF_WT = 8 * MiB, OFF_HB = 40 * MiB, OFF_R1 = 72 * MiB, OFF_R2 = 248 * MiB, OFF_XB = 336 * MiB, WS_END = 368 * MiB;
constexpr size_t WT_MIXA = 0, WT_MIXB = 4194304, WT_FUP = 6291456, WT_FDN = 12058624, WT_MQKV = 524288;
enum { OP_PRO = 0, OP_NORM1, OP_G1, OP_GSP, OP_GOUT, OP_M1, OP_M2, OP_M3, OP_ATT, OP_MOUT, OP_H1, OP_HA, OP_HSCAN, OP_HC, OP_HOUT, OP_NORM2, OP_FUP, OP_FCONV, OP_FDN, OP_FINAL };

struct Params;
struct Params {
    const float* in[28];
    float* out;
    unsigned char* ws;
    int ph_lo, ph_hi;
    unsigned char op[48];
    unsigned char lay[48];
};

typedef const __attribute__((address_space(4))) Params* KP;
__device__ __forceinline__ unsigned pk2(float lo, float hi) { return pg8::cvt_pk_bf16(lo, hi); }
__device__ __forceinline__ float bflo(unsigned u) { return __uint_as_float(u << 16); }
__device__ __forceinline__ float bfhi(unsigned u) { return __uint_as_float(u & 0xffff0000u); }
__device__ __forceinline__ float shx(float v, int m, int lane) { return __int_as_float(__builtin_amdgcn_ds_bpermute((lane ^ m) << 2, __float_as_int(v))); }
template <int CTRL> __device__ __forceinline__ float dppf(float v) { return __int_as_float(__builtin_amdgcn_update_dpp(0, __float_as_int(v), CTRL, 0xf, 0xf, false)); }
__device__ __forceinline__ float rowsum4(float t) {
    const unsigned u = __float_as_uint(t);
    const auto r = __builtin_amdgcn_permlane16_swap(u, u, false, false);
    const float a = __uint_as_float(r[0]) + __uint_as_float(r[1]);
    const unsigned v = __float_as_uint(a);
    const auto q = __builtin_amdgcn_permlane32_swap(v, v, false, false);
    return __uint_as_float(q[0]) + __uint_as_float(q[1]);
}
__device__ __forceinline__ float wave_sum(float v, int lane) {
    (void)lane;
    v += dppf<0xB1>(v); v += dppf<0x4E>(v); v += dppf<0x141>(v); v += dppf<0x140>(v);
    return rowsum4(v);
}
__device__ __forceinline__ float rowmax4(float t) {
    const unsigned u = __float_as_uint(t);
    const auto r = __builtin_amdgcn_permlane16_swap(u, u, false, false);
    const float a = fmaxf(__uint_as_float(r[0]), __uint_as_float(r[1]));
    const unsigned v = __float_as_uint(a);
    const auto q = __builtin_amdgcn_permlane32_swap(v, v, false, false);
    return fmaxf(__uint_as_float(q[0]), __uint_as_float(q[1]));
}
__device__ __forceinline__ float fast_sigmoid(float x) { return __builtin_amdgcn_rcpf(1.f + __builtin_amdgcn_exp2f(-1.4426950408889634f * x)); }
__device__ __forceinline__ float gelu_tanh(float x) { const float u = 0.7978845608028654f * (x + 0.044715f * x * x * x); return x * fast_sigmoid(2.f * u); }
__device__ __forceinline__ f32x4 sigmoid4(const f32x4 x) { const f32x4 ex = x * -1.4426950408889634f; f32x4 s;
#pragma unroll
    for (int e = 0; e < 4; ++e) s[e] = __builtin_amdgcn_rcpf(1.f + __builtin_amdgcn_exp2f(ex[e]));
    return s; }
__device__ __forceinline__ f32x4 gelu_tanh4(const f32x4 x) { const f32x4 t = x * x * 0.044715f + 1.f; const f32x4 ex = x * t * (-2.f * 0.7978845608028654f * 1.4426950408889634f); f32x4 s;
#pragma unroll
    for (int e = 0; e < 4; ++e) s[e] = __builtin_amdgcn_rcpf(1.f + __builtin_amdgcn_exp2f(ex[e]));
    return x * s; }
__device__ __forceinline__ bf16x8 mk8(unsigned a, unsigned b, unsigned c, unsigned d) { u32x4 v = {a, b, c, d}; return __builtin_bit_cast(bf16x8, v); }
__device__ __forceinline__ f32x4 zero4() { float z = 0.f; asm volatile("" : "+v"(z)); return (f32x4){z, z, z, z}; }
#define MFMA16(X, Y, C) __builtin_amdgcn_mfma_f32_16x16x32_bf16((X), (Y), (C), 0, 0, 0)

template <int ACT> struct EpiBf16 {
    static constexpr bool PERM = true, AFTER_DRAIN = false, PERMA = false;
    bf16_t* O; int ldc;
    __device__ __forceinline__ void operator()(const f32x4 (&acc)[2][2][4][2], const Unit& u, int wr, int wc, int fr, int fq) const {
        const int row0 = u.pm * 256 + wr * 64 + fr, col0 = u.pn * 256 + wc * 32 + 8 * fq;
#pragma unroll
        for (int ai = 0; ai < 2; ++ai)
#pragma unroll
            for (int m = 0; m < 4; ++m) { bf16_t* rowp = O + (size_t)(row0 + ai * 128 + m * 16) * ldc + col0;
#pragma unroll
                for (int bj = 0; bj < 2; ++bj) { f32x4 v0 = acc[ai][bj][m][0], v1 = acc[ai][bj][m][1];
                    if (ACT == 1) { v0 = gelu_tanh4(v0); v1 = gelu_tanh4(v1); }
                    u32x4 o = {pk2(v0[0], v0[1]), pk2(v0[2], v0[3]), pk2(v1[0], v1[1]), pk2(v1[2], v1[3])};
                    *(u32x4*)(rowp + bj * 128) = o; } }
    }
};
struct EpiF32 {
    static constexpr bool PERM = false, AFTER_DRAIN = false, PERMA = false;
    float* C; int ldc;
    __device__ __forceinline__ void operator()(const f32x4 (&acc)[2][2][4][2], const Unit& u, int wr, int wc, int fr, int fq) const {
        const int row0 = u.pm * 256 + wr * 64 + fr, col0 = u.pn * 256 + wc * 32 + 4 * fq;
#pragma unroll
        for (int ai = 0; ai < 2; ++ai)
#pragma unroll
            for (int m = 0; m < 4; ++m) { float* rowp = C + (size_t)(row0 + ai * 128 + m * 16) * ldc + col0;
#pragma unroll
                for (int bj = 0; bj < 2; ++bj)
#pragma unroll
                    for (int n = 0; n < 2; ++n) *(f32x4*)(rowp + bj * 128 + n * 16) = acc[ai][bj][m][n]; }
    }
};
struct EpiRes {
    static constexpr bool PERM = true, AFTER_DRAIN = false, PERMA = false;
    const bf16_t* Xs; bf16_t* Xd; const float* gate;
    __device__ __forceinline__ void operator()(const f32x4 (&acc)[2][2][4][2], const Unit& u, int wr, int wc, int fr, int fq) const {
        const int row0 = u.pm * 256 + wr * 64 + fr, col0 = u.pn * 256 + wc * 32 + 8 * fq;
        const float* gp = gate + (unsigned)((u.pm >> 4) * 6144 + col0);
        f32x4 gv[2][2];
#pragma unroll
        for (int bj = 0; bj < 2; ++bj)
#pragma unroll
            for (int n = 0; n < 2; ++n) { gv[bj][n] = *(const f32x4*)(gp + bj * 128 + n * 4); gv[bj][n] = gv[bj][n] + 1.f; }
#pragma unroll
        for (int ai = 0; ai < 2; ++ai)
#pragma unroll
            for (int m = 0; m < 4; ++m) { const unsigned ro = (unsigned)((row0 + ai * 128 + m * 16) * 1024 + col0);
#pragma unroll
                for (int bj = 0; bj < 2; ++bj) { const u32x4 xs = *(const u32x4*)(Xs + ro + bj * 128);
                    const f32x4 a0 = acc[ai][bj][m][0] * gv[bj][0], a1 = acc[ai][bj][m][1] * gv[bj][1];
                    u32x4 o = {pk2(bflo(xs[0]) + a0[0], bfhi(xs[0]) + a0[1]), pk2(bflo(xs[1]) + a0[2], bfhi(xs[1]) + a0[3]), pk2(bflo(xs[2]) + a1[0], bfhi(xs[2]) + a1[1]), pk2(bflo(xs[3]) + a1[2], bfhi(xs[3]) + a1[3])};
                    *(u32x4*)(Xd + ro + bj * 128) = o; } }
    }
};
struct EpiQ {
    static constexpr bool PERM = false, AFTER_DRAIN = false, PERMA = false;
    bf16_t* QF; const float* CSC; const float* CSS; float qs;
    __device__ __forceinline__ void operator()(const f32x4 (&acc)[2][2][4][2], const Unit& u, int wr, int wc, int fr, int fq) const {
        const int b = u.pm >> 4;
#pragma unroll
        for (int bj = 0; bj < 2; ++bj) {
            const int c0 = u.pn * 256 + bj * 128 + wc * 32;
            const int head = c0 / 192, off = c0 - head * 192;
            if (off < 128) {
#pragma unroll
                for (int ai = 0; ai < 2; ++ai)
#pragma unroll
                    for (int m = 0; m < 4; ++m) { const int r = u.pm * 256 + ai * 128 + wr * 64 + m * 16 + fr, s = r & 4095;
                        bf16_t* qp = QF + (unsigned)(((b * 8 + head) * 4096 + s) * 192 + off + 4 * fq);
#pragma unroll
                        for (int n = 0; n < 2; ++n) { const f32x4 v = acc[ai][bj][m][n] * qs; u32x2 o = {pk2(v[0], v[1]), pk2(v[2], v[3])}; *(u32x2*)(qp + 16 * n) = o; } __builtin_amdgcn_sched_barrier(0); }
            } else {
                const int jb = ((off - 128) >> 5) * 16 + 4 * fq;
#pragma unroll
                for (int ai = 0; ai < 2; ++ai)
#pragma unroll
                    for (int m = 0; m < 4; ++m) { const int r = u.pm * 256 + ai * 128 + wr * 64 + m * 16 + fr, s = r & 4095;
                        const f32x4 cs = *(const f32x4*)(CSC + (unsigned)(r * 32 + jb)), sn = *(const f32x4*)(CSS + (unsigned)(r * 32 + jb));
                        const f32x4 x1 = acc[ai][bj][m][0], x2 = acc[ai][bj][m][1];
                        const f32x4 r1 = (x1 * cs - x2 * sn) * qs, r2 = (x2 * cs + x1 * sn) * qs;
                        bf16_t* qp = QF + (unsigned)(((b * 8 + head) * 4096 + s) * 192 + 128 + jb);
                        u32x2 o1 = {pk2(r1[0], r1[1]), pk2(r1[2], r1[3])}, o2 = {pk2(r2[0], r2[1]), pk2(r2[2], r2[3])};
                        *(u32x2*)(qp) = o1; *(u32x2*)(qp + 32) = o2; __builtin_amdgcn_sched_barrier(0); }
            }
        }
    }
};
struct EpiKV {
    static constexpr bool PERM = false, AFTER_DRAIN = false, PERMA = false;
    bf16_t* KF; bf16_t* VT;
    __device__ __forceinline__ void operator()(const f32x4 (&acc)[2][2][4][2], const Unit& u, int wr, int wc, int fr, int fq) const {
        const int b = u.pm >> 4, head = u.pn;
#pragma unroll
        for (int bj = 0; bj < 2; ++bj) {
            const int off = wc * 32;
            if (bj == 0) {
#pragma unroll
                for (int ai = 0; ai < 2; ++ai)
#pragma unroll
                    for (int m = 0; m < 4; ++m) { const int r = u.pm * 256 + ai * 128 + wr * 64 + m * 16 + fr, s = r & 4095;
                        bf16_t* kp = KF + (unsigned)(((b * 8 + head) * 4096 + s) * 192 + off + 4 * fq);
#pragma unroll
                        for (int n = 0; n < 2; ++n) { const f32x4 v = acc[ai][bj][m][n]; u32x2 o = {pk2(v[0], v[1]), pk2(v[2], v[3])}; *(u32x2*)(kp + 16 * n) = o; } __builtin_amdgcn_sched_barrier(0); }
            } else {
#pragma unroll
                for (int ai = 0; ai < 2; ++ai)
#pragma unroll
                    for (int m = 0; m < 4; ++m) { const int r = u.pm * 256 + ai * 128 + wr * 64 + m * 16 + fr, s = r & 4095;
#pragma unroll
                        for (int n = 0; n < 2; ++n) { const f32x4 v = acc[ai][bj][m][n]; const int dv = off + 16 * n + 4 * fq;
                            bf16_t* vp = VT + (unsigned)(((b * 8 + head) * 128 + dv) * 4096 + s);
                            const unsigned p01 = pk2(v[0], v[1]), p23 = pk2(v[2], v[3]);
                            vp[0] = (bf16_t)(p01 & 0xffffu); vp[4096] = (bf16_t)(p01 >> 16); vp[8192] = (bf16_t)(p23 & 0xffffu); vp[12288] = (bf16_t)(p23 >> 16); } __builtin_amdgcn_sched_barrier(0); }
            }
        }
    }
};
struct EpiHg {
    static constexpr bool PERM = true, AFTER_DRAIN = false, PERMA = false;
    unsigned char* R1b; const float* LB;
    __device__ __forceinline__ void operator()(const f32x4 (&acc)[2][2][4][2], const Unit& u, int wr, int wc, int fr, int fq) const {
        const int region = u.pn >> 2, row0 = u.pm * 256 + wr * 64 + fr, cc0 = (u.pn & 3) * 256 + wc * 32 + 8 * fq;
        if (region == 1) {
#pragma unroll
            for (int bj = 0; bj < 2; ++bj) { const int cc = cc0 + bj * 128;
                const f32x4 l0 = *(const f32x4*)(LB + cc), l1 = *(const f32x4*)(LB + cc + 4);
#pragma unroll
                for (int ai = 0; ai < 2; ++ai)
#pragma unroll
                    for (int m = 0; m < 4; ++m) { float* fp = (float*)(R1b + 32 * MiB) + (unsigned)((row0 + ai * 128 + m * 16) * 1024 + cc);
                        f32x4 v0 = acc[ai][bj][m][0], v1 = acc[ai][bj][m][1];
                        v0 = l0 + (1.f - l0) * sigmoid4(v0); v1 = l1 + (1.f - l1) * sigmoid4(v1);
                        *(f32x4*)fp = v0; *(f32x4*)(fp + 4) = v1; __builtin_amdgcn_sched_barrier(0); } }
        } else {
            bf16_t* base = (bf16_t*)(R1b + (region == 0 ? (size_t)0 : (region == 2 ? 96 * MiB : 128 * MiB)));
#pragma unroll
            for (int ai = 0; ai < 2; ++ai)
#pragma unroll
                for (int m = 0; m < 4; ++m) { bf16_t* rowp = base + (unsigned)((row0 + ai * 128 + m * 16) * 1024 + cc0);
#pragma unroll
                    for (int bj = 0; bj < 2; ++bj) { f32x4 v0 = acc[ai][bj][m][0], v1 = acc[ai][bj][m][1];
                        if (region == 3) { v0 = v0 * sigmoid4(v0); v1 = v1 * sigmoid4(v1); }
                        u32x4 o = {pk2(v0[0], v0[1]), pk2(v0[2], v0[3]), pk2(v1[0], v1[1]), pk2(v1[2], v1[3])};
                        *(u32x4*)(rowp + bj * 128) = o; } }
        }
    }
};

struct EpiFFN {
    static constexpr bool PERM = true, AFTER_DRAIN = false, PERMA = true;
    bf16_t* ACT; const bf16_t* CWB;
    __device__ __forceinline__ static f32x4 shr1(const f32x4 v) { f32x4 r;
#pragma unroll
        for (int e = 0; e < 4; ++e) r[e] = __int_as_float(__builtin_amdgcn_update_dpp(0, __float_as_int(v[e]), 0x111, 0xf, 0xf, true));
        return r; }
    template <bool SPECIAL> __device__ __forceinline__ void group(const f32x4 (&acc)[2][2][4][2], int ai, int n, int tok0, int fr, int fcol,
            const f32x4 wg0, const f32x4 wg1, const f32x4 wg2, const f32x4 bg, const f32x4 wv0, const f32x4 wv1, const f32x4 wv2, const f32x4 bv) const {
        const f32x4 sg3 = shr1(acc[ai][0][3][n]), sg2 = shr1(acc[ai][0][2][n]), sv3 = shr1(acc[ai][1][3][n]), sv2 = shr1(acc[ai][1][2][n]);
#pragma unroll
        for (int m = 0; m < 4; ++m) {
            const f32x4 cg = acc[ai][0][m][n], cv = acc[ai][1][m][n];
            f32x4 p1g = m == 0 ? sg3 : acc[ai][0][m == 0 ? 0 : m - 1][n], p1v = m == 0 ? sv3 : acc[ai][1][m == 0 ? 0 : m - 1][n];
            f32x4 p2g = m == 0 ? sg2 : (m == 1 ? sg3 : acc[ai][0][m < 2 ? 0 : m - 2][n]), p2v = m == 0 ? sv2 : (m == 1 ? sv3 : acc[ai][1][m < 2 ? 0 : m - 2][n]);
            const int tok = tok0 + 4 * fr + m;
            if (SPECIAL) { const int sq = tok & 4095; const f32x4 z4 = {0.f, 0.f, 0.f, 0.f}; if (sq == 0) { p1g = z4; p1v = z4; } if (sq <= 1) { p2g = z4; p2v = z4; } }
            const f32x4 yg = bg + wg0 * p2g + wg1 * p1g + wg2 * cg, yv = bv + wv0 * p2v + wv1 * p1v + wv2 * cv;
            const f32x4 ex = yg * -1.4426950408889634f; f32x4 sg;
#pragma unroll
            for (int e = 0; e < 4; ++e) sg[e] = __builtin_amdgcn_rcpf(1.f + __builtin_amdgcn_exp2f(ex[e]));
            const f32x4 o = yg * sg * yv;
            if ((m >= 2 || fr > 0) && tok < T) { u32x2 ov = {pk2(o[0], o[1]), pk2(o[2], o[3])}; *(u32x2*)(ACT + (unsigned)(tok * 2816 + fcol)) = ov; }
        }
    }
    __device__ __forceinline__ void operator()(const f32x4 (&acc)[2][2][4][2], const Unit& u, int wr, int wc, int fr, int fq) const {
        const int fcol0 = u.pn * 128 + wc * 32 + 8 * fq;
        u32x4 tw[8];
#pragma unroll
        for (int i = 0; i < 8; ++i) tw[i] = *(const u32x4*)(CWB + (unsigned)((fcol0 + i) * 8));
#pragma unroll
        for (int n = 0; n < 2; ++n) {
            const int fcol = fcol0 + 4 * n;
            f32x4 wg0, wg1, wg2, bg, wv0, wv1, wv2, bv;
#pragma unroll
            for (int e = 0; e < 4; ++e) { const u32x4 t = tw[4 * n + e]; wg0[e] = bflo(t[0]); wg1[e] = bfhi(t[0]); wg2[e] = bflo(t[1]); bg[e] = bfhi(t[1]); wv0[e] = bflo(t[2]); wv1[e] = bfhi(t[2]); wv2[e] = bflo(t[3]); bv[e] = bfhi(t[3]); }
#pragma unroll
            for (int ai = 0; ai < 2; ++ai) {
                const int b0 = u.pm * 248 + (2 * ai + wr) * 62;
                const bool special = (((b0 + 61) >> 12) << 12) >= b0 - 1;
                if (special) group<true>(acc, ai, n, b0 - 2, fr, fcol, wg0, wg1, wg2, bg, wv0, wv1, wv2, bv);
                else group<false>(acc, ai, n, b0 - 2, fr, fcol, wg0, wg1, wg2, bg, wv0, wv1, wv2, bv);
                __builtin_amdgcn_sched_barrier(0);
            }
        }
    }
};

template <class Epi> __device__ __forceinline__ void run_gemm(const int s_wv, ldsp lds, const bf16_t* A, const bf16_t* Bt, int M, int N, int K, const Epi& E) {
    pg8::Gemm g{A, Bt, M, N, K}; pg8::StaticOrder S; S.init(M, N, (int)gridDim.x, obid());
    pg8::gemm_phase<Epi, pg8::StaticOrder, false>(s_wv, lds, g, S, E, nullptr);
}

__device__ __forceinline__ int rope_rowmap(int n) { const int head = n / 192, d = n - head * 192; if (d < 128) return n; const int r = d - 128, half = r >> 5, j = r & 31; return head * 192 + 128 + (j >> 4) * 32 + half * 16 + (j & 15); }
__device__ __forceinline__ int ffn_rowmap(int n) { const int half = n >= 2816 ? 1 : 0, f = n - half * 2816, t = f >> 7, i = f & 127; return t * 256 + half * 128 + i; }
struct TrJob { const float* src; int srcN, K, N; bf16_t* dst; int dstK, koff, rowoff, pmode; };
__device__ __forceinline__ void run_trjob(const int s_wv, const TrJob J, ldsp lds, const int wg0 = 0, const int nwg = 0) {
    const int tid = otid(), lane = tid & 63, wave = tid >> 6;
    LAS float* sm = (LAS float*)(lds + wave * 8448);
    const int nkt = J.K / 32, nnt = J.N / 64, ntile = nkt * nnt;
    const int nw_ = nwg ? nwg : (int)gridDim.x;
    for (int t = (obid() - wg0) * 8 + wave; t < ntile; t += nw_ * 8) { const int kt = t % nkt, nt = t / nkt;
        const float* sp = J.src + (size_t)(kt * 32) * J.srcN + nt * 64 + lane;
        float v[32];
#pragma unroll
        for (int k = 0; k < 32; ++k) v[k] = sp[(size_t)k * J.srcN];
#pragma unroll
        for (int k = 0; k < 32; ++k) sm[lane * 33 + k] = v[k];
        const int kk = (lane & 15) * 2, nr = lane >> 4;
#pragma unroll
        for (int j = 0; j < 16; ++j) { const int n = nr + 4 * j, sn = nt * 64 + n, drow = J.rowoff + (J.pmode == 1 ? rope_rowmap(sn) : (J.pmode == 2 ? ffn_rowmap(sn) : sn));
            *(unsigned*)(J.dst + (size_t)drow * J.dstK + J.koff + kt * 32 + kk) = pk2(sm[n * 33 + kk], sm[n * 33 + kk + 1]); }
    }
}
__device__ __forceinline__ void zero_fill(bf16_t* dst, int rows, int cols8, int stride, int gtid, int gthreads) {
    const int n = rows * cols8; unsigned zz = 0u; asm volatile("" : "+v"(zz)); const u32x4 z = {zz, zz, zz, zz};
    for (int i = gtid; i < n; i += gthreads) { const int r = i / cols8, c = i - r * cols8; *(u32x4*)(dst + (size_t)r * stride + c * 8) = z; }
}
__device__ __forceinline__ void prep_ffn(const int s_wv, KP p, int layer, ldsp lds, const int wg0, const int nwg) {
    bf16_t* WT = (bf16_t*)(p->ws + OFF_WT);
    const TrJob J0{p->in[23] + (size_t)layer * 1024 * 5632, 5632, 1024, 5632, WT + WT_FUP, 1024, 0, 0, 2};
    const TrJob J1{p->in[26] + (size_t)layer * 2816 * 1024, 1024, 2816, 1024, WT + WT_FDN, 2816, 0, 0, 0};
    run_trjob(s_wv, J0, lds, wg0, nwg); run_trjob(s_wv, J1, lds, wg0, nwg);
}
__device__ __forceinline__ void prep_layer(const int s_wv, KP p, int layer, ldsp lds, const bool with_ffn = true) {
    bf16_t* WT = (bf16_t*)(p->ws + OFF_WT); const int kind = layer % 3, j = layer / 3;
    const int gtid = obid() * NTHREADS + otid(), gthreads = gridDim.x * NTHREADS;
    if (with_ffn) { const TrJob J0{p->in[23] + (size_t)layer * 1024 * 5632, 5632, 1024, 5632, WT + WT_FUP, 1024, 0, 0, 2};
      const TrJob J1{p->in[26] + (size_t)layer * 2816 * 1024, 1024, 2816, 1024, WT + WT_FDN, 2816, 0, 0, 0};
      run_trjob(s_wv, J0, lds); run_trjob(s_wv, J1, lds); }
    if (kind == 0) {
        const TrJob J0{p->in[7] + (size_t)j * 1024 * 4096, 4096, 1024, 4096, WT + WT_MIXA, 1024, 0, 0, 0};
        const TrJob J1{p->in[12] + (size_t)j * 2048 * 1024, 1024, 2048, 1024, WT + WT_MIXB, 2048, 0, 0, 0};
        run_trjob(s_wv, J0, lds); run_trjob(s_wv, J1, lds);
    } else if (kind == 1) {
        const TrJob J0{p->in[13], 448, 1024, 448, WT + WT_MIXA, 1024, 0, 0, 0};
        const TrJob J1{p->in[16], 1536, 256, 1536, WT + WT_MQKV, 256, 0, 0, 1};
        const TrJob J2{p->in[17], 2048, 128, 2048, WT + WT_MQKV + 393216, 256, 0, 0, 0};
        const TrJob J3{p->in[18], 1024, 1024, 1024, WT + WT_MIXB, 1024, 0, 0, 0};
        run_trjob(s_wv, J0, lds); run_trjob(s_wv, J1, lds); run_trjob(s_wv, J2, lds); run_trjob(s_wv, J3, lds);
        zero_fill(WT + WT_MIXA + (size_t)448 * 1024, 64, 128, 1024, gtid, gthreads);
        zero_fill(WT + WT_MQKV + 393216 + 128, 2048, 16, 256, gtid, gthreads);
    } else {
        const TrJob J0{p->in[20], 4096, 1024, 4096, WT + WT_MIXA, 1024, 0, 0, 0};
        const TrJob J1{p->in[22], 1024, 1024, 1024, WT + WT_MIXB, 1024, 0, 0, 0};
        run_trjob(s_wv, J0, lds); run_trjob(s_wv, J1, lds);
    }
}
__device__ __forceinline__ void phase_prologue(const int s_wv, KP p, ldsp lds) {
    const int tid = otid();
    float* MOD = (float*)(p->ws + OFF_MOD);
    LAS float* cact = (LAS float*)lds;
    LAS float* red = (LAS float*)(lds + 16384);
    for (int i = tid; i < 4096; i += NTHREADS) { const float c = p->in[1][i]; cact[i] = c * fast_sigmoid(c); }
    __syncthreads();
    const int l16 = tid & 15, kg = tid >> 4;
    for (int item = obid(); item < 4 * 96; item += gridDim.x) {
        const int layer = item / 96, n0 = (item % 96) * 64;
        const float* w = p->in[3] + (size_t)layer * 1024 * 6144 + n0 + 4 * l16;
        f32x4 a[4] = {{0.f, 0.f, 0.f, 0.f}, {0.f, 0.f, 0.f, 0.f}, {0.f, 0.f, 0.f, 0.f}, {0.f, 0.f, 0.f, 0.f}};
#pragma unroll 8
        for (int kk = 0; kk < 32; ++kk) { const int k = kg * 32 + kk; const f32x4 wv = *(const f32x4*)(w + (size_t)k * 6144);
#pragma unroll
            for (int b = 0; b < 4; ++b) a[b] = a[b] + wv * cact[b * 1024 + k]; }
#pragma unroll
        for (int b = 0; b < 4; ++b) *(LAS f32x4*)(red + (kg * 4 + b) * 64 + 4 * l16) = a[b];
        __syncthreads();
        if (tid < 256) { const int b = tid >> 6, col = tid & 63; float s = 0.f;
#pragma unroll 8
            for (int g = 0; g < 32; ++g) s += red[(g * 4 + b) * 64 + col];
            MOD[(size_t)(layer * 4 + b) * 6144 + n0 + col] = s + p->in[4][(size_t)layer * 6144 + n0 + col]; }
        __syncthreads();
    }
    const int gtid = obid() * NTHREADS + tid, gthreads = gridDim.x * NTHREADS;
    float* CSC = (float*)(p->ws + OFF_CSC); float* CSS = (float*)(p->ws + OFF_CSS);
    const int* pos = (const int*)p->in[2];
    for (int i = gtid; i < T * 32; i += gthreads) { const int t = i >> 5, jj = i & 31;
        const float invf = exp2f(-(float)jj * (13.287712379549449f / 32.f));
        const float ang = (float)pos[t] * invf;
        double rev = (double)ang * 0.15915494309189535; rev -= floor(rev);
        const float rf = (float)rev;
        CSC[i] = __builtin_amdgcn_cosf(rf); CSS[i] = __builtin_amdgcn_sinf(rf); }
    float* LB = (float*)(p->ws + OFF_LB);
    for (int i = gtid; i < 1024; i += gthreads) { const float l0 = p->in[19][i], l1 = p->in[19][1024 + i], l2 = p->in[19][2048 + i], l3 = p->in[19][3072 + i];
        const float mx = fmaxf(fmaxf(l0, l1), fmaxf(l2, l3)); const float e0 = __expf(l0 - mx), e1 = __expf(l1 - mx), e2 = __expf(l2 - mx), e3 = __expf(l3 - mx);
        LB[i] = (e1 + e2) / (e0 + e1 + e2 + e3); }
    prep_layer(s_wv, p, 0, lds);
}
__device__ __forceinline__ void up8(const u32x4 v, float (&o)[8]) { o[0] = bflo(v[0]); o[1] = bfhi(v[0]); o[2] = bflo(v[1]); o[3] = bfhi(v[1]); o[4] = bflo(v[2]); o[5] = bfhi(v[2]); o[6] = bflo(v[3]); o[7] = bfhi(v[3]); }
template <bool SRC32> __device__ __forceinline__ void phase_norm(const int s_wv, const float* X32, bf16_t* XB, const float* g, const float* shift, const float* scale, bf16_t* dst) {
    const int lane = otid() & 63, wave = otid() >> 6;
    for (int rb = obid() * 8 + wave; rb < T / 8; rb += gridDim.x * 8) {
        const int r0 = rb * 8, b = r0 >> 12;
        float G[16], SH[16];
#pragma unroll
        for (int j = 0; j < 2; ++j)
#pragma unroll
            for (int h = 0; h < 2; ++h) { const int c = 8 * lane + 512 * j + 4 * h; const f32x4 gg = *(const f32x4*)(g + c), sc = *(const f32x4*)(scale + (size_t)b * 6144 + c), sh = *(const f32x4*)(shift + (size_t)b * 6144 + c);
#pragma unroll
                for (int e = 0; e < 4; ++e) { G[j * 8 + h * 4 + e] = gg[e] * (sc[e] + 1.f); SH[j * 8 + h * 4 + e] = sh[e]; } }
        for (int r = r0; r < r0 + 8; ++r) {
            float x[16]; float ss = 0.f;
#pragma unroll
            for (int j = 0; j < 2; ++j) { const unsigned off = (unsigned)(r * 1024 + 8 * lane + 512 * j);
                if (SRC32) { const f32x4 a = *(const f32x4*)(X32 + off), c = *(const f32x4*)(X32 + off + 4);
#pragma unroll
                    for (int e = 0; e < 4; ++e) { x[j * 8 + e] = a[e]; x[j * 8 + 4 + e] = c[e]; }
                    u32x4 xo = {pk2(a[0], a[1]), pk2(a[2], a[3]), pk2(c[0], c[1]), pk2(c[2], c[3])}; *(u32x4*)(XB + off) = xo;
                } else { float t[8]; up8(*(const u32x4*)(XB + off), t);
#pragma unroll
                    for (int e = 0; e < 8; ++e) x[j * 8 + e] = t[e]; } }
#pragma unroll
            for (int e = 0; e < 16; ++e) ss += x[e] * x[e];
            ss = wave_sum(ss, lane); const float rstd = rsqrtf(ss * (1.f / 1024.f) + EPS);
#pragma unroll
            for (int j = 0; j < 2; ++j) { float h[8];
#pragma unroll
                for (int e = 0; e < 8; ++e) h[e] = x[j * 8 + e] * rstd * G[j * 8 + e] + SH[j * 8 + e];
                u32x4 o = {pk2(h[0], h[1]), pk2(h[2], h[3]), pk2(h[4], h[5]), pk2(h[6], h[7])}; *(u32x4*)(dst + (unsigned)(r * 1024 + 8 * lane + 512 * j)) = o; }
        }
    }
}
__device__ __forceinline__ void phase_final(const int s_wv, const bf16_t* XB, float* out, const float* g) {
    const int lane = otid() & 63, wave = otid() >> 6;
    for (int r = obid() * 8 + wave; r < T; r += gridDim.x * 8) {
        float x[16]; float ss = 0.f;
#pragma unroll
        for (int j = 0; j < 2; ++j) { float t[8]; up8(*(const u32x4*)(XB + (unsigned)(r * 1024 + 8 * lane + 512 * j)), t);
#pragma unroll
            for (int e = 0; e < 8; ++e) { x[j * 8 + e] = t[e]; ss += t[e] * t[e]; } }
        ss = wave_sum(ss, lane); const float rstd = rsqrtf(ss * (1.f / 1024.f) + EPS);
#pragma unroll
        for (int j = 0; j < 2; ++j)
#pragma unroll
            for (int h = 0; h < 2; ++h) { const int c = 8 * lane + 512 * j + 4 * h; const f32x4 gg = *(const f32x4*)(g + c);
                f32x4 o = {x[j * 8 + h * 4] * rstd * gg[0], x[j * 8 + h * 4 + 1] * rstd * gg[1], x[j * 8 + h * 4 + 2] * rstd * gg[2], x[j * 8 + h * 4 + 3] * rstd * gg[3]};
                *(f32x4*)(out + (size_t)r * 1024 + c) = o; }
    }
}
__device__ __forceinline__ void phase_ffix(const int s_wv, const bf16_t* SIDE, bf16_t* ACT, const float* cw, const float* cb) {
    const int gtid = obid() * NTHREADS + otid(), gthreads = gridDim.x * NTHREADS;
    for (int q = gtid; q < 256 * 2 * 352; q += gthreads) {
        const int cgp = q % 352, gi = q / 352, i = gi & 1, g = gi >> 1, f0 = cgp * 8;
        const bool first = (g & 63) == 0;
        const bf16_t* own = SIDE + (size_t)((g * 4 + 2 + i) * 2) * 2816 + f0;
        const bf16_t* p1 = i == 0 ? SIDE + (size_t)(((g - 1) * 4 + 1) * 2) * 2816 + f0 : SIDE + (size_t)((g * 4 + 2) * 2) * 2816 + f0;
        const bf16_t* p2 = i == 0 ? SIDE + (size_t)(((g - 1) * 4 + 0) * 2) * 2816 + f0 : SIDE + (size_t)(((g - 1) * 4 + 1) * 2) * 2816 + f0;
        float gc[8], vc[8], g1[8], v1[8], g2[8], v2[8];
        up8(*(const u32x4*)own, gc); up8(*(const u32x4*)(own + 2816), vc);
        if (i == 1 || !first) { up8(*(const u32x4*)p1, g1); up8(*(const u32x4*)(p1 + 2816), v1); } else {
#pragma unroll
            for (int e = 0; e < 8; ++e) { g1[e] = 0.f; v1[e] = 0.f; } }
        if (!first) { up8(*(const u32x4*)p2, g2); up8(*(const u32x4*)(p2 + 2816), v2); } else {
#pragma unroll
            for (int e = 0; e < 8; ++e) { g2[e] = 0.f; v2[e] = 0.f; } }
        float o[8];
#pragma unroll
        for (int e = 0; e < 8; ++e) { const int f = f0 + e;
            const float yg = cb[f] + cw[f] * g2[e] + cw[5632 + f] * g1[e] + cw[11264 + f] * gc[e], yv = cb[2816 + f] + cw[2816 + f] * v2[e] + cw[5632 + 2816 + f] * v1[e] + cw[11264 + 2816 + f] * vc[e];
            o[e] = yg * fast_sigmoid(yg) * yv; }
        u32x4 ov = {pk2(o[0], o[1]), pk2(o[2], o[3]), pk2(o[4], o[5]), pk2(o[6], o[7])};
        *(u32x4*)(ACT + (size_t)(g * 64 + i) * 2816 + f0) = ov;
    }
}

__device__ __forceinline__ void phase_gsp(const int s_wv, KP p, int j, ldsp lds) {
    const bf16_t* Z = (const bf16_t*)(p->ws + OFF_R1); bf16_t* Y = (bf16_t*)(p->ws + OFF_R2);
    const float* ws_w = p->in[10] + (size_t)j * 8 * 128 * 128; const float* bs = p->in[11] + (size_t)j * 8 * 128;
    const float* lng = p->in[8] + (size_t)j * 2048; const float* lnb = p->in[9] + (size_t)j * 2048;
    const int tid = otid(), lane = tid & 63, wave = tid >> 6, l15 = lane & 15, g4 = lane >> 4;
    ldsp As = lds, Bs = lds + 34816; LAS float* mu = (LAS float*)(lds + 104448); LAS float* rs = mu + 128;
    for (int unit = obid(); unit < 256; unit += gridDim.x) {
        const int gh = unit & 1, chunk = unit >> 1, t0 = chunk * 128;
        for (int rr = 0; rr < 16; ++rr) { const int r = wave * 16 + rr; const bf16_t* zp = Z + (size_t)(t0 + r) * 4096 + 2048 + lane * 32; float s = 0.f, s2 = 0.f;
#pragma unroll
            for (int i = 0; i < 4; ++i) { float v[8]; up8(*(const u32x4*)(zp + 8 * i), v);
#pragma unroll
                for (int e = 0; e < 8; ++e) { s += v[e]; s2 += v[e] * v[e]; } }
            s = wave_sum(s, lane); s2 = wave_sum(s2, lane);
            if (lane == 0) { const float m = s * (1.f / 2048.f); float var = s2 * (1.f / 2048.f) - m * m; var = fmaxf(var, 0.f); mu[r] = m; rs[r] = rsqrtf(var + EPS); } }
        __syncthreads();
        for (int gi = 0; gi < 4; ++gi) {
            const int g = gh * 4 + gi;
#pragma unroll 2
            for (int i = 0; i < 8; ++i) { const int idx = tid + 512 * i, t = idx >> 5, s4 = (idx & 31) * 4; f32x4 w = *(const f32x4*)(ws_w + (size_t)g * 16384 + t * 128 + s4);
#pragma unroll
                for (int e = 0; e < 4; ++e) w[e] = (s4 + e <= t) ? w[e] : 0.f;
                u32x2 o = {pk2(w[0], w[1]), pk2(w[2], w[3])}; *(LAS u32x2*)(As + t * 272 + s4 * 2) = o; }
#pragma unroll 2
            for (int i = 0; i < 8; ++i) { const int idx = tid + 512 * i, s = idx >> 5, c8 = idx & 31; float v[8]; up8(*(const u32x4*)(Z + (size_t)(t0 + s) * 4096 + 2048 + g * 256 + c8 * 8), v);
                const float m = mu[s], r = rs[s]; const f32x4 ga = *(const f32x4*)(lng + g * 256 + c8 * 8), gb = *(const f32x4*)(lng + g * 256 + c8 * 8 + 4), ba = *(const f32x4*)(lnb + g * 256 + c8 * 8), bb = *(const f32x4*)(lnb + g * 256 + c8 * 8 + 4);
                const int boff = (((s >> 3) ^ (c8 & 15)) << 4) + (s & 7) * 2;
#pragma unroll
                for (int e = 0; e < 8; ++e) { const float gg = e < 4 ? ga[e] : gb[e - 4], bbv = e < 4 ? ba[e] : bb[e - 4]; const float val = (v[e] - m) * r * gg + bbv;
                    *(LAS bf16_t*)(Bs + (c8 * 8 + e) * 272 + boff) = (bf16_t)(pk2(val, 0.f) & 0xffffu); } }
            __syncthreads();
            f32x4 acc[8][2];
#pragma unroll
            for (int tt = 0; tt < 8; ++tt) { acc[tt][0] = zero4(); acc[tt][1] = zero4(); }
#pragma unroll
            for (int tt = 0; tt < 8; ++tt)
#pragma unroll
                for (int ks = 0; ks <= tt / 2; ++ks) { const bf16x8 yf = *(const LAS bf16x8*)(As + (16 * tt + l15) * 272 + (32 * ks + 8 * g4) * 2);
#pragma unroll
                    for (int ct = 0; ct < 2; ++ct) { const int c = 32 * wave + 16 * ct + l15; const bf16x8 xf = *(const LAS bf16x8*)(Bs + c * 272 + (((4 * ks + g4) ^ ((c >> 3) & 15)) << 4));
                        acc[tt][ct] = MFMA16(xf, yf, acc[tt][ct]); } }
#pragma unroll
            for (int tt = 0; tt < 8; ++tt) { const int t = 16 * tt + l15; const float bias = bs[g * 128 + t];
#pragma unroll
                for (int ct = 0; ct < 2; ++ct) { const int c = g * 256 + 32 * wave + 16 * ct + 4 * g4; const u32x2 uu = *(const u32x2*)(Z + (size_t)(t0 + t) * 4096 + c);
                    const f32x4 a = acc[tt][ct]; u32x2 o = {pk2(bflo(uu[0]) * (a[0] + bias), bfhi(uu[0]) * (a[1] + bias)), pk2(bflo(uu[1]) * (a[2] + bias), bfhi(uu[1]) * (a[3] + bias))};
                    *(u32x2*)(Y + (size_t)(t0 + t) * 2048 + c) = o; } }
            __syncthreads();
        }
    }
}

__device__ __forceinline__ void phase_m2(const int s_wv, KP p) {
    const float* A1 = (const float*)(p->ws + OFF_R1); bf16_t* CQN = (bf16_t*)(p->ws + OFF_R1 + 32 * MiB); bf16_t* CKVN = (bf16_t*)(p->ws + OFF_R1 + 40 * MiB); bf16_t* KF = (bf16_t*)(p->ws + OFF_R1 + 96 * MiB);
    const float* CSC = (const float*)(p->ws + OFF_CSC); const float* CSS = (const float*)(p->ws + OFF_CSS);
    const int lane = otid() & 63, wave = otid() >> 6;
    const f32x4 qg = *(const f32x4*)(p->in[14] + 4 * lane); const f32x4 kg = *(const f32x4*)(p->in[15] + 4 * (lane & 31));
    for (int r = obid() * 8 + wave; r < T; r += gridDim.x * 8) {
        const float* a = A1 + (size_t)r * 512;
        const f32x4 cq = *(const f32x4*)(a + 4 * lane); float ss = wave_sum(cq[0] * cq[0] + cq[1] * cq[1] + cq[2] * cq[2] + cq[3] * cq[3], lane);
        const float rq = rsqrtf(ss * (1.f / 256.f) + EPS);
        { const f32x4 h = cq * rq * qg; u32x2 o = {pk2(h[0], h[1]), pk2(h[2], h[3])}; *(u32x2*)(CQN + (size_t)r * 256 + 4 * lane) = o; }
        const f32x4 ck = *(const f32x4*)(a + 256 + 4 * (lane & 31)); float s2 = lane < 32 ? (ck[0] * ck[0] + ck[1] * ck[1] + ck[2] * ck[2] + ck[3] * ck[3]) : 0.f; s2 = wave_sum(s2, lane);
        const float rk = rsqrtf(s2 * (1.f / 128.f) + EPS);
        { const f32x4 h = ck * rk * kg; u32x2 o = {pk2(h[0], h[1]), pk2(h[2], h[3])}; if (lane >= 32) { o[0] = 0u; o[1] = 0u; } *(u32x2*)(CKVN + (size_t)r * 256 + 4 * lane) = o; }
        if (lane < 32) {
            const float x1 = a[384 + lane], x2 = a[416 + lane], c = CSC[(size_t)r * 32 + lane], s = CSS[(size_t)r * 32 + lane];
            const unsigned pr = pk2(x1 * c - x2 * s, x2 * c + x1 * s); const int b = r >> 12, sq = r & 4095;
#pragma unroll
            for (int h8 = 0; h8 < 8; ++h8) { bf16_t* kp = KF + ((size_t)((b * 8 + h8) * 4096 + sq)) * 192 + 128 + lane; kp[0] = (bf16_t)(pr & 0xffffu); kp[32] = (bf16_t)(pr >> 16); } }
    }
}

__device__ __forceinline__ void phase_attn(const int s_wv, KP p, ldsp lds) {
    const bf16_t* QF = (const bf16_t*)(p->ws + OFF_R1 + 48 * MiB); const bf16_t* KF = (const bf16_t*)(p->ws + OFF_R1 + 96 * MiB); const bf16_t* VT = (const bf16_t*)(p->ws + OFF_R1 + 144 * MiB);
    bf16_t* O = (bf16_t*)(p->ws + OFF_R2);
    const int tid = otid(), lane = tid & 63, wave = __builtin_amdgcn_readfirstlane(tid >> 6), l15 = lane & 15, g4 = lane >> 4;
    const int G = gridDim.x, bx = obid(), vcu = (G % 8 == 0) ? (bx % 8) * (G / 8) + bx / 8 : bx;
    constexpr int KB = 25600, VB = 18432, BUF = KB + VB;
    for (int unit = vcu; unit < 256; unit += G) {
        const int bh = unit >> 3, pr = unit & 7, b = bh >> 3, h = bh & 7;
        const unsigned char* kbase = (const unsigned char*)(KF + (size_t)bh * 4096 * 192);
        const unsigned char* vbase = (const unsigned char*)(VT + (size_t)bh * 128 * 4096);
        for (int half = 0; half < 2; ++half) {
            const int qb = half == 0 ? 15 - pr : pr, ntile = 4 * qb + 4;
            const int qrow0 = qb * 256 + 32 * wave;
            bf16x8 Qf[2][6];
#pragma unroll
            for (int qt = 0; qt < 2; ++qt)
#pragma unroll
                for (int ks = 0; ks < 6; ++ks) Qf[qt][ks] = *(const bf16x8*)((const unsigned char*)(QF + (size_t)(bh * 4096 + qrow0) * 192) + (unsigned)(((16 * qt + l15) * 192 + 32 * ks + 8 * g4) * 2));
            f32x4 Oa[2][8]; float mrun[2] = {-1e30f, -1e30f}, lsum[2] = {0.f, 0.f};
#pragma unroll
            for (int qt = 0; qt < 2; ++qt)
#pragma unroll
                for (int d = 0; d < 8; ++d) Oa[qt][d] = zero4();
#define ATT_DMA(j, bufi) do { ldsp kb_ = lds + (bufi) * BUF; \
                for (int c = wave; c < 25; c += 8) { const int q_ = c * 64 + lane, row = q_ / 25, c16 = min(q_ - row * 25, 23); \
                    __builtin_amdgcn_global_load_lds((const unsigned*)(kbase + (size_t)(j) * 24576 + (unsigned)(row * 384 + c16 * 16)), (LAS unsigned*)(kb_ + c * 1024), 16, 0, 0); } \
                for (int c = wave; c < 18; c += 8) { const int q_ = c * 64 + lane, dv = q_ / 9, k8 = min(q_ - dv * 9, 7); \
                    __builtin_amdgcn_global_load_lds((const unsigned*)(vbase + (size_t)(j) * 128 + (unsigned)(dv * 8192 + k8 * 16)), (LAS unsigned*)(kb_ + KB + c * 1024), 16, 0, 0); } } while (0)
            ATT_DMA(0, 0); asm volatile("s_waitcnt vmcnt(0)" ::: "memory"); __syncthreads();
#pragma unroll 1
            for (int j = 0; j < ntile; ++j) {
                if (j + 1 < ntile) ATT_DMA(j + 1, (j + 1) & 1);
                if (wave >= 4) __builtin_amdgcn_s_sleep(8);
                const int jj = j - 4 * qb; const bool diag = jj >= 0; const bool active = !(diag && 64 * jj > 32 * wave + 31);
                ldsp Kb = lds + (j & 1) * BUF; ldsp Vb = Kb + KB;
#pragma unroll
                for (int hs = 0; hs < 2; ++hs) {
                    if (active) {
                        f32x4 S[2][2];
#pragma unroll
                        for (int qt = 0; qt < 2; ++qt) { S[qt][0] = zero4(); S[qt][1] = zero4(); }
                        {
#define ATT_KLD(i) (*(const LAS bf16x8*)(Kb + (16 * (2 * hs + ((i) & 1)) + l15) * 400 + (32 * ((i) >> 1) + 8 * g4) * 2))
                            bf16x8 kq[3]; kq[0] = ATT_KLD(0); kq[1] = ATT_KLD(1);
#pragma unroll
                            for (int i = 0; i < 12; ++i) { if (i + 2 < 12) kq[(i + 2) % 3] = ATT_KLD(i + 2);
                                __builtin_amdgcn_sched_barrier(0);
                                S[0][i & 1] = MFMA16(kq[i % 3], Qf[0][i >> 1], S[0][i & 1]); S[1][i & 1] = MFMA16(kq[i % 3], Qf[1][i >> 1], S[1][i & 1]);
                                __builtin_amdgcn_sched_barrier(0); }
#undef ATT_KLD
                        }
                        bf16x8 Pf[2];
#pragma unroll
                        for (int qt = 0; qt < 2; ++qt) {
                            if (diag) { int dq = 32 * wave + 16 * qt + l15 - 4 * g4 - 64 * jj; asm volatile("" : "+v"(dq));
#pragma unroll
                                for (int sb = 0; sb < 2; ++sb)
#pragma unroll
                                    for (int e = 0; e < 4; ++e) { if (32 * hs + 16 * sb + e > dq) S[qt][sb][e] = -1e30f; } }
                            float tm = -1e30f;
#pragma unroll
                            for (int sb = 0; sb < 2; ++sb)
#pragma unroll
                                for (int e = 0; e < 4; ++e) tm = fmaxf(tm, S[qt][sb][e]);
                            tm = rowmax4(tm);
                            if (__builtin_amdgcn_ballot_w64(tm > mrun[qt]) != 0ull) {
                                const float mn = fmaxf(mrun[qt], tm), sc = __builtin_amdgcn_exp2f(mrun[qt] - mn); mrun[qt] = mn; lsum[qt] *= sc;
#pragma unroll
                                for (int d = 0; d < 8; ++d) Oa[qt][d] = Oa[qt][d] * sc; }
                            const float mn = mrun[qt];
                            float ps = 0.f;
#pragma unroll
                            for (int sb = 0; sb < 2; ++sb)
#pragma unroll
                                for (int e = 0; e < 4; ++e) { const float pe = __builtin_amdgcn_exp2f(S[qt][sb][e] - mn); S[qt][sb][e] = pe; ps += pe; }
                            lsum[qt] += ps;
                            Pf[qt] = mk8(pk2(S[qt][0][0], S[qt][0][1]), pk2(S[qt][0][2], S[qt][0][3]), pk2(S[qt][1][0], S[qt][1][1]), pk2(S[qt][1][2], S[qt][1][3]));
                        }
                        {
#define ATT_VLD(d) __builtin_shufflevector(*(const LAS bf16x4*)(Vb + (16 * (d) + l15) * 144 + (32 * hs + 4 * g4) * 2), *(const LAS bf16x4*)(Vb + (16 * (d) + l15) * 144 + (32 * hs + 16 + 4 * g4) * 2), 0, 1, 2, 3, 4, 5, 6, 7)
                            bf16x8 vq[3]; vq[0] = ATT_VLD(0); vq[1] = ATT_VLD(1);
#pragma unroll
                            for (int d = 0; d < 8; ++d) { if (d + 2 < 8) vq[(d + 2) % 3] = ATT_VLD(d + 2);
                                __builtin_amdgcn_sched_barrier(0);
                                Oa[0][d] = MFMA16(vq[d % 3], Pf[0], Oa[0][d]); Oa[1][d] = MFMA16(vq[d % 3], Pf[1], Oa[1][d]);
                                __builtin_amdgcn_sched_barrier(0); }
#undef ATT_VLD
                        }
                    }
                }
                asm volatile("s_waitcnt vmcnt(0)" ::: "memory"); __syncthreads();
            }
#pragma unroll
            for (int qt = 0; qt < 2; ++qt) { float ls = lsum[qt]; ls = rowsum4(ls); const float inv = 1.f / ls;
                bf16_t* op = (bf16_t*)((unsigned char*)(O + (size_t)(b * 4096 + qrow0) * 1024 + h * 128) + (unsigned)(((16 * qt + l15) * 1024 + 4 * g4) * 2));
#pragma unroll
                for (int d = 0; d < 8; ++d) { const f32x4 v = Oa[qt][d] * inv; u32x2 o = {pk2(v[0], v[1]), pk2(v[2], v[3])}; *(u32x2*)(op + 16 * d) = o; } }
        }
    }
#undef ATT_DMA
}

template <bool TOF32> __device__ __forceinline__ void hg_load_f_v(const float* HF, const bf16_t* HV, int t0, int col0, LAS float* BC, LAS float* K1f, ldsp K1b, ldsp VTl, int tid) {
#pragma unroll
    for (int i = 0; i < 4; ++i) { const int idx = tid + 512 * i, s = idx >> 5, k4 = (idx & 31) * 4; const f32x4 f = *(const f32x4*)(HF + (size_t)(t0 + s) * 1024 + col0 + k4);
#pragma unroll
        for (int e = 0; e < 4; ++e) BC[s * 129 + k4 + e] = __logf(f[e]);
        if (TOF32) {
#pragma unroll
            for (int e = 0; e < 4; ++e) K1f[s * 129 + k4 + e] = 1.f - f[e];
        } else { u32x2 o = {pk2(1.f - f[0], 1.f - f[1]), pk2(1.f - f[2], 1.f - f[3])}; *(LAS u32x2*)(K1b + s * 272 + k4 * 2) = o; } }
#pragma unroll
    for (int i = 0; i < 2; ++i) { const int idx = tid + 512 * i, s = idx >> 4, v8 = idx & 15; const u32x4 vv = *(const u32x4*)(HV + (size_t)(t0 + s) * 1024 + col0 + v8 * 8);
#pragma unroll
        for (int e = 0; e < 4; ++e) { *(LAS bf16_t*)(VTl + (v8 * 8 + 2 * e) * 144 + s * 2) = (bf16_t)(vv[e] & 0xffffu); *(LAS bf16_t*)(VTl + (v8 * 8 + 2 * e + 1) * 144 + s * 2) = (bf16_t)(vv[e] >> 16); } }
}
__device__ __forceinline__ void phase_ha(const int s_wv, KP p, ldsp lds) {
    const float* HF = (const float*)(p->ws + OFF_R1 + 32 * MiB); const bf16_t* HV = (const bf16_t*)(p->ws + OFF_R1 + 96 * MiB);
    bf16_t* LCT = (bf16_t*)(p->ws + OFF_R2); float* DEC = (float*)(p->ws + OFF_R2 + 64 * MiB);
    const int tid = otid(), lane = tid & 63, wave = tid >> 6, l15 = lane & 15, g4 = lane >> 4;
    LAS float* BC = (LAS float*)lds; LAS float* K1 = (LAS float*)(lds + 33024); ldsp KT = lds + 66048; ldsp VTl = lds + 84480;
    for (int u = obid(); u < 2048; u += gridDim.x) {
        const int bh = u >> 6, n = u & 63, b = bh >> 3, h = bh & 7, t0 = b * 4096 + n * 64, col0 = h * 128;
        hg_load_f_v<true>(HF, HV, t0, col0, BC, K1, VTl, VTl, tid);
        __syncthreads();
        if (tid < 128) { float run = 0.f;
#pragma unroll 8
            for (int s = 0; s < 64; ++s) { run += BC[s * 129 + tid]; BC[s * 129 + tid] = run; }
            DEC[(size_t)u * 128 + tid] = __expf(run); }
        __syncthreads();
        { const int sp = tid & 31, kk0 = tid >> 5;
#pragma unroll
          for (int it = 0; it < 8; ++it) { const int k = kk0 + 16 * it; const float bl = BC[63 * 129 + k];
              const float a0 = K1[(2 * sp) * 129 + k] * __expf(bl - BC[(2 * sp) * 129 + k]), a1 = K1[(2 * sp + 1) * 129 + k] * __expf(bl - BC[(2 * sp + 1) * 129 + k]);
              *(LAS unsigned*)(KT + k * 144 + sp * 4) = pk2(a0, a1); } }
        __syncthreads();
        f32x4 acc[8];
#pragma unroll
        for (int vt = 0; vt < 8; ++vt) acc[vt] = zero4();
#pragma unroll
        for (int ks = 0; ks < 2; ++ks) { const bf16x8 xf = *(const LAS bf16x8*)(KT + (16 * wave + l15) * 144 + (32 * ks + 8 * g4) * 2);
#pragma unroll
            for (int vt = 0; vt < 8; ++vt) { const bf16x8 yf = *(const LAS bf16x8*)(VTl + (16 * vt + l15) * 144 + (32 * ks + 8 * g4) * 2); acc[vt] = MFMA16(xf, yf, acc[vt]); } }
#pragma unroll
        for (int vt = 0; vt < 8; ++vt) { u32x2 o = {pk2(acc[vt][0], acc[vt][1]), pk2(acc[vt][2], acc[vt][3])}; *(u32x2*)(LCT + ((size_t)u * 128 + 16 * vt + l15) * 128 + 16 * wave + 4 * g4) = o; }
        __syncthreads();
    }
}
__device__ __forceinline__ void phase_hscan(const int s_wv, KP p) {
    bf16_t* LCT = (bf16_t*)(p->ws + OFF_R2); const float* DEC = (const float*)(p->ws + OFF_R2 + 64 * MiB);
    const int gtid = obid() * NTHREADS + otid(), gthreads = gridDim.x * NTHREADS;
    for (int id = gtid; id < 32 * 128 * 32; id += gthreads) {
        const int k4 = id & 31, v = (id >> 5) & 127, bh = id >> 12;
        f32x4 st = zero4();
#pragma unroll 4
        for (int n = 0; n < 64; ++n) { const int u = bh * 64 + n; bf16_t* ptr = LCT + ((size_t)u * 128 + v) * 128 + 4 * k4;
            const u32x2 t = *(const u32x2*)ptr; const f32x4 dec = *(const f32x4*)(DEC + (size_t)u * 128 + 4 * k4);
            u32x2 o = {pk2(st[0], st[1]), pk2(st[2], st[3])}; *(u32x2*)ptr = o;
            st[0] = dec[0] * st[0] + bflo(t[0]); st[1] = dec[1] * st[1] + bfhi(t[0]); st[2] = dec[2] * st[2] + bflo(t[1]); st[3] = dec[3] * st[3] + bfhi(t[1]); }
    }
}
__device__ __forceinline__ void phase_hc(const int s_wv, KP p, ldsp lds) {
    const bf16_t* HQ = (const bf16_t*)(p->ws + OFF_R1); const float* HF = (const float*)(p->ws + OFF_R1 + 32 * MiB); const bf16_t* HV = (const bf16_t*)(p->ws + OFF_R1 + 96 * MiB); const bf16_t* HG = (const bf16_t*)(p->ws + OFF_R1 + 128 * MiB);
    const bf16_t* SST = (const bf16_t*)(p->ws + OFF_R2); bf16_t* O = (bf16_t*)(p->ws + OFF_HB); const float* ng = p->in[21];
    const int tid = otid(), lane = tid & 63, wave = tid >> 6, l15 = lane & 15, g4 = lane >> 4;
    LAS float* BC = (LAS float*)lds; ldsp QT = lds + 33024; ldsp KTl = lds + 50432; ldsp QH = lds + 67840; ldsp VTl = lds + 85248; ldsp AT = lds + 103680; LAS float* SSQ = (LAS float*)(lds + 112896);
    for (int u = obid(); u < 2048; u += gridDim.x) {
        const int bh = u >> 6, n = u & 63, b = bh >> 3, h = bh & 7, t0 = b * 4096 + n * 64, col0 = h * 128;
        hg_load_f_v<false>(HF, HV, t0, col0, BC, BC, KTl, VTl, tid);
        u32x4 qraw[2];
#pragma unroll
        for (int i = 0; i < 2; ++i) { const int idx = tid + 512 * i, s = idx >> 4, k8 = idx & 15; qraw[i] = *(const u32x4*)(HQ + (size_t)(t0 + s) * 1024 + col0 + k8 * 8); }
        __syncthreads();
        if (tid < 128) { float run = 0.f;
#pragma unroll 8
            for (int s = 0; s < 64; ++s) { run += BC[s * 129 + tid]; BC[s * 129 + tid] = run; } }
        __syncthreads();
#pragma unroll
        for (int i = 0; i < 2; ++i) { const int idx = tid + 512 * i, s = idx >> 4, k8 = idx & 15; float q[8], kk[8], qt[8], qh[8]; up8(qraw[i], q); up8(*(const LAS u32x4*)(KTl + s * 272 + k8 * 16), kk);
#pragma unroll
            for (int e = 0; e < 8; ++e) { const int k = k8 * 8 + e; const float bc = BC[s * 129 + k], bm = BC[31 * 129 + k]; qt[e] = q[e] * __expf(bc - bm); qh[e] = q[e] * __expf(bc); kk[e] = kk[e] * __expf(bm - bc); }
            u32x4 o1 = {pk2(qt[0], qt[1]), pk2(qt[2], qt[3]), pk2(qt[4], qt[5]), pk2(qt[6], qt[7])}, o2 = {pk2(qh[0], qh[1]), pk2(qh[2], qh[3]), pk2(qh[4], qh[5]), pk2(qh[6], qh[7])}, o3 = {pk2(kk[0], kk[1]), pk2(kk[2], kk[3]), pk2(kk[4], kk[5]), pk2(kk[6], kk[7])};
            *(LAS u32x4*)(QT + s * 272 + k8 * 16) = o1; *(LAS u32x4*)(QH + s * 272 + k8 * 16) = o2; *(LAS u32x4*)(KTl + s * 272 + k8 * 16) = o3; }
        __syncthreads();
        { const int st = wave & 3;
#pragma unroll
          for (int ti = 0; ti < 2; ++ti) { const int tt = 2 * (wave >> 2) + ti; f32x4 a = zero4();
              if (st <= tt) {
#pragma unroll
                  for (int ks = 0; ks < 4; ++ks) { const bf16x8 xf = *(const LAS bf16x8*)(KTl + (16 * st + l15) * 272 + (32 * ks + 8 * g4) * 2), yf = *(const LAS bf16x8*)(QT + (16 * tt + l15) * 272 + (32 * ks + 8 * g4) * 2); a = MFMA16(xf, yf, a); }
                  const int t = 16 * tt + l15;
#pragma unroll
                  for (int e = 0; e < 4; ++e) { const int s = 16 * st + 4 * g4 + e; if (s > t) a[e] = 0.f; } }
              u32x2 o = {pk2(a[0], a[1]), pk2(a[2], a[3])}; *(LAS u32x2*)(AT + (16 * tt + l15) * 144 + (16 * st + 4 * g4) * 2) = o; } }
        __syncthreads();
        { const int tt = wave >> 1, vh = wave & 1; f32x4 acc[4];
#pragma unroll
          for (int vi = 0; vi < 4; ++vi) acc[vi] = zero4();
#pragma unroll
          for (int ks = 0; ks < 2; ++ks) if (32 * ks <= 16 * tt + 15) { const bf16x8 yf = *(const LAS bf16x8*)(AT + (16 * tt + l15) * 144 + (32 * ks + 8 * g4) * 2);
#pragma unroll
              for (int vi = 0; vi < 4; ++vi) { const bf16x8 xf = *(const LAS bf16x8*)(VTl + (16 * (4 * vh + vi) + l15) * 144 + (32 * ks + 8 * g4) * 2); acc[vi] = MFMA16(xf, yf, acc[vi]); } }
#pragma unroll
          for (int ks = 0; ks < 4; ++ks) { const bf16x8 yf = *(const LAS bf16x8*)(QH + (16 * tt + l15) * 272 + (32 * ks + 8 * g4) * 2);
#pragma unroll
              for (int vi = 0; vi < 4; ++vi) { const bf16x8 xf = *(const bf16x8*)(SST + ((size_t)u * 128 + 16 * (4 * vh + vi) + l15) * 128 + 32 * ks + 8 * g4); acc[vi] = MFMA16(xf, yf, acc[vi]); } }
          float sq = 0.f;
#pragma unroll
          for (int vi = 0; vi < 4; ++vi)
#pragma unroll
              for (int e = 0; e < 4; ++e) sq += acc[vi][e] * acc[vi][e];
          sq = rowsum4(sq);
          if (g4 == 0) SSQ[(16 * tt + l15) * 2 + vh] = sq;
          __syncthreads();
          const int t = 16 * tt + l15; const float rstd = rsqrtf((SSQ[t * 2] + SSQ[t * 2 + 1]) * (1.f / 128.f) + EPS);
#pragma unroll
          for (int vi = 0; vi < 4; ++vi) { const int v = 16 * (4 * vh + vi) + 4 * g4; const f32x4 gn = *(const f32x4*)(ng + v); const u32x2 gg = *(const u32x2*)(HG + (size_t)(t0 + t) * 1024 + col0 + v);
              const f32x4 a = acc[vi] * rstd * gn; u32x2 o = {pk2(a[0] * bflo(gg[0]), a[1] * bfhi(gg[0])), pk2(a[2] * bflo(gg[1]), a[3] * bfhi(gg[1]))};
              *(u32x2*)(O + (size_t)(t0 + t) * 1024 + col0 + v) = o; } }
        __syncthreads();
    }
}

__global__ void __launch_bounds__(NTHREADS, 2) fwd_kernel(Params pk) {
    extern __shared__ __attribute__((aligned(16))) unsigned char smem[];
    ldsp lds = (ldsp)smem;
    const int ph_lo = pk.ph_lo, ph_hi = pk.ph_hi;
    const int s_wv = __builtin_amdgcn_readfirstlane((int)threadIdx.x >> 6);
    if (threadIdx.x < 4) ((LAS unsigned*)(lds + 131072))[threadIdx.x] = 0u;
    __syncthreads();
    XcdBarrier xbar = xcd_barrier_post((unsigned*)(pk.ws + OFF_BAR), (volatile LAS unsigned*)(lds + 131072), (int)threadIdx.x);
    for (int ph = ph_lo; ph < ph_hi; ++ph) {
        KP p = (KP)__builtin_amdgcn_kernarg_segment_ptr();
        asm volatile("" : "+s"(p));
        const int op = p->op[ph], layraw = p->lay[ph], layer = layraw & 3; const bool dummy = (layraw & 4) != 0;
        unsigned char* ws = p->ws; bf16_t* xdst = dummy ? (bf16_t*)(ws + OFF_R1) : (bf16_t*)(ws + OFF_XB);
        float* MOD = (float*)(ws + OFF_MOD); bf16_t* WT = (bf16_t*)(ws + OFF_WT); bf16_t* HB = (bf16_t*)(ws + OFF_HB); bf16_t* XB = (bf16_t*)(ws + OFF_XB);
        bf16_t* R1 = (bf16_t*)(ws + OFF_R1); bf16_t* R2 = (bf16_t*)(ws + OFF_R2);
        const float* modl = MOD + (size_t)layer * 4 * 6144;
        switch (op) {
        case OP_PRO: phase_prologue(s_wv, p, lds); break;
        case OP_NORM1: if (layer == 0) phase_norm<true>(s_wv, p->in[0], XB, p->in[5], modl + 0, modl + 1024, HB); else { phase_norm<false>(s_wv, p->in[0], XB, p->in[5] + layer * 1024, modl + 0, modl + 1024, HB); prep_layer(s_wv, p, layer, lds, layer != 1); } break;
        case OP_NORM2: { const float* cw = p->in[24] + (size_t)layer * 3 * 5632; const float* cb = p->in[25] + (size_t)layer * 5632; bf16_t* CWB = (bf16_t*)(ws + OFF_CWB);
                         for (int f = obid() * NTHREADS + otid(); f < 2816; f += gridDim.x * NTHREADS) { u32x4 o = {pk2(cw[f], cw[5632 + f]), pk2(cw[11264 + f], cb[f]), pk2(cw[2816 + f], cw[5632 + 2816 + f]), pk2(cw[11264 + 2816 + f], cb[2816 + f])}; *(u32x4*)(CWB + f * 8) = o; }
                         phase_norm<false>(s_wv, p->in[0], XB, p->in[6] + layer * 1024, modl + 3072, modl + 4096, HB); } break;
        case OP_G1: { EpiBf16<1> E{R1, 4096}; run_gemm(s_wv, lds, HB, WT + WT_MIXA, T, 4096, 1024, E); } break;
        case OP_GSP: phase_gsp(s_wv, p, layer / 3, lds); break;
        case OP_GOUT: { EpiRes E{XB, xdst, modl + 2048}; run_gemm(s_wv, lds, R2, WT + WT_MIXB, T, 1024, 2048, E); } break;
        case OP_M1: { EpiF32 E{(float*)R1, 512}; run_gemm(s_wv, lds, HB, WT + WT_MIXA, T, 512, 1024, E);
                      if ((int)gridDim.x >= 256) { if (obid() >= 128) prep_ffn(s_wv, p, layer, lds, 128, (int)gridDim.x - 128); } else prep_ffn(s_wv, p, layer, lds, 0, 0); } break;
        case OP_M2: phase_m2(s_wv, p); break;
        case OP_M3: { EpiQ EQ{(bf16_t*)(ws + OFF_R1 + 48 * MiB), (const float*)(ws + OFF_CSC), (const float*)(ws + OFF_CSS), 0.07216878364870322f * 1.4426950408889634f}; run_gemm(s_wv, lds, (const bf16_t*)(ws + OFF_R1 + 32 * MiB), WT + WT_MQKV, T, 1536, 256, EQ); EpiKV EK{(bf16_t*)(ws + OFF_R1 + 96 * MiB), (bf16_t*)(ws + OFF_R1 + 144 * MiB)}; run_gemm(s_wv, lds, (const bf16_t*)(ws + OFF_R1 + 40 * MiB), WT + WT_MQKV + 393216, T, 2048, 256, EK); } break;
        case OP_ATT: phase_attn(s_wv, p, lds); break;
        case OP_MOUT: { EpiRes E{XB, XB, modl + 2048}; run_gemm(s_wv, lds, R2, WT + WT_MIXB, T, 1024, 1024, E); } break;
        case OP_H1: { EpiHg E{ws + OFF_R1, (const float*)(ws + OFF_LB)}; run_gemm(s_wv, lds, HB, WT + WT_MIXA, T, 4096, 1024, E); } break;
        case OP_HA: phase_ha(s_wv, p, lds); break;
        case OP_HSCAN: phase_hscan(s_wv, p); break;
        case OP_HC: phase_hc(s_wv, p, lds); break;
        case OP_HOUT: { EpiRes E{XB, XB, modl + 2048}; run_gemm(s_wv, lds, HB, WT + WT_MIXB, T, 1024, 1024, E); } break;
        case OP_FUP: { EpiFFN E{R2, (const bf16_t*)(ws + OFF_CWB)}; run_gemm(s_wv, lds, HB - 2 * 1024, WT + WT_FUP, 67 * 256, 5632, 1024, E); } break;
        case OP_FDN: { EpiRes E{XB, xdst, modl + 5120}; run_gemm(s_wv, lds, R2, WT + WT_FDN, T, 1024, 2816, E); } break;
        case OP_FINAL: phase_final(s_wv, XB, p->out, p->in[27]); break;
        default: break;
        }
        if (ph + 1 < ph_hi) { if (ph == ph_lo) { __syncthreads(); cg::this_grid().sync(); } else xcd_barrier(xbar, otid()); }
    }
}

#ifndef MULTI_LAUNCH
#define MULTI_LAUNCH 0
#endif
extern "C" void kernel_launch(void* const* d_in, const int* in_sizes, int n_in, void* d_out, int out_size, void* d_ws, size_t ws_size, hipStream_t stream) {
    static int grid = 0;
    if (grid == 0) {
        int dev = 0, cus = 0, per_cu = 0;
        hipGetDevice(&dev); hipDeviceGetAttribute(&cus, hipDeviceAttributeMultiprocessorCount, dev);
        hipFuncSetAttribute((const void*)fwd_kernel, hipFuncAttributeMaxDynamicSharedMemorySize, LDS_BYTES);
        hipOccupancyMaxActiveBlocksPerMultiprocessor(&per_cu, (const void*)fwd_kernel, NTHREADS, LDS_BYTES);
        if (per_cu < 1) per_cu = 1;
        grid = cus * 1; (void)per_cu;
        if (ws_size < WS_END) fprintf(stderr, "kernel_launch: workspace too small: %zu < %zu\n", ws_size, (size_t)WS_END);
        (void)hipGetLastError();
    }
    (void)hipMemsetAsync((char*)d_ws + OFF_BAR, 0, XCD_BAR_WORDS * sizeof(unsigned), stream);
    Params p{};
    for (int i = 0; i < 28; ++i) p.in[i] = (const float*)d_in[i];
    p.out = (float*)d_out; p.ws = (unsigned char*)d_ws;
    int n = 0;
    auto add = [&](int op, int l) { p.op[n] = (unsigned char)op; p.lay[n] = (unsigned char)l; ++n; };
    add(OP_PRO, 0);
    for (int l = 0; l < 4; ++l) {
        add(OP_NORM1, l);
        if (l % 3 == 0) { add(OP_G1, l); add(OP_GSP, l); add(OP_GOUT, l); }
        else if (l % 3 == 1) { add(OP_M1, l); add(OP_M2, l); add(OP_M3, l); add(OP_ATT, l); add(OP_MOUT, l); }
        else { add(OP_H1, l); add(OP_HA, l); add(OP_HSCAN, l); add(OP_HC, l); add(OP_HOUT, l); }
        add(OP_NORM2, l); add(OP_FUP, l); add(OP_FDN, l);
    }
    add(OP_FINAL, 0);
#if MULTI_LAUNCH
    for (int i = 0; i < n; ++i) { p.ph_lo = i; p.ph_hi = i + 1; hipLaunchKernelGGL(fwd_kernel, dim3(grid), dim3(NTHREADS), LDS_BYTES, stream, p); }
#else
    p.ph_lo = 0; p.ph_hi = n;
    void* args[] = {&p};
    hipError_t e = hipLaunchCooperativeKernel((const void*)fwd_kernel, dim3(grid), dim3(NTHREADS), args, LDS_BYTES, stream);
    if (e != hipSuccess) fprintf(stderr, "cooperative launch failed: %s (grid %d)\n", hipGetErrorString(e), grid);
#endif
}
```

```cpp
#include <hip/hip_runtime.h>
#include <hip/hip_cooperative_groups.h>
#include <cstdio>
#include <cstdint>
namespace cg = cooperative_groups;
__device__ __forceinline__ int otid_w(int w) { int l; asm volatile("v_mbcnt_lo_u32_b32 %0, -1, 0\n\tv_mbcnt_hi_u32_b32 %0, -1, %0" : "=v"(l)); return (w << 6) | l; }
#define otid() otid_w(s_wv)
__device__ __forceinline__ int obid() { int t = blockIdx.x; asm volatile("" : "+s"(t)); return t; }
namespace pg8 {
#define PG8_LAS __attribute__((address_space(3)))
typedef unsigned short bf16_t;
typedef short bf16x8 __attribute__((ext_vector_type(8)));
typedef float f32x4 __attribute__((ext_vector_type(4)));
typedef unsigned u32x4 __attribute__((ext_vector_type(4)));
constexpr int BM = 256, BK = 64, HALF = 128, HTB = HALF * BK * 2  , STAGE_BYTES = 8 * HTB, NXCD = 8, WGM = 8;

__host__ __device__ __forceinline__ int lds_byte(int r, int c) { const int st = (r >> 4) * 2 + (c >> 5), rr = r & 15, cc = c & 31, ob = rr * 64 + cc * 2; return st * 1024 + (ob ^ (((ob >> 9) & 1) << 5)); }
__host__ __device__ __forceinline__ void stage_rc(int b, int& R, int& C) { const int st = b / 1024, sb = b % 1024, swz = sb ^ (((sb >> 9) & 1) << 5); R = (st >> 1) * 16 + swz / 64; C = (st & 1) * 32 + (swz % 64) / 2; }
__host__ __device__ __forceinline__ int perm32(int rho) { const int n = rho >> 4, i = rho & 15; return 8 * (i >> 2) + 4 * n + (i & 3); }

struct Unit { int pm, pn; };
struct Gemm { const bf16_t* A; const bf16_t* Bt; int M, N, K; };

struct StaticOrder {
    int nM, nN, nwg, G, c;
    __host__ __device__ void init(int M, int N, int G_, int c_) { nM = M / BM; nN = N / BM; nwg = nM * nN; G = G_; c = c_; }
    __host__ __device__ bool next(int i, Unit& u) const {
        const long L = (long)i * G + c; if (L >= nwg) return false;
        int wgid = (int)L; { const int q = nwg / NXCD, r = nwg % NXCD, xcd = wgid % NXCD, off = wgid / NXCD; wgid = (xcd < r ? xcd * (q + 1) : r * (q + 1) + (xcd - r) * q) + off; }
        const int nig = WGM * nN, gid = wgid / nig, fm = gid * WGM, gsz = (nM - fm) < WGM ? (nM - fm) : WGM;
        u.pm = fm + ((wgid % nig) % gsz); u.pn = (wgid % nig) / gsz; return true;
    }
    __device__ __forceinline__ void a_ready(const Unit&) const {}
    __device__ __forceinline__ void done(const Unit&) const {}
};
__device__ __forceinline__ unsigned cvt_pk_bf16(float lo, float hi) { unsigned r; asm volatile("v_cvt_pk_bf16_f32 %0, %1, %2" : "=v"(r) : "v"(lo), "v"(hi)); return r; }

template <class Epi, class Sched, bool STAMP = false>
__device__ __forceinline__ void gemm_phase(const int s_wv, PG8_LAS unsigned char* lds, const Gemm g, const Sched& S, const Epi& E, unsigned long long* stamps) {
    const int tid = otid(), wid = __builtin_amdgcn_readfirstlane(tid >> 6), lane = tid & 63, wr = wid >> 2, wc = wid & 3, fr = lane & 15, fq = lane >> 4;
    const int K = g.K, nt = K / BK;
    int ts_lo = 0, ts_hi = 0, nts = 0; const unsigned long long rt_entry = STAMP ? (unsigned long long)wall_clock64() : 0ull;
#define PG8_STAMP() do { if (STAMP && wid == 0 && nts < 64) { const unsigned long long _c = (unsigned long long)clock64(); \
        ts_lo = (lane == nts) ? (int)(unsigned)_c : ts_lo; ts_hi = (lane == nts) ? (int)(unsigned)(_c >> 32) : ts_hi; ++nts; } } while (0)
    PG8_STAMP();
    unsigned voffA[2], voffB[2];
#pragma unroll
    for (int i = 0; i < 2; ++i) { int R, C; stage_rc(tid * 16 + i * 8192, R, C); const int Rb = Epi::PERM ? ((R & ~31) + perm32(R & 31)) : R;
        const int Ra = Epi::PERMA ? (62 * (R >> 6) + 4 * (R & 15) + ((R >> 4) & 3)) : R; voffA[i] = (unsigned)(Ra * K + C) * 2u; voffB[i] = (unsigned)(Rb * K + C) * 2u; }
    const size_t kstep = (size_t)(BK * 2);
    const size_t hstep = (size_t)HALF * K * 2;
    const size_t tstep = 2 * hstep;
    const size_t hstepA = Epi::PERMA ? (size_t)124 * K * 2 : hstep, tstepA = Epi::PERMA ? (size_t)248 * K * 2 : tstep;
    const unsigned ldsw = (unsigned)wid * 1024u;
    const int aoff = lds_byte(wr * 64 + fr, fq * 8), boff = lds_byte(wc * 32 + fr, fq * 8);
#define PG8_SA(b, h) (((b) * 2 + (h)) * HTB)
#define PG8_SB(b, h) ((4 + (b) * 2 + (h)) * HTB)
#define PG8_STAGE(bufoff, gbase, voff) do { _Pragma("unroll") for (int _i = 0; _i < 2; ++_i) \
        __builtin_amdgcn_global_load_lds((const unsigned*)((const char*)(gbase) + (voff)[_i]), (PG8_LAS unsigned*)(lds + (bufoff) + ldsw + _i * 8192), 16, 0, 0); } while (0)
#define PG8_LDA(dst, b, h) do { _Pragma("unroll") for (int m = 0; m < 4; ++m) _Pragma("unroll") for (int k = 0; k < 2; ++k) dst[m][k] = *(const PG8_LAS bf16x8*)(lds + PG8_SA(b, h) + aoff + m * 2048 + k * 1024); } while (0)
#define PG8_LDB(dst, b, h) do { _Pragma("unroll") for (int n = 0; n < 2; ++n) _Pragma("unroll") for (int k = 0; k < 2; ++k) dst[n][k] = *(const PG8_LAS bf16x8*)(lds + PG8_SB(b, h) + boff + n * 2048 + k * 1024); } while (0)
#define PG8_MMA(ai, bj, At, Bt) do { __builtin_amdgcn_s_setprio(1); _Pragma("unroll") for (int m = 0; m < 4; ++m) _Pragma("unroll") for (int n = 0; n < 2; ++n) _Pragma("unroll") for (int k = 0; k < 2; ++k) \
        acc[ai][bj][m][n] = __builtin_amdgcn_mfma_f32_16x16x32_bf16(Bt[n][k], At[m][k], acc[ai][bj][m][n], 0, 0, 0); __builtin_amdgcn_s_setprio(0); } while (0)
#define PG8_WAIT_V(n) asm volatile("s_waitcnt vmcnt(" #n ")" ::: "memory")
#define PG8_WAIT_L(n) asm volatile("s_waitcnt lgkmcnt(" #n ")" ::: "memory")
#define PG8_BAR __builtin_amdgcn_s_barrier()
#define PG8_SCHED __builtin_amdgcn_sched_barrier(0)
    Unit cur, nxt; int ui = 0;
    if (!S.next(0, cur)) return;
    f32x4 acc[2][2][4][2];
#pragma unroll
    for (int a = 0; a < 2; ++a)
#pragma unroll
        for (int b = 0; b < 2; ++b)
#pragma unroll
            for (int m = 0; m < 4; ++m)
#pragma unroll
                for (int n = 0; n < 2; ++n) acc[a][b][m][n] = (f32x4){0.f, 0.f, 0.f, 0.f};
    bf16x8 At[4][2], B0[2][2], B1[2][2];
    const char* cA = (const char*)g.A + (size_t)cur.pm * tstepA; const char* cB = (const char*)g.Bt + (size_t)cur.pn * tstep;
    S.a_ready(cur);
    PG8_STAGE(PG8_SB(0, 0), cB, voffB); PG8_STAGE(PG8_SA(0, 0), cA, voffA); PG8_STAGE(PG8_SB(0, 1), cB + hstep, voffB); PG8_STAGE(PG8_SA(0, 1), cA + hstepA, voffA);
    if (wr == 1) PG8_BAR;
    PG8_WAIT_V(4); PG8_BAR;
    PG8_STAGE(PG8_SB(1, 0), cB + kstep, voffB); PG8_STAGE(PG8_SA(1, 0), cA + kstep, voffA); PG8_STAGE(PG8_SB(1, 1), cB + hstep + kstep, voffB);
    PG8_WAIT_V(6); PG8_BAR;
    PG8_STAMP();
    for (;;) {
        const bool has_next = S.next(ui + 1, nxt);
        const char* nA = has_next ? (const char*)g.A + (size_t)nxt.pm * tstepA : cA; const char* nB = has_next ? (const char*)g.Bt + (size_t)nxt.pn * tstep : cB;
        for (int t = 0; t < nt; t += 2) {
            const bool last = (t == nt - 2);
            const char* a1 = cA + (size_t)(t + 1) * kstep;
            const char* a2 = last ? nA : cA + (size_t)(t + 2) * kstep; const char* b2 = last ? nB : cB + (size_t)(t + 2) * kstep;
            const char* a3 = a2 + kstep; const char* b3 = b2 + kstep;
            if (last && has_next) S.a_ready(nxt);
            PG8_LDB(B0, 0, 0); PG8_SCHED; PG8_LDA(At, 0, 0); PG8_STAGE(PG8_SA(1, 1), a1 + hstepA, voffA);
            PG8_WAIT_L(8); PG8_BAR; PG8_WAIT_L(0); PG8_MMA(0, 0, At, B0); PG8_BAR; PG8_SCHED;
            PG8_LDB(B1, 0, 1); PG8_STAGE(PG8_SB(0, 0), b2, voffB);
            PG8_BAR; PG8_WAIT_L(0); PG8_MMA(0, 1, At, B1); PG8_BAR;
            PG8_LDA(At, 0, 1); PG8_STAGE(PG8_SA(0, 0), a2, voffA);
            PG8_BAR; PG8_WAIT_L(0); PG8_MMA(1, 0, At, B0); PG8_BAR; PG8_SCHED;
            PG8_STAGE(PG8_SB(0, 1), b2 + hstep, voffB);
            PG8_WAIT_V(6); PG8_BAR; PG8_MMA(1, 1, At, B1); PG8_BAR;
            PG8_LDB(B0, 1, 0); PG8_SCHED; PG8_LDA(At, 1, 0); PG8_STAGE(PG8_SA(0, 1), a2 + hstepA, voffA);
            PG8_WAIT_L(8); PG8_BAR; PG8_WAIT_L(0); PG8_MMA(0, 0, At, B0); PG8_BAR; PG8_SCHED;
            PG8_LDB(B1, 1, 1); PG8_STAGE(PG8_SB(1, 0), b3, voffB);
            PG8_BAR; PG8_WAIT_L(0); PG8_MMA(0, 1, At, B1); PG8_BAR;
            PG8_LDA(At, 1, 1); PG8_STAGE(PG8_SA(1, 0), a3, voffA);
            PG8_BAR; PG8_WAIT_L(0); PG8_MMA(1, 0, At, B0); PG8_BAR; PG8_SCHED;
            PG8_STAGE(PG8_SB(1, 1), b3 + hstep, voffB);
            PG8_WAIT_V(6); PG8_BAR; PG8_MMA(1, 1, At, B1); PG8_BAR;
        }
        PG8_STAMP();
        if constexpr (!Epi::AFTER_DRAIN) { E(acc, cur, wr, wc, fr, fq); S.done(cur); }
        PG8_STAMP();
        if (!has_next) break;
#pragma unroll
        for (int a = 0; a < 2; ++a)
#pragma unroll
            for (int b = 0; b < 2; ++b)
#pragma unroll
                for (int m = 0; m < 4; ++m)
#pragma unroll
                    for (int n = 0; n < 2; ++n) acc[a][b][m][n] = (f32x4){0.f, 0.f, 0.f, 0.f};
        cur = nxt; cA = nA; cB = nB; ++ui;
    }
    PG8_WAIT_V(0);
    if (wr == 0) PG8_BAR;
    PG8_BAR;
    if constexpr (Epi::AFTER_DRAIN) { E.fused(acc, cur, wr, wc, fr, fq, lds, wid, lane); S.done(cur); }
    PG8_STAMP();
    if (STAMP && wid == 0) { stamps[lane] = lane < nts ? (((unsigned long long)(unsigned)ts_hi << 32) | (unsigned)ts_lo) : 0ull;
        if (lane == 62) stamps[62] = rt_entry; if (lane == 63) stamps[63] = (unsigned long long)wall_clock64(); }
#undef PG8_STAMP
#undef PG8_SA
#undef PG8_SB
#undef PG8_STAGE
#undef PG8_LDA
#undef PG8_LDB
#undef PG8_MMA
#undef PG8_WAIT_V
#undef PG8_WAIT_L
#undef PG8_BAR
#undef PG8_SCHED
}
}

using pg8::bf16_t; using pg8::bf16x8; using pg8::f32x4; using pg8::u32x4; using pg8::Unit;
typedef unsigned u32x2 __attribute__((ext_vector_type(2)));
typedef short bf16x4 __attribute__((ext_vector_type(4)));
#define LAS __attribute__((address_space(3)))
typedef LAS unsigned char* ldsp;
#define XB_TMO      128
#define XB_XCNT(j)  (256  + 64 * (j))
#define XB_XSUB(j)  (1280 + 64 * (j))
#define XB_XGEN(j)  (2304 + 64 * (j))
#define XB_TOP      3328
#define XB_TOPGEN   3392
#define XCD_BAR_WORDS 3456
#define XB_SPIN_CAP (1u << 18)

__device__ __forceinline__ unsigned xb_ld(unsigned* p)              { return __hip_atomic_load(p, __ATOMIC_RELAXED, __HIP_MEMORY_SCOPE_AGENT); }
__device__ __forceinline__ unsigned xb_add(unsigned* p, unsigned v) { return __hip_atomic_fetch_add(p, v, __ATOMIC_RELAXED, __HIP_MEMORY_SCOPE_AGENT); }
__device__ __forceinline__ unsigned xb_xcc_id() { return (unsigned)__builtin_amdgcn_s_getreg((3 << 11) | 20) & 0xFu; }
#define XB_SPIN(cond, bar) do { unsigned _sp = 0; while (cond) { __builtin_amdgcn_s_sleep(1); \
    if ((++_sp & 255u) == 0u) { if (xb_ld(&(bar)[XB_TMO])) break; if (_sp > XB_SPIN_CAP) { atomicAdd(&(bar)[XB_TMO], 1u); break; } } } } while (0)

struct XcdBarrier {
    unsigned* bar; unsigned x;
    volatile LAS unsigned* st;
};

__device__ __forceinline__ XcdBarrier xcd_barrier_post(unsigned* bar, volatile LAS unsigned* st, const int tid0) {
    XcdBarrier b; b.bar = bar; b.x = xb_xcc_id(); b.st = st;
    if (tid0 == 0) (void)xb_add(&bar[XB_XCNT(b.x)], 1u);
    return b;
}
__device__ __forceinline__ void xcd_barrier_complete(unsigned* bar, unsigned x, unsigned& nloc, unsigned& nx) {
    const unsigned G = gridDim.x * gridDim.y * gridDim.z;
    unsigned sum, cnt, mine, sp = 0u;
    for (;;) {
        sum = 0u; cnt = 0u; mine = 0u;
#pragma unroll
        for (unsigned j = 0; j < 16; ++j) { const unsigned c = xb_ld(&bar[XB_XCNT(j)]); sum += c; cnt += (c > 0u) ? 1u : 0u; mine = (j == x) ? c : mine; }
        if (sum == G) break;
        __builtin_amdgcn_s_sleep(1);
        if ((++sp & 255u) == 0u) { if (xb_ld(&bar[XB_TMO])) break; if (sp > XB_SPIN_CAP) { atomicAdd(&bar[XB_TMO], 1u); break; } }
    }
    nloc = mine > 0u ? mine : 1u; nx = cnt > 0u ? cnt : 1u;
}

__device__ __forceinline__ void xcd_barrier(const XcdBarrier& b, const int tid0) {
    asm volatile("s_waitcnt vmcnt(0)" ::: "memory");
    __syncthreads();
    if (tid0 == 0) {
        unsigned* bar = b.bar;
        __builtin_amdgcn_s_waitcnt(0);
        unsigned nloc = b.st[0], nx = b.st[1];
        if (nloc == 0u) { xcd_barrier_complete(bar, b.x, nloc, nx); b.st[0] = nloc; b.st[1] = nx; }
        const unsigned old = xb_add(&bar[XB_XSUB(b.x)], 1u);
        const unsigned gen = old / nloc;
        if (old + 1u == (gen + 1u) * nloc) {
            __builtin_amdgcn_fence(__ATOMIC_RELEASE, "agent");
            asm volatile("s_waitcnt vmcnt(0)" ::: "memory");
            const unsigned og = xb_add(&bar[XB_TOP], 1u);
            const unsigned tg = og / nx;
            if (og + 1u == (tg + 1u) * nx) xb_add(&bar[XB_TOPGEN], 1u);
            else XB_SPIN(xb_ld(&bar[XB_TOPGEN]) == tg, bar);
            __builtin_amdgcn_fence(__ATOMIC_ACQUIRE, "agent");
            xb_add(&bar[XB_XGEN(b.x)], 1u);
            asm volatile("s_waitcnt vmcnt(0)" ::: "memory");
        } else {
            XB_SPIN(xb_ld(&bar[XB_XGEN(b.x)]) == gen, bar);
            __builtin_amdgcn_fence(__ATOMIC_ACQUIRE, "agent");
            asm volatile("s_waitcnt vmcnt(0)" ::: "memory");
        }
    }
    __syncthreads();
}


constexpr int T = 16384, D = 1024, SEQ = 4096, NBATCH = 4, FF = 2816;
constexpr int NTHREADS = 512, LDS_BYTES = 131072 + 16;
constexpr float EPS = 1e-6f;
constexpr size_t MiB = 1024 * 1024;
constexpr size_t OFF_MOD = 0, OFF_LB = 512 * 1024, OFF_CWB = 576 * 1024, OFF_BAR = 768 * 1024, OFF_CSC = 1 * MiB, OFF_CSS = 3 * MiB, OFF_WT = 8 * MiB, OFF_HB = 40 * MiB, OFF_R1 = 72 * MiB, OFF_R2 = 248 * MiB, OFF_XB = 336 * MiB, WS_END = 368 * MiB;
constexpr size_t WT_MIXA = 0, WT_MIXB = 4194304, WT_FUP = 6291456, WT_FDN = 12058624, WT_MQKV = 524288;
enum { OP_PRO = 0, OP_NORM1, OP_G1, OP_GSP, OP_GOUT, OP_M1, OP_M2, OP_M3, OP_ATT, OP_MOUT, OP_H1, OP_HA, OP_HSCAN, OP_HC, OP_HOUT, OP_NORM2, OP_FUP, OP_FCONV, OP_FDN, OP_FINAL };

struct Params;
struct Params {
    const float* in[28];
    float* out;
    unsigned char* ws;
    int ph_lo, ph_hi;
    unsigned char op[48];
    unsigned char lay[48];
};

typedef const __attribute__((address_space(4))) Params* KP;
__device__ __forceinline__ unsigned pk2(float lo, float hi) { return pg8::cvt_pk_bf16(lo, hi); }
__device__ __forceinline__ float bflo(unsigned u) { return __uint_as_float(u << 16); }
__device__ __forceinline__ float bfhi(unsigned u) { return __uint_as_float(u & 0xffff0000u); }
__device__ __forceinline__ float shx(float v, int m, int lane) { return __int_as_float(__builtin_amdgcn_ds_bpermute((lane ^ m) << 2, __float_as_int(v))); }
template <int CTRL> __device__ __forceinline__ float dppf(float v) { return __int_as_float(__builtin_amdgcn_update_dpp(0, __float_as_int(v), CTRL, 0xf, 0xf, false)); }
__device__ __forceinline__ float rowsum4(float t) {
    const unsigned u = __float_as_uint(t);
    const auto r = __builtin_amdgcn_permlane16_swap(u, u, false, false);
    const float a = __uint_as_float(r[0]) + __uint_as_float(r[1]);
    const unsigned v = __float_as_uint(a);
    const auto q = __builtin_amdgcn_permlane32_swap(v, v, false, false);
    return __uint_as_float(q[0]) + __uint_as_float(q[1]);
}
__device__ __forceinline__ float wave_sum(float v, int lane) {
    (void)lane;
    v += dppf<0xB1>(v); v += dppf<0x4E>(v); v += dppf<0x141>(v); v += dppf<0x140>(v);
    return rowsum4(v);
}
__device__ __forceinline__ float rowmax4(float t) {
    const unsigned u = __float_as_uint(t);
    const auto r = __builtin_amdgcn_permlane16_swap(u, u, false, false);
    const float a = fmaxf(__uint_as_float(r[0]), __uint_as_float(r[1]));
    const unsigned v = __float_as_uint(a);
    const auto q = __builtin_amdgcn_permlane32_swap(v, v, false, false);
    return fmaxf(__uint_as_float(q[0]), __uint_as_float(q[1]));
}
__device__ __forceinline__ float fast_sigmoid(float x) { return __builtin_amdgcn_rcpf(1.f + __builtin_amdgcn_exp2f(-1.4426950408889634f * x)); }
__device__ __forceinline__ float gelu_tanh(float x) { const float u = 0.7978845608028654f * (x + 0.044715f * x * x * x); return x * fast_sigmoid(2.f * u); }
__device__ __forceinline__ f32x4 sigmoid4(const f32x4 x) { const f32x4 ex = x * -1.4426950408889634f; f32x4 s;
#pragma unroll
    for (int e = 0; e < 4; ++e) s[e] = __builtin_amdgcn_rcpf(1.f + __builtin_amdgcn_exp2f(ex[e]));
    return s; }
__device__ __forceinline__ f32x4 gelu_tanh4(const f32x4 x) { const f32x4 t = x * x * 0.044715f + 1.f; const f32x4 ex = x * t * (-2.f * 0.7978845608028654f * 1.4426950408889634f); f32x4 s;
#pragma unroll
    for (int e = 0; e < 4; ++e) s[e] = __builtin_amdgcn_rcpf(1.f + __builtin_amdgcn_exp2f(ex[e]));
    return x * s; }
__device__ __forceinline__ bf16x8 mk8(unsigned a, unsigned b, unsigned c, unsigned d) { u32x4 v = {a, b, c, d}; return __builtin_bit_cast(bf16x8, v); }
__device__ __forceinline__ f32x4 zero4() { float z = 0.f; asm volatile("" : "+v"(z)); return (f32x4){z, z, z, z}; }
#define MFMA16(X, Y, C) __builtin_amdgcn_mfma_f32_16x16x32_bf16((X), (Y), (C), 0, 0, 0)

template <int ACT> struct EpiBf16 {
    static constexpr bool PERM = true, AFTER_DRAIN = false, PERMA = false;
    bf16_t* O; int ldc;
    __device__ __forceinline__ void operator()(const f32x4 (&acc)[2][2][4][2], const Unit& u, int wr, int wc, int fr, int fq) const {
        const int row0 = u.pm * 256 + wr * 64 + fr, col0 = u.pn * 256 + wc * 32 + 8 * fq;
#pragma unroll
        for (int ai = 0; ai < 2; ++ai)
#pragma unroll
            for (int m = 0; m < 4; ++m) { bf16_t* rowp = O + (size_t)(row0 + ai * 128 + m * 16) * ldc + col0;
#pragma unroll
                for (int bj = 0; bj < 2; ++bj) { f32x4 v0 = acc[ai][bj][m][0], v1 = acc[ai][bj][m][1];
                    if (ACT == 1) { v0 = gelu_tanh4(v0); v1 = gelu_tanh4(v1); }
                    u32x4 o = {pk2(v0[0], v0[1]), pk2(v0[2], v0[3]), pk2(v1[0], v1[1]), pk2(v1[2], v1[3])};
                    *(u32x4*)(rowp + bj * 128) = o; } }
    }
};
struct EpiF32 {
    static constexpr bool PERM = false, AFTER_DRAIN = false, PERMA = false;
    float* C; int ldc;
    __device__ __forceinline__ void operator()(const f32x4 (&acc)[2][2][4][2], const Unit& u, int wr, int wc, int fr, int fq) const {
        const int row0 = u.pm * 256 + wr * 64 + fr, col0 = u.pn * 256 + wc * 32 + 4 * fq;
#pragma unroll
        for (int ai = 0; ai < 2; ++ai)
#pragma unroll
            for (int m = 0; m < 4; ++m) { float* rowp = C + (size_t)(row0 + ai * 128 + m * 16) * ldc + col0;
#pragma unroll
                for (int bj = 0; bj < 2; ++bj)
#pragma unroll
                    for (int n = 0; n < 2; ++n) *(f32x4*)(rowp + bj * 128 + n * 16) = acc[ai][bj][m][n]; }
    }
};
struct EpiRes {
    static constexpr bool PERM = true, AFTER_DRAIN = false, PERMA = false;
    const bf16_t* Xs; bf16_t* Xd; const float* gate;
    __device__ __forceinline__ void operator()(const f32x4 (&acc)[2][2][4][2], const Unit& u, int wr, int wc, int fr, int fq) const {
        const int row0 = u.pm * 256 + wr * 64 + fr, col0 = u.pn * 256 + wc * 32 + 8 * fq;
        const float* gp = gate + (unsigned)((u.pm >> 4) * 6144 + col0);
        f32x4 gv[2][2];
#pragma unroll
        for (int bj = 0; bj < 2; ++bj)
#pragma unroll
            for (int n = 0; n < 2; ++n) { gv[bj][n] = *(const f32x4*)(gp + bj * 128 + n * 4); gv[bj][n] = gv[bj][n] + 1.f; }
#pragma unroll
        for (int ai = 0; ai < 2; ++ai)
#pragma unroll
            for (int m = 0; m < 4; ++m) { const unsigned ro = (unsigned)((row0 + ai * 128 + m * 16) * 1024 + col0);
#pragma unroll
                for (int bj = 0; bj < 2; ++bj) { const u32x4 xs = *(const u32x4*)(Xs + ro + bj * 128);
                    const f32x4 a0 = acc[ai][bj][m][0] * gv[bj][0], a1 = acc[ai][bj][m][1] * gv[bj][1];
                    u32x4 o = {pk2(bflo(xs[0]) + a0[0], bfhi(xs[0]) + a0[1]), pk2(bflo(xs[1]) + a0[2], bfhi(xs[1]) + a0[3]), pk2(bflo(xs[2]) + a1[0], bfhi(xs[2]) + a1[1]), pk2(bflo(xs[3]) + a1[2], bfhi(xs[3]) + a1[3])};
                    *(u32x4*)(Xd + ro + bj * 128) = o; } }
    }
};
struct EpiQ {
    static constexpr bool PERM = false, AFTER_DRAIN = false, PERMA = false;
    bf16_t* QF; const float* CSC; const float* CSS; float qs;
    __device__ __forceinline__ void operator()(const f32x4 (&acc)[2][2][4][2], const Unit& u, int wr, int wc, int fr, int fq) const {
        const int b = u.pm >> 4;
#pragma unroll
        for (int bj = 0; bj < 2; ++bj) {
            const int c0 = u.pn * 256 + bj * 128 + wc * 32;
            const int head = c0 / 192, off = c0 - head * 192;
            if (off < 128) {
#pragma unroll
                for (int ai = 0; ai < 2; ++ai)
#pragma unroll
                    for (int m = 0; m < 4; ++m) { const int r = u.pm * 256 + ai * 128 + wr * 64 + m * 16 + fr, s = r & 4095;
                        bf16_t* qp = QF + (unsigned)(((b * 8 + head) * 4096 + s) * 192 + off + 4 * fq);
#pragma unroll
                        for (int n = 0; n < 2; ++n) { const f32x4 v = acc[ai][bj][m][n] * qs; u32x2 o = {pk2(v[0], v[1]), pk2(v[2], v[3])}; *(u32x2*)(qp + 16 * n) = o; } __builtin_amdgcn_sched_barrier(0); }
            } else {
                const int jb = ((off - 128) >> 5) * 16 + 4 * fq;
#pragma unroll
                for (int ai = 0; ai < 2; ++ai)
#pragma unroll
                    for (int m = 0; m < 4; ++m) { const int r = u.pm * 256 + ai * 128 + wr * 64 + m * 16 + fr, s = r & 4095;
                        const f32x4 cs = *(const f32x4*)(CSC + (unsigned)(r * 32 + jb)), sn = *(const f32x4*)(CSS + (unsigned)(r * 32 + jb));
                        const f32x4 x1 = acc[ai][bj][m][0], x2 = acc[ai][bj][m][1];
                        const f32x4 r1 = (x1 * cs - x2 * sn) * qs, r2 = (x2 * cs + x1 * sn) * qs;
                        bf16_t* qp = QF + (unsigned)(((b * 8 + head) * 4096 + s) * 192 + 128 + jb);
                        u32x2 o1 = {pk2(r1[0], r1[1]), pk2(r1[2], r1[3])}, o2 = {pk2(r2[0], r2[1]), pk2(r2[2], r2[3])};
                        *(u32x2*)(qp) = o1; *(u32x2*)(qp + 32) = o2; __builtin_amdgcn_sched_barrier(0); }
            }
        }
    }
};
struct EpiKV {
    static constexpr bool PERM = false, AFTER_DRAIN = false, PERMA = false;
    bf16_t* KF; bf16_t* VT;
    __device__ __forceinline__ void operator()(const f32x4 (&acc)[2][2][4][2], const Unit& u, int wr, int wc, int fr, int fq) const {
        const int b = u.pm >> 4, head = u.pn;
#pragma unroll
        for (int bj = 0; bj < 2; ++bj) {
            const int off = wc * 32;
            if (bj == 0) {
#pragma unroll
                for (int ai = 0; ai < 2; ++ai)
#pragma unroll
                    for (int m = 0; m < 4; ++m) { const int r = u.pm * 256 + ai * 128 + wr * 64 + m * 16 + fr, s = r & 4095;
                        bf16_t* kp = KF + (unsigned)(((b * 8 + head) * 4096 + s) * 192 + off + 4 * fq);
#pragma unroll
                        for (int n = 0; n < 2; ++n) { const f32x4 v = acc[ai][bj][m][n]; u32x2 o = {pk2(v[0], v[1]), pk2(v[2], v[3])}; *(u32x2*)(kp + 16 * n) = o; } __builtin_amdgcn_sched_barrier(0); }
            } else {
#pragma unroll
                for (int ai = 0; ai < 2; ++ai)
#pragma unroll
                    for (int m = 0; m < 4; ++m) { const int r = u.pm * 256 + ai * 128 + wr * 64 + m * 16 + fr, s = r & 4095;
#pragma unroll
                        for (int n = 0; n < 2; ++n) { const f32x4 v = acc[ai][bj][m][n]; const int dv = off + 16 * n + 4 * fq;
                            bf16_t* vp = VT + (unsigned)(((b * 8 + head) * 128 + dv) * 4096 + s);
                            const unsigned p01 = pk2(v[0], v[1]), p23 = pk2(v[2], v[3]);
                            vp[0] = (bf16_t)(p01 & 0xffffu); vp[4096] = (bf16_t)(p01 >> 16); vp[8192] = (bf16_t)(p23 & 0xffffu); vp[12288] = (bf16_t)(p23 >> 16); } __builtin_amdgcn_sched_barrier(0); }
            }
        }
    }
};
struct EpiHg {
    static constexpr bool PERM = true, AFTER_DRAIN = false, PERMA = false;
    unsigned char* R1b; const float* LB;
    __device__ __forceinline__ void operator()(const f32x4 (&acc)[2][2][4][2], const Unit& u, int wr, int wc, int fr, int fq) const {
        const int region = u.pn >> 2, row0 = u.pm * 256 + wr * 64 + fr, cc0 = (u.pn & 3) * 256 + wc * 32 + 8 * fq;
        if (region == 1) {
#pragma unroll
            for (int bj = 0; bj < 2; ++bj) { const int cc = cc0 + bj * 128;
                const f32x4 l0 = *(const f32x4*)(LB + cc), l1 = *(const f32x4*)(LB + cc + 4);
#pragma unroll
                for (int ai = 0; ai < 2; ++ai)
#pragma unroll
                    for (int m = 0; m < 4; ++m) { float* fp = (float*)(R1b + 32 * MiB) + (unsigned)((row0 + ai * 128 + m * 16) * 1024 + cc);
                        f32x4 v0 = acc[ai][bj][m][0], v1 = acc[ai][bj][m][1];
                        v0 = l0 + (1.f - l0) * sigmoid4(v0); v1 = l1 + (1.f - l1) * sigmoid4(v1);
                        *(f32x4*)fp = v0; *(f32x4*)(fp + 4) = v1; __builtin_amdgcn_sched_barrier(0); } }
        } else {
            bf16_t* base = (bf16_t*)(R1b + (region == 0 ? (size_t)0 : (region == 2 ? 96 * MiB : 128 * MiB)));
#pragma unroll
            for (int ai = 0; ai < 2; ++ai)
#pragma unroll
                for (int m = 0; m < 4; ++m) { bf16_t* rowp = base + (unsigned)((row0 + ai * 128 + m * 16) * 1024 + cc0);
#pragma unroll
                    for (int bj = 0; bj < 2; ++bj) { f32x4 v0 = acc[ai][bj][m][0], v1 = acc[ai][bj][m][1];
                        if (region == 3) { v0 = v0 * sigmoid4(v0); v1 = v1 * sigmoid4(v1); }
                        u32x4 o = {pk2(v0[0], v0[1]), pk2(v0[2], v0[3]), pk2(v1[0], v1[1]), pk2(v1[2], v1[3])};
                        *(u32x4*)(rowp + bj * 128) = o; } }
        }
    }
};

struct EpiFFN {
    static constexpr bool PERM = true, AFTER_DRAIN = false, PERMA = true;
    bf16_t* ACT; const bf16_t* CWB;
    __device__ __forceinline__ static f32x4 shr1(const f32x4 v) { f32x4 r;
#pragma unroll
        for (int e = 0; e < 4; ++e) r[e] = __int_as_float(__builtin_amdgcn_update_dpp(0, __float_as_int(v[e]), 0x111, 0xf, 0xf, true));
        return r; }
    template <bool SPECIAL> __device__ __forceinline__ void group(const f32x4 (&acc)[2][2][4][2], int ai, int n, int tok0, int fr, int fcol,
            const f32x4 wg0, const f32x4 wg1, const f32x4 wg2, const f32x4 bg, const f32x4 wv0, const f32x4 wv1, const f32x4 wv2, const f32x4 bv) const {
        const f32x4 sg3 = shr1(acc[ai][0][3][n]), sg2 = shr1(acc[ai][0][2][n]), sv3 = shr1(acc[ai][1][3][n]), sv2 = shr1(acc[ai][1][2][n]);
#pragma unroll
        for (int m = 0; m < 4; ++m) {
            const f32x4 cg = acc[ai][0][m][n], cv = acc[ai][1][m][n];
            f32x4 p1g = m == 0 ? sg3 : acc[ai][0][m == 0 ? 0 : m - 1][n], p1v = m == 0 ? sv3 : acc[ai][1][m == 0 ? 0 : m - 1][n];
            f32x4 p2g = m == 0 ? sg2 : (m == 1 ? sg3 : acc[ai][0][m < 2 ? 0 : m - 2][n]), p2v = m == 0 ? sv2 : (m == 1 ? sv3 : acc[ai][1][m < 2 ? 0 : m - 2][n]);
            const int tok = tok0 + 4 * fr + m;
            if (SPECIAL) { const int sq = tok & 4095; const f32x4 z4 = {0.f, 0.f, 0.f, 0.f}; if (sq == 0) { p1g = z4; p1v = z4; } if (sq <= 1) { p2g = z4; p2v = z4; } }
            const f32x4 yg = bg + wg0 * p2g + wg1 * p1g + wg2 * cg, yv = bv + wv0 * p2v + wv1 * p1v + wv2 * cv;
            const f32x4 ex = yg * -1.4426950408889634f; f32x4 sg;
#pragma unroll
            for (int e = 0; e < 4; ++e) sg[e] = __builtin_amdgcn_rcpf(1.f + __builtin_amdgcn_exp2f(ex[e]));
            const f32x4 o = yg * sg * yv;
            if ((m >= 2 || fr > 0) && tok < T) { u32x2 ov = {pk2(o[0], o[1]), pk2(o[2], o[3])}; *(u32x2*)(ACT + (unsigned)(tok * 2816 + fcol)) = ov; }
        }
    }
    __device__ __forceinline__ void operator()(const f32x4 (&acc)[2][2][4][2], const Unit& u, int wr, int wc, int fr, int fq) const {
        const int fcol0 = u.pn * 128 + wc * 32 + 8 * fq;
        u32x4 tw[8];
#pragma unroll
        for (int i = 0; i < 8; ++i) tw[i] = *(const u32x4*)(CWB + (unsigned)((fcol0 + i) * 8));
#pragma unroll
        for (int n = 0; n < 2; ++n) {
            const int fcol = fcol0 + 4 * n;
            f32x4 wg0, wg1, wg2, bg, wv0, wv1, wv2, bv;
#pragma unroll
            for (int e = 0; e < 4; ++e) { const u32x4 t = tw[4 * n + e]; wg0[e] = bflo(t[0]); wg1[e] = bfhi(t[0]); wg2[e] = bflo(t[1]); bg[e] = bfhi(t[1]); wv0[e] = bflo(t[2]); wv1[e] = bfhi(t[2]); wv2[e] = bflo(t[3]); bv[e] = bfhi(t[3]); }
#pragma unroll
            for (int ai = 0; ai < 2; ++ai) {
                const int b0 = u.pm * 248 + (2 * ai + wr) * 62;
                const bool special = (((b0 + 61) >> 12) << 12) >= b0 - 1;
                if (special) group<true>(acc, ai, n, b0 - 2, fr, fcol, wg0, wg1, wg2, bg, wv0, wv1, wv2, bv);
                else group<false>(acc, ai, n, b0 - 2, fr, fcol, wg0, wg1, wg2, bg, wv0, wv1, wv2, bv);
                __builtin_amdgcn_sched_barrier(0);
            }
        }
    }
};

template <class Epi> __device__ __forceinline__ void run_gemm(const int s_wv, ldsp lds, const bf16_t* A, const bf16_t* Bt, int M, int N, int K, const Epi& E) {
    pg8::Gemm g{A, Bt, M, N, K}; pg8::StaticOrder S; S.init(M, N, (int)gridDim.x, obid());
    pg8::gemm_phase<Epi, pg8::StaticOrder, false>(s_wv, lds, g, S, E, nullptr);
}

__device__ __forceinline__ int rope_rowmap(int n) { const int head = n / 192, d = n - head * 192; if (d < 128) return n; const int r = d - 128, half = r >> 5, j = r & 31; return head * 192 + 128 + (j >> 4) * 32 + half * 16 + (j & 15); }
__device__ __forceinline__ int ffn_rowmap(int n) { const int half = n >= 2816 ? 1 : 0, f = n - half * 2816, t = f >> 7, i = f & 127; return t * 256 + half * 128 + i; }
struct TrJob { const float* src; int srcN, K, N; bf16_t* dst; int dstK, koff, rowoff, pmode; };
__device__ __forceinline__ void run_trjob(const int s_wv, const TrJob J, ldsp lds, const int wg0 = 0, const int nwg = 0) {
    const int tid = otid(), lane = tid & 63, wave = tid >> 6;
    LAS float* sm = (LAS float*)(lds + wave * 8448);
    const int nkt = J.K / 32, nnt = J.N / 64, ntile = nkt * nnt;
    const int nw_ = nwg ? nwg : (int)gridDim.x;
    for (int t = (obid() - wg0) * 8 + wave; t < ntile; t += nw_ * 8) { const int kt = t % nkt, nt = t / nkt;
        const float* sp = J.src + (size_t)(kt * 32) * J.srcN + nt * 64 + lane;
        float v[32];
#pragma unroll
        for (int k = 0; k < 32; ++k) v[k] = sp[(size_t)k * J.srcN];
#pragma unroll
        for (int k = 0; k < 32; ++k) sm[lane * 33 + k] = v[k];
        const int kk = (lane & 15) * 2, nr = lane >> 4;
#pragma unroll
        for (int j = 0; j < 16; ++j) { const int n = nr + 4 * j, sn = nt * 64 + n, drow = J.rowoff + (J.pmode == 1 ? rope_rowmap(sn) : (J.pmode == 2 ? ffn_rowmap(sn) : sn));
            *(unsigned*)(J.dst + (size_t)drow * J.dstK + J.koff + kt * 32 + kk) = pk2(sm[n * 33 + kk], sm[n * 33 + kk + 1]); }
    }
}
__device__ __forceinline__ void zero_fill(bf16_t* dst, int rows, int cols8, int stride, int gtid, int gthreads) {
    const int n = rows * cols8; unsigned zz = 0u; asm volatile("" : "+v"(zz)); const u32x4 z = {zz, zz, zz, zz};
    for (int i = gtid; i < n; i += gthreads) { const int r = i / cols8, c = i - r * cols8; *(u32x4*)(dst + (size_t)r * stride + c * 8) = z; }
}
__device__ __forceinline__ void prep_ffn(const int s_wv, KP p, int layer, ldsp lds, const int wg0, const int nwg) {
    bf16_t* WT = (bf16_t*)(p->ws + OFF_WT);
    const TrJob J0{p->in[23] + (size_t)layer * 1024 * 5632, 5632, 1024, 5632, WT + WT_FUP, 1024, 0, 0, 2};
    const TrJob J1{p->in[26] + (size_t)layer * 2816 * 1024, 1024, 2816, 1024, WT + WT_FDN, 2816, 0, 0, 0};
    run_trjob(s_wv, J0, lds, wg0, nwg); run_trjob(s_wv, J1, lds, wg0, nwg);
}
__device__ __forceinline__ void prep_layer(const int s_wv, KP p, int layer, ldsp lds, const bool with_ffn = true) {
    bf16_t* WT = (bf16_t*)(p->ws + OFF_WT); const int kind = layer % 3, j = layer / 3;
    const int gtid = obid() * NTHREADS + otid(), gthreads = gridDim.x * NTHREADS;
    if (with_ffn) { const TrJob J0{p->in[23] + (size_t)layer * 1024 * 5632, 5632, 1024, 5632, WT + WT_FUP, 1024, 0, 0, 2};
      const TrJob J1{p->in[26] + (size_t)layer * 2816 * 1024, 1024, 2816, 1024, WT + WT_FDN, 2816, 0, 0, 0};
      run_trjob(s_wv, J0, lds); run_trjob(s_wv, J1, lds); }
    if (kind == 0) {
        const TrJob J0{p->in[7] + (size_t)j * 1024 * 4096, 4096, 1024, 4096, WT + WT_MIXA, 1024, 0, 0, 0};
        const TrJob J1{p->in[12] + (size_t)j * 2048 * 1024, 1024, 2048, 1024, WT + WT_MIXB, 2048, 0, 0, 0};
        run_trjob(s_wv, J0, lds); run_trjob(s_wv, J1, lds);
    } else if (kind == 1) {
        const TrJob J0{p->in[13], 448, 1024, 448, WT + WT_MIXA, 1024, 0, 0, 0};
        const TrJob J1{p->in[16], 1536, 256, 1536, WT + WT_MQKV, 256, 0, 0, 1};
        const TrJob J2{p->in[17], 2048, 128, 2048, WT + WT_MQKV + 393216, 256, 0, 0, 0};
        const TrJob J3{p->in[18], 1024, 1024, 1024, WT + WT_MIXB, 1024, 0, 0, 0};
        run_trjob(s_wv, J0, lds); run_trjob(s_wv, J1, lds); run_trjob(s_wv, J2, lds); run_trjob(s_wv, J3, lds);
        zero_fill(WT + WT_MIXA + (size_t)448 * 1024, 64, 128, 1024, gtid, gthreads);
        zero_fill(WT + WT_MQKV + 393216 + 128, 2048, 16, 256, gtid, gthreads);
    } else {
        const TrJob J0{p->in[20], 4096, 1024, 4096, WT + WT_MIXA, 1024, 0, 0, 0};
        const TrJob J1{p->in[22], 1024, 1024, 1024, WT + WT_MIXB, 1024, 0, 0, 0};
        run_trjob(s_wv, J0, lds); run_trjob(s_wv, J1, lds);
    }
}
__device__ __forceinline__ void phase_prologue(const int s_wv, KP p, ldsp lds) {
    const int tid = otid();
    float* MOD = (float*)(p->ws + OFF_MOD);
    LAS float* cact = (LAS float*)lds;
    LAS float* red = (LAS float*)(lds + 16384);
    for (int i = tid; i < 4096; i += NTHREADS) { const float c = p->in[1][i]; cact[i] = c * fast_sigmoid(c); }
    __syncthreads();
    const int l16 = tid & 15, kg = tid >> 4;
    for (int item = obid(); item < 4 * 96; item += gridDim.x) {
        const int layer = item / 96, n0 = (item % 96) * 64;
        const float* w = p->in[3] + (size_t)layer * 1024 * 6144 + n0 + 4 * l16;
        f32x4 a[4] = {{0.f, 0.f, 0.f, 0.f}, {0.f, 0.f, 0.f, 0.f}, {0.f, 0.f, 0.f, 0.f}, {0.f, 0.f, 0.f, 0.f}};
#pragma unroll 8
        for (int kk = 0; kk < 32; ++kk) { const int k = kg * 32 + kk; const f32x4 wv = *(const f32x4*)(w + (size_t)k * 6144);
#pragma unroll
            for (int b = 0; b < 4; ++b) a[b] = a[b] + wv * cact[b * 1024 + k]; }
#pragma unroll
        for (int b = 0; b < 4; ++b) *(LAS f32x4*)(red + (kg * 4 + b) * 64 + 4 * l16) = a[b];
        __syncthreads();
        if (tid < 256) { const int b = tid >> 6, col = tid & 63; float s = 0.f;
#pragma unroll 8
            for (int g = 0; g < 32; ++g) s += red[(g * 4 + b) * 64 + col];
            MOD[(size_t)(layer * 4 + b) * 6144 + n0 + col] = s + p->in[4][(size_t)layer * 6144 + n0 + col]; }
        __syncthreads();
    }
    const int gtid = obid() * NTHREADS + tid, gthreads = gridDim.x * NTHREADS;
    float* CSC = (float*)(p->ws + OFF_CSC); float* CSS = (float*)(p->ws + OFF_CSS);
    const int* pos = (const int*)p->in[2];
    for (int i = gtid; i < T * 32; i += gthreads) { const int t = i >> 5, jj = i & 31;
        const float invf = exp2f(-(float)jj * (13.287712379549449f / 32.f));
        const float ang = (float)pos[t] * invf;
        double rev = (double)ang * 0.15915494309189535; rev -= floor(rev);
        const float rf = (float)rev;
        CSC[i] = __builtin_amdgcn_cosf(rf); CSS[i] = __builtin_amdgcn_sinf(rf); }
    float* LB = (float*)(p->ws + OFF_LB);
    for (int i = gtid; i < 1024; i += gthreads) { const float l0 = p->in[19][i], l1 = p->in[19][1024 + i], l2 = p->in[19][2048 + i], l3 = p->in[19][3072 + i];
        const float mx = fmaxf(fmaxf(l0, l1), fmaxf(l2, l3)); const float e0 = __expf(l0 - mx), e1 = __expf(l1 - mx), e2 = __expf(l2 - mx), e3 = __expf(l3 - mx);
        LB[i] = (e1 + e2) / (e0 + e1 + e2 + e3); }
    prep_layer(s_wv, p, 0, lds);
}
__device__ __forceinline__ void up8(const u32x4 v, float (&o)[8]) { o[0] = bflo(v[0]); o[1] = bfhi(v[0]); o[2] = bflo(v[1]); o[3] = bfhi(v[1]); o[4] = bflo(v[2]); o[5] = bfhi(v[2]); o[6] = bflo(v[3]); o[7] = bfhi(v[3]); }
template <bool SRC32> __device__ __forceinline__ void phase_norm(const int s_wv, const float* X32, bf16_t* XB, const float* g, const float* shift, const float* scale, bf16_t* dst) {
    const int lane = otid() & 63, wave = otid() >> 6;
    for (int rb = obid() * 8 + wave; rb < T / 8; rb += gridDim.x * 8) {
        const int r0 = rb * 8, b = r0 >> 12;
        float G[16], SH[16];
#pragma unroll
        for (int j = 0; j < 2; ++j)
#pragma unroll
            for (int h = 0; h < 2; ++h) { const int c = 8 * lane + 512 * j + 4 * h; const f32x4 gg = *(const f32x4*)(g + c), sc = *(const f32x4*)(scale + (size_t)b * 6144 + c), sh = *(const f32x4*)(shift + (size_t)b * 6144 + c);
#pragma unroll
                for (int e = 0; e < 4; ++e) { G[j * 8 + h * 4 + e] = gg[e] * (sc[e] + 1.f); SH[j * 8 + h * 4 + e] = sh[e]; } }
        for (int r = r0; r < r0 + 8; ++r) {
            float x[16]; float ss = 0.f;
#pragma unroll
            for (int j = 0; j < 2; ++j) { const unsigned off = (unsigned)(r * 1024 + 8 * lane + 512 * j);
                if (SRC32) { const f32x4 a = *(const f32x4*)(X32 + off), c = *(const f32x4*)(X32 + off + 4);
#pragma unroll
                    for (int e = 0; e < 4; ++e) { x[j * 8 + e] = a[e]; x[j * 8 + 4 + e] = c[e]; }
                    u32x4 xo = {pk2(a[0], a[1]), pk2(a[2], a[3]), pk2(c[0], c[1]), pk2(c[2], c[3])}; *(u32x4*)(XB + off) = xo;
                } else { float t[8]; up8(*(const u32x4*)(XB + off), t);
#pragma unroll
                    for (int e = 0; e < 8; ++e) x[j * 8 + e] = t[e]; } }
#pragma unroll
            for (int e = 0; e < 16; ++e) ss += x[e] * x[e];
            ss = wave_sum(ss, lane); const float rstd = rsqrtf(ss * (1.f / 1024.f) + EPS);
#pragma unroll
            for (int j = 0; j < 2; ++j) { float h[8];
#pragma unroll
                for (int e = 0; e < 8; ++e) h[e] = x[j * 8 + e] * rstd * G[j * 8 + e] + SH[j * 8 + e];
                u32x4 o = {pk2(h[0], h[1]), pk2(h[2], h[3]), pk2(h[4], h[5]), pk2(h[6], h[7])}; *(u32x4*)(dst + (unsigned)(r * 1024 + 8 * lane + 512 * j)) = o; }
        }
    }
}
__device__ __forceinline__ void phase_final(const int s_wv, const bf16_t* XB, float* out, const float* g) {
    const int lane = otid() & 63, wave = otid() >> 6;
    for (int r = obid() * 8 + wave; r < T; r += gridDim.x * 8) {
        float x[16]; float ss = 0.f;
#pragma unroll
        for (int j = 0; j < 2; ++j) { float t[8]; up8(*(const u32x4*)(XB + (unsigned)(r * 1024 + 8 * lane + 512 * j)), t);
#pragma unroll
            for (int e = 0; e < 8; ++e) { x[j * 8 + e] = t[e]; ss += t[e] * t[e]; } }
        ss = wave_sum(ss, lane); const float rstd = rsqrtf(ss * (1.f / 1024.f) + EPS);
#pragma unroll
        for (int j = 0; j < 2; ++j)
#pragma unroll
            for (int h = 0; h < 2; ++h) { const int c = 8 * lane + 512 * j + 4 * h; const f32x4 gg = *(const f32x4*)(g + c);
                f32x4 o = {x[j * 8 + h * 4] * rstd * gg[0], x[j * 8 + h * 4 + 1] * rstd * gg[1], x[j * 8 + h * 4 + 2] * rstd * gg[2], x[j * 8 + h * 4 + 3] * rstd * gg[3]};
                *(f32x4*)(out + (size_t)r * 1024 + c) = o; }
    }
}
__device__ __forceinline__ void phase_ffix(const int s_wv, const bf16_t* SIDE, bf16_t* ACT, const float* cw, const float* cb) {
    const int gtid = obid() * NTHREADS + otid(), gthreads = gridDim.x * NTHREADS;
    for (int q = gtid; q < 256 * 2 * 352; q += gthreads) {
        const int cgp = q % 352, gi = q / 352, i = gi & 1, g = gi >> 1, f0 = cgp * 8;
        const bool first = (g & 63) == 0;
        const bf16_t* own = SIDE + (size_t)((g * 4 + 2 + i) * 2) * 2816 + f0;
        const bf16_t* p1 = i == 0 ? SIDE + (size_t)(((g - 1) * 4 + 1) * 2) * 2816 + f0 : SIDE + (size_t)((g * 4 + 2) * 2) * 2816 + f0;
        const bf16_t* p2 = i == 0 ? SIDE + (size_t)(((g - 1) * 4 + 0) * 2) * 2816 + f0 : SIDE + (size_t)(((g - 1) * 4 + 1) * 2) * 2816 + f0;
        float gc[8], vc[8], g1[8], v1[8], g2[8], v2[8];
        up8(*(const u32x4*)own, gc); up8(*(const u32x4*)(own + 2816), vc);
        if (i == 1 || !first) { up8(*(const u32x4*)p1, g1); up8(*(const u32x4*)(p1 + 2816), v1); } else {
#pragma unroll
            for (int e = 0; e < 8; ++e) { g1[e] = 0.f; v1[e] = 0.f; } }
        if (!first) { up8(*(const u32x4*)p2, g2); up8(*(const u32x4*)(p2 + 2816), v2); } else {
#pragma unroll
            for (int e = 0; e < 8; ++e) { g2[e] = 0.f; v2[e] = 0.f; } }
        float o[8];
#pragma unroll
        for (int e = 0; e < 8; ++e) { const int f = f0 + e;
            const float yg = cb[f] + cw[f] * g2[e] + cw[5632 + f] * g1[e] + cw[11264 + f] * gc[e], yv = cb[2816 + f] + cw[2816 + f] * v2[e] + cw[5632 + 2816 + f] * v1[e] + cw[11264 + 2816 + f] * vc[e];
            o[e] = yg * fast_sigmoid(yg) * yv; }
        u32x4 ov = {pk2(o[0], o[1]), pk2(o[2], o[3]), pk2(o[4], o[5]), pk2(o[6], o[7])};
        *(u32x4*)(ACT + (size_t)(g * 64 + i) * 2816 + f0) = ov;
    }
}

__device__ __forceinline__ void phase_gsp(const int s_wv, KP p, int j, ldsp lds) {
    const bf16_t* Z = (const bf16_t*)(p->ws + OFF_R1); bf16_t* Y = (bf16_t*)(p->ws + OFF_R2);
    const float* ws_w = p->in[10] + (size_t)j * 8 * 128 * 128; const float* bs = p->in[11] + (size_t)j * 8 * 128;
    const float* lng = p->in[8] + (size_t)j * 2048; const float* lnb = p->in[9] + (size_t)j * 2048;
    const int tid = otid(), lane = tid & 63, wave = tid >> 6, l15 = lane & 15, g4 = lane >> 4;
    ldsp As = lds, Bs = lds + 34816; LAS float* mu = (LAS float*)(lds + 104448); LAS float* rs = mu + 128;
    for (int unit = obid(); unit < 256; unit += gridDim.x) {
        const int gh = unit & 1, chunk = unit >> 1, t0 = chunk * 128;
        for (int rr = 0; rr < 16; ++rr) { const int r = wave * 16 + rr; const bf16_t* zp = Z + (size_t)(t0 + r) * 4096 + 2048 + lane * 32; float s = 0.f, s2 = 0.f;
#pragma unroll
            for (int i = 0; i < 4; ++i) { float v[8]; up8(*(const u32x4*)(zp + 8 * i), v);
#pragma unroll
                for (int e = 0; e < 8; ++e) { s += v[e]; s2 += v[e] * v[e]; } }
            s = wave_sum(s, lane); s2 = wave_sum(s2, lane);
            if (lane == 0) { const float m = s * (1.f / 2048.f); float var = s2 * (1.f / 2048.f) - m * m; var = fmaxf(var, 0.f); mu[r] = m; rs[r] = rsqrtf(var + EPS); } }
        __syncthreads();
        for (int gi = 0; gi < 4; ++gi) {
            const int g = gh * 4 + gi;
#pragma unroll 2
            for (int i = 0; i < 8; ++i) { const int idx = tid + 512 * i, t = idx >> 5, s4 = (idx & 31) * 4; f32x4 w = *(const f32x4*)(ws_w + (size_t)g * 16384 + t * 128 + s4);
#pragma unroll
                for (int e = 0; e < 4; ++e) w[e] = (s4 + e <= t) ? w[e] : 0.f;
                u32x2 o = {pk2(w[0], w[1]), pk2(w[2], w[3])}; *(LAS u32x2*)(As + t * 272 + s4 * 2) = o; }
#pragma unroll 2
            for (int i = 0; i < 4; ++i) { const int idx = tid + 512 * i, s = (idx >> 5) * 2, c8 = idx & 31; float v0[8], v1[8];
                up8(*(const u32x4*)(Z + (size_t)(t0 + s) * 4096 + 2048 + g * 256 + c8 * 8), v0); up8(*(const u32x4*)(Z + (size_t)(t0 + s + 1) * 4096 + 2048 + g * 256 + c8 * 8), v1);
                const float m0 = mu[s], r0 = rs[s], m1 = mu[s + 1], r1 = rs[s + 1]; const f32x4 ga = *(const f32x4*)(lng + g * 256 + c8 * 8), gb = *(const f32x4*)(lng + g * 256 + c8 * 8 + 4), ba = *(const f32x4*)(lnb + g * 256 + c8 * 8), bb = *(const f32x4*)(lnb + g * 256 + c8 * 8 + 4);
                const int boff = (((s >> 3) ^ (c8 & 15)) << 4) + (s & 7) * 2;
#pragma unroll
                for (int e = 0; e < 8; ++e) { const float gg = e < 4 ? ga[e] : gb[e - 4], bbv = e < 4 ? ba[e] : bb[e - 4];
                    *(LAS unsigned*)(Bs + (c8 * 8 + e) * 272 + boff) = pk2((v0[e] - m0) * r0 * gg + bbv, (v1[e] - m1) * r1 * gg + bbv); } }
            __syncthreads();
            f32x4 acc[8][2];
#pragma unroll
            for (int tt = 0; tt < 8; ++tt) { acc[tt][0] = zero4(); acc[tt][1] = zero4(); }
#pragma unroll
            for (int tt = 0; tt < 8; ++tt)
#pragma unroll
                for (int ks = 0; ks <= tt / 2; ++ks) { const bf16x8 yf = *(const LAS bf16x8*)(As + (16 * tt + l15) * 272 + (32 * ks + 8 * g4) * 2);
#pragma unroll
                    for (int ct = 0; ct < 2; ++ct) { const int c = 32 * wave + 16 * ct + l15; const bf16x8 xf = *(const LAS bf16x8*)(Bs + c * 272 + (((4 * ks + g4) ^ ((c >> 3) & 15)) << 4));
                        acc[tt][ct] = MFMA16(xf, yf, acc[tt][ct]); } }
#pragma unroll
            for (int tt = 0; tt < 8; ++tt) { const int t = 16 * tt + l15; const float bias = bs[g * 128 + t];
#pragma unroll
                for (int ct = 0; ct < 2; ++ct) { const int c = g * 256 + 32 * wave + 16 * ct + 4 * g4; const u32x2 uu = *(const u32x2*)(Z + (size_t)(t0 + t) * 4096 + c);
                    const f32x4 a = acc[tt][ct]; u32x2 o = {pk2(bflo(uu[0]) * (a[0] + bias), bfhi(uu[0]) * (a[1] + bias)), pk2(bflo(uu[1]) * (a[2] + bias), bfhi(uu[1]) * (a[3] + bias))};
                    *(u32x2*)(Y + (size_t)(t0 + t) * 2048 + c) = o; } }
            __syncthreads();
        }
    }
}

__device__ __forceinline__ void phase_m2(const int s_wv, KP p) {
    const float* A1 = (const float*)(p->ws + OFF_R1); bf16_t* CQN = (bf16_t*)(p->ws + OFF_R1 + 32 * MiB); bf16_t* CKVN = (bf16_t*)(p->ws + OFF_R1 + 40 * MiB); bf16_t* KF = (bf16_t*)(p->ws + OFF_R1 + 96 * MiB);
    const float* CSC = (const float*)(p->ws + OFF_CSC); const float* CSS = (const float*)(p->ws + OFF_CSS);
    const int lane = otid() & 63, wave = otid() >> 6;
    const f32x4 qg = *(const f32x4*)(p->in[14] + 4 * lane); const f32x4 kg = *(const f32x4*)(p->in[15] + 4 * (lane & 31));
    for (int r = obid() * 8 + wave; r < T; r += gridDim.x * 8) {
        const float* a = A1 + (size_t)r * 512;
        const f32x4 cq = *(const f32x4*)(a + 4 * lane); float ss = wave_sum(cq[0] * cq[0] + cq[1] * cq[1] + cq[2] * cq[2] + cq[3] * cq[3], lane);
        const float rq = rsqrtf(ss * (1.f / 256.f) + EPS);
        { const f32x4 h = cq * rq * qg; u32x2 o = {pk2(h[0], h[1]), pk2(h[2], h[3])}; *(u32x2*)(CQN + (size_t)r * 256 + 4 * lane) = o; }
        const f32x4 ck = *(const f32x4*)(a + 256 + 4 * (lane & 31)); float s2 = lane < 32 ? (ck[0] * ck[0] + ck[1] * ck[1] + ck[2] * ck[2] + ck[3] * ck[3]) : 0.f; s2 = wave_sum(s2, lane);
        const float rk = rsqrtf(s2 * (1.f / 128.f) + EPS);
        { const f32x4 h = ck * rk * kg; u32x2 o = {pk2(h[0], h[1]), pk2(h[2], h[3])}; if (lane >= 32) { o[0] = 0u; o[1] = 0u; } *(u32x2*)(CKVN + (size_t)r * 256 + 4 * lane) = o; }
        if (lane < 32) {
            const float x1 = a[384 + lane], x2 = a[416 + lane], c = CSC[(size_t)r * 32 + lane], s = CSS[(size_t)r * 32 + lane];
            const unsigned pr = pk2(x1 * c - x2 * s, x2 * c + x1 * s); const int b = r >> 12, sq = r & 4095;
#pragma unroll
            for (int h8 = 0; h8 < 8; ++h8) { bf16_t* kp = KF + ((size_t)((b * 8 + h8) * 4096 + sq)) * 192 + 128 + lane; kp[0] = (bf16_t)(pr & 0xffffu); kp[32] = (bf16_t)(pr >> 16); } }
    }
}

__device__ __forceinline__ void phase_attn(const int s_wv, KP p, ldsp lds) {
    const bf16_t* QF = (const bf16_t*)(p->ws + OFF_R1 + 48 * MiB); const bf16_t* KF = (const bf16_t*)(p->ws + OFF_R1 + 96 * MiB); const bf16_t* VT = (const bf16_t*)(p->ws + OFF_R1 + 144 * MiB);
    bf16_t* O = (bf16_t*)(p->ws + OFF_R2);
    const int tid = otid(), lane = tid & 63, wave = __builtin_amdgcn_readfirstlane(tid >> 6), l15 = lane & 15, g4 = lane >> 4;
    const int G = gridDim.x, bx = obid(), vcu = (G % 8 == 0) ? (bx % 8) * (G / 8) + bx / 8 : bx;
    constexpr int KB = 25600, VB = 18432, BUF = KB + VB;
    for (int unit = vcu; unit < 256; unit += G) {
        const int bh = unit >> 3, pr = unit & 7, b = bh >> 3, h = bh & 7;
        const unsigned char* kbase = (const unsigned char*)(KF + (size_t)bh * 4096 * 192);
        const unsigned char* vbase = (const unsigned char*)(VT + (size_t)bh * 128 * 4096);
        for (int half = 0; half < 2; ++half) {
            const int qb = half == 0 ? 15 - pr : pr, ntile = 4 * qb + 4;
            const int qrow0 = qb * 256 + 32 * wave;
            bf16x8 Qf[2][6];
#pragma unroll
            for (int qt = 0; qt < 2; ++qt)
#pragma unroll
                for (int ks = 0; ks < 6; ++ks) Qf[qt][ks] = *(const bf16x8*)((const unsigned char*)(QF + (size_t)(bh * 4096 + qrow0) * 192) + (unsigned)(((16 * qt + l15) * 192 + 32 * ks + 8 * g4) * 2));
            f32x4 Oa[2][8]; float mrun[2] = {-1e30f, -1e30f}, lsum[2] = {0.f, 0.f};
#pragma unroll
            for (int qt = 0; qt < 2; ++qt)
#pragma unroll
                for (int d = 0; d < 8; ++d) Oa[qt][d] = zero4();
#define ATT_DMA(j, bufi) do { ldsp kb_ = lds + (bufi) * BUF; \
                for (int c = wave; c < 25; c += 8) { const int q_ = c * 64 + lane, row = q_ / 25, c16 = min(q_ - row * 25, 23); \
                    __builtin_amdgcn_global_load_lds((const unsigned*)(kbase + (size_t)(j) * 24576 + (unsigned)(row * 384 + c16 * 16)), (LAS unsigned*)(kb_ + c * 1024), 16, 0, 0); } \
                for (int c = wave; c < 18; c += 8) { const int q_ = c * 64 + lane, dv = q_ / 9, k8 = min(q_ - dv * 9, 7); \
                    __builtin_amdgcn_global_load_lds((const unsigned*)(vbase + (size_t)(j) * 128 + (unsigned)(dv * 8192 + k8 * 16)), (LAS unsigned*)(kb_ + KB + c * 1024), 16, 0, 0); } } while (0)
            ATT_DMA(0, 0); asm volatile("s_waitcnt vmcnt(0)" ::: "memory"); __syncthreads();
#pragma unroll 1
            for (int j = 0; j < ntile; ++j) {
                if (j + 1 < ntile) ATT_DMA(j + 1, (j + 1) & 1);
                if (wave >= 4) __builtin_amdgcn_s_sleep(8);
                const int jj = j - 4 * qb; const bool diag = jj >= 0; const bool active = !(diag && 64 * jj > 32 * wave + 31);
                ldsp Kb = lds + (j & 1) * BUF; ldsp Vb = Kb + KB;
#pragma unroll
                for (int hs = 0; hs < 2; ++hs) {
                    if (active) {
                        f32x4 S[2][2];
#pragma unroll
                        for (int qt = 0; qt < 2; ++qt) { S[qt][0] = zero4(); S[qt][1] = zero4(); }
                        {
#define ATT_KLD(i) (*(const LAS bf16x8*)(Kb + (16 * (2 * hs + ((i) & 1)) + l15) * 400 + (32 * ((i) >> 1) + 8 * g4) * 2))
                            bf16x8 kq[3]; kq[0] = ATT_KLD(0); kq[1] = ATT_KLD(1);
#pragma unroll
                            for (int i = 0; i < 12; ++i) { if (i + 2 < 12) kq[(i + 2) % 3] = ATT_KLD(i + 2);
                                __builtin_amdgcn_sched_barrier(0);
                                S[0][i & 1] = MFMA16(kq[i % 3], Qf[0][i >> 1], S[0][i & 1]); S[1][i & 1] = MFMA16(kq[i % 3], Qf[1][i >> 1], S[1][i & 1]);
                                __builtin_amdgcn_sched_barrier(0); }
#undef ATT_KLD
                        }
                        bf16x8 Pf[2];
#pragma unroll
                        for (int qt = 0; qt < 2; ++qt) {
                            if (diag) { int dq = 32 * wave + 16 * qt + l15 - 4 * g4 - 64 * jj; asm volatile("" : "+v"(dq));
#pragma unroll
                                for (int sb = 0; sb < 2; ++sb)
#pragma unroll
                                    for (int e = 0; e < 4; ++e) { if (32 * hs + 16 * sb + e > dq) S[qt][sb][e] = -1e30f; } }
                            float tm = -1e30f;
#pragma unroll
                            for (int sb = 0; sb < 2; ++sb)
#pragma unroll
                                for (int e = 0; e < 4; ++e) tm = fmaxf(tm, S[qt][sb][e]);
                            tm = rowmax4(tm);
                            if (__builtin_amdgcn_ballot_w64(tm > mrun[qt]) != 0ull) {
                                const float mn = fmaxf(mrun[qt], tm), sc = __builtin_amdgcn_exp2f(mrun[qt] - mn); mrun[qt] = mn; lsum[qt] *= sc;
#pragma unroll
                                for (int d = 0; d < 8; ++d) Oa[qt][d] = Oa[qt][d] * sc; }
                            const float mn = mrun[qt];
                            float ps = 0.f;
#pragma unroll
                            for (int sb = 0; sb < 2; ++sb)
#pragma unroll
                                for (int e = 0; e < 4; ++e) { const float pe = __builtin_amdgcn_exp2f(S[qt][sb][e] - mn); S[qt][sb][e] = pe; ps += pe; }
                            lsum[qt] += ps;
                            Pf[qt] = mk8(pk2(S[qt][0][0], S[qt][0][1]), pk2(S[qt][0][2], S[qt][0][3]), pk2(S[qt][1][0], S[qt][1][1]), pk2(S[qt][1][2], S[qt][1][3]));
                        }
                        {
#define ATT_VLD(d) __builtin_shufflevector(*(const LAS bf16x4*)(Vb + (16 * (d) + l15) * 144 + (32 * hs + 4 * g4) * 2), *(const LAS bf16x4*)(Vb + (16 * (d) + l15) * 144 + (32 * hs + 16 + 4 * g4) * 2), 0, 1, 2, 3, 4, 5, 6, 7)
                            bf16x8 vq[3]; vq[0] = ATT_VLD(0); vq[1] = ATT_VLD(1);
#pragma unroll
                            for (int d = 0; d < 8; ++d) { if (d + 2 < 8) vq[(d + 2) % 3] = ATT_VLD(d + 2);
                                __builtin_amdgcn_sched_barrier(0);
                                Oa[0][d] = MFMA16(vq[d % 3], Pf[0], Oa[0][d]); Oa[1][d] = MFMA16(vq[d % 3], Pf[1], Oa[1][d]);
                                __builtin_amdgcn_sched_barrier(0); }
#undef ATT_VLD
                        }
                    }
                }
                asm volatile("s_waitcnt vmcnt(0)" ::: "memory"); __syncthreads();
            }
#pragma unroll
            for (int qt = 0; qt < 2; ++qt) { float ls = lsum[qt]; ls = rowsum4(ls); const float inv = 1.f / ls;
                bf16_t* op = (bf16_t*)((unsigned char*)(O + (size_t)(b * 4096 + qrow0) * 1024 + h * 128) + (unsigned)(((16 * qt + l15) * 1024 + 4 * g4) * 2));
#pragma unroll
                for (int d = 0; d < 8; ++d) { const f32x4 v = Oa[qt][d] * inv; u32x2 o = {pk2(v[0], v[1]), pk2(v[2], v[3])}; *(u32x2*)(op + 16 * d) = o; } }
        }
    }
#undef ATT_DMA
}

template <bool TOF32> __device__ __forceinline__ void hg_load_f_v(const float* HF, const bf16_t* HV, int t0, int col0, LAS float* BC, LAS float* K1f, ldsp K1b, ldsp VTl, int tid) {
#pragma unroll
    for (int i = 0; i < 4; ++i) { const int idx = tid + 512 * i, s = idx >> 5, k4 = (idx & 31) * 4; const f32x4 f = *(const f32x4*)(HF + (size_t)(t0 + s) * 1024 + col0 + k4);
#pragma unroll
        for (int e = 0; e < 4; ++e) BC[s * 129 + k4 + e] = __logf(f[e]);
        if (TOF32) {
#pragma unroll
            for (int e = 0; e < 4; ++e) K1f[s * 129 + k4 + e] = 1.f - f[e];
        } else { u32x2 o = {pk2(1.f - f[0], 1.f - f[1]), pk2(1.f - f[2], 1.f - f[3])}; *(LAS u32x2*)(K1b + s * 272 + k4 * 2) = o; } }
#pragma unroll
    for (int i = 0; i < 2; ++i) { const int idx = tid + 512 * i, s = idx >> 4, v8 = idx & 15; const u32x4 vv = *(const u32x4*)(HV + (size_t)(t0 + s) * 1024 + col0 + v8 * 8);
#pragma unroll
        for (int e = 0; e < 4; ++e) { *(LAS bf16_t*)(VTl + (v8 * 8 + 2 * e) * 144 + s * 2) = (bf16_t)(vv[e] & 0xffffu); *(LAS bf16_t*)(VTl + (v8 * 8 + 2 * e + 1) * 144 + s * 2) = (bf16_t)(vv[e] >> 16); } }
}
__device__ __forceinline__ void phase_ha(const int s_wv, KP p, ldsp lds) {
    const float* HF = (const float*)(p->ws + OFF_R1 + 32 * MiB); const bf16_t* HV = (const bf16_t*)(p->ws + OFF_R1 + 96 * MiB);
    bf16_t* LCT = (bf16_t*)(p->ws + OFF_R2); float* DEC = (float*)(p->ws + OFF_R2 + 64 * MiB);
    const int tid = otid(), lane = tid & 63, wave = tid >> 6, l15 = lane & 15, g4 = lane >> 4;
    LAS float* BC = (LAS float*)lds; LAS float* K1 = (LAS float*)(lds + 33024); ldsp KT = lds + 66048; ldsp VTl = lds + 84480;
    for (int u = obid(); u < 2048; u += gridDim.x) {
        const int bh = u >> 6, n = u & 63, b = bh >> 3, h = bh & 7, t0 = b * 4096 + n * 64, col0 = h * 128;
        hg_load_f_v<true>(HF, HV, t0, col0, BC, K1, VTl, VTl, tid);
        __syncthreads();
        if (tid < 128) { float run = 0.f;
#pragma unroll 8
            for (int s = 0; s < 64; ++s) { run += BC[s * 129 + tid]; BC[s * 129 + tid] = run; }
            DEC[(size_t)u * 128 + tid] = __expf(run); }
        __syncthreads();
        { const int sp = tid & 31, kk0 = tid >> 5;
#pragma unroll
          for (int it = 0; it < 8; ++it) { const int k = kk0 + 16 * it; const float bl = BC[63 * 129 + k];
              const float a0 = K1[(2 * sp) * 129 + k] * __expf(bl - BC[(2 * sp) * 129 + k]), a1 = K1[(2 * sp + 1) * 129 + k] * __expf(bl - BC[(2 * sp + 1) * 129 + k]);
              *(LAS unsigned*)(KT + k * 144 + sp * 4) = pk2(a0, a1); } }
        __syncthreads();
        f32x4 acc[8];
#pragma unroll
        for (int vt = 0; vt < 8; ++vt) acc[vt] = zero4();
#pragma unroll
        for (int ks = 0; ks < 2; ++ks) { const bf16x8 xf = *(const LAS bf16x8*)(KT + (16 * wave + l15) * 144 + (32 * ks + 8 * g4) * 2);
#pragma unroll
            for (int vt = 0; vt < 8; ++vt) { const bf16x8 yf = *(const LAS bf16x8*)(VTl + (16 * vt + l15) * 144 + (32 * ks + 8 * g4) * 2); acc[vt] = MFMA16(xf, yf, acc[vt]); } }
#pragma unroll
        for (int vt = 0; vt < 8; ++vt) { u32x2 o = {pk2(acc[vt][0], acc[vt][1]), pk2(acc[vt][2], acc[vt][3])}; *(u32x2*)(LCT + ((size_t)u * 128 + 16 * vt + l15) * 128 + 16 * wave + 4 * g4) = o; }
        __syncthreads();
    }
}
__device__ __forceinline__ void phase_hscan(const int s_wv, KP p) {
    bf16_t* LCT = (bf16_t*)(p->ws + OFF_R2); const float* DEC = (const float*)(p->ws + OFF_R2 + 64 * MiB);
    const int gtid = obid() * NTHREADS + otid(), gthreads = gridDim.x * NTHREADS;
    for (int id = gtid; id < 32 * 128 * 32; id += gthreads) {
        const int k4 = id & 31, v = (id >> 5) & 127, bh = id >> 12;
        f32x4 st = zero4();
#pragma unroll 4
        for (int n = 0; n < 64; ++n) { const int u = bh * 64 + n; bf16_t* ptr = LCT + ((size_t)u * 128 + v) * 128 + 4 * k4;
            const u32x2 t = *(const u32x2*)ptr; const f32x4 dec = *(const f32x4*)(DEC + (size_t)u * 128 + 4 * k4);
            u32x2 o = {pk2(st[0], st[1]), pk2(st[2], st[3])}; *(u32x2*)ptr = o;
            st[0] = dec[0] * st[0] + bflo(t[0]); st[1] = dec[1] * st[1] + bfhi(t[0]); st[2] = dec[2] * st[2] + bflo(t[1]); st[3] = dec[3] * st[3] + bfhi(t[1]); }
    }
}
__device__ __forceinline__ void phase_hc(const int s_wv, KP p, ldsp lds) {
    const bf16_t* HQ = (const bf16_t*)(p->ws + OFF_R1); const float* HF = (const float*)(p->ws + OFF_R1 + 32 * MiB); const bf16_t* HV = (const bf16_t*)(p->ws + OFF_R1 + 96 * MiB); const bf16_t* HG = (const bf16_t*)(p->ws + OFF_R1 + 128 * MiB);
    const bf16_t* SST = (const bf16_t*)(p->ws + OFF_R2); bf16_t* O = (bf16_t*)(p->ws + OFF_HB); const float* ng = p->in[21];
    const int tid = otid(), lane = tid & 63, wave = tid >> 6, l15 = lane & 15, g4 = lane >> 4;
    LAS float* BC = (LAS float*)lds; ldsp QT = lds + 33024; ldsp KTl = lds + 50432; ldsp QH = lds + 67840; ldsp VTl = lds + 85248; ldsp AT = lds + 103680; LAS float* SSQ = (LAS float*)(lds + 112896);
    for (int u = obid(); u < 2048; u += gridDim.x) {
        const int bh = u >> 6, n = u & 63, b = bh >> 3, h = bh & 7, t0 = b * 4096 + n * 64, col0 = h * 128;
        hg_load_f_v<false>(HF, HV, t0, col0, BC, BC, KTl, VTl, tid);
        u32x4 qraw[2];
#pragma unroll
        for (int i = 0; i < 2; ++i) { const int idx = tid + 512 * i, s = idx >> 4, k8 = idx & 15; qraw[i] = *(const u32x4*)(HQ + (size_t)(t0 + s) * 1024 + col0 + k8 * 8); }
        __syncthreads();
        if (tid < 128) { float run = 0.f;
#pragma unroll 8
            for (int s = 0; s < 64; ++s) { run += BC[s * 129 + tid]; BC[s * 129 + tid] = run; } }
        __syncthreads();
#pragma unroll
        for (int i = 0; i < 2; ++i) { const int idx = tid + 512 * i, s = idx >> 4, k8 = idx & 15; float q[8], kk[8], qt[8], qh[8]; up8(qraw[i], q); up8(*(const LAS u32x4*)(KTl + s * 272 + k8 * 16), kk);
#pragma unroll
            for (int e = 0; e < 8; ++e) { const int k = k8 * 8 + e; const float bc = BC[s * 129 + k], bm = BC[31 * 129 + k]; qt[e] = q[e] * __expf(bc - bm); qh[e] = q[e] * __expf(bc); kk[e] = kk[e] * __expf(bm - bc); }
            u32x4 o1 = {pk2(qt[0], qt[1]), pk2(qt[2], qt[3]), pk2(qt[4], qt[5]), pk2(qt[6], qt[7])}, o2 = {pk2(qh[0], qh[1]), pk2(qh[2], qh[3]), pk2(qh[4], qh[5]), pk2(qh[6], qh[7])}, o3 = {pk2(kk[0], kk[1]), pk2(kk[2], kk[3]), pk2(kk[4], kk[5]), pk2(kk[6], kk[7])};
            *(LAS u32x4*)(QT + s * 272 + k8 * 16) = o1; *(LAS u32x4*)(QH + s * 272 + k8 * 16) = o2; *(LAS u32x4*)(KTl + s * 272 + k8 * 16) = o3; }
        __syncthreads();
        { const int st = wave & 3;
#pragma unroll
          for (int ti = 0; ti < 2; ++ti) { const int tt = 2 * (wave >> 2) + ti; f32x4 a = zero4();
              if (st <= tt) {
#pragma unroll
                  for (int ks = 0; ks < 4; ++ks) { const bf16x8 xf = *(const LAS bf16x8*)(KTl + (16 * st + l15) * 272 + (32 * ks + 8 * g4) * 2), yf = *(const LAS bf16x8*)(QT + (16 * tt + l15) * 272 + (32 * ks + 8 * g4) * 2); a = MFMA16(xf, yf, a); }
                  const int t = 16 * tt + l15;
#pragma unroll
                  for (int e = 0; e < 4; ++e) { const int s = 16 * st + 4 * g4 + e; if (s > t) a[e] = 0.f; } }
              u32x2 o = {pk2(a[0], a[1]), pk2(a[2], a[3])}; *(LAS u32x2*)(AT + (16 * tt + l15) * 144 + (16 * st + 4 * g4) * 2) = o; } }
        __syncthreads();
        { const int tt = wave >> 1, vh = wave & 1; f32x4 acc[4];
#pragma unroll
          for (int vi = 0; vi < 4; ++vi) acc[vi] = zero4();
#pragma unroll
          for (int ks = 0; ks < 2; ++ks) if (32 * ks <= 16 * tt + 15) { const bf16x8 yf = *(const LAS bf16x8*)(AT + (16 * tt + l15) * 144 + (32 * ks + 8 * g4) * 2);
#pragma unroll
              for (int vi = 0; vi < 4; ++vi) { const bf16x8 xf = *(const LAS bf16x8*)(VTl + (16 * (4 * vh + vi) + l15) * 144 + (32 * ks + 8 * g4) * 2); acc[vi] = MFMA16(xf, yf, acc[vi]); } }
#pragma unroll
          for (int ks = 0; ks < 4; ++ks) { const bf16x8 yf = *(const LAS bf16x8*)(QH + (16 * tt + l15) * 272 + (32 * ks + 8 * g4) * 2);
#pragma unroll
              for (int vi = 0; vi < 4; ++vi) { const bf16x8 xf = *(const bf16x8*)(SST + ((size_t)u * 128 + 16 * (4 * vh + vi) + l15) * 128 + 32 * ks + 8 * g4); acc[vi] = MFMA16(xf, yf, acc[vi]); } }
          float sq = 0.f;
#pragma unroll
          for (int vi = 0; vi < 4; ++vi)
#pragma unroll
              for (int e = 0; e < 4; ++e) sq += acc[vi][e] * acc[vi][e];
          sq = rowsum4(sq);
          if (g4 == 0) SSQ[(16 * tt + l15) * 2 + vh] = sq;
          __syncthreads();
          const int t = 16 * tt + l15; const float rstd = rsqrtf((SSQ[t * 2] + SSQ[t * 2 + 1]) * (1.f / 128.f) + EPS);
#pragma unroll
          for (int vi = 0; vi < 4; ++vi) { const int v = 16 * (4 * vh + vi) + 4 * g4; const f32x4 gn = *(const f32x4*)(ng + v); const u32x2 gg = *(const u32x2*)(HG + (size_t)(t0 + t) * 1024 + col0 + v);
              const f32x4 a = acc[vi] * rstd * gn; u32x2 o = {pk2(a[0] * bflo(gg[0]), a[1] * bfhi(gg[0])), pk2(a[2] * bflo(gg[1]), a[3] * bfhi(gg[1]))};
              *(u32x2*)(O + (size_t)(t0 + t) * 1024 + col0 + v) = o; } }
        __syncthreads();
    }
}

__global__ void __launch_bounds__(NTHREADS, 2) fwd_kernel(Params pk) {
    extern __shared__ __attribute__((aligned(16))) unsigned char smem[];
    ldsp lds = (ldsp)smem;
    const int ph_lo = pk.ph_lo, ph_hi = pk.ph_hi;
    const int s_wv = __builtin_amdgcn_readfirstlane((int)threadIdx.x >> 6);
    if (threadIdx.x < 4) ((LAS unsigned*)(lds + 131072))[threadIdx.x] = 0u;
    __syncthreads();
    XcdBarrier xbar = xcd_barrier_post((unsigned*)(pk.ws + OFF_BAR), (volatile LAS unsigned*)(lds + 131072), (int)threadIdx.x);
    for (int ph = ph_lo; ph < ph_hi; ++ph) {
        KP p = (KP)__builtin_amdgcn_kernarg_segment_ptr();
        asm volatile("" : "+s"(p));
        const int op = p->op[ph], layraw = p->lay[ph], layer = layraw & 3; const bool dummy = (layraw & 4) != 0;
        unsigned char* ws = p->ws; bf16_t* xdst = dummy ? (bf16_t*)(ws + OFF_R1) : (bf16_t*)(ws + OFF_XB);
        float* MOD = (float*)(ws + OFF_MOD); bf16_t* WT = (bf16_t*)(ws + OFF_WT); bf16_t* HB = (bf16_t*)(ws + OFF_HB); bf16_t* XB = (bf16_t*)(ws + OFF_XB);
        bf16_t* R1 = (bf16_t*)(ws + OFF_R1); bf16_t* R2 = (bf16_t*)(ws + OFF_R2);
        const float* modl = MOD + (size_t)layer * 4 * 6144;
        switch (op) {
        case OP_PRO: phase_prologue(s_wv, p, lds); break;
        case OP_NORM1: if (layer == 0) phase_norm<true>(s_wv, p->in[0], XB, p->in[5], modl + 0, modl + 1024, HB); else { phase_norm<false>(s_wv, p->in[0], XB, p->in[5] + layer * 1024, modl + 0, modl + 1024, HB); prep_layer(s_wv, p, layer, lds, layer != 1); } break;
        case OP_NORM2: { const float* cw = p->in[24] + (size_t)layer * 3 * 5632; const float* cb = p->in[25] + (size_t)layer * 5632; bf16_t* CWB = (bf16_t*)(ws + OFF_CWB);
                         for (int f = obid() * NTHREADS + otid(); f < 2816; f += gridDim.x * NTHREADS) { u32x4 o = {pk2(cw[f], cw[5632 + f]), pk2(cw[11264 + f], cb[f]), pk2(cw[2816 + f], cw[5632 + 2816 + f]), pk2(cw[11264 + 2816 + f], cb[2816 + f])}; *(u32x4*)(CWB + f * 8) = o; }
                         phase_norm<false>(s_wv, p->in[0], XB, p->in[6] + layer * 1024, modl + 3072, modl + 4096, HB); } break;
        case OP_G1: { EpiBf16<1> E{R1, 4096}; run_gemm(s_wv, lds, HB, WT + WT_MIXA, T, 4096, 1024, E); } break;
        case OP_GSP: phase_gsp(s_wv, p, layer / 3, lds); break;
        case OP_GOUT: { EpiRes E{XB, xdst, modl + 2048}; run_gemm(s_wv, lds, R2, WT + WT_MIXB, T, 1024, 2048, E); } break;
        case OP_M1: { EpiF32 E{(float*)R1, 512}; run_gemm(s_wv, lds, HB, WT + WT_MIXA, T, 512, 1024, E);
                      if ((int)gridDim.x >= 256) { if (obid() >= 128) prep_ffn(s_wv, p, layer, lds, 128, (int)gridDim.x - 128); } else prep_ffn(s_wv, p, layer, lds, 0, 0); } break;
        case OP_M2: phase_m2(s_wv, p); break;
        case OP_M3: { EpiQ EQ{(bf16_t*)(ws + OFF_R1 + 48 * MiB), (const float*)(ws + OFF_CSC), (const float*)(ws + OFF_CSS), 0.07216878364870322f * 1.4426950408889634f}; run_gemm(s_wv, lds, (const bf16_t*)(ws + OFF_R1 + 32 * MiB), WT + WT_MQKV, T, 1536, 256, EQ); EpiKV EK{(bf16_t*)(ws + OFF_R1 + 96 * MiB), (bf16_t*)(ws + OFF_R1 + 144 * MiB)}; run_gemm(s_wv, lds, (const bf16_t*)(ws + OFF_R1 + 40 * MiB), WT + WT_MQKV + 393216, T, 2048, 256, EK); } break;
        case OP_ATT: phase_attn(s_wv, p, lds); break;
        case OP_MOUT: { EpiRes E{XB, XB, modl + 2048}; run_gemm(s_wv, lds, R2, WT + WT_MIXB, T, 1024, 1024, E); } break;
        case OP_H1: { EpiHg E{ws + OFF_R1, (const float*)(ws + OFF_LB)}; run_gemm(s_wv, lds, HB, WT + WT_MIXA, T, 4096, 1024, E); } break;
        case OP_HA: phase_ha(s_wv, p, lds); break;
        case OP_HSCAN: phase_hscan(s_wv, p); break;
        case OP_HC: phase_hc(s_wv, p, lds); break;
        case OP_HOUT: { EpiRes E{XB, XB, modl + 2048}; run_gemm(s_wv, lds, HB, WT + WT_MIXB, T, 1024, 1024, E); } break;
        case OP_FUP: { EpiFFN E{R2, (const bf16_t*)(ws + OFF_CWB)}; run_gemm(s_wv, lds, HB - 2 * 1024, WT + WT_FUP, 67 * 256, 5632, 1024, E); } break;
        case OP_FDN: { EpiRes E{XB, xdst, modl + 5120}; run_gemm(s_wv, lds, R2, WT + WT_FDN, T, 1024, 2816, E); } break;
        case OP_FINAL: phase_final(s_wv, XB, p->out, p->in[27]); break;
        default: break;
        }
        if (ph + 1 < ph_hi) { if (ph == ph_lo) { __syncthreads(); cg::this_grid().sync(); } else xcd_barrier(xbar, otid()); }
    }
}

#ifndef MULTI_LAUNCH
#define MULTI_LAUNCH 0
#endif
extern "C" void kernel_launch(void* const* d_in, const int* in_sizes, int n_in, void* d_out, int out_size, void* d_ws, size_t ws_size, hipStream_t stream) {
    static int grid = 0;
    if (grid == 0) {
        int dev = 0, cus = 0, per_cu = 0;
        hipGetDevice(&dev); hipDeviceGetAttribute(&cus, hipDeviceAttributeMultiprocessorCount, dev);
        hipFuncSetAttribute((const void*)fwd_kernel, hipFuncAttributeMaxDynamicSharedMemorySize, LDS_BYTES);
        hipOccupancyMaxActiveBlocksPerMultiprocessor(&per_cu, (const void*)fwd_kernel, NTHREADS, LDS_BYTES);
        if (per_cu < 1) per_cu = 1;
        grid = cus * 1; (void)per_cu;
        if (ws_size < WS_END) fprintf(stderr, "kernel_launch: workspace too small: %zu < %zu\n", ws_size, (size_t)WS_END);
        (void)hipGetLastError();
    }
    (void)hipMemsetAsync((char*)d_ws + OFF_BAR, 0, XCD_BAR_WORDS * sizeof(unsigned), stream);
    Params p{};
    for (int i = 0; i < 28; ++i) p.in[i] = (const float*)d_in[i];
    p.out = (float*)d_out; p.ws = (unsigned char*)d_ws;
    int n = 0;
    auto add = [&](int op, int l) { p.op[n] = (unsigned char)op; p.lay[n] = (unsigned char)l; ++n; };
    add(OP_PRO, 0);
    for (int l = 0; l < 4; ++l) {
        add(OP_NORM1, l);
        if (l % 3 == 0) { add(OP_G1, l); add(OP_GSP, l); add(OP_GOUT, l); }
        else if (l % 3 == 1) { add(OP_M1, l); add(OP_M2, l); add(OP_M3, l); add(OP_ATT, l); add(OP_MOUT, l); }
        else { add(OP_H1, l); add(OP_HA, l); add(OP_HSCAN, l); add(OP_HC, l); add(OP_HOUT, l); }
        add(OP_NORM2, l); add(OP_FUP, l); add(OP_FDN, l);
    }
    add(OP_FINAL, 0);
#if MULTI_LAUNCH
    for (int i = 0; i < n; ++i) { p.ph_lo = i; p.ph_hi = i + 1; hipLaunchKernelGGL(fwd_kernel, dim3(grid), dim3(NTHREADS), LDS_BYTES, stream, p); }
#else
    p.ph_lo = 0; p.ph_hi = n;
    void* args[] = {&p};
    hipError_t e = hipLaunchCooperativeKernel((const void*)fwd_kernel, dim3(grid), dim3(NTHREADS), args, LDS_BYTES, stream);
    if (e != hipSuccess) fprintf(stderr, "cooperative launch failed: %s (grid %d)\n", hipGetErrorString(e), grid);
#endif
}
```

```cpp
#include <hip/hip_runtime.h>
#include <hip/hip_cooperative_groups.h>
#include <cstdio>
#include <cstdint>
namespace cg = cooperative_groups;
__device__ __forceinline__ int otid_w(int w) { int l; asm volatile("v_mbcnt_lo_u32_b32 %0, -1, 0\n\tv_mbcnt_hi_u32_b32 %0, -1, %0" : "=v"(l)); return (w << 6) | l; }
#define otid() otid_w(s_wv)
__device__ __forceinline__ int obid() { int t = blockIdx.x; asm volatile("" : "+s"(t)); return t; }
namespace pg8 {
#define PG8_LAS __attribute__((address_space(3)))
typedef unsigned short bf16_t;
typedef short bf16x8 __attribute__((ext_vector_type(8)));
typedef float f32x4 __attribute__((ext_vector_type(4)));
typedef unsigned u32x4 __attribute__((ext_vector_type(4)));
constexpr int BM = 256, BK = 64, HALF = 128, HTB = HALF * BK * 2  , STAGE_BYTES = 8 * HTB, NXCD = 8, WGM = 8;

__host__ __device__ __forceinline__ int lds_byte(int r, int c) { const int st = (r >> 4) * 2 + (c >> 5), rr = r & 15, cc = c & 31, ob = rr * 64 + cc * 2; return st * 1024 + (ob ^ (((ob >> 9) & 1) << 5)); }
__host__ __device__ __forceinline__ void stage_rc(int b, int& R, int& C) { const int st = b / 1024, sb = b % 1024, swz = sb ^ (((sb >> 9) & 1) << 5); R = (st >> 1) * 16 + swz / 64; C = (st & 1) * 32 + (swz % 64) / 2; }
__host__ __device__ __forceinline__ int perm32(int rho) { const int n = rho >> 4, i = rho & 15; return 8 * (i >> 2) + 4 * n + (i & 3); }

struct Unit { int pm, pn; };
struct Gemm { const bf16_t* A; const bf16_t* Bt; int M, N, K; };

struct StaticOrder {
    int nM, nN, nwg, G, c;
    __host__ __device__ void init(int M, int N, int G_, int c_) { nM = M / BM; nN = N / BM; nwg = nM * nN; G = G_; c = c_; }
    __host__ __device__ bool next(int i, Unit& u) const {
        const long L = (long)i * G + c; if (L >= nwg) return false;
        int wgid = (int)L; { const int q = nwg / NXCD, r = nwg % NXCD, xcd = wgid % NXCD, off = wgid / NXCD; wgid = (xcd < r ? xcd * (q + 1) : r * (q + 1) + (xcd - r) * q) + off; }
        const int nig = WGM * nN, gid = wgid / nig, fm = gid * WGM, gsz = (nM - fm) < WGM ? (nM - fm) : WGM;
        u.pm = fm + ((wgid % nig) % gsz); u.pn = (wgid % nig) / gsz; return true;
    }
    __device__ __forceinline__ void a_ready(const Unit&) const {}
    __device__ __forceinline__ void done(const Unit&) const {}
};
__device__ __forceinline__ unsigned cvt_pk_bf16(float lo, float hi) { unsigned r; asm volatile("v_cvt_pk_bf16_f32 %0, %1, %2" : "=v"(r) : "v"(lo), "v"(hi)); return r; }

template <class Epi, class Sched, bool STAMP = false>
__device__ __forceinline__ void gemm_phase(const int s_wv, PG8_LAS unsigned char* lds, const Gemm g, const Sched& S, const Epi& E, unsigned long long* stamps) {
    const int tid = otid(), wid = __builtin_amdgcn_readfirstlane(tid >> 6), lane = tid & 63, wr = wid >> 2, wc = wid & 3, fr = lane & 15, fq = lane >> 4;
    const int K = g.K, nt = K / BK;
    int ts_lo = 0, ts_hi = 0, nts = 0; const unsigned long long rt_entry = STAMP ? (unsigned long long)wall_clock64() : 0ull;
#define PG8_STAMP() do { if (STAMP && wid == 0 && nts < 64) { const unsigned long long _c = (unsigned long long)clock64(); \
        ts_lo = (lane == nts) ? (int)(unsigned)_c : ts_lo; ts_hi = (lane == nts) ? (int)(unsigned)(_c >> 32) : ts_hi; ++nts; } } while (0)
    PG8_STAMP();
    unsigned voffA[2], voffB[2];
#pragma unroll
    for (int i = 0; i < 2; ++i) { int R, C; stage_rc(tid * 16 + i * 8192, R, C); const int Rb = Epi::PERM ? ((R & ~31) + perm32(R & 31)) : R;
        const int Ra = Epi::PERMA ? (62 * (R >> 6) + 4 * (R & 15) + ((R >> 4) & 3)) : R; voffA[i] = (unsigned)(Ra * K + C) * 2u; voffB[i] = (unsigned)(Rb * K + C) * 2u; }
    const size_t kstep = (size_t)(BK * 2);
    const size_t hstep = (size_t)HALF * K * 2;
    const size_t tstep = 2 * hstep;
    const size_t hstepA = Epi::PERMA ? (size_t)124 * K * 2 : hstep, tstepA = Epi::PERMA ? (size_t)248 * K * 2 : tstep;
    const unsigned ldsw = (unsigned)wid * 1024u;
    const int aoff = lds_byte(wr * 64 + fr, fq * 8), boff = lds_byte(wc * 32 + fr, fq * 8);
#define PG8_SA(b, h) (((b) * 2 + (h)) * HTB)
#define PG8_SB(b, h) ((4 + (b) * 2 + (h)) * HTB)
#define PG8_STAGE(bufoff, gbase, voff) do { _Pragma("unroll") for (int _i = 0; _i < 2; ++_i) \
        __builtin_amdgcn_global_load_lds((const unsigned*)((const char*)(gbase) + (voff)[_i]), (PG8_LAS unsigned*)(lds + (bufoff) + ldsw + _i * 8192), 16, 0, 0); } while (0)
#define PG8_LDA(dst, b, h) do { _Pragma("unroll") for (int m = 0; m < 4; ++m) _Pragma("unroll") for (int k = 0; k < 2; ++k) dst[m][k] = *(const PG8_LAS bf16x8*)(lds + PG8_SA(b, h) + aoff + m * 2048 + k * 1024); } while (0)
#define PG8_LDB(dst, b, h) do { _Pragma("unroll") for (int n = 0; n < 2; ++n) _Pragma("unroll") for (int k = 0; k < 2; ++k) dst[n][k] = *(const PG8_LAS bf16x8*)(lds + PG8_SB(b, h) + boff + n * 2048 + k * 1024); } while (0)
#define PG8_MMA(ai, bj, At, Bt) do { __builtin_amdgcn_s_setprio(1); _Pragma("unroll") for (int m = 0; m < 4; ++m) _Pragma("unroll") for (int n = 0; n < 2; ++n) _Pragma("unroll") for (int k = 0; k < 2; ++k) \
        acc[ai][bj][m][n] = __builtin_amdgcn_mfma_f32_16x16x32_bf16(Bt[n][k], At[m][k], acc[ai][bj][m][n], 0, 0, 0); __builtin_amdgcn_s_setprio(0); } while (0)
#define PG8_WAIT_V(n) asm volatile("s_waitcnt vmcnt(" #n ")" ::: "memory")
#define PG8_WAIT_L(n) asm volatile("s_waitcnt lgkmcnt(" #n ")" ::: "memory")
#define PG8_BAR __builtin_amdgcn_s_barrier()
#define PG8_SCHED __builtin_amdgcn_sched_barrier(0)
    Unit cur, nxt; int ui = 0;
    if (!S.next(0, cur)) return;
    f32x4 acc[2][2][4][2];
#pragma unroll
    for (int a = 0; a < 2; ++a)
#pragma unroll
        for (int b = 0; b < 2; ++b)
#pragma unroll
            for (int m = 0; m < 4; ++m)
#pragma unroll
                for (int n = 0; n < 2; ++n) acc[a][b][m][n] = (f32x4){0.f, 0.f, 0.f, 0.f};
    bf16x8 At[4][2], B0[2][2], B1[2][2];
    const char* cA = (const char*)g.A + (size_t)cur.pm * tstepA; const char* cB = (const char*)g.Bt + (size_t)cur.pn * tstep;
    S.a_ready(cur);
    PG8_STAGE(PG8_SB(0, 0), cB, voffB); PG8_STAGE(PG8_SA(0, 0), cA, voffA); PG8_STAGE(PG8_SB(0, 1), cB + hstep, voffB); PG8_STAGE(PG8_SA(0, 1), cA + hstepA, voffA);
    if (wr == 1) PG8_BAR;
    PG8_WAIT_V(4); PG8_BAR;
    PG8_STAGE(PG8_SB(1, 0), cB + kstep, voffB); PG8_STAGE(PG8_SA(1, 0), cA + kstep, voffA); PG8_STAGE(PG8_SB(1, 1), cB + hstep + kstep, voffB);
    PG8_WAIT_V(6); PG8_BAR;
    PG8_STAMP();
    for (;;) {
        const bool has_next = S.next(ui + 1, nxt);
        const char* nA = has_next ? (const char*)g.A + (size_t)nxt.pm * tstepA : cA; const char* nB = has_next ? (const char*)g.Bt + (size_t)nxt.pn * tstep : cB;
        for (int t = 0; t < nt; t += 2) {
            const bool last = (t == nt - 2);
            const char* a1 = cA + (size_t)(t + 1) * kstep;
            const char* a2 = last ? nA : cA + (size_t)(t + 2) * kstep; const char* b2 = last ? nB : cB + (size_t)(t + 2) * kstep;
            const char* a3 = a2 + kstep; const char* b3 = b2 + kstep;
            if (last && has_next) S.a_ready(nxt);
            PG8_LDB(B0, 0, 0); PG8_SCHED; PG8_LDA(At, 0, 0); PG8_STAGE(PG8_SA(1, 1), a1 + hstepA, voffA);
            PG8_WAIT_L(8); PG8_BAR; PG8_WAIT_L(0); PG8_MMA(0, 0, At, B0); PG8_BAR; PG8_SCHED;
            PG8_LDB(B1, 0, 1); PG8_STAGE(PG8_SB(0, 0), b2, voffB);
            PG8_BAR; PG8_WAIT_L(0); PG8_MMA(0, 1, At, B1); PG8_BAR;
            PG8_LDA(At, 0, 1); PG8_STAGE(PG8_SA(0, 0), a2, voffA);
            PG8_BAR; PG8_WAIT_L(0); PG8_MMA(1, 0, At, B0); PG8_BAR; PG8_SCHED;
            PG8_STAGE(PG8_SB(0, 1), b2 + hstep, voffB);
            PG8_WAIT_V(6); PG8_BAR; PG8_MMA(1, 1, At, B1); PG8_BAR;
            PG8_LDB(B0, 1, 0); PG8_SCHED; PG8_LDA(At, 1, 0); PG8_STAGE(PG8_SA(0, 1), a2 + hstepA, voffA);
            PG8_WAIT_L(8); PG8_BAR; PG8_WAIT_L(0); PG8_MMA(0, 0, At, B0); PG8_BAR; PG8_SCHED;
            PG8_LDB(B1, 1, 1); PG8_STAGE(PG8_SB(1, 0), b3, voffB);
            PG8_BAR; PG8_WAIT_L(0); PG8_MMA(0, 1, At, B1); PG8_BAR;
            PG8_LDA(At, 1, 1); PG8_STAGE(PG8_SA(1, 0), a3, voffA);
            PG8_BAR; PG8_WAIT_L(0); PG8_MMA(1, 0, At, B0); PG8_BAR; PG8_SCHED;
            PG8_STAGE(PG8_SB(1, 1), b3 + hstep, voffB);
            PG8_WAIT_V(6); PG8_BAR; PG8_MMA(1, 1, At, B1); PG8_BAR;
        }
        PG8_STAMP();
        if constexpr (!Epi::AFTER_DRAIN) { E(acc, cur, wr, wc, fr, fq); S.done(cur); }
        PG8_STAMP();
        if (!has_next) break;
#pragma unroll
        for (int a = 0; a < 2; ++a)
#pragma unroll
            for (int b = 0; b < 2; ++b)
#pragma unroll
                for (int m = 0; m < 4; ++m)
#pragma unroll
                    for (int n = 0; n < 2; ++n) acc[a][b][m][n] = (f32x4){0.f, 0.f, 0.f, 0.f};
        cur = nxt; cA = nA; cB = nB; ++ui;
    }
    PG8_WAIT_V(0);
    if (wr == 0) PG8_BAR;
    PG8_BAR;
    if constexpr (Epi::AFTER_DRAIN) { E.fused(acc, cur, wr, wc, fr, fq, lds, wid, lane); S.done(cur); }
    PG8_STAMP();
    if (STAMP && wid == 0) { stamps[lane] = lane < nts ? (((unsigned long long)(unsigned)ts_hi << 32) | (unsigned)ts_lo) : 0ull;
        if (lane == 62) stamps[62] = rt_entry; if (lane == 63) stamps[63] = (unsigned long long)wall_clock64(); }
#undef PG8_STAMP
#undef PG8_SA
#undef PG8_SB
#undef PG8_STAGE
#undef PG8_LDA
#undef PG8_LDB
#undef PG8_MMA
#undef PG8_WAIT_V
#undef PG8_WAIT_L
#undef PG8_BAR
#undef PG8_SCHED
}
}

using pg8::bf16_t; using pg8::bf16x8; using pg8::f32x4; using pg8::u32x4; using pg8::Unit;
typedef unsigned u32x2 __attribute__((ext_vector_type(2)));
typedef short bf16x4 __attribute__((ext_vector_type(4)));
#define LAS __attribute__((address_space(3)))
typedef LAS unsigned char* ldsp;
#define XB_TMO      128
#define XB_XCNT(j)  (256  + 64 * (j))
#define XB_XSUB(j)  (1280 + 64 * (j))
#define XB_XGEN(j)  (2304 + 64 * (j))
#define XB_TOP      3328
#define XB_TOPGEN   3392
#define XCD_BAR_WORDS 3456
#define XB_SPIN_CAP (1u << 18)

__device__ __forceinline__ unsigned xb_ld(unsigned* p)              { return __hip_atomic_load(p, __ATOMIC_RELAXED, __HIP_MEMORY_SCOPE_AGENT); }
__device__ __forceinline__ unsigned xb_add(unsigned* p, unsigned v) { return __hip_atomic_fetch_add(p, v, __ATOMIC_RELAXED, __HIP_MEMORY_SCOPE_AGENT); }
__device__ __forceinline__ unsigned xb_xcc_id() { return (unsigned)__builtin_amdgcn_s_getreg((3 << 11) | 20) & 0xFu; }
#define XB_SPIN(cond, bar) do { unsigned _sp = 0; while (cond) { __builtin_amdgcn_s_sleep(1); \
    if ((++_sp & 255u) == 0u) { if (xb_ld(&(bar)[XB_TMO])) break; if (_sp > XB_SPIN_CAP) { atomicAdd(&(bar)[XB_TMO], 1u); break; } } } } while (0)

struct XcdBarrier {
    unsigned* bar; unsigned x;
    volatile LAS unsigned* st;
};

__device__ __forceinline__ XcdBarrier xcd_barrier_post(unsigned* bar, volatile LAS unsigned* st, const int tid0) {
    XcdBarrier b; b.bar = bar; b.x = xb_xcc_id(); b.st = st;
    if (tid0 == 0) (void)xb_add(&bar[XB_XCNT(b.x)], 1u);
    return b;
}
__device__ __forceinline__ void xcd_barrier_complete(unsigned* bar, unsigned x, unsigned& nloc, unsigned& nx) {
    const unsigned G = gridDim.x * gridDim.y * gridDim.z;
    unsigned sum, cnt, mine, sp = 0u;
    for (;;) {
        sum = 0u; cnt = 0u; mine = 0u;
#pragma unroll
        for (unsigned j = 0; j < 16; ++j) { const unsigned c = xb_ld(&bar[XB_XCNT(j)]); sum += c; cnt += (c > 0u) ? 1u : 0u; mine = (j == x) ? c : mine; }
        if (sum == G) break;
        __builtin_amdgcn_s_sleep(1);
        if ((++sp & 255u) == 0u) { if (xb_ld(&bar[XB_TMO])) break; if (sp > XB_SPIN_CAP) { atomicAdd(&bar[XB_TMO], 1u); break; } }
    }
    nloc = mine > 0u ? mine : 1u; nx = cnt > 0u ? cnt : 1u;
}

__device__ __forceinline__ void xcd_barrier(const XcdBarrier& b, const int tid0) {
    asm volatile("s_waitcnt vmcnt(0)" ::: "memory");
    __syncthreads();
    if (tid0 == 0) {
        unsigned* bar = b.bar;
        __builtin_amdgcn_s_waitcnt(0);
        unsigned nloc = b.st[0], nx = b.st[1];
        if (nloc == 0u) { xcd_barrier_complete(bar, b.x, nloc, nx); b.st[0] = nloc; b.st[1] = nx; }
        const unsigned old = xb_add(&bar[XB_XSUB(b.x)], 1u);
        const unsigned gen = old / nloc;
        if (old + 1u == (gen + 1u) * nloc) {
            __builtin_amdgcn_fence(__ATOMIC_RELEASE, "agent");
            asm volatile("s_waitcnt vmcnt(0)" ::: "memory");
            const unsigned og = xb_add(&bar[XB_TOP], 1u);
            const unsigned tg = og / nx;
            if (og + 1u == (tg + 1u) * nx) xb_add(&bar[XB_TOPGEN], 1u);
            else XB_SPIN(xb_ld(&bar[XB_TOPGEN]) == tg, bar);
            __builtin_amdgcn_fence(__ATOMIC_ACQUIRE, "agent");
            xb_add(&bar[XB_XGEN(b.x)], 1u);
            asm volatile("s_waitcnt vmcnt(0)" ::: "memory");
        } else {
            XB_SPIN(xb_ld(&bar[XB_XGEN(b.x)]) == gen, bar);
            __builtin_amdgcn_fence(__ATOMIC_ACQUIRE, "agent");
            asm volatile("s_waitcnt vmcnt(0)" ::: "memory");
        }
    }
    __syncthreads();
}


constexpr int T = 16384, D = 1024, SEQ = 4096, NBATCH = 4, FF = 2816;
constexpr int NTHREADS = 512, LDS_BYTES = 131072 + 16;
constexpr float EPS = 1e-6f;
constexpr size_t MiB = 1024 * 1024;
constexpr size_t OFF_MOD = 0, OFF_LB = 512 * 1024, OFF_CWB = 576 * 1024, OFF_BAR = 768 * 1024, OFF_CSC = 1 * MiB, OFF_CSS = 3 * MiB, OFF_WT = 8 * MiB, OFF_HB = 40 * MiB, OFF_R1 = 72 * MiB, OFF_R2 = 248 * MiB, OFF_XB = 336 * MiB, WS_END = 368 * MiB;
constexpr size_t WT_MIXA = 0, WT_MIXB = 4194304, WT_FUP = 6291456, WT_FDN = 12058624, WT_MQKV = 524288;
enum { OP_PRO = 0, OP_NORM1, OP_G1, OP_GSP, OP_GOUT, OP_M1, OP_M2, OP_M3, OP_ATT, OP_MOUT, OP_H1, OP_HA, OP_HSCAN, OP_HC, OP_HOUT, OP_NORM2, OP_FUP, OP_FCONV, OP_FDN, OP_FINAL };

struct Params;
struct Params {
    const float* in[28];
    float* out;
    unsigned char* ws;
    int ph_lo, ph_hi;
    unsigned char op[48];
    unsigned char lay[48];
};

typedef const __attribute__((address_space(4))) Params* KP;
__device__ __forceinline__ unsigned pk2(float lo, float hi) { return pg8::cvt_pk_bf16(lo, hi); }
__device__ __forceinline__ float bflo(unsigned u) { return __uint_as_float(u << 16); }
__device__ __forceinline__ float bfhi(unsigned u) { return __uint_as_float(u & 0xffff0000u); }
__device__ __forceinline__ float shx(float v, int m, int lane) { return __int_as_float(__builtin_amdgcn_ds_bpermute((lane ^ m) << 2, __float_as_int(v))); }
template <int CTRL> __device__ __forceinline__ float dppf(float v) { return __int_as_float(__builtin_amdgcn_update_dpp(0, __float_as_int(v), CTRL, 0xf, 0xf, false)); }
__device__ __forceinline__ float rowsum4(float t) {
    const unsigned u = __float_as_uint(t);
    const auto r = __builtin_amdgcn_permlane16_swap(u, u, false, false);
    const float a = __uint_as_float(r[0]) + __uint_as_float(r[1]);
    const unsigned v = __float_as_uint(a);
    const auto q = __builtin_amdgcn_permlane32_swap(v, v, false, false);
    return __uint_as_float(q[0]) + __uint_as_float(q[1]);
}
__device__ __forceinline__ float wave_sum(float v, int lane) {
    (void)lane;
    v += dppf<0xB1>(v); v += dppf<0x4E>(v); v += dppf<0x141>(v); v += dppf<0x140>(v);
    return rowsum4(v);
}
__device__ __forceinline__ float rowmax4(float t) {
    const unsigned u = __float_as_uint(t);
    const auto r = __builtin_amdgcn_permlane16_swap(u, u, false, false);
    const float a = fmaxf(__uint_as_float(r[0]), __uint_as_float(r[1]));
    const unsigned v = __float_as_uint(a);
    const auto q = __builtin_amdgcn_permlane32_swap(v, v, false, false);
    return fmaxf(__uint_as_float(q[0]), __uint_as_float(q[1]));
}
__device__ __forceinline__ float fast_sigmoid(float x) { return __builtin_amdgcn_rcpf(1.f + __builtin_amdgcn_exp2f(-1.4426950408889634f * x)); }
__device__ __forceinline__ float gelu_tanh(float x) { const float u = 0.7978845608028654f * (x + 0.044715f * x * x * x); return x * fast_sigmoid(2.f * u); }
__device__ __forceinline__ f32x4 sigmoid4(const f32x4 x) { const f32x4 ex = x * -1.4426950408889634f; f32x4 s;
#pragma unroll
    for (int e = 0; e < 4; ++e) s[e] = __builtin_amdgcn_rcpf(1.f + __builtin_amdgcn_exp2f(ex[e]));
    return s; }
__device__ __forceinline__ f32x4 gelu_tanh4(const f32x4 x) { const f32x4 t = x * x * 0.044715f + 1.f; const f32x4 ex = x * t * (-2.f * 0.7978845608028654f * 1.4426950408889634f); f32x4 s;
#pragma unroll
    for (int e = 0; e < 4; ++e) s[e] = __builtin_amdgcn_rcpf(1.f + __builtin_amdgcn_exp2f(ex[e]));
    return x * s; }
__device__ __forceinline__ bf16x8 mk8(unsigned a, unsigned b, unsigned c, unsigned d) { u32x4 v = {a, b, c, d}; return __builtin_bit_cast(bf16x8, v); }
__device__ __forceinline__ f32x4 zero4() { float z = 0.f; asm volatile("" : "+v"(z)); return (f32x4){z, z, z, z}; }
#define MFMA16(X, Y, C) __builtin_amdgcn_mfma_f32_16x16x32_bf16((X), (Y), (C), 0, 0, 0)

template <int ACT> struct EpiBf16 {
    static constexpr bool PERM = true, AFTER_DRAIN = false, PERMA = false;
    bf16_t* O; int ldc;
    __device__ __forceinline__ void operator()(const f32x4 (&acc)[2][2][4][2], const Unit& u, int wr, int wc, int fr, int fq) const {
        const int row0 = u.pm * 256 + wr * 64 + fr, col0 = u.pn * 256 + wc * 32 + 8 * fq;
#pragma unroll
        for (int ai = 0; ai < 2; ++ai)
#pragma unroll
            for (int m = 0; m < 4; ++m) { bf16_t* rowp = O + (size_t)(row0 + ai * 128 + m * 16) * ldc + col0;
#pragma unroll
                for (int bj = 0; bj < 2; ++bj) { f32x4 v0 = acc[ai][bj][m][0], v1 = acc[ai][bj][m][1];
                    if (ACT == 1) { v0 = gelu_tanh4(v0); v1 = gelu_tanh4(v1); }
                    u32x4 o = {pk2(v0[0], v0[1]), pk2(v0[2], v0[3]), pk2(v1[0], v1[1]), pk2(v1[2], v1[3])};
                    *(u32x4*)(rowp + bj * 128) = o; } }
    }
};
struct EpiF32 {
    static constexpr bool PERM = false, AFTER_DRAIN = false, PERMA = false;
    float* C; int ldc;
    __device__ __forceinline__ void operator()(const f32x4 (&acc)[2][2][4][2], const Unit& u, int wr, int wc, int fr, int fq) const {
        const int row0 = u.pm * 256 + wr * 64 + fr, col0 = u.pn * 256 + wc * 32 + 4 * fq;
#pragma unroll
        for (int ai = 0; ai < 2; ++ai)
#pragma unroll
            for (int m = 0; m < 4; ++m) { float* rowp = C + (size_t)(row0 + ai * 128 + m * 16) * ldc + col0;
#pragma unroll
                for (int bj = 0; bj < 2; ++bj)
#pragma unroll
                    for (int n = 0; n < 2; ++n) *(f32x4*)(rowp + bj * 128 + n * 16) = acc[ai][bj][m][n]; }
    }
};
struct EpiRes {
    static constexpr bool PERM = true, AFTER_DRAIN = false, PERMA = false;
    const bf16_t* Xs; bf16_t* Xd; const float* gate;
    __device__ __forceinline__ void operator()(const f32x4 (&acc)[2][2][4][2], const Unit& u, int wr, int wc, int fr, int fq) const {
        const int row0 = u.pm * 256 + wr * 64 + fr, col0 = u.pn * 256 + wc * 32 + 8 * fq;
        const float* gp = gate + (unsigned)((u.pm >> 4) * 6144 + col0);
        f32x4 gv[2][2];
#pragma unroll
        for (int bj = 0; bj < 2; ++bj)
#pragma unroll
            for (int n = 0; n < 2; ++n) { gv[bj][n] = *(const f32x4*)(gp + bj * 128 + n * 4); gv[bj][n] = gv[bj][n] + 1.f; }
#pragma unroll
        for (int ai = 0; ai < 2; ++ai)
#pragma unroll
            for (int m = 0; m < 4; ++m) { const unsigned ro = (unsigned)((row0 + ai * 128 + m * 16) * 1024 + col0);
#pragma unroll
                for (int bj = 0; bj < 2; ++bj) { const u32x4 xs = *(const u32x4*)(Xs + ro + bj * 128);
                    const f32x4 a0 = acc[ai][bj][m][0] * gv[bj][0], a1 = acc[ai][bj][m][1] * gv[bj][1];
                    u32x4 o = {pk2(bflo(xs[0]) + a0[0], bfhi(xs[0]) + a0[1]), pk2(bflo(xs[1]) + a0[2], bfhi(xs[1]) + a0[3]), pk2(bflo(xs[2]) + a1[0], bfhi(xs[2]) + a1[1]), pk2(bflo(xs[3]) + a1[2], bfhi(xs[3]) + a1[3])};
                    *(u32x4*)(Xd + ro + bj * 128) = o; } }
    }
};
struct EpiQ {
    static constexpr bool PERM = false, AFTER_DRAIN = false, PERMA = false;
    bf16_t* QF; const float* CSC; const float* CSS; float qs;
    __device__ __forceinline__ void operator()(const f32x4 (&acc)[2][2][4][2], const Unit& u, int wr, int wc, int fr, int fq) const {
        const int b = u.pm >> 4;
#pragma unroll
        for (int bj = 0; bj < 2; ++bj) {
            const int c0 = u.pn * 256 + bj * 128 + wc * 32;
            const int head = c0 / 192, off = c0 - head * 192;
            if (off < 128) {
#pragma unroll
                for (int ai = 0; ai < 2; ++ai)
#pragma unroll
                    for (int m = 0; m < 4; ++m) { const int r = u.pm * 256 + ai * 128 + wr * 64 + m * 16 + fr, s = r & 4095;
                        bf16_t* qp = QF + (unsigned)(((b * 8 + head) * 4096 + s) * 192 + off + 4 * fq);
#pragma unroll
                        for (int n = 0; n < 2; ++n) { const f32x4 v = acc[ai][bj][m][n] * qs; u32x2 o = {pk2(v[0], v[1]), pk2(v[2], v[3])}; *(u32x2*)(qp + 16 * n) = o; } __builtin_amdgcn_sched_barrier(0); }
            } else {
                const int jb = ((off - 128) >> 5) * 16 + 4 * fq;
#pragma unroll
                for (int ai = 0; ai < 2; ++ai)
#pragma unroll
                    for (int m = 0; m < 4; ++m) { const int r = u.pm * 256 + ai * 128 + wr * 64 + m * 16 + fr, s = r & 4095;
                        const f32x4 cs = *(const f32x4*)(CSC + (unsigned)(r * 32 + jb)), sn = *(const f32x4*)(CSS + (unsigned)(r * 32 + jb));
                        const f32x4 x1 = acc[ai][bj][m][0], x2 = acc[ai][bj][m][1];
                        const f32x4 r1 = (x1 * cs - x2 * sn) * qs, r2 = (x2 * cs + x1 * sn) * qs;
                        bf16_t* qp = QF + (unsigned)(((b * 8 + head) * 4096 + s) * 192 + 128 + jb);
                        u32x2 o1 = {pk2(r1[0], r1[1]), pk2(r1[2], r1[3])}, o2 = {pk2(r2[0], r2[1]), pk2(r2[2], r2[3])};
                        *(u32x2*)(qp) = o1; *(u32x2*)(qp + 32) = o2; __builtin_amdgcn_sched_barrier(0); }
            }
        }
    }
};
struct EpiKV {
    static constexpr bool PERM = false, AFTER_DRAIN = false, PERMA = false;
    bf16_t* KF; bf16_t* VT;
    __device__ __forceinline__ void operator()(const f32x4 (&acc)[2][2][4][2], const Unit& u, int wr, int wc, int fr, int fq) const {
        const int b = u.pm >> 4, head = u.pn;
#pragma unroll
        for (int bj = 0; bj < 2; ++bj) {
            const int off = wc * 32;
            if (bj == 0) {
#pragma unroll
                for (int ai = 0; ai < 2; ++ai)
#pragma unroll
                    for (int m = 0; m < 4; ++m) { const int r = u.pm * 256 + ai * 128 + wr * 64 + m * 16 + fr, s = r & 4095;
                        bf16_t* kp = KF + (unsigned)(((b * 8 + head) * 4096 + s) * 192 + off + 4 * fq);
#pragma unroll
                        for (int n = 0; n < 2; ++n) { const f32x4 v = acc[ai][bj][m][n]; u32x2 o = {pk2(v[0], v[1]), pk2(v[2], v[3])}; *(u32x2*)(kp + 16 * n) = o; } __builtin_amdgcn_sched_barrier(0); }
            } else {
#pragma unroll
                for (int ai = 0; ai < 2; ++ai)
#pragma unroll
                    for (int m = 0; m < 4; ++m) { const int r = u.pm * 256 + ai * 128 + wr * 64 + m * 16 + fr, s = r & 4095;
#pragma unroll
                        for (int n = 0; n < 2; ++n) { const f32x4 v = acc[ai][bj][m][n]; const int dv = off + 16 * n + 4 * fq;
                            bf16_t* vp = VT + (unsigned)(((b * 8 + head) * 128 + dv) * 4096 + s);
                            const unsigned p01 = pk2(v[0], v[1]), p23 = pk2(v[2], v[3]);
                            vp[0] = (bf16_t)(p01 & 0xffffu); vp[4096] = (bf16_t)(p01 >> 16); vp[8192] = (bf16_t)(p23 & 0xffffu); vp[12288] = (bf16_t)(p23 >> 16); } __builtin_amdgcn_sched_barrier(0); }
            }
        }
    }
};
struct EpiHg {
    static constexpr bool PERM = true, AFTER_DRAIN = false, PERMA = false;
    unsigned char* R1b; const float* LB;
    __device__ __forceinline__ void operator()(const f32x4 (&acc)[2][2][4][2], const Unit& u, int wr, int wc, int fr, int fq) const {
        const int region = u.pn >> 2, row0 = u.pm * 256 + wr * 64 + fr, cc0 = (u.pn & 3) * 256 + wc * 32 + 8 * fq;
        if (region == 1) {
#pragma unroll
            for (int bj = 0; bj < 2; ++bj) { const int cc = cc0 + bj * 128;
                const f32x4 l0 = *(const f32x4*)(LB + cc), l1 = *(const f32x4*)(LB + cc + 4);
#pragma unroll
                for (int ai = 0; ai < 2; ++ai)
#pragma unroll
                    for (int m = 0; m < 4; ++m) { float* fp = (float*)(R1b + 32 * MiB) + (unsigned)((row0 + ai * 128 + m * 16) * 1024 + cc);
                        f32x4 v0 = acc[ai][bj][m][0], v1 = acc[ai][bj][m][1];
                        v0 = l0 + (1.f - l0) * sigmoid4(v0); v1 = l1 + (1.f - l1) * sigmoid4(v1);
                        *(f32x4*)fp = v0; *(f32x4*)(fp + 4) = v1; __builtin_amdgcn_sched_barrier(0); } }
        } else {
            bf16_t* base = (bf16_t*)(R1b + (region == 0 ? (size_t)0 : (region == 2 ? 96 * MiB : 128 * MiB)));
#pragma unroll
            for (int ai = 0; ai < 2; ++ai)
#pragma unroll
                for (int m = 0; m < 4; ++m) { bf16_t* rowp = base + (unsigned)((row0 + ai * 128 + m * 16) * 1024 + cc0);
#pragma unroll
                    for (int bj = 0; bj < 2; ++bj) { f32x4 v0 = acc[ai][bj][m][0], v1 = acc[ai][bj][m][1];
                        if (region == 3) { v0 = v0 * sigmoid4(v0); v1 = v1 * sigmoid4(v1); }
                        u32x4 o = {pk2(v0[0], v0[1]), pk2(v0[2], v0[3]), pk2(v1[0], v1[1]), pk2(v1[2], v1[3])};
                        *(u32x4*)(rowp + bj * 128) = o; } }
        }
    }
};

struct EpiFFN {
    static constexpr bool PERM = true, AFTER_DRAIN = false, PERMA = true;
    bf16_t* ACT; const bf16_t* CWB;
    __device__ __forceinline__ static f32x4 shr1(const f32x4 v) { f32x4 r;
#pragma unroll
        for (int e = 0; e < 4; ++e) r[e] = __int_as_float(__builtin_amdgcn_update_dpp(0, __float_as_int(v[e]), 0x111, 0xf, 0xf, true));
        return r; }
    template <bool SPECIAL> __device__ __forceinline__ void group(const f32x4 (&acc)[2][2][4][2], int ai, int n, int tok0, int fr, int fcol,
            const f32x4 wg0, const f32x4 wg1, const f32x4 wg2, const f32x4 bg, const f32x4 wv0, const f32x4 wv1, const f32x4 wv2, const f32x4 bv) const {
        const f32x4 sg3 = shr1(acc[ai][0][3][n]), sg2 = shr1(acc[ai][0][2][n]), sv3 = shr1(acc[ai][1][3][n]), sv2 = shr1(acc[ai][1][2][n]);
#pragma unroll
        for (int m = 0; m < 4; ++m) {
            const f32x4 cg = acc[ai][0][m][n], cv = acc[ai][1][m][n];
            f32x4 p1g = m == 0 ? sg3 : acc[ai][0][m == 0 ? 0 : m - 1][n], p1v = m == 0 ? sv3 : acc[ai][1][m == 0 ? 0 : m - 1][n];
            f32x4 p2g = m == 0 ? sg2 : (m == 1 ? sg3 : acc[ai][0][m < 2 ? 0 : m - 2][n]), p2v = m == 0 ? sv2 : (m == 1 ? sv3 : acc[ai][1][m < 2 ? 0 : m - 2][n]);
            const int tok = tok0 + 4 * fr + m;
            if (SPECIAL) { const int sq = tok & 4095; const f32x4 z4 = {0.f, 0.f, 0.f, 0.f}; if (sq == 0) { p1g = z4; p1v = z4; } if (sq <= 1) { p2g = z4; p2v = z4; } }
            const f32x4 yg = bg + wg0 * p2g + wg1 * p1g + wg2 * cg, yv = bv + wv0 * p2v + wv1 * p1v + wv2 * cv;
            const f32x4 ex = yg * -1.4426950408889634f; f32x4 sg;
#pragma unroll
            for (int e = 0; e < 4; ++e) sg[e] = __builtin_amdgcn_rcpf(1.f + __builtin_amdgcn_exp2f(ex[e]));
            const f32x4 o = yg * sg * yv;
            if ((m >= 2 || fr > 0) && tok < T) { u32x2 ov = {pk2(o[0], o[1]), pk2(o[2], o[3])}; *(u32x2*)(ACT + (unsigned)(tok * 2816 + fcol)) = ov; }
        }
    }
    __device__ __forceinline__ void operator()(const f32x4 (&acc)[2][2][4][2], const Unit& u, int wr, int wc, int fr, int fq) const {
        const int fcol0 = u.pn * 128 + wc * 32 + 8 * fq;
        u32x4 tw[8];
#pragma unroll
        for (int i = 0; i < 8; ++i) tw[i] = *(const u32x4*)(CWB + (unsigned)((fcol0 + i) * 8));
#pragma unroll
        for (int n = 0; n < 2; ++n) {
            const int fcol = fcol0 + 4 * n;
            f32x4 wg0, wg1, wg2, bg, wv0, wv1, wv2, bv;
#pragma unroll
            for (int e = 0; e < 4; ++e) { const u32x4 t = tw[4 * n + e]; wg0[e] = bflo(t[0]); wg1[e] = bfhi(t[0]); wg2[e] = bflo(t[1]); bg[e] = bfhi(t[1]); wv0[e] = bflo(t[2]); wv1[e] = bfhi(t[2]); wv2[e] = bflo(t[3]); bv[e] = bfhi(t[3]); }
#pragma unroll
            for (int ai = 0; ai < 2; ++ai) {
                const int b0 = u.pm * 248 + (2 * ai + wr) * 62;
                const bool special = (((b0 + 61) >> 12) << 12) >= b0 - 1;
                if (special) group<true>(acc, ai, n, b0 - 2, fr, fcol, wg0, wg1, wg2, bg, wv0, wv1, wv2, bv);
                else group<false>(acc, ai, n, b0 - 2, fr, fcol, wg0, wg1, wg2, bg, wv0, wv1, wv2, bv);
                __builtin_amdgcn_sched_barrier(0);
            }
        }
    }
};

template <class Epi> __device__ __forceinline__ void run_gemm(const int s_wv, ldsp lds, const bf16_t* A, const bf16_t* Bt, int M, int N, int K, const Epi& E) {
    pg8::Gemm g{A, Bt, M, N, K}; pg8::StaticOrder S; S.init(M, N, (int)gridDim.x, obid());
    pg8::gemm_phase<Epi, pg8::StaticOrder, false>(s_wv, lds, g, S, E, nullptr);
}

__device__ __forceinline__ int rope_rowmap(int n) { const int head = n / 192, d = n - head * 192; if (d < 128) return n; const int r = d - 128, half = r >> 5, j = r & 31; return head * 192 + 128 + (j >> 4) * 32 + half * 16 + (j & 15); }
__device__ __forceinline__ int ffn_rowmap(int n) { const int half = n >= 2816 ? 1 : 0, f = n - half * 2816, t = f >> 7, i = f & 127; return t * 256 + half * 128 + i; }
struct TrJob { const float* src; int srcN, K, N; bf16_t* dst; int dstK, koff, rowoff, pmode; };
__device__ __forceinline__ void run_trjob(const int s_wv, const TrJob J, ldsp lds, const int wg0 = 0, const int nwg = 0) {
    const int tid = otid(), lane = tid & 63, wave = tid >> 6;
    LAS float* sm = (LAS float*)(lds + wave * 8448);
    const int nkt = J.K / 32, nnt = J.N / 64, ntile = nkt * nnt;
    const int nw_ = nwg ? nwg : (int)gridDim.x;
    for (int t = (obid() - wg0) * 8 + wave; t < ntile; t += nw_ * 8) { const int kt = t % nkt, nt = t / nkt;
        const float* sp = J.src + (size_t)(kt * 32) * J.srcN + nt * 64 + lane;
        float v[32];
#pragma unroll
        for (int k = 0; k < 32; ++k) v[k] = sp[(size_t)k * J.srcN];
#pragma unroll
        for (int k = 0; k < 32; ++k) sm[lane * 33 + k] = v[k];
        const int kk = (lane & 15) * 2, nr = lane >> 4;
#pragma unroll
        for (int j = 0; j < 16; ++j) { const int n = nr + 4 * j, sn = nt * 64 + n, drow = J.rowoff + (J.pmode == 1 ? rope_rowmap(sn) : (J.pmode == 2 ? ffn_rowmap(sn) : sn));
            *(unsigned*)(J.dst + (size_t)drow * J.dstK + J.koff + kt * 32 + kk) = pk2(sm[n * 33 + kk], sm[n * 33 + kk + 1]); }
    }
}
__device__ __forceinline__ void zero_fill(bf16_t* dst, int rows, int cols8, int stride, int gtid, int gthreads) {
    const int n = rows * cols8; unsigned zz = 0u; asm volatile("" : "+v"(zz)); const u32x4 z = {zz, zz, zz, zz};
    for (int i = gtid; i < n; i += gthreads) { const int r = i / cols8, c = i - r * cols8; *(u32x4*)(dst + (size_t)r * stride + c * 8) = z; }
}
__device__ __forceinline__ void prep_ffn(const int s_wv, KP p, int layer, ldsp lds, const int wg0, const int nwg) {
    bf16_t* WT = (bf16_t*)(p->ws + OFF_WT);
    const TrJob J0{p->in[23] + (size_t)layer * 1024 * 5632, 5632, 1024, 5632, WT + WT_FUP, 1024, 0, 0, 2};
    const TrJob J1{p->in[26] + (size_t)layer * 2816 * 1024, 1024, 2816, 1024, WT + WT_FDN, 2816, 0, 0, 0};
    run_trjob(s_wv, J0, lds, wg0, nwg); run_trjob(s_wv, J1, lds, wg0, nwg);
}
__device__ __forceinline__ void prep_layer(const int s_wv, KP p, int layer, ldsp lds, const bool with_ffn = true) {
    bf16_t* WT = (bf16_t*)(p->ws + OFF_WT); const int kind = layer % 3, j = layer / 3;
    const int gtid = obid() * NTHREADS + otid(), gthreads = gridDim.x * NTHREADS;
    if (with_ffn) { const TrJob J0{p->in[23] + (size_t)layer * 1024 * 5632, 5632, 1024, 5632, WT + WT_FUP, 1024, 0, 0, 2};
      const TrJob J1{p->in[26] + (size_t)layer * 2816 * 1024, 1024, 2816, 1024, WT + WT_FDN, 2816, 0, 0, 0};
      run_trjob(s_wv, J0, lds); run_trjob(s_wv, J1, lds); }
    if (kind == 0) {
        const TrJob J0{p->in[7] + (size_t)j * 1024 * 4096, 4096, 1024, 4096, WT + WT_MIXA, 1024, 0, 0, 0};
        const TrJob J1{p->in[12] + (size_t)j * 2048 * 1024, 1024, 2048, 1024, WT + WT_MIXB, 2048, 0, 0, 0};
        run_trjob(s_wv, J0, lds); run_trjob(s_wv, J1, lds);
    } else if (kind == 1) {
        const TrJob J0{p->in[13], 448, 1024, 448, WT + WT_MIXA, 1024, 0, 0, 0};
        const TrJob J1{p->in[16], 1536, 256, 1536, WT + WT_MQKV, 256, 0, 0, 1};
        const TrJob J2{p->in[17], 2048, 128, 2048, WT + WT_MQKV + 393216, 256, 0, 0, 0};
        const TrJob J3{p->in[18], 1024, 1024, 1024, WT + WT_MIXB, 1024, 0, 0, 0};
        run_trjob(s_wv, J0, lds); run_trjob(s_wv, J1, lds); run_trjob(s_wv, J2, lds); run_trjob(s_wv, J3, lds);
        zero_fill(WT + WT_MIXA + (size_t)448 * 1024, 64, 128, 1024, gtid, gthreads);
        zero_fill(WT + WT_MQKV + 393216 + 128, 2048, 16, 256, gtid, gthreads);
    } else {
        const TrJob J0{p->in[20], 4096, 1024, 4096, WT + WT_MIXA, 1024, 0, 0, 0};
        const TrJob J1{p->in[22], 1024, 1024, 1024, WT + WT_MIXB, 1024, 0, 0, 0};
        run_trjob(s_wv, J0, lds); run_trjob(s_wv, J1, lds);
    }
}
__device__ __forceinline__ void phase_prologue(const int s_wv, KP p, ldsp lds) {
    const int tid = otid();
    float* MOD = (float*)(p->ws + OFF_MOD);
    LAS float* cact = (LAS float*)lds;
    LAS float* red = (LAS float*)(lds + 16384);
    for (int i = tid; i < 4096; i += NTHREADS) { const float c = p->in[1][i]; cact[i] = c * fast_sigmoid(c); }
    __syncthreads();
    const int l16 = tid & 15, kg = tid >> 4;
    for (int item = obid(); item < 4 * 96; item += gridDim.x) {
        const int layer = item / 96, n0 = (item % 96) * 64;
        const float* w = p->in[3] + (size_t)layer * 1024 * 6144 + n0 + 4 * l16;
        f32x4 a[4] = {{0.f, 0.f, 0.f, 0.f}, {0.f, 0.f, 0.f, 0.f}, {0.f, 0.f, 0.f, 0.f}, {0.f, 0.f, 0.f, 0.f}};
#pragma unroll 8
        for (int kk = 0; kk < 32; ++kk) { const int k = kg * 32 + kk; const f32x4 wv = *(const f32x4*)(w + (size_t)k * 6144);
#pragma unroll
            for (int b = 0; b < 4; ++b) a[b] = a[b] + wv * cact[b * 1024 + k]; }
#pragma unroll
        for (int b = 0; b < 4; ++b) *(LAS f32x4*)(red + (kg * 4 + b) * 64 + 4 * l16) = a[b];
        __syncthreads();
        if (tid < 256) { const int b = tid >> 6, col = tid & 63; float s = 0.f;
#pragma unroll 8
            for (int g = 0; g < 32; ++g) s += red[(g * 4 + b) * 64 + col];
            MOD[(size_t)(layer * 4 + b) * 6144 + n0 + col] = s + p->in[4][(size_t)layer * 6144 + n0 + col]; }
        __syncthreads();
    }
    const int gtid = obid() * NTHREADS + tid, gthreads = gridDim.x * NTHREADS;
    float* CSC = (float*)(p->ws + OFF_CSC); float* CSS = (float*)(p->ws + OFF_CSS);
    const int* pos = (const int*)p->in[2];
    for (int i = gtid; i < T * 32; i += gthreads) { const int t = i >> 5, jj = i & 31;
        const float invf = exp2f(-(float)jj * (13.287712379549449f / 32.f));
        const float ang = (float)pos[t] * invf;
        double rev = (double)ang * 0.15915494309189535; rev -= floor(rev);
        const float rf = (float)rev;
        CSC[i] = __builtin_amdgcn_cosf(rf); CSS[i] = __builtin_amdgcn_sinf(rf); }
    float* LB = (float*)(p->ws + OFF_LB);
    for (int i = gtid; i < 1024; i += gthreads) { const float l0 = p->in[19][i], l1 = p->in[19][1024 + i], l2 = p->in[19][2048 + i], l3 = p->in[19][3072 + i];
        const float mx = fmaxf(fmaxf(l0, l1), fmaxf(l2, l3)); const float e0 = __expf(l0 - mx), e1 = __expf(l1 - mx), e2 = __expf(l2 - mx), e3 = __expf(l3 - mx);
        LB[i] = (e1 + e2) / (e0 + e1 + e2 + e3); }
    prep_layer(s_wv, p, 0, lds);
}
__device__ __forceinline__ void up8(const u32x4 v, float (&o)[8]) { o[0] = bflo(v[0]); o[1] = bfhi(v[0]); o[2] = bflo(v[1]); o[3] = bfhi(v[1]); o[4] = bflo(v[2]); o[5] = bfhi(v[2]); o[6] = bflo(v[3]); o[7] = bfhi(v[3]); }
template <bool SRC32> __device__ __forceinline__ void phase_norm(const int s_wv, const float* X32, bf16_t* XB, const float* g, const float* shift, const float* scale, bf16_t* dst) {
    const int lane = otid() & 63, wave = otid() >> 6;
    for (int rb = obid() * 8 + wave; rb < T / 8; rb += gridDim.x * 8) {
        const int r0 = rb * 8, b = r0 >> 12;
        float G[16], SH[16];
#pragma unroll
        for (int j = 0; j < 2; ++j)
#pragma unroll
            for (int h = 0; h < 2; ++h) { const int c = 8 * lane + 512 * j + 4 * h; const f32x4 gg = *(const f32x4*)(g + c), sc = *(const f32x4*)(scale + (size_t)b * 6144 + c), sh = *(const f32x4*)(shift + (size_t)b * 6144 + c);
#pragma unroll
                for (int e = 0; e < 4; ++e) { G[j * 8 + h * 4 + e] = gg[e] * (sc[e] + 1.f); SH[j * 8 + h * 4 + e] = sh[e]; } }
        for (int r = r0; r < r0 + 8; ++r) {
            float x[16]; float ss = 0.f;
#pragma unroll
            for (int j = 0; j < 2; ++j) { const unsigned off = (unsigned)(r * 1024 + 8 * lane + 512 * j);
                if (SRC32) { const f32x4 a = *(const f32x4*)(X32 + off), c = *(const f32x4*)(X32 + off + 4);
#pragma unroll
                    for (int e = 0; e < 4; ++e) { x[j * 8 + e] = a[e]; x[j * 8 + 4 + e] = c[e]; }
                    u32x4 xo = {pk2(a[0], a[1]), pk2(a[2], a[3]), pk2(c[0], c[1]), pk2(c[2], c[3])}; *(u32x4*)(XB + off) = xo;
                } else { float t[8]; up8(*(const u32x4*)(XB + off), t);
#pragma unroll
                    for (int e = 0; e < 8; ++e) x[j * 8 + e] = t[e]; } }
#pragma unroll
            for (int e = 0; e < 16; ++e) ss += x[e] * x[e];
            ss = wave_sum(ss, lane); const float rstd = rsqrtf(ss * (1.f / 1024.f) + EPS);
#pragma unroll
            for (int j = 0; j < 2; ++j) { float h[8];
#pragma unroll
                for (int e = 0; e < 8; ++e) h[e] = x[j * 8 + e] * rstd * G[j * 8 + e] + SH[j * 8 + e];
                u32x4 o = {pk2(h[0], h[1]), pk2(h[2], h[3]), pk2(h[4], h[5]), pk2(h[6], h[7])}; *(u32x4*)(dst + (unsigned)(r * 1024 + 8 * lane + 512 * j)) = o; }
        }
    }
}
__device__ __forceinline__ void phase_final(const int s_wv, const bf16_t* XB, float* out, const float* g) {
    const int lane = otid() & 63, wave = otid() >> 6;
    for (int r = obid() * 8 + wave; r < T; r += gridDim.x * 8) {
        float x[16]; float ss = 0.f;
#pragma unroll
        for (int j = 0; j < 2; ++j) { float t[8]; up8(*(const u32x4*)(XB + (unsigned)(r * 1024 + 8 * lane + 512 * j)), t);
#pragma unroll
            for (int e = 0; e < 8; ++e) { x[j * 8 + e] = t[e]; ss += t[e] * t[e]; } }
        ss = wave_sum(ss, lane); const float rstd = rsqrtf(ss * (1.f / 1024.f) + EPS);
#pragma unroll
        for (int j = 0; j < 2; ++j)
#pragma unroll
            for (int h = 0; h < 2; ++h) { const int c = 8 * lane + 512 * j + 4 * h; const f32x4 gg = *(const f32x4*)(g + c);
                f32x4 o = {x[j * 8 + h * 4] * rstd * gg[0], x[j * 8 + h * 4 + 1] * rstd * gg[1], x[j * 8 + h * 4 + 2] * rstd * gg[2], x[j * 8 + h * 4 + 3] * rstd * gg[3]};
                *(f32x4*)(out + (size_t)r * 1024 + c) = o; }
    }
}
__device__ __forceinline__ void phase_ffix(const int s_wv, const bf16_t* SIDE, bf16_t* ACT, const float* cw, const float* cb) {
    const int gtid = obid() * NTHREADS + otid(), gthreads = gridDim.x * NTHREADS;
    for (int q = gtid; q < 256 * 2 * 352; q += gthreads) {
        const int cgp = q % 352, gi = q / 352, i = gi & 1, g = gi >> 1, f0 = cgp * 8;
        const bool first = (g & 63) == 0;
        const bf16_t* own = SIDE + (size_t)((g * 4 + 2 + i) * 2) * 2816 + f0;
        const bf16_t* p1 = i == 0 ? SIDE + (size_t)(((g - 1) * 4 + 1) * 2) * 2816 + f0 : SIDE + (size_t)((g * 4 + 2) * 2) * 2816 + f0;
        const bf16_t* p2 = i == 0 ? SIDE + (size_t)(((g - 1) * 4 + 0) * 2) * 2816 + f0 : SIDE + (size_t)(((g - 1) * 4 + 1) * 2) * 2816 + f0;
        float gc[8], vc[8], g1[8], v1[8], g2[8], v2[8];
        up8(*(const u32x4*)own, gc); up8(*(const u32x4*)(own + 2816), vc);
        if (i == 1 || !first) { up8(*(const u32x4*)p1, g1); up8(*(const u32x4*)(p1 + 2816), v1); } else {
#pragma unroll
            for (int e = 0; e < 8; ++e) { g1[e] = 0.f; v1[e] = 0.f; } }
        if (!first) { up8(*(const u32x4*)p2, g2); up8(*(const u32x4*)(p2 + 2816), v2); } else {
#pragma unroll
            for (int e = 0; e < 8; ++e) { g2[e] = 0.f; v2[e] = 0.f; } }
        float o[8];
#pragma unroll
        for (int e = 0; e < 8; ++e) { const int f = f0 + e;
            const float yg = cb[f] + cw[f] * g2[e] + cw[5632 + f] * g1[e] + cw[11264 + f] * gc[e], yv = cb[2816 + f] + cw[2816 + f] * v2[e] + cw[5632 + 2816 + f] * v1[e] + cw[11264 + 2816 + f] * vc[e];
            o[e] = yg * fast_sigmoid(yg) * yv; }
        u32x4 ov = {pk2(o[0], o[1]), pk2(o[2], o[3]), pk2(o[4], o[5]), pk2(o[6], o[7])};
        *(u32x4*)(ACT + (size_t)(g * 64 + i) * 2816 + f0) = ov;
    }
}

__device__ __forceinline__ void phase_gsp(const int s_wv, KP p, int j, ldsp lds) {
    const bf16_t* Z = (const bf16_t*)(p->ws + OFF_R1); bf16_t* Y = (bf16_t*)(p->ws + OFF_R2);
    const float* ws_w = p->in[10] + (size_t)j * 8 * 128 * 128; const float* bs = p->in[11] + (size_t)j * 8 * 128;
    const float* lng = p->in[8] + (size_t)j * 2048; const float* lnb = p->in[9] + (size_t)j * 2048;
    const int tid = otid(), lane = tid & 63, wave = tid >> 6, l15 = lane & 15, g4 = lane >> 4;
    ldsp As = lds, Bs = lds + 34816; LAS float* mu = (LAS float*)(lds + 104448); LAS float* rs = mu + 128;
    for (int unit = obid(); unit < 256; unit += gridDim.x) {
        const int gh = unit & 1, chunk = unit >> 1, t0 = chunk * 128;
        for (int rr = 0; rr < 16; ++rr) { const int r = wave * 16 + rr; const bf16_t* zp = Z + (size_t)(t0 + r) * 4096 + 2048 + lane * 32; float s = 0.f, s2 = 0.f;
#pragma unroll
            for (int i = 0; i < 4; ++i) { float v[8]; up8(*(const u32x4*)(zp + 8 * i), v);
#pragma unroll
                for (int e = 0; e < 8; ++e) { s += v[e]; s2 += v[e] * v[e]; } }
            s = wave_sum(s, lane); s2 = wave_sum(s2, lane);
            if (lane == 0) { const float m = s * (1.f / 2048.f); float var = s2 * (1.f / 2048.f) - m * m; var = fmaxf(var, 0.f); mu[r] = m; rs[r] = rsqrtf(var + EPS); } }
        __syncthreads();
        for (int gi = 0; gi < 4; ++gi) {
            const int g = gh * 4 + gi;
#pragma unroll 2
            for (int i = 0; i < 8; ++i) { const int idx = tid + 512 * i, t = idx >> 5, s4 = (idx & 31) * 4; f32x4 w = *(const f32x4*)(ws_w + (size_t)g * 16384 + t * 128 + s4);
#pragma unroll
                for (int e = 0; e < 4; ++e) w[e] = (s4 + e <= t) ? w[e] : 0.f;
                u32x2 o = {pk2(w[0], w[1]), pk2(w[2], w[3])}; *(LAS u32x2*)(As + t * 272 + s4 * 2) = o; }
#pragma unroll 2
            for (int i = 0; i < 4; ++i) { const int idx = tid + 512 * i, s = (idx >> 5) * 2, c8 = idx & 31; float v0[8], v1[8];
                up8(*(const u32x4*)(Z + (size_t)(t0 + s) * 4096 + 2048 + g * 256 + c8 * 8), v0); up8(*(const u32x4*)(Z + (size_t)(t0 + s + 1) * 4096 + 2048 + g * 256 + c8 * 8), v1);
                const float m0 = mu[s], r0 = rs[s], m1 = mu[s + 1], r1 = rs[s + 1]; const f32x4 ga = *(const f32x4*)(lng + g * 256 + c8 * 8), gb = *(const f32x4*)(lng + g * 256 + c8 * 8 + 4), ba = *(const f32x4*)(lnb + g * 256 + c8 * 8), bb = *(const f32x4*)(lnb + g * 256 + c8 * 8 + 4);
                const int boff = (((s >> 3) ^ (c8 & 15)) << 4) + (s & 7) * 2;
#pragma unroll
                for (int e = 0; e < 8; ++e) { const float gg = e < 4 ? ga[e] : gb[e - 4], bbv = e < 4 ? ba[e] : bb[e - 4];
                    *(LAS unsigned*)(Bs + (c8 * 8 + e) * 272 + boff) = pk2((v0[e] - m0) * r0 * gg + bbv, (v1[e] - m1) * r1 * gg + bbv); } }
            __syncthreads();
            f32x4 acc[8][2];
#pragma unroll
            for (int tt = 0; tt < 8; ++tt) { acc[tt][0] = zero4(); acc[tt][1] = zero4(); }
#pragma unroll
            for (int tt = 0; tt < 8; ++tt)
#pragma unroll
                for (int ks = 0; ks <= tt / 2; ++ks) { const bf16x8 yf = *(const LAS bf16x8*)(As + (16 * tt + l15) * 272 + (32 * ks + 8 * g4) * 2);
#pragma unroll
                    for (int ct = 0; ct < 2; ++ct) { const int c = 32 * wave + 16 * ct + l15; const bf16x8 xf = *(const LAS bf16x8*)(Bs + c * 272 + (((4 * ks + g4) ^ ((c >> 3) & 15)) << 4));
                        acc[tt][ct] = MFMA16(xf, yf, acc[tt][ct]); } }
#pragma unroll
            for (int tt = 0; tt < 8; ++tt) { const int t = 16 * tt + l15; const float bias = bs[g * 128 + t];
#pragma unroll
                for (int ct = 0; ct < 2; ++ct) { const int c = g * 256 + 32 * wave + 16 * ct + 4 * g4; const u32x2 uu = *(const u32x2*)(Z + (size_t)(t0 + t) * 4096 + c);
                    const f32x4 a = acc[tt][ct]; u32x2 o = {pk2(bflo(uu[0]) * (a[0] + bias), bfhi(uu[0]) * (a[1] + bias)), pk2(bflo(uu[1]) * (a[2] + bias), bfhi(uu[1]) * (a[3] + bias))};
                    *(u32x2*)(Y + (size_t)(t0 + t) * 2048 + c) = o; } }
            __syncthreads();
        }
    }
}

__device__ __forceinline__ void phase_m2(const int s_wv, KP p) {
    const float* A1 = (const float*)(p->ws + OFF_R1); bf16_t* CQN = (bf16_t*)(p->ws + OFF_R1 + 32 * MiB); bf16_t* CKVN = (bf16_t*)(p->ws + OFF_R1 + 40 * MiB); bf16_t* KF = (bf16_t*)(p->ws + OFF_R1 + 96 * MiB);
    const float* CSC = (const float*)(p->ws + OFF_CSC); const float* CSS = (const float*)(p->ws + OFF_CSS);
    const int lane = otid() & 63, wave = otid() >> 6;
    const f32x4 qg = *(const f32x4*)(p->in[14] + 4 * lane); const f32x4 kg = *(const f32x4*)(p->in[15] + 4 * (lane & 31));
    for (int r = obid() * 8 + wave; r < T; r += gridDim.x * 8) {
        const float* a = A1 + (size_t)r * 512;
        const f32x4 cq = *(const f32x4*)(a + 4 * lane); float ss = wave_sum(cq[0] * cq[0] + cq[1] * cq[1] + cq[2] * cq[2] + cq[3] * cq[3], lane);
        const float rq = rsqrtf(ss * (1.f / 256.f) + EPS);
        { const f32x4 h = cq * rq * qg; u32x2 o = {pk2(h[0], h[1]), pk2(h[2], h[3])}; *(u32x2*)(CQN + (size_t)r * 256 + 4 * lane) = o; }
        const f32x4 ck = *(const f32x4*)(a + 256 + 4 * (lane & 31)); float s2 = lane < 32 ? (ck[0] * ck[0] + ck[1] * ck[1] + ck[2] * ck[2] + ck[3] * ck[3]) : 0.f; s2 = wave_sum(s2, lane);
        const float rk = rsqrtf(s2 * (1.f / 128.f) + EPS);
        { const f32x4 h = ck * rk * kg; u32x2 o = {pk2(h[0], h[1]), pk2(h[2], h[3])}; if (lane >= 32) { o[0] = 0u; o[1] = 0u; } *(u32x2*)(CKVN + (size_t)r * 256 + 4 * lane) = o; }
        if (lane < 32) {
            const float x1 = a[384 + lane], x2 = a[416 + lane], c = CSC[(size_t)r * 32 + lane], s = CSS[(size_t)r * 32 + lane];
            const unsigned pr = pk2(x1 * c - x2 * s, x2 * c + x1 * s); const int b = r >> 12, sq = r & 4095;
#pragma unroll
            for (int h8 = 0; h8 < 8; ++h8) { bf16_t* kp = KF + ((size_t)((b * 8 + h8) * 4096 + sq)) * 192 + 128 + lane; kp[0] = (bf16_t)(pr & 0xffffu); kp[32] = (bf16_t)(pr >> 16); } }
    }
}

__device__ __forceinline__ void phase_attn(const int s_wv, KP p, ldsp lds) {
    const bf16_t* QF = (const bf16_t*)(p->ws + OFF_R1 + 48 * MiB); const bf16_t* KF = (const bf16_t*)(p->ws + OFF_R1 + 96 * MiB); const bf16_t* VT = (const bf16_t*)(p->ws + OFF_R1 + 144 * MiB);
    bf16_t* O = (bf16_t*)(p->ws + OFF_R2);
    const int tid = otid(), lane = tid & 63, wave = __builtin_amdgcn_readfirstlane(tid >> 6), l15 = lane & 15, g4 = lane >> 4;
    const int G = gridDim.x, bx = obid(), vcu = (G % 8 == 0) ? (bx % 8) * (G / 8) + bx / 8 : bx;
    constexpr int KB = 25600, VB = 18432, BUF = KB + VB;
    for (int unit = vcu; unit < 256; unit += G) {
        const int bh = unit >> 3, pr = unit & 7, b = bh >> 3, h = bh & 7;
        const unsigned char* kbase = (const unsigned char*)(KF + (size_t)bh * 4096 * 192);
        const unsigned char* vbase = (const unsigned char*)(VT + (size_t)bh * 128 * 4096);
        for (int half = 0; half < 2; ++half) {
            const int qb = half == 0 ? 15 - pr : pr, ntile = 4 * qb + 4;
            const int qrow0 = qb * 256 + 32 * wave;
            bf16x8 Qf[2][6];
#pragma unroll
            for (int qt = 0; qt < 2; ++qt)
#pragma unroll
                for (int ks = 0; ks < 6; ++ks) Qf[qt][ks] = *(const bf16x8*)((const unsigned char*)(QF + (size_t)(bh * 4096 + qrow0) * 192) + (unsigned)(((16 * qt + l15) * 192 + 32 * ks + 8 * g4) * 2));
            f32x4 Oa[2][8]; float mrun[2] = {-1e30f, -1e30f}, lsum[2] = {0.f, 0.f};
#pragma unroll
            for (int qt = 0; qt < 2; ++qt)
#pragma unroll
                for (int d = 0; d < 8; ++d) Oa[qt][d] = zero4();
#define ATT_DMA(j, bufi) do { ldsp kb_ = lds + (bufi) * BUF; \
                for (int c = wave; c < 25; c += 8) { const int q_ = c * 64 + lane, row = q_ / 25, c16 = min(q_ - row * 25, 23); \
                    __builtin_amdgcn_global_load_lds((const unsigned*)(kbase + (size_t)(j) * 24576 + (unsigned)(row * 384 + c16 * 16)), (LAS unsigned*)(kb_ + c * 1024), 16, 0, 0); } \
                for (int c = wave; c < 18; c += 8) { const int q_ = c * 64 + lane, dv = q_ / 9, k8 = min(q_ - dv * 9, 7); \
                    __builtin_amdgcn_global_load_lds((const unsigned*)(vbase + (size_t)(j) * 128 + (unsigned)(dv * 8192 + k8 * 16)), (LAS unsigned*)(kb_ + KB + c * 1024), 16, 0, 0); } } while (0)
            ATT_DMA(0, 0); asm volatile("s_waitcnt vmcnt(0)" ::: "memory"); __syncthreads();
#pragma unroll 1
            for (int j = 0; j < ntile; ++j) {
                if (j + 1 < ntile) ATT_DMA(j + 1, (j + 1) & 1);
                ;
                const int jj = j - 4 * qb; const bool diag = jj >= 0; const bool active = !(diag && 64 * jj > 32 * wave + 31);
                ldsp Kb = lds + (j & 1) * BUF; ldsp Vb = Kb + KB;
#pragma unroll
                for (int hs = 0; hs < 2; ++hs) {
                    if (active) {
                        f32x4 S[2][2];
#pragma unroll
                        for (int qt = 0; qt < 2; ++qt) { S[qt][0] = zero4(); S[qt][1] = zero4(); }
                        {
#define ATT_KLD(i) (*(const LAS bf16x8*)(Kb + (16 * (2 * hs + ((i) & 1)) + l15) * 400 + (32 * ((i) >> 1) + 8 * g4) * 2))
                            bf16x8 kq[3]; kq[0] = ATT_KLD(0); kq[1] = ATT_KLD(1);
#pragma unroll
                            for (int i = 0; i < 12; ++i) { if (i + 2 < 12) kq[(i + 2) % 3] = ATT_KLD(i + 2);
                                __builtin_amdgcn_sched_barrier(0);
                                S[0][i & 1] = MFMA16(kq[i % 3], Qf[0][i >> 1], S[0][i & 1]); S[1][i & 1] = MFMA16(kq[i % 3], Qf[1][i >> 1], S[1][i & 1]);
                                __builtin_amdgcn_sched_barrier(0); }
#undef ATT_KLD
                        }
                        bf16x8 Pf[2];
#pragma unroll
                        for (int qt = 0; qt < 2; ++qt) {
                            if (diag) { int dq = 32 * wave + 16 * qt + l15 - 4 * g4 - 64 * jj; asm volatile("" : "+v"(dq));
#pragma unroll
                                for (int sb = 0; sb < 2; ++sb)
#pragma unroll
                                    for (int e = 0; e < 4; ++e) { if (32 * hs + 16 * sb + e > dq) S[qt][sb][e] = -1e30f; } }
                            float tm = -1e30f;
#pragma unroll
                            for (int sb = 0; sb < 2; ++sb)
#pragma unroll
                                for (int e = 0; e < 4; ++e) tm = fmaxf(tm, S[qt][sb][e]);
                            tm = rowmax4(tm);
                            if (__builtin_amdgcn_ballot_w64(tm > mrun[qt]) != 0ull) {
                                const float mn = fmaxf(mrun[qt], tm), sc = __builtin_amdgcn_exp2f(mrun[qt] - mn); mrun[qt] = mn; lsum[qt] *= sc;
#pragma unroll
                                for (int d = 0; d < 8; ++d) Oa[qt][d] = Oa[qt][d] * sc; }
                            const float mn = mrun[qt];
                            float ps = 0.f;
#pragma unroll
                            for (int sb = 0; sb < 2; ++sb)
#pragma unroll
                                for (int e = 0; e < 4; ++e) { const float pe = __builtin_amdgcn_exp2f(S[qt][sb][e] - mn); S[qt][sb][e] = pe; ps += pe; }
                            lsum[qt] += ps;
                            Pf[qt] = mk8(pk2(S[qt][0][0], S[qt][0][1]), pk2(S[qt][0][2], S[qt][0][3]), pk2(S[qt][1][0], S[qt][1][1]), pk2(S[qt][1][2], S[qt][1][3]));
                        }
                        {
#define ATT_VLD(d) __builtin_shufflevector(*(const LAS bf16x4*)(Vb + (16 * (d) + l15) * 144 + (32 * hs + 4 * g4) * 2), *(const LAS bf16x4*)(Vb + (16 * (d) + l15) * 144 + (32 * hs + 16 + 4 * g4) * 2), 0, 1, 2, 3, 4, 5, 6, 7)
                            bf16x8 vq[3]; vq[0] = ATT_VLD(0); vq[1] = ATT_VLD(1);
#pragma unroll
                            for (int d = 0; d < 8; ++d) { if (d + 2 < 8) vq[(d + 2) % 3] = ATT_VLD(d + 2);
                                __builtin_amdgcn_sched_barrier(0);
                                Oa[0][d] = MFMA16(vq[d % 3], Pf[0], Oa[0][d]); Oa[1][d] = MFMA16(vq[d % 3], Pf[1], Oa[1][d]);
                                __builtin_amdgcn_sched_barrier(0); }
#undef ATT_VLD
                        }
                    }
                }
                asm volatile("s_waitcnt vmcnt(0)" ::: "memory"); __syncthreads();
            }
#pragma unroll
            for (int qt = 0; qt < 2; ++qt) { float ls = lsum[qt]; ls = rowsum4(ls); const float inv = 1.f / ls;
                bf16_t* op = (bf16_t*)((unsigned char*)(O + (size_t)(b * 4096 + qrow0) * 1024 + h * 128) + (unsigned)(((16 * qt + l15) * 1024 + 4 * g4) * 2));
#pragma unroll
                for (int d = 0; d < 8; ++d) { const f32x4 v = Oa[qt][d] * inv; u32x2 o = {pk2(v[0], v[1]), pk2(v[2], v[3])}; *(u32x2*)(op + 16 * d) = o; } }
        }
    }
#undef ATT_DMA
}

template <bool TOF32> __device__ __forceinline__ void hg_load_f_v(const float* HF, const bf16_t* HV, int t0, int col0, LAS float* BC, LAS float* K1f, ldsp K1b, ldsp VTl, int tid) {
#pragma unroll
    for (int i = 0; i < 4; ++i) { const int idx = tid + 512 * i, s = idx >> 5, k4 = (idx & 31) * 4; const f32x4 f = *(const f32x4*)(HF + (size_t)(t0 + s) * 1024 + col0 + k4);
#pragma unroll
        for (int e = 0; e < 4; ++e) BC[s * 129 + k4 + e] = __logf(f[e]);
        if (TOF32) {
#pragma unroll
            for (int e = 0; e < 4; ++e) K1f[s * 129 + k4 + e] = 1.f - f[e];
        } else { u32x2 o = {pk2(1.f - f[0], 1.f - f[1]), pk2(1.f - f[2], 1.f - f[3])}; *(LAS u32x2*)(K1b + s * 272 + k4 * 2) = o; } }
#pragma unroll
    for (int i = 0; i < 2; ++i) { const int idx = tid + 512 * i, s = idx >> 4, v8 = idx & 15; const u32x4 vv = *(const u32x4*)(HV + (size_t)(t0 + s) * 1024 + col0 + v8 * 8);
#pragma unroll
        for (int e = 0; e < 4; ++e) { *(LAS bf16_t*)(VTl + (v8 * 8 + 2 * e) * 144 + s * 2) = (bf16_t)(vv[e] & 0xffffu); *(LAS bf16_t*)(VTl + (v8 * 8 + 2 * e + 1) * 144 + s * 2) = (bf16_t)(vv[e] >> 16); } }
}
__device__ __forceinline__ void phase_ha(const int s_wv, KP p, ldsp lds) {
    const float* HF = (const float*)(p->ws + OFF_R1 + 32 * MiB); const bf16_t* HV = (const bf16_t*)(p->ws + OFF_R1 + 96 * MiB);
    bf16_t* LCT = (bf16_t*)(p->ws + OFF_R2); float* DEC = (float*)(p->ws + OFF_R2 + 64 * MiB);
    const int tid = otid(), lane = tid & 63, wave = tid >> 6, l15 = lane & 15, g4 = lane >> 4;
    LAS float* BC = (LAS float*)lds; LAS float* K1 = (LAS float*)(lds + 33024); ldsp KT = lds + 66048; ldsp VTl = lds + 84480;
    for (int u = obid(); u < 2048; u += gridDim.x) {
        const int bh = u >> 6, n = u & 63, b = bh >> 3, h = bh & 7, t0 = b * 4096 + n * 64, col0 = h * 128;
        hg_load_f_v<true>(HF, HV, t0, col0, BC, K1, VTl, VTl, tid);
        __syncthreads();
        if (tid < 128) { float run = 0.f;
#pragma unroll 8
            for (int s = 0; s < 64; ++s) { run += BC[s * 129 + tid]; BC[s * 129 + tid] = run; }
            DEC[(size_t)u * 128 + tid] = __expf(run); }
        __syncthreads();
        { const int sp = tid & 31, kk0 = tid >> 5;
#pragma unroll
          for (int it = 0; it < 8; ++it) { const int k = kk0 + 16 * it; const float bl = BC[63 * 129 + k];
              const float a0 = K1[(2 * sp) * 129 + k] * __expf(bl - BC[(2 * sp) * 129 + k]), a1 = K1[(2 * sp + 1) * 129 + k] * __expf(bl - BC[(2 * sp + 1) * 129 + k]);
              *(LAS unsigned*)(KT + k * 144 + sp * 4) = pk2(a0, a1); } }
        __syncthreads();
        f32x4 acc[8];
#pragma unroll
        for (int vt = 0; vt < 8; ++vt) acc[vt] = zero4();
#pragma unroll
        for (int ks = 0; ks < 2; ++ks) { const bf16x8 xf = *(const LAS bf16x8*)(KT + (16 * wave + l15) * 144 + (32 * ks + 8 * g4) * 2);
#pragma unroll
            for (int vt = 0; vt < 8; ++vt) { const bf16x8 yf = *(const LAS bf16x8*)(VTl + (16 * vt + l15) * 144 + (32 * ks + 8 * g4) * 2); acc[vt] = MFMA16(xf, yf, acc[vt]); } }
#pragma unroll
        for (int vt = 0; vt < 8; ++vt) { u32x2 o = {pk2(acc[vt][0], acc[vt][1]), pk2(acc[vt][2], acc[vt][3])}; *(u32x2*)(LCT + ((size_t)u * 128 + 16 * vt + l15) * 128 + 16 * wave + 4 * g4) = o; }
        __syncthreads();
    }
}
__device__ __forceinline__ void phase_hscan(const int s_wv, KP p) {
    bf16_t* LCT = (bf16_t*)(p->ws + OFF_R2); const float* DEC = (const float*)(p->ws + OFF_R2 + 64 * MiB);
    const int gtid = obid() * NTHREADS + otid(), gthreads = gridDim.x * NTHREADS;
    for (int id = gtid; id < 32 * 128 * 32; id += gthreads) {
        const int k4 = id & 31, v = (id >> 5) & 127, bh = id >> 12;
        f32x4 st = zero4();
#pragma unroll 4
        for (int n = 0; n < 64; ++n) { const int u = bh * 64 + n; bf16_t* ptr = LCT + ((size_t)u * 128 + v) * 128 + 4 * k4;
            const u32x2 t = *(const u32x2*)ptr; const f32x4 dec = *(const f32x4*)(DEC + (size_t)u * 128 + 4 * k4);
            u32x2 o = {pk2(st[0], st[1]), pk2(st[2], st[3])}; *(u32x2*)ptr = o;
            st[0] = dec[0] * st[0] + bflo(t[0]); st[1] = dec[1] * st[1] + bfhi(t[0]); st[2] = dec[2] * st[2] + bflo(t[1]); st[3] = dec[3] * st[3] + bfhi(t[1]); }
    }
}
__device__ __forceinline__ void phase_hc(const int s_wv, KP p, ldsp lds) {
    const bf16_t* HQ = (const bf16_t*)(p->ws + OFF_R1); const float* HF = (const float*)(p->ws + OFF_R1 + 32 * MiB); const bf16_t* HV = (const bf16_t*)(p->ws + OFF_R1 + 96 * MiB); const bf16_t* HG = (const bf16_t*)(p->ws + OFF_R1 + 128 * MiB);
    const bf16_t* SST = (const bf16_t*)(p->ws + OFF_R2); bf16_t* O = (bf16_t*)(p->ws + OFF_HB); const float* ng = p->in[21];
    const int tid = otid(), lane = tid & 63, wave = tid >> 6, l15 = lane & 15, g4 = lane >> 4;
    LAS float* BC = (LAS float*)lds; ldsp QT = lds + 33024; ldsp KTl = lds + 50432; ldsp QH = lds + 67840; ldsp VTl = lds + 85248; ldsp AT = lds + 103680; LAS float* SSQ = (LAS float*)(lds + 112896);
    for (int u = obid(); u < 2048; u += gridDim.x) {
        const int bh = u >> 6, n = u & 63, b = bh >> 3, h = bh & 7, t0 = b * 4096 + n * 64, col0 = h * 128;
        hg_load_f_v<false>(HF, HV, t0, col0, BC, BC, KTl, VTl, tid);
        u32x4 qraw[2];
#pragma unroll
        for (int i = 0; i < 2; ++i) { const int idx = tid + 512 * i, s = idx >> 4, k8 = idx & 15; qraw[i] = *(const u32x4*)(HQ + (size_t)(t0 + s) * 1024 + col0 + k8 * 8); }
        __syncthreads();
        if (tid < 128) { float run = 0.f;
#pragma unroll 8
            for (int s = 0; s < 64; ++s) { run += BC[s * 129 + tid]; BC[s * 129 + tid] = run; } }
        __syncthreads();
#pragma unroll
        for (int i = 0; i < 2; ++i) { const int idx = tid + 512 * i, s = idx >> 4, k8 = idx & 15; float q[8], kk[8], qt[8], qh[8]; up8(qraw[i], q); up8(*(const LAS u32x4*)(KTl + s * 272 + k8 * 16), kk);
#pragma unroll
            for (int e = 0; e < 8; ++e) { const int k = k8 * 8 + e; const float bc = BC[s * 129 + k], bm = BC[31 * 129 + k]; qt[e] = q[e] * __expf(bc - bm); qh[e] = q[e] * __expf(bc); kk[e] = kk[e] * __expf(bm - bc); }
            u32x4 o1 = {pk2(qt[0], qt[1]), pk2(qt[2], qt[3]), pk2(qt[4], qt[5]), pk2(qt[6], qt[7])}, o2 = {pk2(qh[0], qh[1]), pk2(qh[2], qh[3]), pk2(qh[4], qh[5]), pk2(qh[6], qh[7])}, o3 = {pk2(kk[0], kk[1]), pk2(kk[2], kk[3]), pk2(kk[4], kk[5]), pk2(kk[6], kk[7])};
            *(LAS u32x4*)(QT + s * 272 + k8 * 16) = o1; *(LAS u32x4*)(QH + s * 272 + k8 * 16) = o2; *(LAS u32x4*)(KTl + s * 272 + k8 * 16) = o3; }
        __syncthreads();
        { const int st = wave & 3;
#pragma unroll
          for (int ti = 0; ti < 2; ++ti) { const int tt = 2 * (wave >> 2) + ti; f32x4 a = zero4();
              if (st <= tt) {
#pragma unroll
                  for (int ks = 0; ks < 4; ++ks) { const bf16x8 xf = *(const LAS bf16x8*)(KTl + (16 * st + l15) * 272 + (32 * ks + 8 * g4) * 2), yf = *(const LAS bf16x8*)(QT + (16 * tt + l15) * 272 + (32 * ks + 8 * g4) * 2); a = MFMA16(xf, yf, a); }
                  const int t = 16 * tt + l15;
#pragma unroll
                  for (int e = 0; e < 4; ++e) { const int s = 16 * st + 4 * g4 + e; if (s > t) a[e] = 0.f; } }
              u32x2 o = {pk2(a[0], a[1]), pk2(a[2], a[3])}; *(LAS u32x2*)(AT + (16 * tt + l15) * 144 + (16 * st + 4 * g4) * 2) = o; } }
        __syncthreads();
        { const int tt = wave >> 1, vh = wave & 1; f32x4 acc[4];
#pragma unroll
          for (int vi = 0; vi < 4; ++vi) acc[vi] = zero4();
#pragma unroll
          for (int ks = 0; ks < 2; ++ks) if (32 * ks <= 16 * tt + 15) { const bf16x8 yf = *(const LAS bf16x8*)(AT + (16 * tt + l15) * 144 + (32 * ks + 8 * g4) * 2);
#pragma unroll
              for (int vi = 0; vi < 4; ++vi) { const bf16x8 xf = *(const LAS bf16x8*)(VTl + (16 * (4 * vh + vi) + l15) * 144 + (32 * ks + 8 * g4) * 2); acc[vi] = MFMA16(xf, yf, acc[vi]); } }
#pragma unroll
          for (int ks = 0; ks < 4; ++ks) { const bf16x8 yf = *(const LAS bf16x8*)(QH + (16 * tt + l15) * 272 + (32 * ks + 8 * g4) * 2);
#pragma unroll
              for (int vi = 0; vi < 4; ++vi) { const bf16x8 xf = *(const bf16x8*)(SST + ((size_t)u * 128 + 16 * (4 * vh + vi) + l15) * 128 + 32 * ks + 8 * g4); acc[vi] = MFMA16(xf, yf, acc[vi]); } }
          float sq = 0.f;
#pragma unroll
          for (int vi = 0; vi < 4; ++vi)
#pragma unroll
              for (int e = 0; e < 4; ++e) sq += acc[vi][e] * acc[vi][e];
          sq = rowsum4(sq);
          if (g4 == 0) SSQ[(16 * tt + l15) * 2 + vh] = sq;
          __syncthreads();
          const int t = 16 * tt + l15; const float rstd = rsqrtf((SSQ[t * 2] + SSQ[t * 2 + 1]) * (1.f / 128.f) + EPS);
#pragma unroll
          for (int vi = 0; vi < 4; ++vi) { const int v = 16 * (4 * vh + vi) + 4 * g4; const f32x4 gn = *(const f32x4*)(ng + v); const u32x2 gg = *(const u32x2*)(HG + (size_t)(t0 + t) * 1024 + col0 + v);
              const f32x4 a = acc[vi] * rstd * gn; u32x2 o = {pk2(a[0] * bflo(gg[0]), a[1] * bfhi(gg[0])), pk2(a[2] * bflo(gg[1]), a[3] * bfhi(gg[1]))};
              *(u32x2*)(O + (size_t)(t0 + t) * 1024 + col0 + v) = o; } }
        __syncthreads();
    }
}

__global__ void __launch_bounds__(NTHREADS, 2) fwd_kernel(Params pk) {
    extern __shared__ __attribute__((aligned(16))) unsigned char smem[];
    ldsp lds = (ldsp)smem;
    const int ph_lo = pk.ph_lo, ph_hi = pk.ph_hi;
    const int s_wv = __builtin_amdgcn_readfirstlane((int)threadIdx.x >> 6);
    if (threadIdx.x < 4) ((LAS unsigned*)(lds + 131072))[threadIdx.x] = 0u;
    __syncthreads();
    XcdBarrier xbar = xcd_barrier_post((unsigned*)(pk.ws + OFF_BAR), (volatile LAS unsigned*)(lds + 131072), (int)threadIdx.x);
    for (int ph = ph_lo; ph < ph_hi; ++ph) {
        KP p = (KP)__builtin_amdgcn_kernarg_segment_ptr();
        asm volatile("" : "+s"(p));
        const int op = p->op[ph], layraw = p->lay[ph], layer = layraw & 3; const bool dummy = (layraw & 4) != 0;
        unsigned char* ws = p->ws; bf16_t* xdst = dummy ? (bf16_t*)(ws + OFF_R1) : (bf16_t*)(ws + OFF_XB);
        float* MOD = (float*)(ws + OFF_MOD); bf16_t* WT = (bf16_t*)(ws + OFF_WT); bf16_t* HB = (bf16_t*)(ws + OFF_HB); bf16_t* XB = (bf16_t*)(ws + OFF_XB);
        bf16_t* R1 = (bf16_t*)(ws + OFF_R1); bf16_t* R2 = (bf16_t*)(ws + OFF_R2);
        const float* modl = MOD + (size_t)layer * 4 * 6144;
        switch (op) {
        case OP_PRO: phase_prologue(s_wv, p, lds); break;
        case OP_NORM1: if (layer == 0) phase_norm<true>(s_wv, p->in[0], XB, p->in[5], modl + 0, modl + 1024, HB); else { phase_norm<false>(s_wv, p->in[0], XB, p->in[5] + layer * 1024, modl + 0, modl + 1024, HB); prep_layer(s_wv, p, layer, lds, layer != 1); } break;
        case OP_NORM2: { const float* cw = p->in[24] + (size_t)layer * 3 * 5632; const float* cb = p->in[25] + (size_t)layer * 5632; bf16_t* CWB = (bf16_t*)(ws + OFF_CWB);
                         for (int f = obid() * NTHREADS + otid(); f < 2816; f += gridDim.x * NTHREADS) { u32x4 o = {pk2(cw[f], cw[5632 + f]), pk2(cw[11264 + f], cb[f]), pk2(cw[2816 + f], cw[5632 + 2816 + f]), pk2(cw[11264 + 2816 + f], cb[2816 + f])}; *(u32x4*)(CWB + f * 8) = o; }
                         phase_norm<false>(s_wv, p->in[0], XB, p->in[6] + layer * 1024, modl + 3072, modl + 4096, HB); } break;
        case OP_G1: { EpiBf16<1> E{R1, 4096}; run_gemm(s_wv, lds, HB, WT + WT_MIXA, T, 4096, 1024, E); } break;
        case OP_GSP: phase_gsp(s_wv, p, layer / 3, lds); break;
        case OP_GOUT: { EpiRes E{XB, xdst, modl + 2048}; run_gemm(s_wv, lds, R2, WT + WT_MIXB, T, 1024, 2048, E); } break;
        case OP_M1: { EpiF32 E{(float*)R1, 512}; run_gemm(s_wv, lds, HB, WT + WT_MIXA, T, 512, 1024, E);
                      if ((int)gridDim.x >= 256) { if (obid() >= 128) prep_ffn(s_wv, p, layer, lds, 128, (int)gridDim.x - 128); } else prep_ffn(s_wv, p, layer, lds, 0, 0); } break;
        case OP_M2: phase_m2(s_wv, p); break;
        case OP_M3: { EpiQ EQ{(bf16_t*)(ws + OFF_R1 + 48 * MiB), (const float*)(ws + OFF_CSC), (const float*)(ws + OFF_CSS), 0.07216878364870322f * 1.4426950408889634f}; run_gemm(s_wv, lds, (const bf16_t*)(ws + OFF_R1 + 32 * MiB), WT + WT_MQKV, T, 1536, 256, EQ); EpiKV EK{(bf16_t*)(ws + OFF_R1 + 96 * MiB), (bf16_t*)(ws + OFF_R1 + 144 * MiB)}; run_gemm(s_wv, lds, (const bf16_t*)(ws + OFF_R1 + 40 * MiB), WT + WT_MQKV + 393216, T, 2048, 256, EK); } break;
        case OP_ATT: phase_attn(s_wv, p, lds); break;
        case OP_MOUT: { EpiRes E{XB, XB, modl + 2048}; run_gemm(s_wv, lds, R2, WT + WT_MIXB, T, 1024, 1024, E); } break;
        case OP_H1: { EpiHg E{ws + OFF_R1, (const float*)(ws + OFF_LB)}; run_gemm(s_wv, lds, HB, WT + WT_MIXA, T, 4096, 1024, E); } break;
        case OP_HA: phase_ha(s_wv, p, lds); break;
        case OP_HSCAN: phase_hscan(s_wv, p); break;
        case OP_HC: phase_hc(s_wv, p, lds); break;
        case OP_HOUT: { EpiRes E{XB, XB, modl + 2048}; run_gemm(s_wv, lds, HB, WT + WT_MIXB, T, 1024, 1024, E); } break;
        case OP_FUP: { EpiFFN E{R2, (const bf16_t*)(ws + OFF_CWB)}; run_gemm(s_wv, lds, HB - 2 * 1024, WT + WT_FUP, 67 * 256, 5632, 1024, E); } break;
        case OP_FDN: { EpiRes E{XB, xdst, modl + 5120}; run_gemm(s_wv, lds, R2, WT + WT_FDN, T, 1024, 2816, E); } break;
        case OP_FINAL: phase_final(s_wv, XB, p->out, p->in[27]); break;
        default: break;
        }
        if (ph + 1 < ph_hi) { if (ph == ph_lo) { __syncthreads(); cg::this_grid().sync(); } else xcd_barrier(xbar, otid()); }
    }
}

#ifndef MULTI_LAUNCH
#define MULTI_LAUNCH 0
#endif
extern "C" void kernel_launch(void* const* d_in, const int* in_sizes, int n_in, void* d_out, int out_size, void* d_ws, size_t ws_size, hipStream_t stream) {
    static int grid = 0;
    if (grid == 0) {
        int dev = 0, cus = 0, per_cu = 0;
        hipGetDevice(&dev); hipDeviceGetAttribute(&cus, hipDeviceAttributeMultiprocessorCount, dev);
        hipFuncSetAttribute((const void*)fwd_kernel, hipFuncAttributeMaxDynamicSharedMemorySize, LDS_BYTES);
        hipOccupancyMaxActiveBlocksPerMultiprocessor(&per_cu, (const void*)fwd_kernel, NTHREADS, LDS_BYTES);
        if (per_cu < 1) per_cu = 1;
        grid = cus * 1; (void)per_cu;
        if (ws_size < WS_END) fprintf(stderr, "kernel_launch: workspace too small: %zu < %zu\n", ws_size, (size_t)WS_END);
        (void)hipGetLastError();
    }
    (void)hipMemsetAsync((char*)d_ws + OFF_BAR, 0, XCD_BAR_WORDS * sizeof(unsigned), stream);
    Params p{};
    for (int i = 0; i < 28; ++i) p.in[i] = (const float*)d_in[i];
    p.out = (float*)d_out; p.ws = (unsigned char*)d_ws;
    int n = 0;
    auto add = [&](int op, int l) { p.op[n] = (unsigned char)op; p.lay[n] = (unsigned char)l; ++n; };
    add(OP_PRO, 0);
    for (int l = 0; l < 4; ++l) {
        add(OP_NORM1, l);
        if (l % 3 == 0) { add(OP_G1, l); add(OP_GSP, l); add(OP_GOUT, l); }
        else if (l % 3 == 1) { add(OP_M1, l); add(OP_M2, l); add(OP_M3, l); add(OP_ATT, l); add(OP_MOUT, l); }
        else { add(OP_H1, l); add(OP_HA, l); add(OP_HSCAN, l); add(OP_HC, l); add(OP_HOUT, l); }
        add(OP_NORM2, l); add(OP_FUP, l); add(OP_FDN, l);
    }
    add(OP_FINAL, 0);
#if MULTI_LAUNCH
    for (int i = 0; i < n; ++i) { p.ph_lo = i; p.ph_hi = i + 1; hipLaunchKernelGGL(fwd_kernel, dim3(grid), dim3(NTHREADS), LDS_BYTES, stream, p); }
#else
    p.ph_lo = 0; p.ph_hi = n;
    void* args[] = {&p};
    hipError_t e = hipLaunchCooperativeKernel((const void*)fwd_kernel, dim3(grid), dim3(NTHREADS), args, LDS_BYTES, stream);
    if (e != hipSuccess) fprintf(stderr, "cooperative launch failed: %s (grid %d)\n", hipGetErrorString(e), grid);
#endif
}
```

```cpp
#include <hip/hip_runtime.h>
#include <hip/hip_cooperative_groups.h>
#include <cstdio>
#include <cstdint>
namespace cg = cooperative_groups;
__device__ __forceinline__ int otid_w(int w) { int l; asm volatile("v_mbcnt_lo_u32_b32 %0, -1, 0\n\tv_mbcnt_hi_u32_b32 %0, -1, %0" : "=v"(l)); return (w << 6) | l; }
#define otid() otid_w(s_wv)
__device__ __forceinline__ int obid() { int t = blockIdx.x; asm volatile("" : "+s"(t)); return t; }
namespace pg8 {
#define PG8_LAS __attribute__((address_space(3)))
typedef unsigned short bf16_t;
typedef short bf16x8 __attribute__((ext_vector_type(8)));
typedef float f32x4 __attribute__((ext_vector_type(4)));
typedef unsigned u32x4 __attribute__((ext_vector_type(4)));
constexpr int BM = 256, BK = 64, HALF = 128, HTB = HALF * BK * 2  , STAGE_BYTES = 8 * HTB, NXCD = 8, WGM = 8;

__host__ __device__ __forceinline__ int lds_byte(int r, int c) { const int st = (r >> 4) * 2 + (c >> 5), rr = r & 15, cc = c & 31, ob = rr * 64 + cc * 2; return st * 1024 + (ob ^ (((ob >> 9) & 1) << 5)); }
__host__ __device__ __forceinline__ void stage_rc(int b, int& R, int& C) { const int st = b / 1024, sb = b % 1024, swz = sb ^ (((sb >> 9) & 1) << 5); R = (st >> 1) * 16 + swz / 64; C = (st & 1) * 32 + (swz % 64) / 2; }
__host__ __device__ __forceinline__ int perm32(int rho) { const int n = rho >> 4, i = rho & 15; return 8 * (i >> 2) + 4 * n + (i & 3); }

struct Unit { int pm, pn; };
struct Gemm { const bf16_t* A; const bf16_t* Bt; int M, N, K; };

struct StaticOrder {
    int nM, nN, nwg, G, c;
    __host__ __device__ void init(int M, int N, int G_, int c_) { nM = M / BM; nN = N / BM; nwg = nM * nN; G = G_; c = c_; }
    __host__ __device__ bool next(int i, Unit& u) const {
        const long L = (long)i * G + c; if (L >= nwg) return false;
        int wgid = (int)L; { const int q = nwg / NXCD, r = nwg % NXCD, xcd = wgid % NXCD, off = wgid / NXCD; wgid = (xcd < r ? xcd * (q + 1) : r * (q + 1) + (xcd - r) * q) + off; }
        const int nig = WGM * nN, gid = wgid / nig, fm = gid * WGM, gsz = (nM - fm) < WGM ? (nM - fm) : WGM;
        u.pm = fm + ((wgid % nig) % gsz); u.pn = (wgid % nig) / gsz; return true;
    }
    __device__ __forceinline__ void a_ready(const Unit&) const {}
    __device__ __forceinline__ void done(const Unit&) const {}
};
__device__ __forceinline__ unsigned cvt_pk_bf16(float lo, float hi) { unsigned r; asm volatile("v_cvt_pk_bf16_f32 %0, %1, %2" : "=v"(r) : "v"(lo), "v"(hi)); return r; }

template <class Epi, class Sched, bool STAMP = false>
__device__ __forceinline__ void gemm_phase(const int s_wv, PG8_LAS unsigned char* lds, const Gemm g, const Sched& S, const Epi& E, unsigned long long* stamps) {
    const int tid = otid(), wid = __builtin_amdgcn_readfirstlane(tid >> 6), lane = tid & 63, wr = wid >> 2, wc = wid & 3, fr = lane & 15, fq = lane >> 4;
    const int K = g.K, nt = K / BK;
    int ts_lo = 0, ts_hi = 0, nts = 0; const unsigned long long rt_entry = STAMP ? (unsigned long long)wall_clock64() : 0ull;
#define PG8_STAMP() do { if (STAMP && wid == 0 && nts < 64) { const unsigned long long _c = (unsigned long long)clock64(); \
        ts_lo = (lane == nts) ? (int)(unsigned)_c : ts_lo; ts_hi = (lane == nts) ? (int)(unsigned)(_c >> 32) : ts_hi; ++nts; } } while (0)
    PG8_STAMP();
    unsigned voffA[2], voffB[2];
#pragma unroll
    for (int i = 0; i < 2; ++i) { int R, C; stage_rc(tid * 16 + i * 8192, R, C); const int Rb = Epi::PERM ? ((R & ~31) + perm32(R & 31)) : R;
        const int Ra = Epi::PERMA ? (62 * (R >> 6) + 4 * (R & 15) + ((R >> 4) & 3)) : R; voffA[i] = (unsigned)(Ra * K + C) * 2u; voffB[i] = (unsigned)(Rb * K + C) * 2u; }
    const size_t kstep = (size_t)(BK * 2);
    const size_t hstep = (size_t)HALF * K * 2;
    const size_t tstep = 2 * hstep;
    const size_t hstepA = Epi::PERMA ? (size_t)124 * K * 2 : hstep, tstepA = Epi::PERMA ? (size_t)248 * K * 2 : tstep;
    const unsigned ldsw = (unsigned)wid * 1024u;
    const int aoff = lds_byte(wr * 64 + fr, fq * 8), boff = lds_byte(wc * 32 + fr, fq * 8);
#define PG8_SA(b, h) (((b) * 2 + (h)) * HTB)
#define PG8_SB(b, h) ((4 + (b) * 2 + (h)) * HTB)
#define PG8_STAGE(bufoff, gbase, voff) do { _Pragma("unroll") for (int _i = 0; _i < 2; ++_i) \
        __builtin_amdgcn_global_load_lds((const unsigned*)((const char*)(gbase) + (voff)[_i]), (PG8_LAS unsigned*)(lds + (bufoff) + ldsw + _i * 8192), 16, 0, 0); } while (0)
#define PG8_LDA(dst, b, h) do { _Pragma("unroll") for (int m = 0; m < 4; ++m) _Pragma("unroll") for (int k = 0; k < 2; ++k) dst[m][k] = *(const PG8_LAS bf16x8*)(lds + PG8_SA(b, h) + aoff + m * 2048 + k * 1024); } while (0)
#define PG8_LDB(dst, b, h) do { _Pragma("unroll") for (int n = 0; n < 2; ++n) _Pragma("unroll") for (int k = 0; k < 2; ++k) dst[n][k] = *(const PG8_LAS bf16x8*)(lds + PG8_SB(b, h) + boff + n * 2048 + k * 1024); } while (0)
#define PG8_MMA(ai, bj, At, Bt) do { __builtin_amdgcn_s_setprio(1); _Pragma("unroll") for (int m = 0; m < 4; ++m) _Pragma("unroll") for (int n = 0; n < 2; ++n) _Pragma("unroll") for (int k = 0; k < 2; ++k) \
        acc[ai][bj][m][n] = __builtin_amdgcn_mfma_f32_16x16x32_bf16(Bt[n][k], At[m][k], acc[ai][bj][m][n], 0, 0, 0); __builtin_amdgcn_s_setprio(0); } while (0)
#define PG8_WAIT_V(n) asm volatile("s_waitcnt vmcnt(" #n ")" ::: "memory")
#define PG8_WAIT_L(n) asm volatile("s_waitcnt lgkmcnt(" #n ")" ::: "memory")
#define PG8_BAR __builtin_amdgcn_s_barrier()
#define PG8_SCHED __builtin_amdgcn_sched_barrier(0)
    Unit cur, nxt; int ui = 0;
    if (!S.next(0, cur)) return;
    f32x4 acc[2][2][4][2];
#pragma unroll
    for (int a = 0; a < 2; ++a)
#pragma unroll
        for (int b = 0; b < 2; ++b)
#pragma unroll
            for (int m = 0; m < 4; ++m)
#pragma unroll
                for (int n = 0; n < 2; ++n) acc[a][b][m][n] = (f32x4){0.f, 0.f, 0.f, 0.f};
    bf16x8 At[4][2], B0[2][2], B1[2][2];
    const char* cA = (const char*)g.A + (size_t)cur.pm * tstepA; const char* cB = (const char*)g.Bt + (size_t)cur.pn * tstep;
    S.a_ready(cur);
    PG8_STAGE(PG8_SB(0, 0), cB, voffB); PG8_STAGE(PG8_SA(0, 0), cA, voffA); PG8_STAGE(PG8_SB(0, 1), cB + hstep, voffB); PG8_STAGE(PG8_SA(0, 1), cA + hstepA, voffA);
    if (wr == 1) PG8_BAR;
    PG8_WAIT_V(4); PG8_BAR;
    PG8_STAGE(PG8_SB(1, 0), cB + kstep, voffB); PG8_STAGE(PG8_SA(1, 0), cA + kstep, voffA); PG8_STAGE(PG8_SB(1, 1), cB + hstep + kstep, voffB);
    PG8_WAIT_V(6); PG8_BAR;
    PG8_STAMP();
    for (;;) {
        const bool has_next = S.next(ui + 1, nxt);
        const char* nA = has_next ? (const char*)g.A + (size_t)nxt.pm * tstepA : cA; const char* nB = has_next ? (const char*)g.Bt + (size_t)nxt.pn * tstep : cB;
        for (int t = 0; t < nt; t += 2) {
            const bool last = (t == nt - 2);
            const char* a1 = cA + (size_t)(t + 1) * kstep;
            const char* a2 = last ? nA : cA + (size_t)(t + 2) * kstep; const char* b2 = last ? nB : cB + (size_t)(t + 2) * kstep;
            const char* a3 = a2 + kstep; const char* b3 = b2 + kstep;
            if (last && has_next) S.a_ready(nxt);
            PG8_LDB(B0, 0, 0); PG8_SCHED; PG8_LDA(At, 0, 0); PG8_STAGE(PG8_SA(1, 1), a1 + hstepA, voffA);
            PG8_WAIT_L(8); PG8_BAR; PG8_WAIT_L(0); PG8_MMA(0, 0, At, B0); PG8_BAR; PG8_SCHED;
            PG8_LDB(B1, 0, 1); PG8_STAGE(PG8_SB(0, 0), b2, voffB);
            PG8_BAR; PG8_WAIT_L(0); PG8_MMA(0, 1, At, B1); PG8_BAR;
            PG8_LDA(At, 0, 1); PG8_STAGE(PG8_SA(0, 0), a2, voffA);
            PG8_BAR; PG8_WAIT_L(0); PG8_MMA(1, 0, At, B0); PG8_BAR; PG8_SCHED;
            PG8_STAGE(PG8_SB(0, 1), b2 + hstep, voffB);
            PG8_WAIT_V(6); PG8_BAR; PG8_MMA(1, 1, At, B1); PG8_BAR;
            PG8_LDB(B0, 1, 0); PG8_SCHED; PG8_LDA(At, 1, 0); PG8_STAGE(PG8_SA(0, 1), a2 + hstepA, voffA);
            PG8_WAIT_L(8); PG8_BAR; PG8_WAIT_L(0); PG8_MMA(0, 0, At, B0); PG8_BAR; PG8_SCHED;
            PG8_LDB(B1, 1, 1); PG8_STAGE(PG8_SB(1, 0), b3, voffB);
            PG8_BAR; PG8_WAIT_L(0); PG8_MMA(0, 1, At, B1); PG8_BAR;
            PG8_LDA(At, 1, 1); PG8_STAGE(PG8_SA(1, 0), a3, voffA);
            PG8_BAR; PG8_WAIT_L(0); PG8_MMA(1, 0, At, B0); PG8_BAR; PG8_SCHED;
            PG8_STAGE(PG8_SB(1, 1), b3 + hstep, voffB);
            PG8_WAIT_V(6); PG8_BAR; PG8_MMA(1, 1, At, B1); PG8_BAR;
        }
        PG8_STAMP();
        if constexpr (!Epi::AFTER_DRAIN) { E(acc, cur, wr, wc, fr, fq); S.done(cur); }
        PG8_STAMP();
        if (!has_next) break;
#pragma unroll
        for (int a = 0; a < 2; ++a)
#pragma unroll
            for (int b = 0; b < 2; ++b)
#pragma unroll
                for (int m = 0; m < 4; ++m)
#pragma unroll
                    for (int n = 0; n < 2; ++n) acc[a][b][m][n] = (f32x4){0.f, 0.f, 0.f, 0.f};
        cur = nxt; cA = nA; cB = nB; ++ui;
    }
    PG8_WAIT_V(0);
    if (wr == 0) PG8_BAR;
    PG8_BAR;
    if constexpr (Epi::AFTER_DRAIN) { E.fused(acc, cur, wr, wc, fr, fq, lds, wid, lane); S.done(cur); }
    PG8_STAMP();
    if (STAMP && wid == 0) { stamps[lane] = lane < nts ? (((unsigned long long)(unsigned)ts_hi << 32) | (unsigned)ts_lo) : 0ull;
        if (lane == 62) stamps[62] = rt_entry; if (lane == 63) stamps[63] = (unsigned long long)wall_clock64(); }
#undef PG8_STAMP
#undef PG8_SA
#undef PG8_SB
#undef PG8_STAGE
#undef PG8_LDA
#undef PG8_LDB
#undef PG8_MMA
#undef PG8_WAIT_V
#undef PG8_WAIT_L
#undef PG8_BAR
#undef PG8_SCHED
}
}

using pg8::bf16_t; using pg8::bf16x8; using pg8::f32x4; using pg8::u32x4; using pg8::Unit;
typedef unsigned u32x2 __attribute__((ext_vector_type(2)));
typedef short bf16x4 __attribute__((ext_vector_type(4)));
#define LAS __attribute__((address_space(3)))
typedef LAS unsigned char* ldsp;
#define XB_TMO      128
#define XB_XCNT(j)  (256  + 64 * (j))
#define XB_XSUB(j)  (1280 + 64 * (j))
#define XB_XGEN(j)  (2304 + 64 * (j))
#define XB_TOP      3328
#define XB_TOPGEN   3392
#define XCD_BAR_WORDS 3456
#define XB_SPIN_CAP (1u << 18)

__device__ __forceinline__ unsigned xb_ld(unsigned* p)              { return __hip_atomic_load(p, __ATOMIC_RELAXED, __HIP_MEMORY_SCOPE_AGENT); }
__device__ __forceinline__ unsigned xb_add(unsigned* p, unsigned v) { return __hip_atomic_fetch_add(p, v, __ATOMIC_RELAXED, __HIP_MEMORY_SCOPE_AGENT); }
__device__ __forceinline__ unsigned xb_xcc_id() { return (unsigned)__builtin_amdgcn_s_getreg((3 << 11) | 20) & 0xFu; }
#define XB_SPIN(cond, bar) do { unsigned _sp = 0; while (cond) { __builtin_amdgcn_s_sleep(1); \
    if ((++_sp & 255u) == 0u) { if (xb_ld(&(bar)[XB_TMO])) break; if (_sp > XB_SPIN_CAP) { atomicAdd(&(bar)[XB_TMO], 1u); break; } } } } while (0)

struct XcdBarrier {
    unsigned* bar; unsigned x;
    volatile LAS unsigned* st;
};

__device__ __forceinline__ XcdBarrier xcd_barrier_post(unsigned* bar, volatile LAS unsigned* st, const int tid0) {
    XcdBarrier b; b.bar = bar; b.x = xb_xcc_id(); b.st = st;
    if (tid0 == 0) (void)xb_add(&bar[XB_XCNT(b.x)], 1u);
    return b;
}
__device__ __forceinline__ void xcd_barrier_complete(unsigned* bar, unsigned x, unsigned& nloc, unsigned& nx) {
    const unsigned G = gridDim.x * gridDim.y * gridDim.z;
    unsigned sum, cnt, mine, sp = 0u;
    for (;;) {
        sum = 0u; cnt = 0u; mine = 0u;
#pragma unroll
        for (unsigned j = 0; j < 16; ++j) { const unsigned c = xb_ld(&bar[XB_XCNT(j)]); sum += c; cnt += (c > 0u) ? 1u : 0u; mine = (j == x) ? c : mine; }
        if (sum == G) break;
        __builtin_amdgcn_s_sleep(1);
        if ((++sp & 255u) == 0u) { if (xb_ld(&bar[XB_TMO])) break; if (sp > XB_SPIN_CAP) { atomicAdd(&bar[XB_TMO], 1u); break; } }
    }
    nloc = mine > 0u ? mine : 1u; nx = cnt > 0u ? cnt : 1u;
}

__device__ __forceinline__ void xcd_barrier(const XcdBarrier& b, const int tid0) {
    asm volatile("s_waitcnt vmcnt(0)" ::: "memory");
    __syncthreads();
    if (tid0 == 0) {
        unsigned* bar = b.bar;
        __builtin_amdgcn_s_waitcnt(0);
        unsigned nloc = b.st[0], nx = b.st[1];
        if (nloc == 0u) { xcd_barrier_complete(bar, b.x, nloc, nx); b.st[0] = nloc; b.st[1] = nx; }
        const unsigned old = xb_add(&bar[XB_XSUB(b.x)], 1u);
        const unsigned gen = old / nloc;
        if (old + 1u == (gen + 1u) * nloc) {
            __builtin_amdgcn_fence(__ATOMIC_RELEASE, "agent");
            asm volatile("s_waitcnt vmcnt(0)" ::: "memory");
            const unsigned og = xb_add(&bar[XB_TOP], 1u);
            const unsigned tg = og / nx;
            if (og + 1u == (tg + 1u) * nx) xb_add(&bar[XB_TOPGEN], 1u);
            else XB_SPIN(xb_ld(&bar[XB_TOPGEN]) == tg, bar);
            __builtin_amdgcn_fence(__ATOMIC_ACQUIRE, "agent");
            xb_add(&bar[XB_XGEN(b.x)], 1u);
            asm volatile("s_waitcnt vmcnt(0)" ::: "memory");
        } else {
            XB_SPIN(xb_ld(&bar[XB_XGEN(b.x)]) == gen, bar);
            __builtin_amdgcn_fence(__ATOMIC_ACQUIRE, "agent");
            asm volatile("s_waitcnt vmcnt(0)" ::: "memory");
        }
    }
    __syncthreads();
}


constexpr int T = 16384, D = 1024, SEQ = 4096, NBATCH = 4, FF = 2816;
constexpr int NTHREADS = 512, LDS_BYTES = 131072 + 16;
constexpr float EPS = 1e-6f;
constexpr size_t MiB = 1024 * 1024;
constexpr size_t OFF_MOD = 0, OFF_LB = 512 * 1024, OFF_CWB = 576 * 1024, OFF_BAR = 768 * 1024, OFF_CSC = 1 * MiB, OFF_CSS = 3 * MiB, OFF_WT = 8 * MiB, OFF_HB = 40 * MiB, OFF_R1 = 72 * MiB, OFF_R2 = 248 * MiB, OFF_XB = 336 * MiB, WS_END = 368 * MiB;
constexpr size_t WT_MIXA = 0, WT_MIXB = 4194304, WT_FUP = 6291456, WT_FDN = 12058624, WT_MQKV = 524288;
enum { OP_PRO = 0, OP_NORM1, OP_G1, OP_GSP, OP_GOUT, OP_M1, OP_M2, OP_M3, OP_ATT, OP_MOUT, OP_H1, OP_HA, OP_HSCAN, OP_HC, OP_HOUT, OP_NORM2, OP_FUP, OP_FCONV, OP_FDN, OP_FINAL };

struct Params;
struct Params {
    const float* in[28];
    float* out;
    unsigned char* ws;
    int ph_lo, ph_hi;
    unsigned char op[48];
    unsigned char lay[48];
};

typedef const __attribute__((address_space(4))) Params* KP;
__device__ __forceinline__ unsigned pk2(float lo, float hi) { return pg8::cvt_pk_bf16(lo, hi); }
__device__ __forceinline__ float bflo(unsigned u) { return __uint_as_float(u << 16); }
__device__ __forceinline__ float bfhi(unsigned u) { return __uint_as_float(u & 0xffff0000u); }
__device__ __forceinline__ float shx(float v, int m, int lane) { return __int_as_float(__builtin_amdgcn_ds_bpermute((lane ^ m) << 2, __float_as_int(v))); }
template <int CTRL> __device__ __forceinline__ float dppf(float v) { return __int_as_float(__builtin_amdgcn_update_dpp(0, __float_as_int(v), CTRL, 0xf, 0xf, false)); }
__device__ __forceinline__ float rowsum4(float t) {
    const unsigned u = __float_as_uint(t);
    const auto r = __builtin_amdgcn_permlane16_swap(u, u, false, false);
    const float a = __uint_as_float(r[0]) + __uint_as_float(r[1]);
    const unsigned v = __float_as_uint(a);
    const auto q = __builtin_amdgcn_permlane32_swap(v, v, false, false);
    return __uint_as_float(q[0]) + __uint_as_float(q[1]);
}
__device__ __forceinline__ float wave_sum(float v, int lane) {
    (void)lane;
    v += dppf<0xB1>(v); v += dppf<0x4E>(v); v += dppf<0x141>(v); v += dppf<0x140>(v);
    return rowsum4(v);
}
__device__ __forceinline__ float rowmax4(float t) {
    const unsigned u = __float_as_uint(t);
    const auto r = __builtin_amdgcn_permlane16_swap(u, u, false, false);
    const float a = fmaxf(__uint_as_float(r[0]), __uint_as_float(r[1]));
    const unsigned v = __float_as_uint(a);
    const auto q = __builtin_amdgcn_permlane32_swap(v, v, false, false);
    return fmaxf(__uint_as_float(q[0]), __uint_as_float(q[1]));
}
__device__ __forceinline__ float fast_sigmoid(float x) { return __builtin_amdgcn_rcpf(1.f + __builtin_amdgcn_exp2f(-1.4426950408889634f * x)); }
__device__ __forceinline__ float gelu_tanh(float x) { const float u = 0.7978845608028654f * (x + 0.044715f * x * x * x); return x * fast_sigmoid(2.f * u); }
__device__ __forceinline__ f32x4 sigmoid4(const f32x4 x) { const f32x4 ex = x * -1.4426950408889634f; f32x4 s;
#pragma unroll
    for (int e = 0; e < 4; ++e) s[e] = __builtin_amdgcn_rcpf(1.f + __builtin_amdgcn_exp2f(ex[e]));
    return s; }
__device__ __forceinline__ f32x4 gelu_tanh4(const f32x4 x) { const f32x4 t = x * x * 0.044715f + 1.f; const f32x4 ex = x * t * (-2.f * 0.7978845608028654f * 1.4426950408889634f); f32x4 s;
#pragma unroll
    for (int e = 0; e < 4; ++e) s[e] = __builtin_amdgcn_rcpf(1.f + __builtin_amdgcn_exp2f(ex[e]));
    return x * s; }
__device__ __forceinline__ bf16x8 mk8(unsigned a, unsigned b, unsigned c, unsigned d) { u32x4 v = {a, b, c, d}; return __builtin_bit_cast(bf16x8, v); }
__device__ __forceinline__ f32x4 zero4() { float z = 0.f; asm volatile("" : "+v"(z)); return (f32x4){z, z, z, z}; }
#define MFMA16(X, Y, C) __builtin_amdgcn_mfma_f32_16x16x32_bf16((X), (Y), (C), 0, 0, 0)

template <int ACT> struct EpiBf16 {
    static constexpr bool PERM = true, AFTER_DRAIN = false, PERMA = false;
    bf16_t* O; int ldc;
    __device__ __forceinline__ void operator()(const f32x4 (&acc)[2][2][4][2], const Unit& u, int wr, int wc, int fr, int fq) const {
        const int row0 = u.pm * 256 + wr * 64 + fr, col0 = u.pn * 256 + wc * 32 + 8 * fq;
#pragma unroll
        for (int ai = 0; ai < 2; ++ai)
#pragma unroll
            for (int m = 0; m < 4; ++m) { bf16_t* rowp = O + (size_t)(row0 + ai * 128 + m * 16) * ldc + col0;
#pragma unroll
                for (int bj = 0; bj < 2; ++bj) { f32x4 v0 = acc[ai][bj][m][0], v1 = acc[ai][bj][m][1];
                    if (ACT == 1) { v0 = gelu_tanh4(v0); v1 = gelu_tanh4(v1); }
                    u32x4 o = {pk2(v0[0], v0[1]), pk2(v0[2], v0[3]), pk2(v1[0], v1[1]), pk2(v1[2], v1[3])};
                    *(u32x4*)(rowp + bj * 128) = o; } }
    }
};
struct EpiF32 {
    static constexpr bool PERM = false, AFTER_DRAIN = false, PERMA = false;
    float* C; int ldc;
    __device__ __forceinline__ void operator()(const f32x4 (&acc)[2][2][4][2], const Unit& u, int wr, int wc, int fr, int fq) const {
        const int row0 = u.pm * 256 + wr * 64 + fr, col0 = u.pn * 256 + wc * 32 + 4 * fq;
#pragma unroll
        for (int ai = 0; ai < 2; ++ai)
#pragma unroll
            for (int m = 0; m < 4; ++m) { float* rowp = C + (size_t)(row0 + ai * 128 + m * 16) * ldc + col0;
#pragma unroll
                for (int bj = 0; bj < 2; ++bj)
#pragma unroll
                    for (int n = 0; n < 2; ++n) *(f32x4*)(rowp + bj * 128 + n * 16) = acc[ai][bj][m][n]; }
    }
};
struct EpiRes {
    static constexpr bool PERM = true, AFTER_DRAIN = false, PERMA = false;
    const bf16_t* Xs; bf16_t* Xd; const float* gate;
    __device__ __forceinline__ void operator()(const f32x4 (&acc)[2][2][4][2], const Unit& u, int wr, int wc, int fr, int fq) const {
        const int row0 = u.pm * 256 + wr * 64 + fr, col0 = u.pn * 256 + wc * 32 + 8 * fq;
        const float* gp = gate + (unsigned)((u.pm >> 4) * 6144 + col0);
        f32x4 gv[2][2];
#pragma unroll
        for (int bj = 0; bj < 2; ++bj)
#pragma unroll
            for (int n = 0; n < 2; ++n) { gv[bj][n] = *(const f32x4*)(gp + bj * 128 + n * 4); gv[bj][n] = gv[bj][n] + 1.f; }
#pragma unroll
        for (int ai = 0; ai < 2; ++ai)
#pragma unroll
            for (int m = 0; m < 4; ++m) { const unsigned ro = (unsigned)((row0 + ai * 128 + m * 16) * 1024 + col0);
#pragma unroll
                for (int bj = 0; bj < 2; ++bj) { const u32x4 xs = *(const u32x4*)(Xs + ro + bj * 128);
                    const f32x4 a0 = acc[ai][bj][m][0] * gv[bj][0], a1 = acc[ai][bj][m][1] * gv[bj][1];
                    u32x4 o = {pk2(bflo(xs[0]) + a0[0], bfhi(xs[0]) + a0[1]), pk2(bflo(xs[1]) + a0[2], bfhi(xs[1]) + a0[3]), pk2(bflo(xs[2]) + a1[0], bfhi(xs[2]) + a1[1]), pk2(bflo(xs[3]) + a1[2], bfhi(xs[3]) + a1[3])};
                    *(u32x4*)(Xd + ro + bj * 128) = o; } }
    }
};
struct EpiQ {
    static constexpr bool PERM = false, AFTER_DRAIN = false, PERMA = false;
    bf16_t* QF; const float* CSC; const float* CSS; float qs;
    __device__ __forceinline__ void operator()(const f32x4 (&acc)[2][2][4][2], const Unit& u, int wr, int wc, int fr, int fq) const {
        const int b = u.pm >> 4;
#pragma unroll
        for (int bj = 0; bj < 2; ++bj) {
            const int c0 = u.pn * 256 + bj * 128 + wc * 32;
            const int head = c0 / 192, off = c0 - head * 192;
            if (off < 128) {
#pragma unroll
                for (int ai = 0; ai < 2; ++ai)
#pragma unroll
                    for (int m = 0; m < 4; ++m) { const int r = u.pm * 256 + ai * 128 + wr * 64 + m * 16 + fr, s = r & 4095;
                        bf16_t* qp = QF + (unsigned)(((b * 8 + head) * 4096 + s) * 192 + off + 4 * fq);
#pragma unroll
                        for (int n = 0; n < 2; ++n) { const f32x4 v = acc[ai][bj][m][n] * qs; u32x2 o = {pk2(v[0], v[1]), pk2(v[2], v[3])}; *(u32x2*)(qp + 16 * n) = o; } __builtin_amdgcn_sched_barrier(0); }
            } else {
                const int jb = ((off - 128) >> 5) * 16 + 4 * fq;
#pragma unroll
                for (int ai = 0; ai < 2; ++ai)
#pragma unroll
                    for (int m = 0; m < 4; ++m) { const int r = u.pm * 256 + ai * 128 + wr * 64 + m * 16 + fr, s = r & 4095;
                        const f32x4 cs = *(const f32x4*)(CSC + (unsigned)(r * 32 + jb)), sn = *(const f32x4*)(CSS + (unsigned)(r * 32 + jb));
                        const f32x4 x1 = acc[ai][bj][m][0], x2 = acc[ai][bj][m][1];
                        const f32x4 r1 = (x1 * cs - x2 * sn) * qs, r2 = (x2 * cs + x1 * sn) * qs;
                        bf16_t* qp = QF + (unsigned)(((b * 8 + head) * 4096 + s) * 192 + 128 + jb);
                        u32x2 o1 = {pk2(r1[0], r1[1]), pk2(r1[2], r1[3])}, o2 = {pk2(r2[0], r2[1]), pk2(r2[2], r2[3])};
                        *(u32x2*)(qp) = o1; *(u32x2*)(qp + 32) = o2; __builtin_amdgcn_sched_barrier(0); }
            }
        }
    }
};
struct EpiKV {
    static constexpr bool PERM = false, AFTER_DRAIN = false, PERMA = false;
    bf16_t* KF; bf16_t* VT;
    __device__ __forceinline__ void operator()(const f32x4 (&acc)[2][2][4][2], const Unit& u, int wr, int wc, int fr, int fq) const {
        const int b = u.pm >> 4, head = u.pn;
#pragma unroll
        for (int bj = 0; bj < 2; ++bj) {
            const int off = wc * 32;
            if (bj == 0) {
#pragma unroll
                for (int ai = 0; ai < 2; ++ai)
#pragma unroll
                    for (int m = 0; m < 4; ++m) { const int r = u.pm * 256 + ai * 128 + wr * 64 + m * 16 + fr, s = r & 4095;
                        bf16_t* kp = KF + (unsigned)(((b * 8 + head) * 4096 + s) * 192 + off + 4 * fq);
#pragma unroll
                        for (int n = 0; n < 2; ++n) { const f32x4 v = acc[ai][bj][m][n]; u32x2 o = {pk2(v[0], v[1]), pk2(v[2], v[3])}; *(u32x2*)(kp + 16 * n) = o; } __builtin_amdgcn_sched_barrier(0); }
            } else {
#pragma unroll
                for (int ai = 0; ai < 2; ++ai)
#pragma unroll
                    for (int m = 0; m < 4; ++m) { const int r = u.pm * 256 + ai * 128 + wr * 64 + m * 16 + fr, s = r & 4095;
#pragma unroll
                        for (int n = 0; n < 2; ++n) { const f32x4 v = acc[ai][bj][m][n]; const int dv = off + 16 * n + 4 * fq;
                            bf16_t* vp = VT + (unsigned)(((b * 8 + head) * 128 + dv) * 4096 + s);
                            const unsigned p01 = pk2(v[0], v[1]), p23 = pk2(v[2], v[3]);
                            vp[0] = (bf16_t)(p01 & 0xffffu); vp[4096] = (bf16_t)(p01 >> 16); vp[8192] = (bf16_t)(p23 & 0xffffu); vp[12288] = (bf16_t)(p23 >> 16); } __builtin_amdgcn_sched_barrier(0); }
            }
        }
    }
};
struct EpiHg {
    static constexpr bool PERM = true, AFTER_DRAIN = false, PERMA = false;
    unsigned char* R1b; const float* LB;
    __device__ __forceinline__ void operator()(const f32x4 (&acc)[2][2][4][2], const Unit& u, int wr, int wc, int fr, int fq) const {
        const int region = u.pn >> 2, row0 = u.pm * 256 + wr * 64 + fr, cc0 = (u.pn & 3) * 256 + wc * 32 + 8 * fq;
        if (region == 1) {
#pragma unroll
            for (int bj = 0; bj < 2; ++bj) { const int cc = cc0 + bj * 128;
                const f32x4 l0 = *(const f32x4*)(LB + cc), l1 = *(const f32x4*)(LB + cc + 4);
#pragma unroll
                for (int ai = 0; ai < 2; ++ai)
#pragma unroll
                    for (int m = 0; m < 4; ++m) { float* fp = (float*)(R1b + 32 * MiB) + (unsigned)((row0 + ai * 128 + m * 16) * 1024 + cc);
                        f32x4 v0 = acc[ai][bj][m][0], v1 = acc[ai][bj][m][1];
                        v0 = l0 + (1.f - l0) * sigmoid4(v0); v1 = l1 + (1.f - l1) * sigmoid4(v1);
                        *(f32x4*)fp = v0; *(f32x4*)(fp + 4) = v1; __builtin_amdgcn_sched_barrier(0); } }
        } else {
            bf16_t* base = (bf16_t*)(R1b + (region == 0 ? (size_t)0 : (region == 2 ? 96 * MiB : 128 * MiB)));
#pragma unroll
            for (int ai = 0; ai < 2; ++ai)
#pragma unroll
                for (int m = 0; m < 4; ++m) { bf16_t* rowp = base + (unsigned)((row0 + ai * 128 + m * 16) * 1024 + cc0);
#pragma unroll
                    for (int bj = 0; bj < 2; ++bj) { f32x4 v0 = acc[ai][bj][m][0], v1 = acc[ai][bj][m][1];
                        if (region == 3) { v0 = v0 * sigmoid4(v0); v1 = v1 * sigmoid4(v1); }
                        u32x4 o = {pk2(v0[0], v0[1]), pk2(v0[2], v0[3]), pk2(v1[0], v1[1]), pk2(v1[2], v1[3])};
                        *(u32x4*)(rowp + bj * 128) = o; } }
        }
    }
};

struct EpiFFN {
    static constexpr bool PERM = true, AFTER_DRAIN = false, PERMA = true;
    bf16_t* ACT; const bf16_t* CWB;
    __device__ __forceinline__ static f32x4 shr1(const f32x4 v) { f32x4 r;
#pragma unroll
        for (int e = 0; e < 4; ++e) r[e] = __int_as_float(__builtin_amdgcn_update_dpp(0, __float_as_int(v[e]), 0x111, 0xf, 0xf, true));
        return r; }
    template <bool SPECIAL> __device__ __forceinline__ void group(const f32x4 (&acc)[2][2][4][2], int ai, int n, int tok0, int fr, int fcol,
            const f32x4 wg0, const f32x4 wg1, const f32x4 wg2, const f32x4 bg, const f32x4 wv0, const f32x4 wv1, const f32x4 wv2, const f32x4 bv) const {
        const f32x4 sg3 = shr1(acc[ai][0][3][n]), sg2 = shr1(acc[ai][0][2][n]), sv3 = shr1(acc[ai][1][3][n]), sv2 = shr1(acc[ai][1][2][n]);
#pragma unroll
        for (int m = 0; m < 4; ++m) {
            const f32x4 cg = acc[ai][0][m][n], cv = acc[ai][1][m][n];
            f32x4 p1g = m == 0 ? sg3 : acc[ai][0][m == 0 ? 0 : m - 1][n], p1v = m == 0 ? sv3 : acc[ai][1][m == 0 ? 0 : m - 1][n];
            f32x4 p2g = m == 0 ? sg2 : (m == 1 ? sg3 : acc[ai][0][m < 2 ? 0 : m - 2][n]), p2v = m == 0 ? sv2 : (m == 1 ? sv3 : acc[ai][1][m < 2 ? 0 : m - 2][n]);
            const int tok = tok0 + 4 * fr + m;
            if (SPECIAL) { const int sq = tok & 4095; const f32x4 z4 = {0.f, 0.f, 0.f, 0.f}; if (sq == 0) { p1g = z4; p1v = z4; } if (sq <= 1) { p2g = z4; p2v = z4; } }
            const f32x4 yg = bg + wg0 * p2g + wg1 * p1g + wg2 * cg, yv = bv + wv0 * p2v + wv1 * p1v + wv2 * cv;
            const f32x4 ex = yg * -1.4426950408889634f; f32x4 sg;
#pragma unroll
            for (int e = 0; e < 4; ++e) sg[e] = __builtin_amdgcn_rcpf(1.f + __builtin_amdgcn_exp2f(ex[e]));
            const f32x4 o = yg * sg * yv;
            if ((m >= 2 || fr > 0) && tok < T) { u32x2 ov = {pk2(o[0], o[1]), pk2(o[2], o[3])}; *(u32x2*)(ACT + (unsigned)(tok * 2816 + fcol)) = ov; }
        }
    }
    __device__ __forceinline__ void operator()(const f32x4 (&acc)[2][2][4][2], const Unit& u, int wr, int wc, int fr, int fq) const {
        const int fcol0 = u.pn * 128 + wc * 32 + 8 * fq;
        u32x4 tw[8];
#pragma unroll
        for (int i = 0; i < 8; ++i) tw[i] = *(const u32x4*)(CWB + (unsigned)((fcol0 + i) * 8));
#pragma unroll
        for (int n = 0; n < 2; ++n) {
            const int fcol = fcol0 + 4 * n;
            f32x4 wg0, wg1, wg2, bg, wv0, wv1, wv2, bv;
#pragma unroll
            for (int e = 0; e < 4; ++e) { const u32x4 t = tw[4 * n + e]; wg0[e] = bflo(t[0]); wg1[e] = bfhi(t[0]); wg2[e] = bflo(t[1]); bg[e] = bfhi(t[1]); wv0[e] = bflo(t[2]); wv1[e] = bfhi(t[2]); wv2[e] = bflo(t[3]); bv[e] = bfhi(t[3]); }
#pragma unroll
            for (int ai = 0; ai < 2; ++ai) {
                const int b0 = u.pm * 248 + (2 * ai + wr) * 62;
                const bool special = (((b0 + 61) >> 12) << 12) >= b0 - 1;
                if (special) group<true>(acc, ai, n, b0 - 2, fr, fcol, wg0, wg1, wg2, bg, wv0, wv1, wv2, bv);
                else group<false>(acc, ai, n, b0 - 2, fr, fcol, wg0, wg1, wg2, bg, wv0, wv1, wv2, bv);
                __builtin_amdgcn_sched_barrier(0);
            }
        }
    }
};

template <class Epi> __device__ __forceinline__ void run_gemm(const int s_wv, ldsp lds, const bf16_t* A, const bf16_t* Bt, int M, int N, int K, const Epi& E) {
    pg8::Gemm g{A, Bt, M, N, K}; pg8::StaticOrder S; S.init(M, N, (int)gridDim.x, obid());
    pg8::gemm_phase<Epi, pg8::StaticOrder, false>(s_wv, lds, g, S, E, nullptr);
}

__device__ __forceinline__ int rope_rowmap(int n) { const int head = n / 192, d = n - head * 192; if (d < 128) return n; const int r = d - 128, half = r >> 5, j = r & 31; return head * 192 + 128 + (j >> 4) * 32 + half * 16 + (j & 15); }
__device__ __forceinline__ int ffn_rowmap(int n) { const int half = n >= 2816 ? 1 : 0, f = n - half * 2816, t = f >> 7, i = f & 127; return t * 256 + half * 128 + i; }
struct TrJob { const float* src; int srcN, K, N; bf16_t* dst; int dstK, koff, rowoff, pmode; };
__device__ __forceinline__ void run_trjob(const int s_wv, const TrJob J, ldsp lds, const int wg0 = 0, const int nwg = 0) {
    const int tid = otid(), lane = tid & 63, wave = tid >> 6;
    LAS float* sm = (LAS float*)(lds + wave * 8448);
    const int nkt = J.K / 32, nnt = J.N / 64, ntile = nkt * nnt;
    const int nw_ = nwg ? nwg : (int)gridDim.x;
    for (int t = (obid() - wg0) * 8 + wave; t < ntile; t += nw_ * 8) { const int kt = t % nkt, nt = t / nkt;
        const float* sp = J.src + (size_t)(kt * 32) * J.srcN + nt * 64 + lane;
        float v[32];
#pragma unroll
        for (int k = 0; k < 32; ++k) v[k] = sp[(size_t)k * J.srcN];
#pragma unroll
        for (int k = 0; k < 32; ++k) sm[lane * 33 + k] = v[k];
        const int kk = (lane & 15) * 2, nr = lane >> 4;
#pragma unroll
        for (int j = 0; j < 16; ++j) { const int n = nr + 4 * j, sn = nt * 64 + n, drow = J.rowoff + (J.pmode == 1 ? rope_rowmap(sn) : (J.pmode == 2 ? ffn_rowmap(sn) : sn));
            *(unsigned*)(J.dst + (size_t)drow * J.dstK + J.koff + kt * 32 + kk) = pk2(sm[n * 33 + kk], sm[n * 33 + kk + 1]); }
    }
}
__device__ __forceinline__ void zero_fill(bf16_t* dst, int rows, int cols8, int stride, int gtid, int gthreads) {
    const int n = rows * cols8; unsigned zz = 0u; asm volatile("" : "+v"(zz)); const u32x4 z = {zz, zz, zz, zz};
    for (int i = gtid; i < n; i += gthreads) { const int r = i / cols8, c = i - r * cols8; *(u32x4*)(dst + (size_t)r * stride + c * 8) = z; }
}
__device__ __forceinline__ void prep_ffn(const int s_wv, KP p, int layer, ldsp lds, const int wg0, const int nwg) {
    bf16_t* WT = (bf16_t*)(p->ws + OFF_WT);
    const TrJob J0{p->in[23] + (size_t)layer * 1024 * 5632, 5632, 1024, 5632, WT + WT_FUP, 1024, 0, 0, 2};
    const TrJob J1{p->in[26] + (size_t)layer * 2816 * 1024, 1024, 2816, 1024, WT + WT_FDN, 2816, 0, 0, 0};
    run_trjob(s_wv, J0, lds, wg0, nwg); run_trjob(s_wv, J1, lds, wg0, nwg);
}
__device__ __forceinline__ void prep_layer(const int s_wv, KP p, int layer, ldsp lds, const bool with_ffn = true) {
    bf16_t* WT = (bf16_t*)(p->ws + OFF_WT); const int kind = layer % 3, j = layer / 3;
    const int gtid = obid() * NTHREADS + otid(), gthreads = gridDim.x * NTHREADS;
    if (with_ffn) { const TrJob J0{p->in[23] + (size_t)layer * 1024 * 5632, 5632, 1024, 5632, WT + WT_FUP, 1024, 0, 0, 2};
      const TrJob J1{p->in[26] + (size_t)layer * 2816 * 1024, 1024, 2816, 1024, WT + WT_FDN, 2816, 0, 0, 0};
      run_trjob(s_wv, J0, lds); run_trjob(s_wv, J1, lds); }
    if (kind == 0) {
        const TrJob J0{p->in[7] + (size_t)j * 1024 * 4096, 4096, 1024, 4096, WT + WT_MIXA, 1024, 0, 0, 0};
        const TrJob J1{p->in[12] + (size_t)j * 2048 * 1024, 1024, 2048, 1024, WT + WT_MIXB, 2048, 0, 0, 0};
        run_trjob(s_wv, J0, lds); run_trjob(s_wv, J1, lds);
    } else if (kind == 1) {
        const TrJob J0{p->in[13], 448, 1024, 448, WT + WT_MIXA, 1024, 0, 0, 0};
        const TrJob J1{p->in[16], 1536, 256, 1536, WT + WT_MQKV, 256, 0, 0, 1};
        const TrJob J2{p->in[17], 2048, 128, 2048, WT + WT_MQKV + 393216, 256, 0, 0, 0};
        const TrJob J3{p->in[18], 1024, 1024, 1024, WT + WT_MIXB, 1024, 0, 0, 0};
        run_trjob(s_wv, J0, lds); run_trjob(s_wv, J1, lds); run_trjob(s_wv, J2, lds); run_trjob(s_wv, J3, lds);
        zero_fill(WT + WT_MIXA + (size_t)448 * 1024, 64, 128, 1024, gtid, gthreads);
        zero_fill(WT + WT_MQKV + 393216 + 128, 2048, 16, 256, gtid, gthreads);
    } else {
        const TrJob J0{p->in[20], 4096, 1024, 4096, WT + WT_MIXA, 1024, 0, 0, 0};
        const TrJob J1{p->in[22], 1024, 1024, 1024, WT + WT_MIXB, 1024, 0, 0, 0};
        run_trjob(s_wv, J0, lds); run_trjob(s_wv, J1, lds);
    }
}
__device__ __forceinline__ void phase_prologue(const int s_wv, KP p, ldsp lds) {
    const int tid = otid();
    float* MOD = (float*)(p->ws + OFF_MOD);
    LAS float* cact = (LAS float*)lds;
    LAS float* red = (LAS float*)(lds + 16384);
    for (int i = tid; i < 4096; i += NTHREADS) { const float c = p->in[1][i]; cact[i] = c * fast_sigmoid(c); }
    __syncthreads();
    const int l16 = tid & 15, kg = tid >> 4;
    for (int item = obid(); item < 4 * 96; item += gridDim.x) {
        const int layer = item / 96, n0 = (item % 96) * 64;
        const float* w = p->in[3] + (size_t)layer * 1024 * 6144 + n0 + 4 * l16;
        f32x4 a[4] = {{0.f, 0.f, 0.f, 0.f}, {0.f, 0.f, 0.f, 0.f}, {0.f, 0.f, 0.f, 0.f}, {0.f, 0.f, 0.f, 0.f}};
#pragma unroll 8
        for (int kk = 0; kk < 32; ++kk) { const int k = kg * 32 + kk; const f32x4 wv = *(const f32x4*)(w + (size_t)k * 6144);
#pragma unroll
            for (int b = 0; b < 4; ++b) a[b] = a[b] + wv * cact[b * 1024 + k]; }
#pragma unroll
        for (int b = 0; b < 4; ++b) *(LAS f32x4*)(red + (kg * 4 + b) * 64 + 4 * l16) = a[b];
        __syncthreads();
        if (tid < 256) { const int b = tid >> 6, col = tid & 63; float s = 0.f;
#pragma unroll 8
            for (int g = 0; g < 32; ++g) s += red[(g * 4 + b) * 64 + col];
            MOD[(size_t)(layer * 4 + b) * 6144 + n0 + col] = s + p->in[4][(size_t)layer * 6144 + n0 + col]; }
        __syncthreads();
    }
    const int gtid = obid() * NTHREADS + tid, gthreads = gridDim.x * NTHREADS;
    float* CSC = (float*)(p->ws + OFF_CSC); float* CSS = (float*)(p->ws + OFF_CSS);
    const int* pos = (const int*)p->in[2];
    for (int i = gtid; i < T * 32; i += gthreads) { const int t = i >> 5, jj = i & 31;
        const float invf = exp2f(-(float)jj * (13.287712379549449f / 32.f));
        const float ang = (float)pos[t] * invf;
        double rev = (double)ang * 0.15915494309189535; rev -= floor(rev);
        const float rf = (float)rev;
        CSC[i] = __builtin_amdgcn_cosf(rf); CSS[i] = __builtin_amdgcn_sinf(rf); }
    float* LB = (float*)(p->ws + OFF_LB);
    for (int i = gtid; i < 1024; i += gthreads) { const float l0 = p->in[19][i], l1 = p->in[19][1024 + i], l2 = p->in[19][2048 + i], l3 = p->in[19][3072 + i];
        const float mx = fmaxf(fmaxf(l0, l1), fmaxf(l2, l3)); const float e0 = __expf(l0 - mx), e1 = __expf(l1 - mx), e2 = __expf(l2 - mx), e3 = __expf(l3 - mx);
        LB[i] = (e1 + e2) / (e0 + e1 + e2 + e3); }
    prep_layer(s_wv, p, 0, lds);
}
__device__ __forceinline__ void up8(const u32x4 v, float (&o)[8]) { o[0] = bflo(v[0]); o[1] = bfhi(v[0]); o[2] = bflo(v[1]); o[3] = bfhi(v[1]); o[4] = bflo(v[2]); o[5] = bfhi(v[2]); o[6] = bflo(v[3]); o[7] = bfhi(v[3]); }
template <bool SRC32> __device__ __forceinline__ void phase_norm(const int s_wv, const float* X32, bf16_t* XB, const float* g, const float* shift, const float* scale, bf16_t* dst) {
    const int lane = otid() & 63, wave = otid() >> 6;
    for (int rb = obid() * 8 + wave; rb < T / 8; rb += gridDim.x * 8) {
        const int r0 = rb * 8, b = r0 >> 12;
        float G[16], SH[16];
#pragma unroll
        for (int j = 0; j < 2; ++j)
#pragma unroll
            for (int h = 0; h < 2; ++h) { const int c = 8 * lane + 512 * j + 4 * h; const f32x4 gg = *(const f32x4*)(g + c), sc = *(const f32x4*)(scale + (size_t)b * 6144 + c), sh = *(const f32x4*)(shift + (size_t)b * 6144 + c);
#pragma unroll
                for (int e = 0; e < 4; ++e) { G[j * 8 + h * 4 + e] = gg[e] * (sc[e] + 1.f); SH[j * 8 + h * 4 + e] = sh[e]; } }
        for (int r = r0; r < r0 + 8; ++r) {
            float x[16]; float ss = 0.f;
#pragma unroll
            for (int j = 0; j < 2; ++j) { const unsigned off = (unsigned)(r * 1024 + 8 * lane + 512 * j);
                if (SRC32) { const f32x4 a = *(const f32x4*)(X32 + off), c = *(const f32x4*)(X32 + off + 4);
#pragma unroll
                    for (int e = 0; e < 4; ++e) { x[j * 8 + e] = a[e]; x[j * 8 + 4 + e] = c[e]; }
                    u32x4 xo = {pk2(a[0], a[1]), pk2(a[2], a[3]), pk2(c[0], c[1]), pk2(c[2], c[3])}; *(u32x4*)(XB + off) = xo;
                } else { float t[8]; up8(*(const u32x4*)(XB + off), t);
#pragma unroll
                    for (int e = 0; e < 8; ++e) x[j * 8 + e] = t[e]; } }
#pragma unroll
            for (int e = 0; e < 16; ++e) ss += x[e] * x[e];
            ss = wave_sum(ss, lane); const float rstd = rsqrtf(ss * (1.f / 1024.f) + EPS);
#pragma unroll
            for (int j = 0; j < 2; ++j) { float h[8];
#pragma unroll
                for (int e = 0; e < 8; ++e) h[e] = x[j * 8 + e] * rstd * G[j * 8 + e] + SH[j * 8 + e];
                u32x4 o = {pk2(h[0], h[1]), pk2(h[2], h[3]), pk2(h[4], h[5]), pk2(h[6], h[7])}; *(u32x4*)(dst + (unsigned)(r * 1024 + 8 * lane + 512 * j)) = o; }
        }
    }
}
__device__ __forceinline__ void phase_final(const int s_wv, const bf16_t* XB, float* out, const float* g) {
    const int lane = otid() & 63, wave = otid() >> 6;
    for (int r = obid() * 8 + wave; r < T; r += gridDim.x * 8) {
        float x[16]; float ss = 0.f;
#pragma unroll
        for (int j = 0; j < 2; ++j) { float t[8]; up8(*(const u32x4*)(XB + (unsigned)(r * 1024 + 8 * lane + 512 * j)), t);
#pragma unroll
            for (int e = 0; e < 8; ++e) { x[j * 8 + e] = t[e]; ss += t[e] * t[e]; } }
        ss = wave_sum(ss, lane); const float rstd = rsqrtf(ss * (1.f / 1024.f) + EPS);
#pragma unroll
        for (int j = 0; j < 2; ++j)
#pragma unroll
            for (int h = 0; h < 2; ++h) { const int c = 8 * lane + 512 * j + 4 * h; const f32x4 gg = *(const f32x4*)(g + c);
                f32x4 o = {x[j * 8 + h * 4] * rstd * gg[0], x[j * 8 + h * 4 + 1] * rstd * gg[1], x[j * 8 + h * 4 + 2] * rstd * gg[2], x[j * 8 + h * 4 + 3] * rstd * gg[3]};
                *(f32x4*)(out + (size_t)r * 1024 + c) = o; }
    }
}
__device__ __forceinline__ void phase_ffix(const int s_wv, const bf16_t* SIDE, bf16_t* ACT, const float* cw, const float* cb) {
    const int gtid = obid() * NTHREADS + otid(), gthreads = gridDim.x * NTHREADS;
    for (int q = gtid; q < 256 * 2 * 352; q += gthreads) {
        const int cgp = q % 352, gi = q / 352, i = gi & 1, g = gi >> 1, f0 = cgp * 8;
        const bool first = (g & 63) == 0;
        const bf16_t* own = SIDE + (size_t)((g * 4 + 2 + i) * 2) * 2816 + f0;
        const bf16_t* p1 = i == 0 ? SIDE + (size_t)(((g - 1) * 4 + 1) * 2) * 2816 + f0 : SIDE + (size_t)((g * 4 + 2) * 2) * 2816 + f0;
        const bf16_t* p2 = i == 0 ? SIDE + (size_t)(((g - 1) * 4 + 0) * 2) * 2816 + f0 : SIDE + (size_t)(((g - 1) * 4 + 1) * 2) * 2816 + f0;
        float gc[8], vc[8], g1[8], v1[8], g2[8], v2[8];
        up8(*(const u32x4*)own, gc); up8(*(const u32x4*)(own + 2816), vc);
        if (i == 1 || !first) { up8(*(const u32x4*)p1, g1); up8(*(const u32x4*)(p1 + 2816), v1); } else {
#pragma unroll
            for (int e = 0; e < 8; ++e) { g1[e] = 0.f; v1[e] = 0.f; } }
        if (!first) { up8(*(const u32x4*)p2, g2); up8(*(const u32x4*)(p2 + 2816), v2); } else {
#pragma unroll
            for (int e = 0; e < 8; ++e) { g2[e] = 0.f; v2[e] = 0.f; } }
        float o[8];
#pragma unroll
        for (int e = 0; e < 8; ++e) { const int f = f0 + e;
            const float yg = cb[f] + cw[f] * g2[e] + cw[5632 + f] * g1[e] + cw[11264 + f] * gc[e], yv = cb[2816 + f] + cw[2816 + f] * v2[e] + cw[5632 + 2816 + f] * v1[e] + cw[11264 + 2816 + f] * vc[e];
            o[e] = yg * fast_sigmoid(yg) * yv; }
        u32x4 ov = {pk2(o[0], o[1]), pk2(o[2], o[3]), pk2(o[4], o[5]), pk2(o[6], o[7])};
        *(u32x4*)(ACT + (size_t)(g * 64 + i) * 2816 + f0) = ov;
    }
}

__device__ __forceinline__ void phase_gsp(const int s_wv, KP p, int j, ldsp lds) {
    const bf16_t* Z = (const bf16_t*)(p->ws + OFF_R1); bf16_t* Y = (bf16_t*)(p->ws + OFF_R2);
    const float* ws_w = p->in[10] + (size_t)j * 8 * 128 * 128; const float* bs = p->in[11] + (size_t)j * 8 * 128;
    const float* lng = p->in[8] + (size_t)j * 2048; const float* lnb = p->in[9] + (size_t)j * 2048;
    const int tid = otid(), lane = tid & 63, wave = tid >> 6, l15 = lane & 15, g4 = lane >> 4;
    ldsp As = lds, Bs = lds + 34816; LAS float* mu = (LAS float*)(lds + 104448); LAS float* rs = mu + 128;
    for (int unit = obid(); unit < 256; unit += gridDim.x) {
        const int gh = unit & 1, chunk = unit >> 1, t0 = chunk * 128;
        for (int rr = 0; rr < 16; ++rr) { const int r = wave * 16 + rr; const bf16_t* zp = Z + (size_t)(t0 + r) * 4096 + 2048 + lane * 32; float s = 0.f, s2 = 0.f;
#pragma unroll
            for (int i = 0; i < 4; ++i) { float v[8]; up8(*(const u32x4*)(zp + 8 * i), v);
#pragma unroll
                for (int e = 0; e < 8; ++e) { s += v[e]; s2 += v[e] * v[e]; } }
            s = wave_sum(s, lane); s2 = wave_sum(s2, lane);
            if (lane == 0) { const float m = s * (1.f / 2048.f); float var = s2 * (1.f / 2048.f) - m * m; var = fmaxf(var, 0.f); mu[r] = m; rs[r] = rsqrtf(var + EPS); } }
        __syncthreads();
        for (int gi = 0; gi < 4; ++gi) {
            const int g = gh * 4 + gi;
#pragma unroll 2
            for (int i = 0; i < 8; ++i) { const int idx = tid + 512 * i, t = idx >> 5, s4 = (idx & 31) * 4; f32x4 w = *(const f32x4*)(ws_w + (size_t)g * 16384 + t * 128 + s4);
#pragma unroll
                for (int e = 0; e < 4; ++e) w[e] = (s4 + e <= t) ? w[e] : 0.f;
                u32x2 o = {pk2(w[0], w[1]), pk2(w[2], w[3])}; *(LAS u32x2*)(As + t * 272 + s4 * 2) = o; }
#pragma unroll 2
            for (int i = 0; i < 4; ++i) { const int idx = tid + 512 * i, s = (idx >> 5) * 2, c8 = idx & 31; float v0[8], v1[8];
                up8(*(const u32x4*)(Z + (size_t)(t0 + s) * 4096 + 2048 + g * 256 + c8 * 8), v0); up8(*(const u32x4*)(Z + (size_t)(t0 + s + 1) * 4096 + 2048 + g * 256 + c8 * 8), v1);
                const float m0 = mu[s], r0 = rs[s], m1 = mu[s + 1], r1 = rs[s + 1]; const f32x4 ga = *(const f32x4*)(lng + g * 256 + c8 * 8), gb = *(const f32x4*)(lng + g * 256 + c8 * 8 + 4), ba = *(const f32x4*)(lnb + g * 256 + c8 * 8), bb = *(const f32x4*)(lnb + g * 256 + c8 * 8 + 4);
                const int boff = (((s >> 3) ^ (c8 & 15)) << 4) + (s & 7) * 2;
#pragma unroll
                for (int e = 0; e < 8; ++e) { const float gg = e < 4 ? ga[e] : gb[e - 4], bbv = e < 4 ? ba[e] : bb[e - 4];
                    *(LAS unsigned*)(Bs + (c8 * 8 + e) * 272 + boff) = pk2((v0[e] - m0) * r0 * gg + bbv, (v1[e] - m1) * r1 * gg + bbv); } }
            __syncthreads();
            f32x4 acc[8][2];
#pragma unroll
            for (int tt = 0; tt < 8; ++tt) { acc[tt][0] = zero4(); acc[tt][1] = zero4(); }
#pragma unroll
            for (int tt = 0; tt < 8; ++tt)
#pragma unroll
                for (int ks = 0; ks <= tt / 2; ++ks) { const bf16x8 yf = *(const LAS bf16x8*)(As + (16 * tt + l15) * 272 + (32 * ks + 8 * g4) * 2);
#pragma unroll
                    for (int ct = 0; ct < 2; ++ct) { const int c = 32 * wave + 16 * ct + l15; const bf16x8 xf = *(const LAS bf16x8*)(Bs + c * 272 + (((4 * ks + g4) ^ ((c >> 3) & 15)) << 4));
                        acc[tt][ct] = MFMA16(xf, yf, acc[tt][ct]); } }
#pragma unroll
            for (int tt = 0; tt < 8; ++tt) { const int t = 16 * tt + l15; const float bias = bs[g * 128 + t];
#pragma unroll
                for (int ct = 0; ct < 2; ++ct) { const int c = g * 256 + 32 * wave + 16 * ct + 4 * g4; const u32x2 uu = *(const u32x2*)(Z + (size_t)(t0 + t) * 4096 + c);
                    const f32x4 a = acc[tt][ct]; u32x2 o = {pk2(bflo(uu[0]) * (a[0] + bias), bfhi(uu[0]) * (a[1] + bias)), pk2(bflo(uu[1]) * (a[2] + bias), bfhi(uu[1]) * (a[3] + bias))};
                    *(u32x2*)(Y + (size_t)(t0 + t) * 2048 + c) = o; } }
            __syncthreads();
        }
    }
}

__device__ __forceinline__ void phase_m2(const int s_wv, KP p) {
    const float* A1 = (const float*)(p->ws + OFF_R1); bf16_t* CQN = (bf16_t*)(p->ws + OFF_R1 + 32 * MiB); bf16_t* CKVN = (bf16_t*)(p->ws + OFF_R1 + 40 * MiB); bf16_t* KF = (bf16_t*)(p->ws + OFF_R1 + 96 * MiB);
    const float* CSC = (const float*)(p->ws + OFF_CSC); const float* CSS = (const float*)(p->ws + OFF_CSS);
    const int lane = otid() & 63, wave = otid() >> 6;
    const f32x4 qg = *(const f32x4*)(p->in[14] + 4 * lane); const f32x4 kg = *(const f32x4*)(p->in[15] + 4 * (lane & 31));
    for (int r = obid() * 8 + wave; r < T; r += gridDim.x * 8) {
        const float* a = A1 + (size_t)r * 512;
        const f32x4 cq = *(const f32x4*)(a + 4 * lane); float ss = wave_sum(cq[0] * cq[0] + cq[1] * cq[1] + cq[2] * cq[2] + cq[3] * cq[3], lane);
        const float rq = rsqrtf(ss * (1.f / 256.f) + EPS);
        { const f32x4 h = cq * rq * qg; u32x2 o = {pk2(h[0], h[1]), pk2(h[2], h[3])}; *(u32x2*)(CQN + (size_t)r * 256 + 4 * lane) = o; }
        const f32x4 ck = *(const f32x4*)(a + 256 + 4 * (lane & 31)); float s2 = lane < 32 ? (ck[0] * ck[0] + ck[1] * ck[1] + ck[2] * ck[2] + ck[3] * ck[3]) : 0.f; s2 = wave_sum(s2, lane);
        const float rk = rsqrtf(s2 * (1.f / 128.f) + EPS);
        { const f32x4 h = ck * rk * kg; u32x2 o = {pk2(h[0], h[1]), pk2(h[2], h[3])}; if (lane >= 32) { o[0] = 0u; o[1] = 0u; } *(u32x2*)(CKVN + (size_t)r * 256 + 4 * lane) = o; }
        if (lane < 32) {
            const float x1 = a[384 + lane], x2 = a[416 + lane], c = CSC[(size_t)r * 32 + lane], s = CSS[(size_t)r * 32 + lane];
            const unsigned pr = pk2(x1 * c - x2 * s, x2 * c + x1 * s); const int b = r >> 12, sq = r & 4095;
#pragma unroll
            for (int h8 = 0; h8 < 8; ++h8) { bf16_t* kp = KF + ((size_t)((b * 8 + h8) * 4096 + sq)) * 192 + 128 + lane; kp[0] = (bf16_t)(pr & 0xffffu); kp[32] = (bf16_t)(pr >> 16); } }
    }
}

__device__ __forceinline__ void phase_attn(const int s_wv, KP p, ldsp lds) {
    const bf16_t* QF = (const bf16_t*)(p->ws + OFF_R1 + 48 * MiB); const bf16_t* KF = (const bf16_t*)(p->ws + OFF_R1 + 96 * MiB); const bf16_t* VT = (const bf16_t*)(p->ws + OFF_R1 + 144 * MiB);
    bf16_t* O = (bf16_t*)(p->ws + OFF_R2);
    const int tid = otid(), lane = tid & 63, wave = __builtin_amdgcn_readfirstlane(tid >> 6), l15 = lane & 15, g4 = lane >> 4;
    const int G = gridDim.x, bx = obid(), vcu = (G % 8 == 0) ? (bx % 8) * (G / 8) + bx / 8 : bx;
    constexpr int KB = 25600, VB = 18432, BUF = KB + VB;
    for (int unit = vcu; unit < 256; unit += G) {
        const int bh = unit >> 3, pr = unit & 7, b = bh >> 3, h = bh & 7;
        const unsigned char* kbase = (const unsigned char*)(KF + (size_t)bh * 4096 * 192);
        const unsigned char* vbase = (const unsigned char*)(VT + (size_t)bh * 128 * 4096);
        for (int half = 0; half < 2; ++half) {
            const int qb = half == 0 ? 15 - pr : pr, ntile = 4 * qb + 4;
            const int qrow0 = qb * 256 + 32 * wave;
            bf16x8 Qf[2][6];
#pragma unroll
            for (int qt = 0; qt < 2; ++qt)
#pragma unroll
                for (int ks = 0; ks < 6; ++ks) Qf[qt][ks] = *(const bf16x8*)((const unsigned char*)(QF + (size_t)(bh * 4096 + qrow0) * 192) + (unsigned)(((16 * qt + l15) * 192 + 32 * ks + 8 * g4) * 2));
            f32x4 Oa[2][8]; float mrun[2] = {-1e30f, -1e30f}, lsum[2] = {0.f, 0.f};
#pragma unroll
            for (int qt = 0; qt < 2; ++qt)
#pragma unroll
                for (int d = 0; d < 8; ++d) Oa[qt][d] = zero4();
#define ATT_DMA(j, bufi) do { ldsp kb_ = lds + (bufi) * BUF; \
                for (int c = wave; c < 25; c += 8) { const int q_ = c * 64 + lane, row = q_ / 25, c16 = min(q_ - row * 25, 23); \
                    __builtin_amdgcn_global_load_lds((const unsigned*)(kbase + (size_t)(j) * 24576 + (unsigned)(row * 384 + c16 * 16)), (LAS unsigned*)(kb_ + c * 1024), 16, 0, 0); } \
                for (int c = wave; c < 18; c += 8) { const int q_ = c * 64 + lane, dv = q_ / 9, k8 = min(q_ - dv * 9, 7); \
                    __builtin_amdgcn_global_load_lds((const unsigned*)(vbase + (size_t)(j) * 128 + (unsigned)(dv * 8192 + k8 * 16)), (LAS unsigned*)(kb_ + KB + c * 1024), 16, 0, 0); } } while (0)
            ATT_DMA(0, 0); asm volatile("s_waitcnt vmcnt(0)" ::: "memory"); __syncthreads();
#pragma unroll 1
            for (int j = 0; j < ntile; ++j) {
                if (j + 1 < ntile) ATT_DMA(j + 1, (j + 1) & 1);
                ;
                const int jj = j - 4 * qb; const bool diag = jj >= 0; const bool active = !(diag && 64 * jj > 32 * wave + 31);
                ldsp Kb = lds + (j & 1) * BUF; ldsp Vb = Kb + KB;
#pragma unroll
                for (int hs = 0; hs < 2; ++hs) {
                    if (active) {
                        f32x4 S[2][2];
#pragma unroll
                        for (int qt = 0; qt < 2; ++qt) { S[qt][0] = zero4(); S[qt][1] = zero4(); }
                        {
#define ATT_KLD(i) (*(const LAS bf16x8*)(Kb + (16 * (2 * hs + ((i) & 1)) + l15) * 400 + (32 * ((i) >> 1) + 8 * g4) * 2))
                            bf16x8 kq[3]; kq[0] = ATT_KLD(0); kq[1] = ATT_KLD(1);
#pragma unroll
                            for (int i = 0; i < 12; ++i) { if (i + 2 < 12) kq[(i + 2) % 3] = ATT_KLD(i + 2);
                                __builtin_amdgcn_sched_barrier(0);
                                S[0][i & 1] = MFMA16(kq[i % 3], Qf[0][i >> 1], S[0][i & 1]); S[1][i & 1] = MFMA16(kq[i % 3], Qf[1][i >> 1], S[1][i & 1]);
                                __builtin_amdgcn_sched_barrier(0); }
#undef ATT_KLD
                        }
                        bf16x8 Pf[2];
#pragma unroll
                        for (int qt = 0; qt < 2; ++qt) {
                            if (diag) { int dq = 32 * wave + 16 * qt + l15 - 4 * g4 - 64 * jj; asm volatile("" : "+v"(dq));
#pragma unroll
                                for (int sb = 0; sb < 2; ++sb)
#pragma unroll
                                    for (int e = 0; e < 4; ++e) { if (32 * hs + 16 * sb + e > dq) S[qt][sb][e] = -1e30f; } }
                            float tm = -1e30f;
#pragma unroll
                            for (int sb = 0; sb < 2; ++sb)
#pragma unroll
                                for (int e = 0; e < 4; ++e) tm = fmaxf(tm, S[qt][sb][e]);
                            tm = rowmax4(tm);
                            if (__builtin_amdgcn_ballot_w64(tm > mrun[qt]) != 0ull) {
                                const float mn = fmaxf(mrun[qt], tm), sc = __builtin_amdgcn_exp2f(mrun[qt] - mn); mrun[qt] = mn; lsum[qt] *= sc;
#pragma unroll
                                for (int d = 0; d < 8; ++d) Oa[qt][d] = Oa[qt][d] * sc; }
                            const float mn = mrun[qt];
                            float ps = 0.f;
#pragma unroll
                            for (int sb = 0; sb < 2; ++sb)
#pragma unroll
                                for (int e = 0; e < 4; ++e) { const float pe = __builtin_amdgcn_exp2f(S[qt][sb][e] - mn); S[qt][sb][e] = pe; ps += pe; }
                            lsum[qt] += ps;
                            Pf[qt] = mk8(pk2(S[qt][0][0], S[qt][0][1]), pk2(S[qt][0][2], S[qt][0][3]), pk2(S[qt][1][0], S[qt][1][1]), pk2(S[qt][1][2], S[qt][1][3]));
                        }
                        {
#define ATT_VLD(d) __builtin_shufflevector(*(const LAS bf16x4*)(Vb + (16 * (d) + l15) * 144 + (32 * hs + 4 * g4) * 2), *(const LAS bf16x4*)(Vb + (16 * (d) + l15) * 144 + (32 * hs + 16 + 4 * g4) * 2), 0, 1, 2, 3, 4, 5, 6, 7)
                            bf16x8 vq[3]; vq[0] = ATT_VLD(0); vq[1] = ATT_VLD(1);
#pragma unroll
                            for (int d = 0; d < 8; ++d) { if (d + 2 < 8) vq[(d + 2) % 3] = ATT_VLD(d + 2);
                                __builtin_amdgcn_sched_barrier(0);
                                Oa[0][d] = MFMA16(vq[d % 3], Pf[0], Oa[0][d]); Oa[1][d] = MFMA16(vq[d % 3], Pf[1], Oa[1][d]);
                                __builtin_amdgcn_sched_barrier(0); }
#undef ATT_VLD
                        }
                    }
                }
                asm volatile("s_waitcnt vmcnt(0)" ::: "memory"); __syncthreads();
            }
#pragma unroll
            for (int qt = 0; qt < 2; ++qt) { float ls = lsum[qt]; ls = rowsum4(ls); const float inv = 1.f / ls;
                bf16_t* op = (bf16_t*)((unsigned char*)(O + (size_t)(b * 4096 + qrow0) * 1024 + h * 128) + (unsigned)(((16 * qt + l15) * 1024 + 4 * g4) * 2));
#pragma unroll
                for (int d = 0; d < 8; ++d) { const f32x4 v = Oa[qt][d] * inv; u32x2 o = {pk2(v[0], v[1]), pk2(v[2], v[3])}; *(u32x2*)(op + 16 * d) = o; } }
        }
    }
#undef ATT_DMA
}

template <bool TOF32> __device__ __forceinline__ void hg_load_f_v(const float* HF, const bf16_t* HV, int t0, int col0, LAS float* BC, LAS float* K1f, ldsp K1b, ldsp VTl, int tid) {
#pragma unroll
    for (int i = 0; i < 4; ++i) { const int idx = tid + 512 * i, s = idx >> 5, k4 = (idx & 31) * 4; const f32x4 f = *(const f32x4*)(HF + (size_t)(t0 + s) * 1024 + col0 + k4);
#pragma unroll
        for (int e = 0; e < 4; ++e) BC[s * 129 + k4 + e] = __logf(f[e]);
        if (TOF32) {
#pragma unroll
            for (int e = 0; e < 4; ++e) K1f[s * 129 + k4 + e] = 1.f - f[e];
        } else { u32x2 o = {pk2(1.f - f[0], 1.f - f[1]), pk2(1.f - f[2], 1.f - f[3])}; *(LAS u32x2*)(K1b + s * 272 + k4 * 2) = o; } }
#pragma unroll
    for (int i = 0; i < 2; ++i) { const int idx = tid + 512 * i, s = idx >> 4, v8 = idx & 15; const u32x4 vv = *(const u32x4*)(HV + (size_t)(t0 + s) * 1024 + col0 + v8 * 8);
#pragma unroll
        for (int e = 0; e < 4; ++e) { *(LAS bf16_t*)(VTl + (v8 * 8 + 2 * e) * 144 + s * 2) = (bf16_t)(vv[e] & 0xffffu); *(LAS bf16_t*)(VTl + (v8 * 8 + 2 * e + 1) * 144 + s * 2) = (bf16_t)(vv[e] >> 16); } }
}
__device__ __forceinline__ void phase_ha(const int s_wv, KP p, ldsp lds) {
    const float* HF = (const float*)(p->ws + OFF_R1 + 32 * MiB); const bf16_t* HV = (const bf16_t*)(p->ws + OFF_R1 + 96 * MiB);
    bf16_t* LCT = (bf16_t*)(p->ws + OFF_R2); float* DEC = (float*)(p->ws + OFF_R2 + 64 * MiB);
    const int tid = otid(), lane = tid & 63, wave = tid >> 6, l15 = lane & 15, g4 = lane >> 4;
    LAS float* BC = (LAS float*)lds; LAS float* K1 = (LAS float*)(lds + 33024); ldsp KT = lds + 66048; ldsp VTl = lds + 84480;
    for (int u = obid(); u < 2048; u += gridDim.x) {
        const int bh = u >> 6, n = u & 63, b = bh >> 3, h = bh & 7, t0 = b * 4096 + n * 64, col0 = h * 128;
        hg_load_f_v<true>(HF, HV, t0, col0, BC, K1, VTl, VTl, tid);
        __syncthreads();
        if (tid < 128) { float run = 0.f;
#pragma unroll 8
            for (int s = 0; s < 64; ++s) { run += BC[s * 129 + tid]; BC[s * 129 + tid] = run; }
            DEC[(size_t)u * 128 + tid] = __expf(run); }
        __syncthreads();
        { const int sp = tid & 31, kk0 = tid >> 5;
#pragma unroll
          for (int it = 0; it < 8; ++it) { const int k = kk0 + 16 * it; const float bl = BC[63 * 129 + k];
              const float a0 = K1[(2 * sp) * 129 + k] * __expf(bl - BC[(2 * sp) * 129 + k]), a1 = K1[(2 * sp + 1) * 129 + k] * __expf(bl - BC[(2 * sp + 1) * 129 + k]);
              *(LAS unsigned*)(KT + k * 144 + sp * 4) = pk2(a0, a1); } }
        __syncthreads();
        f32x4 acc[8];
#pragma unroll
        for (int vt = 0; vt < 8; ++vt) acc[vt] = zero4();
#pragma unroll
        for (int ks = 0; ks < 2; ++ks) { const bf16x8 xf = *(const LAS bf16x8*)(KT + (16 * wave + l15) * 144 + (32 * ks + 8 * g4) * 2);
#pragma unroll
            for (int vt = 0; vt < 8; ++vt) { const bf16x8 yf = *(const LAS bf16x8*)(VTl + (16 * vt + l15) * 144 + (32 * ks + 8 * g4) * 2); acc[vt] = MFMA16(xf, yf, acc[vt]); } }
#pragma unroll
        for (int vt = 0; vt < 8; ++vt) { u32x2 o = {pk2(acc[vt][0], acc[vt][1]), pk2(acc[vt][2], acc[vt][3])}; *(u32x2*)(LCT + ((size_t)u * 128 + 16 * vt + l15) * 128 + 16 * wave + 4 * g4) = o; }
        __syncthreads();
    }
}
__device__ __forceinline__ void phase_hscan(const int s_wv, KP p) {
    bf16_t* LCT = (bf16_t*)(p->ws + OFF_R2); const float* DEC = (const float*)(p->ws + OFF_R2 + 64 * MiB);
    const int gtid = obid() * NTHREADS + otid(), gthreads = gridDim.x * NTHREADS;
    for (int id = gtid; id < 32 * 128 * 32; id += gthreads) {
        const int k4 = id & 31, v = (id >> 5) & 127, bh = id >> 12;
        f32x4 st = zero4();
#pragma unroll 4
        for (int n = 0; n < 64; ++n) { const int u = bh * 64 + n; bf16_t* ptr = LCT + ((size_t)u * 128 + v) * 128 + 4 * k4;
            const u32x2 t = *(const u32x2*)ptr; const f32x4 dec = *(const f32x4*)(DEC + (size_t)u * 128 + 4 * k4);
            u32x2 o = {pk2(st[0], st[1]), pk2(st[2], st[3])}; *(u32x2*)ptr = o;
            st[0] = dec[0] * st[0] + bflo(t[0]); st[1] = dec[1] * st[1] + bfhi(t[0]); st[2] = dec[2] * st[2] + bflo(t[1]); st[3] = dec[3] * st[3] + bfhi(t[1]); }
    }
}
__device__ __forceinline__ void phase_hc(const int s_wv, KP p, ldsp lds) {
    const bf16_t* HQ = (const bf16_t*)(p->ws + OFF_R1); const float* HF = (const float*)(p->ws + OFF_R1 + 32 * MiB); const bf16_t* HV = (const bf16_t*)(p->ws + OFF_R1 + 96 * MiB); const bf16_t* HG = (const bf16_t*)(p->ws + OFF_R1 + 128 * MiB);
    const bf16_t* SST = (const bf16_t*)(p->ws + OFF_R2); bf16_t* O = (bf16_t*)(p->ws + OFF_HB); const float* ng = p->in[21];
    const int tid = otid(), lane = tid & 63, wave = tid >> 6, l15 = lane & 15, g4 = lane >> 4;
    LAS float* BC = (LAS float*)lds; ldsp QT = lds + 33024; ldsp KTl = lds + 50432; ldsp QH = lds + 67840; ldsp VTl = lds + 85248; ldsp AT = lds + 103680; LAS float* SSQ = (LAS float*)(lds + 112896);
    for (int u = obid(); u < 2048; u += gridDim.x) {
        const int bh = u >> 6, n = u & 63, b = bh >> 3, h = bh & 7, t0 = b * 4096 + n * 64, col0 = h * 128;
        hg_load_f_v<false>(HF, HV, t0, col0, BC, BC, KTl, VTl, tid);
        u32x4 qraw[2];
#pragma unroll
        for (int i = 0; i < 2; ++i) { const int idx = tid + 512 * i, s = idx >> 4, k8 = idx & 15; qraw[i] = *(const u32x4*)(HQ + (size_t)(t0 + s) * 1024 + col0 + k8 * 8); }
        __syncthreads();
        if (tid < 128) { float run = 0.f;
#pragma unroll 8
            for (int s = 0; s < 64; ++s) { run += BC[s * 129 + tid]; BC[s * 129 + tid] = run; } }
        __syncthreads();
#pragma unroll
        for (int i = 0; i < 2; ++i) { const int idx = tid + 512 * i, s = idx >> 4, k8 = idx & 15; float q[8], kk[8], qt[8], qh[8]; up8(qraw[i], q); up8(*(const LAS u32x4*)(KTl + s * 272 + k8 * 16), kk);
#pragma unroll
            for (int e = 0; e < 8; ++e) { const int k = k8 * 8 + e; const float bc = BC[s * 129 + k], bm = BC[31 * 129 + k]; qt[e] = q[e] * __expf(bc - bm); qh[e] = q[e] * __expf(bc); kk[e] = kk[e] * __expf(bm - bc); }
            u32x4 o1 = {pk2(qt[0], qt[1]), pk2(qt[2], qt[3]), pk2(qt[4], qt[5]), pk2(qt[6], qt[7])}, o2 = {pk2(qh[0], qh[1]), pk2(qh[2], qh[3]), pk2(qh[4], qh[5]), pk2(qh[6], qh[7])}, o3 = {pk2(kk[0], kk[1]), pk2(kk[2], kk[3]), pk2(kk[4], kk[5]), pk2(kk[6], kk[7])};
            *(LAS u32x4*)(QT + s * 272 + k8 * 16) = o1; *(LAS u32x4*)(QH + s * 272 + k8 * 16) = o2; *(LAS u32x4*)(KTl + s * 272 + k8 * 16) = o3; }
        __syncthreads();
        { const int st = wave & 3;
#pragma unroll
          for (int ti = 0; ti < 2; ++ti) { const int tt = 2 * (wave >> 2) + ti; f32x4 a = zero4();
              if (st <= tt) {
#pragma unroll
                  for (int ks = 0; ks < 4; ++ks) { const bf16x8 xf = *(const LAS bf16x8*)(KTl + (16 * st + l15) * 272 + (32 * ks + 8 * g4) * 2), yf = *(const LAS bf16x8*)(QT + (16 * tt + l15) * 272 + (32 * ks + 8 * g4) * 2); a = MFMA16(xf, yf, a); }
                  const int t = 16 * tt + l15;
#pragma unroll
                  for (int e = 0; e < 4; ++e) { const int s = 16 * st + 4 * g4 + e; if (s > t) a[e] = 0.f; } }
              u32x2 o = {pk2(a[0], a[1]), pk2(a[2], a[3])}; *(LAS u32x2*)(AT + (16 * tt + l15) * 144 + (16 * st + 4 * g4) * 2) = o; } }
        __syncthreads();
        { const int tt = wave >> 1, vh = wave & 1; f32x4 acc[4];
#pragma unroll
          for (int vi = 0; vi < 4; ++vi) acc[vi] = zero4();
#pragma unroll
          for (int ks = 0; ks < 2; ++ks) if (32 * ks <= 16 * tt + 15) { const bf16x8 yf = *(const LAS bf16x8*)(AT + (16 * tt + l15) * 144 + (32 * ks + 8 * g4) * 2);
#pragma unroll
              for (int vi = 0; vi < 4; ++vi) { const bf16x8 xf = *(const LAS bf16x8*)(VTl + (16 * (4 * vh + vi) + l15) * 144 + (32 * ks + 8 * g4) * 2); acc[vi] = MFMA16(xf, yf, acc[vi]); } }
#pragma unroll
          for (int ks = 0; ks < 4; ++ks) { const bf16x8 yf = *(const LAS bf16x8*)(QH + (16 * tt + l15) * 272 + (32 * ks + 8 * g4) * 2);
#pragma unroll
              for (int vi = 0; vi < 4; ++vi) { const bf16x8 xf = *(const bf16x8*)(SST + ((size_t)u * 128 + 16 * (4 * vh + vi) + l15) * 128 + 32 * ks + 8 * g4); acc[vi] = MFMA16(xf, yf, acc[vi]); } }
          float sq = 0.f;
#pragma unroll
          for (int vi = 0; vi < 4; ++vi)
#pragma unroll
              for (int e = 0; e < 4; ++e) sq += acc[vi][e] * acc[vi][e];
          sq = rowsum4(sq);
          if (g4 == 0) SSQ[(16 * tt + l15) * 2 + vh] = sq;
          __syncthreads();
          const int t = 16 * tt + l15; const float rstd = rsqrtf((SSQ[t * 2] + SSQ[t * 2 + 1]) * (1.f / 128.f) + EPS);
#pragma unroll
          for (int vi = 0; vi < 4; ++vi) { const int v = 16 * (4 * vh + vi) + 4 * g4; const f32x4 gn = *(const f32x4*)(ng + v); const u32x2 gg = *(const u32x2*)(HG + (size_t)(t0 + t) * 1024 + col0 + v);
              const f32x4 a = acc[vi] * rstd * gn; u32x2 o = {pk2(a[0] * bflo(gg[0]), a[1] * bfhi(gg[0])), pk2(a[2] * bflo(gg[1]), a[3] * bfhi(gg[1]))};
              *(u32x2*)(O + (size_t)(t0 + t) * 1024 + col0 + v) = o; } }
        __syncthreads();
    }
}

__global__ void __launch_bounds__(NTHREADS, 2) fwd_kernel(Params pk) {
    extern __shared__ __attribute__((aligned(16))) unsigned char smem[];
    ldsp lds = (ldsp)smem;
    const int ph_lo = pk.ph_lo, ph_hi = pk.ph_hi;
    const int s_wv = __builtin_amdgcn_readfirstlane((int)threadIdx.x >> 6);
    if (threadIdx.x < 4) ((LAS unsigned*)(lds + 131072))[threadIdx.x] = 0u;
    __syncthreads();
    XcdBarrier xbar = xcd_barrier_post((unsigned*)(pk.ws + OFF_BAR), (volatile LAS unsigned*)(lds + 131072), (int)threadIdx.x);
    for (int ph = ph_lo; ph < ph_hi; ++ph) {
        KP p = (KP)__builtin_amdgcn_kernarg_segment_ptr();
        asm volatile("" : "+s"(p));
        const int op = p->op[ph], layraw = p->lay[ph], layer = layraw & 3; const bool dummy = (layraw & 4) != 0;
        unsigned char* ws = p->ws; bf16_t* xdst = dummy ? (bf16_t*)(ws + OFF_R1) : (bf16_t*)(ws + OFF_XB);
        float* MOD = (float*)(ws + OFF_MOD); bf16_t* WT = (bf16_t*)(ws + OFF_WT); bf16_t* HB = (bf16_t*)(ws + OFF_HB); bf16_t* XB = (bf16_t*)(ws + OFF_XB);
        bf16_t* R1 = (bf16_t*)(ws + OFF_R1); bf16_t* R2 = (bf16_t*)(ws + OFF_R2);
        const float* modl = MOD + (size_t)layer * 4 * 6144;
        switch (op) {
        case OP_PRO: phase_prologue(s_wv, p, lds); break;
        case OP_NORM1: if (layer == 0) phase_norm<true>(s_wv, p->in[0], XB, p->in[5], modl + 0, modl + 1024, HB); else { phase_norm<false>(s_wv, p->in[0], XB, p->in[5] + layer * 1024, modl + 0, modl + 1024, HB); prep_layer(s_wv, p, layer, lds, layer != 1); } break;
        case OP_NORM2: { const float* cw = p->in[24] + (size_t)layer * 3 * 5632; const float* cb = p->in[25] + (size_t)layer * 5632; bf16_t* CWB = (bf16_t*)(ws + OFF_CWB);
                         for (int f = obid() * NTHREADS + otid(); f < 2816; f += gridDim.x * NTHREADS) { u32x4 o = {pk2(cw[f], cw[5632 + f]), pk2(cw[11264 + f], cb[f]), pk2(cw[2816 + f], cw[5632 + 2816 + f]), pk2(cw[11264 + 2816 + f], cb[2816 + f])}; *(u32x4*)(CWB + f * 8) = o; }
                         phase_norm<false>(s_wv, p->in[0], XB, p->in[6] + layer * 1024, modl + 3072, modl + 4096, HB); } break;
        case OP_G1: { EpiBf16<1> E{R1, 4096}; run_gemm(s_wv, lds, HB, WT + WT_MIXA, T, 4096, 1024, E); } break;
        case OP_GSP: phase_gsp(s_wv, p, layer / 3, lds); break;
        case OP_GOUT: { EpiRes E{XB, xdst, modl + 2048}; run_gemm(s_wv, lds, R2, WT + WT_MIXB, T, 1024, 2048, E); } break;
        case OP_M1: { EpiF32 E{(float*)R1, 512}; run_gemm(s_wv, lds, HB, WT + WT_MIXA, T, 512, 1024, E);
                      if ((int)gridDim.x >= 256) { if (obid() >= 128) prep_ffn(s_wv, p, layer, lds, 128, (int)gridDim.x - 128); } else prep_ffn(s_wv, p, layer, lds, 0, 0); } break;
        case OP_M2: phase_m2(s_wv, p); break;
        case OP_M3: { EpiQ EQ{(bf16_t*)(ws + OFF_R1 + 48 * MiB), (const float*)(ws + OFF_CSC), (const float*)(ws + OFF_CSS), 0.07216878364870322f * 1.4426950408889634f}; run_gemm(s_wv, lds, (const bf16_t*)(ws + OFF_R1 + 32 * MiB), WT + WT_MQKV, T, 1536, 256, EQ); EpiKV EK{(bf16_t*)(ws + OFF_R1 + 96 * MiB), (bf16_t*)(ws + OFF_R1 + 144 * MiB)}; run_gemm(s_wv, lds, (const bf16_t*)(ws + OFF_R1 + 40 * MiB), WT + WT_MQKV + 393216, T, 2048, 256, EK); } break;
        case OP_ATT: phase_attn(s_wv, p, lds); break;
        case OP_MOUT: { EpiRes E{XB, XB, modl + 2048}; run_gemm(s_wv, lds, R2, WT + WT_MIXB, T, 1024, 1024, E); } break;
        case OP_H1: { EpiHg E{ws + OFF_R1, (const float*)(ws + OFF_LB)}; run_gemm(s_wv, lds, HB, WT + WT_MIXA, T, 4096, 1024, E); } break;
        case OP_HA: phase_ha(s_wv, p, lds); break;
        case OP_HSCAN: phase_hscan(s_wv, p); break;
        case OP_HC: phase_hc(s_wv, p, lds); break;
        case OP_HOUT: { EpiRes E{XB, XB, modl + 2048}; run_gemm(s_wv, lds, HB, WT + WT_MIXB, T, 1024, 1024, E); } break;
        case OP_FUP: { EpiFFN E{R2, (const bf16_t*)(ws + OFF_CWB)}; run_gemm(s_wv, lds, HB - 2 * 1024, WT + WT_FUP, 67 * 256, 5632, 1024, E); } break;
        case OP_FDN: { EpiRes E{XB, xdst, modl + 5120}; run_gemm(s_wv, lds, R2, WT + WT_FDN, T, 1024, 2816, E); } break;
        case OP_FINAL: phase_final(s_wv, XB, p->out, p->in[27]); break;
        default: break;
        }
        if (ph + 1 < ph_hi) { if (ph_hi > 1000) { __syncthreads(); cg::this_grid().sync(); } xcd_barrier(xbar, otid()); }
    }
}

#ifndef MULTI_LAUNCH
#define MULTI_LAUNCH 0
#endif
extern "C" void kernel_launch(void* const* d_in, const int* in_sizes, int n_in, void* d_out, int out_size, void* d_ws, size_t ws_size, hipStream_t stream) {
    static int grid = 0;
    if (grid == 0) {
        int dev = 0, cus = 0, per_cu = 0;
        hipGetDevice(&dev); hipDeviceGetAttribute(&cus, hipDeviceAttributeMultiprocessorCount, dev);
        hipFuncSetAttribute((const void*)fwd_kernel, hipFuncAttributeMaxDynamicSharedMemorySize, LDS_BYTES);
        hipOccupancyMaxActiveBlocksPerMultiprocessor(&per_cu, (const void*)fwd_kernel, NTHREADS, LDS_BYTES);
        if (per_cu < 1) per_cu = 1;
        grid = cus * 1; (void)per_cu;
        if (ws_size < WS_END) fprintf(stderr, "kernel_launch: workspace too small: %zu < %zu\n", ws_size, (size_t)WS_END);
        (void)hipGetLastError();
    }
    (void)hipMemsetAsync((char*)d_ws + OFF_BAR, 0, XCD_BAR_WORDS * sizeof(unsigned), stream);
    Params p{};
    for (int i = 0; i < 28; ++i) p.in[i] = (const float*)d_in[i];
    p.out = (float*)d_out; p.ws = (unsigned char*)d_ws;
    int n = 0;
    auto add = [&](int op, int l) { p.op[n] = (unsigned char)op; p.lay[n] = (unsigned char)l; ++n; };
    add(OP_PRO, 0);
    for (int l = 0; l < 4; ++l) {
        add(OP_NORM1, l);
        if (l % 3 == 0) { add(OP_G1, l); add(OP_GSP, l); add(OP_GOUT, l); }
        else if (l % 3 == 1) { add(OP_M1, l); add(OP_M2, l); add(OP_M3, l); add(OP_ATT, l); add(OP_MOUT, l); }
        else { add(OP_H1, l); add(OP_HA, l); add(OP_HSCAN, l); add(OP_HC, l); add(OP_HOUT, l); }
        add(OP_NORM2, l); add(OP_FUP, l); add(OP_FDN, l);
    }
    add(OP_FINAL, 0);
#if MULTI_LAUNCH
    for (int i = 0; i < n; ++i) { p.ph_lo = i; p.ph_hi = i + 1; hipLaunchKernelGGL(fwd_kernel, dim3(grid), dim3(NTHREADS), LDS_BYTES, stream, p); }
#else
    p.ph_lo = 0; p.ph_hi = n;
    void* args[] = {&p};
    hipError_t e = hipLaunchCooperativeKernel((const void*)fwd_kernel, dim3(grid), dim3(NTHREADS), args, LDS_BYTES, stream);
    if (e != hipSuccess) fprintf(stderr, "cooperative launch failed: %s (grid %d)\n", hipGetErrorString(e), grid);
#endif
}
```
